# Optimizing an MI355X kernel written in HIP

```python
import math
import jax
import jax.numpy as jnp
from jax import lax
import numpy as np

D_MODEL = 1024
BATCH = 4
SEQ = 4096
DEPTH = 2
DEC_BATCH = 32
DEC_SEQ = 4
PAST_LEN = 8192
PAGE_SIZE = 128

HEAD_DIM = 64
N_EVEN = (DEPTH + 1) // 2
N_ODD = DEPTH // 2
NORM_EPS = 1e-6
ROPE_THETA = 10000.0
RWKV_HEADS = D_MODEL // (2 * HEAD_DIM)
RWKV_DIM = RWKV_HEADS * HEAD_DIM
DECAY_LORA = 64
AAA_LORA = 64
GATE_LORA = 128
RWKV_COLS = 3 * RWKV_DIM + DECAY_LORA + AAA_LORA + GATE_LORA
RWKV_GN_EPS = 64e-5
NSA_HEADS = D_MODEL // (2 * HEAD_DIM)
NSA_KV_HEADS = 2
NSA_DIM = NSA_HEADS * HEAD_DIM
CMP_STRIDE = 16
CMP_LEN = 2 * CMP_STRIDE
SEL_BLOCK = 64
SEL_TOPN = 16
WINDOW = 512
NSA_QBLK = 64
FORCE_BONUS = 100.0
NSA_COLS = NSA_DIM + 6 * NSA_KV_HEADS * HEAD_DIM + 3 * NSA_HEADS
EVEN_COLS = RWKV_COLS + NSA_COLS
MOBA_HEADS = D_MODEL // HEAD_DIM
MOBA_KV_HEADS = 4
MOBA_DIM = MOBA_HEADS * HEAD_DIM
MOBA_BLOCK = 256
MOBA_TOPK = 3
MOBA_QBLK = 32
ODD_COLS = MOBA_DIM + 2 * MOBA_KV_HEADS * HEAD_DIM
D_FF = -(-8 * D_MODEL // (3 * 256)) * 256

kernel_name = 'rwkv7_nsa_moba_hybrid_step'


def rms_norm(x, g):
    xf = x.astype(jnp.float32)
    y = xf * lax.rsqrt(jnp.mean(xf * xf, axis=-1, keepdims=True) + NORM_EPS)
    return (y * g.astype(jnp.float32)).astype(x.dtype)


def rope(x, pos):
    half = HEAD_DIM // 2
    inv = ROPE_THETA ** (-jnp.arange(half, dtype=jnp.float32) / half)
    ang = pos.astype(jnp.float32)[:, None] * inv[None, :]
    cos = jnp.cos(ang)[None, :, None, :]
    sin = jnp.sin(ang)[None, :, None, :]
    xf = x.astype(jnp.float32)
    x1, x2 = xf[..., :half], xf[..., half:]
    return jnp.concatenate([x1 * cos - x2 * sin, x2 * cos + x1 * sin], axis=-1).astype(x.dtype)


def masked_softmax(s, mask):
    s = jnp.where(mask, s.astype(jnp.float32), -jnp.inf)
    m = jnp.max(s, axis=-1, keepdims=True)
    e = jnp.exp(s - jnp.where(jnp.isfinite(m), m, 0.0))
    return e / jnp.maximum(jnp.sum(e, axis=-1, keepdims=True), 1e-30)


def swiglu(x, wg, wu, wd):
    return (jax.nn.silu(x @ wg) * (x @ wu)) @ wd


def even_project(xn, pos, w_in, gate_b):
    B, T, _ = xn.shape
    proj = xn @ w_in
    rw = proj[..., :RWKV_COLS]
    o = RWKV_COLS
    q = proj[..., o:o + NSA_DIM].reshape(B, T, NSA_HEADS, HEAD_DIM)
    o += NSA_DIM
    kv = proj[..., o:o + 6 * NSA_KV_HEADS * HEAD_DIM].reshape(B, T, 3, 2, NSA_KV_HEADS, HEAD_DIM)
    o += 6 * NSA_KV_HEADS * HEAD_DIM
    gates = jax.nn.sigmoid(proj[..., o:] + gate_b).reshape(B, T, NSA_HEADS, 3)
    k = rope(kv[:, :, :, 0].reshape(B, T, 3 * NSA_KV_HEADS, HEAD_DIM), pos).reshape(B, T, 3, NSA_KV_HEADS, HEAD_DIM)
    kv = jnp.stack([k, kv[:, :, :, 1]], axis=3).reshape(B, T, 6, NSA_KV_HEADS, HEAD_DIM)
    return rw, rope(q, pos), kv, gates


def rwkv_mix(rw, shift_prev, wkv0, p):
    mu, w0, w_up, a0, a_up, g_up, k_k, k_a, r_k, ln_g, ln_b = p
    B, T, _ = rw.shape
    f32 = jnp.float32
    prev = jnp.concatenate([shift_prev[:, None].astype(rw.dtype), rw[:, :-1]], axis=1)
    xm = rw + (prev - rw) * mu
    r, k, v, xw, xa, xg = jnp.split(xm, [RWKV_DIM, 2 * RWKV_DIM, 3 * RWKV_DIM, 3 * RWKV_DIM + DECAY_LORA, 3 * RWKV_DIM + DECAY_LORA + AAA_LORA], axis=-1)

    def heads(t):
        return t.astype(f32).reshape(B, T, RWKV_HEADS, HEAD_DIM)

    w = jnp.exp(-math.exp(-0.5) * jax.nn.sigmoid((w0 + jnp.tanh(xw) @ w_up).astype(f32)))
    a = jax.nn.sigmoid((a0 + xa @ a_up).astype(f32))
    g = jax.nn.sigmoid(xg) @ g_up
    kk = heads(k * k_k)
    kk = kk / jnp.maximum(jnp.sqrt(jnp.sum(kk * kk, axis=-1, keepdims=True)), 1e-12)
    k = k.astype(f32) * (1.0 + (a - 1.0) * k_a)
    r, w, k, v, a = heads(r), heads(w), heads(k), heads(v), heads(a)

    def step(S, inp):
        r_t, w_t, k_t, v_t, kk_t, a_t = inp
        sk = jnp.einsum('bhij,bhj->bhi', S, kk_t)
        S = S * w_t[:, :, None, :] - sk[..., None] * (kk_t * a_t)[:, :, None, :] + v_t[..., None] * k_t[:, :, None, :]
        return S, jnp.einsum('bhij,bhj->bhi', S, r_t)

    xs = tuple(jnp.moveaxis(t, 1, 0) for t in (r, w, k, v, kk, a))
    wkv, y = lax.scan(step, wkv0.astype(f32), xs)
    y = jnp.moveaxis(y, 0, 1)
    m = jnp.mean(y, axis=-1, keepdims=True)
    var = jnp.mean(jnp.square(y - m), axis=-1, keepdims=True)
    y = ((y - m) * lax.rsqrt(var + RWKV_GN_EPS)).reshape(B, T, RWKV_DIM) * ln_g + ln_b
    bonus = (jnp.sum(r * k * r_k, axis=-1, keepdims=True) * v).reshape(B, T, RWKV_DIM)
    out = (y + bonus) * g
    return out.astype(rw.dtype), rw[:, -1], wkv.astype(wkv0.dtype)


def nsa_compress(x, w1, pe, w2):
    B, L, G, dh = x.shape
    nch = L // CMP_STRIDE
    ch = x[:, :nch * CMP_STRIDE].reshape(B, nch, CMP_STRIDE, G, dh)
    h_a = jnp.einsum('bncgd,cde->bnge', ch, w1[:CMP_STRIDE])
    h_b = jnp.einsum('bncgd,cde->bnge', ch, w1[CMP_STRIDE:])
    bias = jnp.einsum('cd,cde->e', pe, w1)
    h = jax.nn.gelu(h_a[:, :-1] + h_b[:, 1:] + bias)
    return jnp.einsum('bnge,ef->bngf', h, w2)


def cmp_sel_overlap(nc, nsel):
    i = jnp.arange(nc, dtype=jnp.int32)[:, None]
    j = jnp.arange(nsel, dtype=jnp.int32)[None, :]
    lo = jnp.maximum(i * CMP_STRIDE, j * SEL_BLOCK)
    hi = jnp.minimum(i * CMP_STRIDE + CMP_LEN, (j + 1) * SEL_BLOCK)
    return jnp.clip(hi - lo, 0).astype(jnp.float32) / CMP_LEN


def nsa_prepare(kv4, cw):
    w1, pe, w2 = cw
    B, L = kv4.shape[:2]
    kc = nsa_compress(kv4[:, :, 0], w1[0], pe[0], w2[0]).transpose(0, 2, 1, 3)
    vc = nsa_compress(kv4[:, :, 1], w1[1], pe[1], w2[1]).transpose(0, 2, 1, 3)
    nsel = -(-L // SEL_BLOCK)
    sel = jnp.pad(kv4[:, :, 2:4], ((0, 0), (0, nsel * SEL_BLOCK - L), (0, 0), (0, 0), (0, 0)))
    sel = sel.reshape(B, nsel, SEL_BLOCK, 2, NSA_KV_HEADS, HEAD_DIM).transpose(3, 0, 4, 1, 2, 5)
    return kc, vc, sel[0], sel[1]


def nsa_block(q, q_pos, kc, vc, ks, vs, kw, vw, w_pos, gates):
    B, T = q.shape[:2]
    G, R = NSA_KV_HEADS, NSA_HEADS // NSA_KV_HEADS
    nc, nsel = kc.shape[2], ks.shape[2]
    qg = (q * HEAD_DIM ** -0.5).reshape(B, T, G, R, HEAD_DIM).transpose(0, 2, 3, 1, 4)
    t = q_pos[:, None]
    c_end = jnp.arange(nc, dtype=jnp.int32) * CMP_STRIDE + (CMP_LEN - 1)
    p_c = masked_softmax(jnp.einsum('bgrtd,bgnd->bgrtn', qg, kc), c_end[None, :] <= t)
    o_c = jnp.einsum('bgrtn,bgnd->bgrtd', p_c.astype(vc.dtype), vc)
    imp = jnp.einsum('bgrtn,nj->bgtj', p_c, cmp_sel_overlap(nc, nsel))
    blk = jnp.arange(nsel, dtype=jnp.int32)[None, :]
    cur = t // SEL_BLOCK
    forced = ((blk == cur) | (blk == cur - 1) | (blk == 0)).astype(jnp.float32)
    score = jnp.where(blk <= cur, imp + FORCE_BONUS * forced, -jnp.inf)
    n_top = min(SEL_TOPN, nsel)
    top_s, idx = lax.top_k(score, n_top)
    b_ix = jnp.arange(B)[:, None, None, None]
    g_ix = jnp.arange(G)[None, :, None, None]
    kg = ks[b_ix, g_ix, idx].reshape(B, G, T, n_top * SEL_BLOCK, HEAD_DIM)
    vg = vs[b_ix, g_ix, idx].reshape(B, G, T, n_top * SEL_BLOCK, HEAD_DIM)
    kpos = (idx[..., None] * SEL_BLOCK + jnp.arange(SEL_BLOCK, dtype=jnp.int32)).reshape(B, G, T, n_top * SEL_BLOCK)
    m_sel = jnp.repeat(jnp.isfinite(top_s), SEL_BLOCK, axis=-1) & (kpos <= t)
    p_s = masked_softmax(jnp.einsum('bgrtd,bgtsd->bgrts', qg, kg), m_sel[:, :, None])
    o_s = jnp.einsum('bgrts,bgtsd->bgrtd', p_s.astype(vg.dtype), vg)
    wp = w_pos[None, :]
    m_w = (wp <= t) & (wp > t - WINDOW) & (wp >= 0)
    p_w = masked_softmax(jnp.einsum('bgrtd,bgwd->bgrtw', qg, kw), m_w)
    o_w = jnp.einsum('bgrtw,bgwd->bgrtd', p_w.astype(vw.dtype), vw)
    gt = gates.reshape(B, T, G, R, 3).transpose(0, 2, 3, 1, 4).astype(jnp.float32)
    o = gt[..., 0:1] * o_c + gt[..., 1:2] * o_s + gt[..., 2:3] * o_w
    return o.transpose(0, 3, 1, 2, 4).reshape(B, T, NSA_DIM).astype(q.dtype)


def nsa_prompt(q, kv, gates, cw):
    B, T = q.shape[:2]
    kc, vc, ks, vs = nsa_prepare(kv[:, :, :4], cw)
    win = jnp.pad(kv[:, :, 4:6], ((0, 0), (WINDOW, 0), (0, 0), (0, 0), (0, 0))).transpose(2, 0, 3, 1, 4)

    def block(bi):
        q0 = bi * NSA_QBLK
        kw = lax.dynamic_slice_in_dim(win, q0, WINDOW + NSA_QBLK, axis=3)
        return nsa_block(lax.dynamic_slice_in_dim(q, q0, NSA_QBLK, axis=1),
                         q0 + jnp.arange(NSA_QBLK, dtype=jnp.int32), kc, vc, ks, vs, kw[0], kw[1],
                         q0 - WINDOW + jnp.arange(WINDOW + NSA_QBLK, dtype=jnp.int32),
                         lax.dynamic_slice_in_dim(gates, q0, NSA_QBLK, axis=1))

    out = lax.map(block, jnp.arange(T // NSA_QBLK, dtype=jnp.int32))
    return out.transpose(1, 0, 2, 3).reshape(B, T, NSA_DIM)


def nsa_sample(q, kv, gates, pos, cache, page_table, win_buf, past_len, cw):
    Bs, T = q.shape[:2]
    past = cache[page_table].reshape(Bs, past_len, 4, NSA_KV_HEADS, HEAD_DIM).astype(kv.dtype)
    kc, vc, ks, vs = nsa_prepare(jnp.concatenate([past, kv[:, :, :4]], axis=1), cw)
    nw = win_buf.shape[1]
    win = jnp.concatenate([win_buf.astype(kv.dtype), kv[:, :, 4:6]], axis=1)
    wt = win.transpose(2, 0, 3, 1, 4)
    wpos = past_len - nw + jnp.arange(nw + T, dtype=jnp.int32)
    out = nsa_block(q, pos, kc, vc, ks, vs, wt[0], wt[1], wpos, gates)
    return out, win[:, T:]


def odd_project(xn, pos, w_in):
    B, T, _ = xn.shape
    proj = xn @ w_in
    q = rope(proj[..., :MOBA_DIM].reshape(B, T, MOBA_HEADS, HEAD_DIM), pos)
    kv = proj[..., MOBA_DIM:].reshape(B, T, 2, MOBA_KV_HEADS, HEAD_DIM)
    kv = jnp.stack([rope(kv[:, :, 0], pos), kv[:, :, 1]], axis=2)
    return q, kv


def moba_prepare(kv):
    B, L = kv.shape[:2]
    nb = -(-L // MOBA_BLOCK)
    kvp = jnp.pad(kv, ((0, 0), (0, nb * MOBA_BLOCK - L), (0, 0), (0, 0), (0, 0)))
    kvp = kvp.reshape(B, nb, MOBA_BLOCK, 2, MOBA_KV_HEADS, HEAD_DIM).transpose(3, 0, 4, 1, 2, 5)
    means = jnp.mean(kvp[0].astype(jnp.float32), axis=3)
    return kvp[0], kvp[1], means


def moba_block(q, q_pos, kb, vb, means):
    B, T = q.shape[:2]
    G, R = MOBA_KV_HEADS, MOBA_HEADS // MOBA_KV_HEADS
    nb = kb.shape[2]
    qg = (q * HEAD_DIM ** -0.5).reshape(B, T, G, R, HEAD_DIM).transpose(0, 2, 3, 1, 4)
    t = q_pos[:, None]
    cur = t // MOBA_BLOCK
    gate = jnp.einsum('bgrtd,bgnd->bgrtn', qg.astype(jnp.float32), means)
    gate = jnp.where(jnp.arange(nb, dtype=jnp.int32)[None, :] < cur, gate, -jnp.inf)
    n_top = min(MOBA_TOPK, nb)
    top_s, idx = lax.top_k(gate, n_top)
    idx = jnp.concatenate([idx, jnp.broadcast_to(cur[None, None, None], (B, G, R, T, 1)).astype(idx.dtype)], axis=-1)
    ok = jnp.concatenate([jnp.isfinite(top_s), jnp.ones((B, G, R, T, 1), dtype=bool)], axis=-1)
    n_slot = n_top + 1
    b_ix = jnp.arange(B)[:, None, None, None]
    g_ix = jnp.arange(G)[None, :, None, None]
    s = jnp.concatenate([jnp.einsum('bgrtd,bgrtkd->bgrtk', qg, kb[b_ix, g_ix, idx[..., j]]) for j in range(n_slot)], axis=-1)
    kpos = (idx[..., None] * MOBA_BLOCK + jnp.arange(MOBA_BLOCK, dtype=jnp.int32)).reshape(B, G, R, T, n_slot * MOBA_BLOCK)
    mask = jnp.repeat(ok, MOBA_BLOCK, axis=-1) & (kpos <= t)
    p = masked_softmax(s, mask).reshape(B, G, R, T, n_slot, MOBA_BLOCK)
    o = jnp.einsum('bgrtk,bgrtkd->bgrtd', p[..., 0, :].astype(vb.dtype), vb[b_ix, g_ix, idx[..., 0]])
    for j in range(1, n_slot):
        o = o + jnp.einsum('bgrtk,bgrtkd->bgrtd', p[..., j, :].astype(vb.dtype), vb[b_ix, g_ix, idx[..., j]])
    return o.transpose(0, 3, 1, 2, 4).reshape(B, T, MOBA_DIM).astype(q.dtype)


def moba_prompt(q, kv):
    B, T = q.shape[:2]
    kb, vb, means = moba_prepare(kv)

    def block(bi):
        q0 = bi * MOBA_QBLK
        return moba_block(lax.dynamic_slice_in_dim(q, q0, MOBA_QBLK, axis=1),
                          q0 + jnp.arange(MOBA_QBLK, dtype=jnp.int32), kb, vb, means)

    out = lax.map(block, jnp.arange(T // MOBA_QBLK, dtype=jnp.int32))
    return out.transpose(1, 0, 2, 3).reshape(B, T, MOBA_DIM)


def moba_sample(q, kv, pos, cache, page_table, past_len):
    Bs = q.shape[0]
    past = cache[page_table].reshape(Bs, past_len, 2, MOBA_KV_HEADS, HEAD_DIM).astype(kv.dtype)
    kb, vb, means = moba_prepare(jnp.concatenate([past, kv], axis=1))
    return moba_block(q, pos, kb, vb, means)


def setup_inputs(seed: int = 0) -> dict:
    key = jax.random.key(seed)
    keys = jax.random.split(key, 40)

    def nrm(i, shape, scale):
        return jax.random.normal(keys[i], shape, jnp.float32) * scale

    n_pages = PAST_LEN // PAGE_SIZE
    n_used = DEC_BATCH * n_pages
    n_phys = n_used + n_used // 4
    win_buf = min(WINDOW, PAST_LEN)
    page_table = jax.random.permutation(keys[0], n_phys)[:n_used].reshape(DEC_BATCH, n_pages).astype(jnp.int32)
    return {
        'x_prompt': nrm(1, (BATCH, SEQ, D_MODEL), 1.0),
        'x_sample': nrm(2, (DEC_BATCH, DEC_SEQ, D_MODEL), 1.0),
        'cache_nsa_kv': nrm(3, (N_EVEN, n_phys, PAGE_SIZE, 4, NSA_KV_HEADS, HEAD_DIM), 1.0),
        'cache_moba_kv': nrm(4, (N_ODD, n_phys, PAGE_SIZE, 2, MOBA_KV_HEADS, HEAD_DIM), 1.0),
        'state_win_kv': nrm(5, (N_EVEN, DEC_BATCH, win_buf, 2, NSA_KV_HEADS, HEAD_DIM), 1.0),
        'state_wkv': nrm(6, (N_EVEN, DEC_BATCH, RWKV_HEADS, HEAD_DIM, HEAD_DIM), 0.5),
        'state_shift': nrm(7, (N_EVEN, DEC_BATCH, RWKV_COLS), 1.0),
        'page_table': page_table,
        'norm_mix': 1.0 + nrm(8, (DEPTH, D_MODEL), 0.1),
        'norm_ffn': 1.0 + nrm(9, (DEPTH, D_MODEL), 0.1),
        'norm_final': 1.0 + nrm(10, (D_MODEL,), 0.1),
        'even_w_in': nrm(11, (N_EVEN, D_MODEL, EVEN_COLS), D_MODEL ** -0.5),
        'even_w_out': nrm(12, (N_EVEN, RWKV_DIM + NSA_DIM, D_MODEL), (RWKV_DIM + NSA_DIM) ** -0.5),
        'rwkv_mu': jax.random.uniform(keys[13], (N_EVEN, RWKV_COLS), jnp.float32),
        'rwkv_w0': nrm(14, (N_EVEN, RWKV_DIM), 0.5),
        'rwkv_w_up': nrm(15, (N_EVEN, DECAY_LORA, RWKV_DIM), 0.1),
        'rwkv_a0': nrm(16, (N_EVEN, RWKV_DIM), 0.5),
        'rwkv_a_up': nrm(17, (N_EVEN, AAA_LORA, RWKV_DIM), 0.1),
        'rwkv_g_up': nrm(18, (N_EVEN, GATE_LORA, RWKV_DIM), GATE_LORA ** -0.5),
        'rwkv_k_k': 0.85 + nrm(19, (N_EVEN, RWKV_DIM), 0.05),
        'rwkv_k_a': 1.0 + nrm(20, (N_EVEN, RWKV_DIM), 0.05),
        'rwkv_r_k': nrm(21, (N_EVEN, RWKV_HEADS, HEAD_DIM), 0.1),
        'rwkv_ln_g': 1.0 + nrm(22, (N_EVEN, RWKV_DIM), 0.1),
        'rwkv_ln_b': nrm(23, (N_EVEN, RWKV_DIM), 0.02),
        'nsa_gate_b': nrm(24, (N_EVEN, 3 * NSA_HEADS), 0.1),
        'nsa_cmp_w1': nrm(25, (N_EVEN, 2, CMP_LEN, HEAD_DIM, HEAD_DIM), (CMP_LEN * HEAD_DIM) ** -0.5),
        'nsa_cmp_pe': nrm(26, (N_EVEN, 2, CMP_LEN, HEAD_DIM), 0.1),
        'nsa_cmp_w2': nrm(27, (N_EVEN, 2, HEAD_DIM, HEAD_DIM), HEAD_DIM ** -0.5),
        'odd_w_in': nrm(28, (N_ODD, D_MODEL, ODD_COLS), D_MODEL ** -0.5),
        'odd_w_out': nrm(29, (N_ODD, MOBA_DIM, D_MODEL), MOBA_DIM ** -0.5),
        'ffn_w_gate': nrm(30, (DEPTH, D_MODEL, D_FF), D_MODEL ** -0.5),
        'ffn_w_up': nrm(31, (DEPTH, D_MODEL, D_FF), D_MODEL ** -0.5),
        'ffn_w_down': nrm(32, (DEPTH, D_FF, D_MODEL), D_FF ** -0.5),
    }


def reference(x_prompt, x_sample, cache_nsa_kv, cache_moba_kv, state_win_kv, state_wkv, state_shift, page_table,
              norm_mix, norm_ffn, norm_final, even_w_in, even_w_out, rwkv_mu, rwkv_w0, rwkv_w_up, rwkv_a0,
              rwkv_a_up, rwkv_g_up, rwkv_k_k, rwkv_k_a, rwkv_r_k, rwkv_ln_g, rwkv_ln_b, nsa_gate_b,
              nsa_cmp_w1, nsa_cmp_pe, nsa_cmp_w2, odd_w_in, odd_w_out, ffn_w_gate, ffn_w_up, ffn_w_down):
    B, T = x_prompt.shape[:2]
    Bs, Ts = x_sample.shape[:2]
    past_len = page_table.shape[1] * cache_nsa_kv.shape[2]
    pos_p = jnp.arange(T, dtype=jnp.int32)
    pos_s = past_len + jnp.arange(Ts, dtype=jnp.int32)
    hp, hs = x_prompt, x_sample
    nsa_p, nsa_s, moba_p, moba_s = [], [], [], []
    win_p, win_s, wkv_p, wkv_s, sh_p, sh_s = [], [], [], [], [], []
    for layer in range(DEPTH):
        i = layer // 2
        xp = rms_norm(hp, norm_mix[layer])
        xs = rms_norm(hs, norm_mix[layer])
        if layer % 2 == 0:
            rp = (rwkv_mu[i], rwkv_w0[i], rwkv_w_up[i], rwkv_a0[i], rwkv_a_up[i], rwkv_g_up[i],
                  rwkv_k_k[i], rwkv_k_a[i], rwkv_r_k[i], rwkv_ln_g[i], rwkv_ln_b[i])
            cw = (nsa_cmp_w1[i], nsa_cmp_pe[i], nsa_cmp_w2[i])
            rw, q, kv, gates = even_project(xp, pos_p, even_w_in[i], nsa_gate_b[i])
            a_out, shift_new, wkv_new = rwkv_mix(rw, jnp.zeros((B, RWKV_COLS), rw.dtype),
                                                 jnp.zeros((B, RWKV_HEADS, HEAD_DIM, HEAD_DIM), rw.dtype), rp)
            b_out = nsa_prompt(q, kv, gates, cw)
            hp = hp + jnp.concatenate([a_out, b_out], axis=-1) @ even_w_out[i]
            nsa_p.append(kv[:, :, :4])
            win_p.append(kv[:, T - min(WINDOW, T):, 4:6])
            wkv_p.append(wkv_new)
            sh_p.append(shift_new)
            rw, q, kv, gates = even_project(xs, pos_s, even_w_in[i], nsa_gate_b[i])
            a_out, shift_new, wkv_new = rwkv_mix(rw, state_shift[i], state_wkv[i], rp)
            b_out, win_new = nsa_sample(q, kv, gates, pos_s, cache_nsa_kv[i], page_table, state_win_kv[i], past_len, cw)
            hs = hs + jnp.concatenate([a_out, b_out], axis=-1) @ even_w_out[i]
            nsa_s.append(kv[:, :, :4])
            win_s.append(win_new)
            wkv_s.append(wkv_new)
            sh_s.append(shift_new)
        else:
            q, kv = odd_project(xp, pos_p, odd_w_in[i])
            hp = hp + moba_prompt(q, kv) @ odd_w_out[i]
            moba_p.append(kv)
            q, kv = odd_project(xs, pos_s, odd_w_in[i])
            hs = hs + moba_sample(q, kv, pos_s, cache_moba_kv[i], page_table, past_len) @ odd_w_out[i]
            moba_s.append(kv)
        hp = hp + swiglu(rms_norm(hp, norm_ffn[layer]), ffn_w_gate[layer], ffn_w_up[layer], ffn_w_down[layer])
        hs = hs + swiglu(rms_norm(hs, norm_ffn[layer]), ffn_w_gate[layer], ffn_w_up[layer], ffn_w_down[layer])
    y_prompt = rms_norm(hp, norm_final)
    y_sample = rms_norm(hs, norm_final)
    return (y_prompt, y_sample, jnp.stack(nsa_p), jnp.stack(nsa_s), jnp.stack(moba_p), jnp.stack(moba_s),
            jnp.stack(win_p), jnp.stack(win_s), jnp.stack(wkv_p), jnp.stack(wkv_s), jnp.stack(sh_p), jnp.stack(sh_s))
```

```cpp
#include <hip/hip_runtime.h>
#include <cstdio>
#include <cstdint>
namespace pg8 {
#define PG8_LAS __attribute__((address_space(3)))
typedef unsigned short bf16_t;
typedef short bf16x8 __attribute__((ext_vector_type(8)));
typedef float f32x4 __attribute__((ext_vector_type(4)));
typedef unsigned u32x4 __attribute__((ext_vector_type(4)));
constexpr int BM = 256, BK = 64, HALF = 128, HTB = HALF * BK * 2  , STAGE_BYTES = 8 * HTB, NXCD = 8, WGM = 8;

__host__ __device__ __forceinline__ int lds_byte(int r, int c) { const int st = (r >> 4) * 2 + (c >> 5), rr = r & 15, cc = c & 31, ob = rr * 64 + cc * 2; return st * 1024 + (ob ^ (((ob >> 9) & 1) << 5)); }
__host__ __device__ __forceinline__ void stage_rc(int b, int& R, int& C) { const int st = b / 1024, sb = b % 1024, swz = sb ^ (((sb >> 9) & 1) << 5); R = (st >> 1) * 16 + swz / 64; C = (st & 1) * 32 + (swz % 64) / 2; }
__host__ __device__ __forceinline__ int perm32(int rho) { const int n = rho >> 4, i = rho & 15; return 8 * (i >> 2) + 4 * n + (i & 3); }

struct Unit { int pm, pn; };
struct Gemm { const bf16_t* A; const bf16_t* Bt; int M, N, K; };

struct StaticOrder {
    int nM, nN, nwg, G, c;
    __host__ __device__ void init(int M, int N, int G_, int c_) { nM = M / BM; nN = N / BM; nwg = nM * nN; G = G_; c = c_; }
    __host__ __device__ bool next(int i, Unit& u) const {
        const long L = (long)i * G + c; if (L >= nwg) return false;
        int wgid = (int)L; { const int q = nwg / NXCD, r = nwg % NXCD, xcd = wgid % NXCD, off = wgid / NXCD; wgid = (xcd < r ? xcd * (q + 1) : r * (q + 1) + (xcd - r) * q) + off; }
        const int nig = WGM * nN, gid = wgid / nig, fm = gid * WGM, gsz = (nM - fm) < WGM ? (nM - fm) : WGM;
        u.pm = fm + ((wgid % nig) % gsz); u.pn = (wgid % nig) / gsz; return true;
    }
    __device__ __forceinline__ void a_ready(const Unit&) const {}
    __device__ __forceinline__ void done(const Unit&) const {}
};

template <class Epi, class Sched, bool ALIGN_EPI = false, bool SP2 = false>
__device__ __forceinline__ void gemm_phase(PG8_LAS unsigned char* lds, const Gemm g, const Sched& S, const Epi& E) {
    const int tid = threadIdx.x, wid = __builtin_amdgcn_readfirstlane(tid >> 6), lane = tid & 63, wr = wid >> 2, wc = wid & 3, fr = lane & 15, fq = lane >> 4;
    const int K = g.K, nt = K / BK;
    unsigned voffA[2], voffB[2];
#pragma unroll
    for (int i = 0; i < 2; ++i) { int R, C; stage_rc(tid * 16 + i * 8192, R, C); const int Rb = Epi::PERM ? ((R & ~31) + perm32(R & 31)) : R;
        voffA[i] = (unsigned)(R * K + C) * 2u; voffB[i] = (unsigned)(Rb * K + C) * 2u; }
    const size_t kstep = (size_t)(BK * 2);
    const size_t hstep = (size_t)HALF * K * 2;
    const size_t tstep = 2 * hstep;
    const unsigned ldsw = (unsigned)wid * 1024u;
    const int aoff = lds_byte(wr * 64 + fr, fq * 8), boff = lds_byte(wc * 32 + fr, fq * 8);
#define PG8_SA(b, h) (((b) * 2 + (h)) * HTB)
#define PG8_SB(b, h) ((4 + (b) * 2 + (h)) * HTB)
#define PG8_STAGE(bufoff, gbase, voff) do { _Pragma("unroll") for (int _i = 0; _i < 2; ++_i) \
        __builtin_amdgcn_global_load_lds((const unsigned*)((const char*)(gbase) + (voff)[_i]), (PG8_LAS unsigned*)(lds + (bufoff) + ldsw + _i * 8192), 16, 0, 0); } while (0)
#define PG8_LDA(dst, b, h) do { _Pragma("unroll") for (int m = 0; m < 4; ++m) _Pragma("unroll") for (int k = 0; k < 2; ++k) dst[m][k] = *(const PG8_LAS bf16x8*)(lds + PG8_SA(b, h) + aoff + m * 2048 + k * 1024); } while (0)
#define PG8_LDB(dst, b, h) do { _Pragma("unroll") for (int n = 0; n < 2; ++n) _Pragma("unroll") for (int k = 0; k < 2; ++k) dst[n][k] = *(const PG8_LAS bf16x8*)(lds + PG8_SB(b, h) + boff + n * 2048 + k * 1024); } while (0)
#define PG8_MMA(ai, bj, At, Bt) do { __builtin_amdgcn_s_setprio(1); _Pragma("unroll") for (int m = 0; m < 4; ++m) _Pragma("unroll") for (int n = 0; n < 2; ++n) _Pragma("unroll") for (int k = 0; k < 2; ++k) \
        acc[ai][bj][m][n] = __builtin_amdgcn_mfma_f32_16x16x32_bf16(Bt[n][k], At[m][k], acc[ai][bj][m][n], 0, 0, 0); __builtin_amdgcn_s_setprio(0); } while (0)
#define PG8_WAIT_V(n) asm volatile("s_waitcnt vmcnt(" #n ")" ::: "memory")
#define PG8_WAIT_L(n) asm volatile("s_waitcnt lgkmcnt(" #n ")" ::: "memory")
#define PG8_BAR __builtin_amdgcn_s_barrier()
#define PG8_SCHED __builtin_amdgcn_sched_barrier(0)
    Unit cur, nxt; int ui = 0;
    if (!S.next(0, cur)) return;
    f32x4 acc[2][2][4][2];
#pragma unroll
    for (int a = 0; a < 2; ++a)
#pragma unroll
        for (int b = 0; b < 2; ++b)
#pragma unroll
            for (int m = 0; m < 4; ++m)
#pragma unroll
                for (int n = 0; n < 2; ++n) acc[a][b][m][n] = (f32x4){0.f, 0.f, 0.f, 0.f};
    bf16x8 At[4][2], B0[2][2], B1[2][2];
    const char* cA = (const char*)g.A + (size_t)cur.pm * tstep; const char* cB = (const char*)g.Bt + (size_t)cur.pn * tstep;
    S.a_ready(cur);
    if constexpr (SP2) {
        PG8_STAGE(PG8_SB(0, 0), cB, voffB); PG8_STAGE(PG8_SB(0, 1), cB + hstep, voffB); PG8_STAGE(PG8_SA(0, 0), cA, voffA); PG8_STAGE(PG8_SA(0, 1), cA + hstep, voffA);
        if (wr == 1) PG8_BAR;
        PG8_WAIT_V(2); PG8_BAR;
        PG8_STAGE(PG8_SB(1, 0), cB + kstep, voffB); PG8_STAGE(PG8_SA(1, 0), cA + kstep, voffA); PG8_STAGE(PG8_SB(1, 1), cB + hstep + kstep, voffB);
        PG8_WAIT_V(6); PG8_BAR;
    } else {
        PG8_STAGE(PG8_SB(0, 0), cB, voffB); PG8_STAGE(PG8_SA(0, 0), cA, voffA); PG8_STAGE(PG8_SB(0, 1), cB + hstep, voffB); PG8_STAGE(PG8_SA(0, 1), cA + hstep, voffA);
        if (wr == 1) PG8_BAR;
        PG8_WAIT_V(4); PG8_BAR;
        PG8_STAGE(PG8_SB(1, 0), cB + kstep, voffB); PG8_STAGE(PG8_SA(1, 0), cA + kstep, voffA); PG8_STAGE(PG8_SB(1, 1), cB + hstep + kstep, voffB);
        PG8_WAIT_V(6); PG8_BAR;
    }
    for (;;) {
        const bool has_next = S.next(ui + 1, nxt);
        const char* nA = has_next ? (const char*)g.A + (size_t)nxt.pm * tstep : cA; const char* nB = has_next ? (const char*)g.Bt + (size_t)nxt.pn * tstep : cB;
        for (int t = 0; t < nt; t += 2) {
            const bool last = (t == nt - 2);
            const char* a1 = cA + (size_t)(t + 1) * kstep;
            const char* a2 = last ? nA : cA + (size_t)(t + 2) * kstep; const char* b2 = last ? nB : cB + (size_t)(t + 2) * kstep;
            const char* a3 = a2 + kstep; const char* b3 = b2 + kstep;
            if (last && has_next) S.a_ready(nxt);
            if constexpr (SP2) {
            PG8_LDB(B0, 0, 0); PG8_LDB(B1, 0, 1); PG8_SCHED; PG8_LDA(At, 0, 0); PG8_STAGE(PG8_SA(1, 1), a1 + hstep, voffA);
            PG8_WAIT_V(8); PG8_WAIT_L(0); PG8_BAR; PG8_MMA(0, 0, At, B0); PG8_MMA(0, 1, At, B1); PG8_BAR; PG8_SCHED;
            PG8_LDA(At, 0, 1); PG8_STAGE(PG8_SB(0, 0), b2, voffB); PG8_STAGE(PG8_SB(0, 1), b2 + hstep, voffB); PG8_STAGE(PG8_SA(0, 0), a2, voffA);
            PG8_WAIT_V(8); PG8_WAIT_L(0); PG8_BAR; PG8_MMA(1, 0, At, B0); PG8_MMA(1, 1, At, B1); PG8_BAR; PG8_SCHED;
            PG8_LDB(B0, 1, 0); PG8_LDB(B1, 1, 1); PG8_SCHED; PG8_LDA(At, 1, 0); PG8_STAGE(PG8_SA(0, 1), a2 + hstep, voffA);
            PG8_WAIT_V(8); PG8_WAIT_L(0); PG8_BAR; PG8_MMA(0, 0, At, B0); PG8_MMA(0, 1, At, B1); PG8_BAR; PG8_SCHED;
            PG8_LDA(At, 1, 1); PG8_STAGE(PG8_SB(1, 0), b3, voffB); PG8_STAGE(PG8_SB(1, 1), b3 + hstep, voffB); PG8_STAGE(PG8_SA(1, 0), a3, voffA);
            PG8_WAIT_V(8); PG8_WAIT_L(0); PG8_BAR; PG8_MMA(1, 0, At, B0); PG8_MMA(1, 1, At, B1); PG8_BAR; PG8_SCHED;
            } else {
            PG8_LDB(B0, 0, 0); PG8_SCHED; PG8_LDA(At, 0, 0); PG8_STAGE(PG8_SA(1, 1), a1 + hstep, voffA);
            PG8_WAIT_L(8); PG8_BAR; PG8_WAIT_L(0); PG8_MMA(0, 0, At, B0); PG8_BAR; PG8_SCHED;
            PG8_LDB(B1, 0, 1); PG8_STAGE(PG8_SB(0, 0), b2, voffB);
            PG8_BAR; PG8_WAIT_L(0); PG8_MMA(0, 1, At, B1); PG8_BAR;
            PG8_LDA(At, 0, 1); PG8_STAGE(PG8_SA(0, 0), a2, voffA);
            PG8_BAR; PG8_WAIT_L(0); PG8_MMA(1, 0, At, B0); PG8_BAR; PG8_SCHED;
            PG8_STAGE(PG8_SB(0, 1), b2 + hstep, voffB);
            PG8_WAIT_V(6); PG8_BAR; PG8_MMA(1, 1, At, B1); PG8_BAR;
            PG8_LDB(B0, 1, 0); PG8_SCHED; PG8_LDA(At, 1, 0); PG8_STAGE(PG8_SA(0, 1), a2 + hstep, voffA);
            PG8_WAIT_L(8); PG8_BAR; PG8_WAIT_L(0); PG8_MMA(0, 0, At, B0); PG8_BAR; PG8_SCHED;
            PG8_LDB(B1, 1, 1); PG8_STAGE(PG8_SB(1, 0), b3, voffB);
            PG8_BAR; PG8_WAIT_L(0); PG8_MMA(0, 1, At, B1); PG8_BAR;
            PG8_LDA(At, 1, 1); PG8_STAGE(PG8_SA(1, 0), a3, voffA);
            PG8_BAR; PG8_WAIT_L(0); PG8_MMA(1, 0, At, B0); PG8_BAR; PG8_SCHED;
            PG8_STAGE(PG8_SB(1, 1), b3 + hstep, voffB);
            PG8_WAIT_V(6); PG8_BAR; PG8_MMA(1, 1, At, B1); PG8_BAR;
            }
        }
        if constexpr (ALIGN_EPI) { if (wr == 0) PG8_BAR; }
        if constexpr (!Epi::AFTER_DRAIN) { E(acc, cur, wr, wc, fr, fq); S.done(cur); }
        if (!has_next) break;
#pragma unroll
        for (int a = 0; a < 2; ++a)
#pragma unroll
            for (int b = 0; b < 2; ++b)
#pragma unroll
                for (int m = 0; m < 4; ++m)
#pragma unroll
                    for (int n = 0; n < 2; ++n) acc[a][b][m][n] = (f32x4){0.f, 0.f, 0.f, 0.f};
        cur = nxt; cA = nA; cB = nB; ++ui;
        if constexpr (ALIGN_EPI) { if (wr == 1) PG8_BAR; }
    }
    PG8_WAIT_V(0);
    if constexpr (!ALIGN_EPI) { if (wr == 0) PG8_BAR; }
    PG8_BAR;
    if constexpr (Epi::AFTER_DRAIN) { E.fused(acc, cur, wr, wc, fr, fq, lds, wid, lane); S.done(cur); }
#undef PG8_SA
#undef PG8_SB
#undef PG8_STAGE
#undef PG8_LDA
#undef PG8_LDB
#undef PG8_MMA
#undef PG8_WAIT_V
#undef PG8_WAIT_L
#undef PG8_BAR
#undef PG8_SCHED
}
}
#define PG8_SP2 true
#define PG8_ALIGN true
#define GAS __attribute__((address_space(1)))
#define LAS __attribute__((address_space(3)))
typedef unsigned short bf16;
typedef unsigned v4u __attribute__((ext_vector_type(4)));
typedef unsigned v2u __attribute__((ext_vector_type(2)));
typedef float f32x4 __attribute__((ext_vector_type(4)));
typedef float f32x2 __attribute__((ext_vector_type(2)));
typedef float f32x16 __attribute__((ext_vector_type(16)));
typedef short bf16x8 __attribute__((ext_vector_type(8)));
typedef short s16x4 __attribute__((ext_vector_type(4)));
typedef __bf16 bf16x2_t __attribute__((ext_vector_type(2)));
#define DI __device__ __forceinline__
#define LDS_WAIT() asm volatile("s_waitcnt lgkmcnt(0)" ::: "memory")
#define VM_WAIT() asm volatile("s_waitcnt vmcnt(0)" ::: "memory")

DI unsigned pk2(float lo, float hi) { f32x2 v = {lo, hi}; bf16x2_t b = __builtin_convertvector(v, bf16x2_t); return __builtin_bit_cast(unsigned, b); }
DI float bflo(unsigned u) { return __uint_as_float(u << 16); }
DI float bfhi(unsigned u) { return __uint_as_float(u & 0xffff0000u); }
DI float bf2f(bf16 u) { return __uint_as_float((unsigned)u << 16); }
DI float wave_sum(float v) {
#pragma unroll
    for (int o = 1; o < 64; o <<= 1) v += __shfl_xor(v, o);
    return v;
}
DI float sigmoidf_(float x) { return 1.0f / (1.0f + __expf(-x)); }

constexpr int D = 1024, MP = 16384, MS = 128, MT = 16640, SEQ = 4096, NB = 4, NSQ = 32, TS = 4;
constexpr int RWC = 1792, FF = 2816, NPG = 64, PAGE = 128, PAST = 8192;
constexpr int NWAVES = 8;
constexpr size_t O_YP = 0, O_YS = O_YP + (size_t)MP * D, O_NSAP = O_YS + (size_t)MS * D, O_NSAS = O_NSAP + (size_t)MP * 512,
                 O_MOBP = O_NSAS + (size_t)MS * 512, O_MOBS = O_MOBP + (size_t)MP * 512, O_WINP = O_MOBS + (size_t)MS * 512,
                 O_WINS = O_WINP + (size_t)NB * 512 * 256, O_WKVP = O_WINS + (size_t)NSQ * 512 * 256, O_WKVS = O_WKVP + (size_t)NB * 8 * 4096,
                 O_SHP = O_WKVS + (size_t)NSQ * 8 * 4096, O_SHS = O_SHP + (size_t)NB * RWC, O_END = O_SHS + (size_t)NSQ * RWC;
constexpr size_t al(size_t x) { return (x + 4095) & ~(size_t)4095; }
constexpr size_t WS_CTL = 0, CTL_BYTES = 1u << 20;
constexpr size_t WS_ROPE  = CTL_BYTES;
constexpr size_t WS_WIN0  = al(WS_ROPE + (size_t)4100 * 32 * 8);
constexpr size_t WS_WG0   = al(WS_WIN0 + (size_t)3072 * 1024 * 2);
constexpr size_t WS_WOUT0 = al(WS_WG0 + (size_t)64 * 1024 * 2);
constexpr size_t WS_WGU0  = al(WS_WOUT0 + (size_t)1024 * 1024 * 2);
constexpr size_t WS_WDN0  = al(WS_WGU0 + (size_t)5632 * 1024 * 2);
constexpr size_t WS_WIN1  = al(WS_WDN0 + (size_t)1024 * 2816 * 2);
constexpr size_t WS_WOUT1 = al(WS_WIN1 + (size_t)1536 * 1024 * 2);
constexpr size_t WS_WGU1  = al(WS_WOUT1 + (size_t)1024 * 1024 * 2);
constexpr size_t WS_WDN1  = al(WS_WGU1 + (size_t)5632 * 1024 * 2);
constexpr size_t WS_WLORA = al(WS_WDN1 + (size_t)1024 * 2816 * 2);
constexpr size_t WS_WCMP  = al(WS_WLORA + (size_t)1536 * 256 * 2);
constexpr size_t WS_XN    = al(WS_WCMP + (size_t)256 * 1024 * 2);
constexpr size_t WS_RW    = al(WS_XN + (size_t)MT * 1024 * 2);
constexpr size_t WS_Q0    = al(WS_RW + (size_t)MT * RWC * 2);
constexpr size_t WS_GATES = al(WS_Q0 + (size_t)MT * 512 * 2);
constexpr size_t WS_KV0   = al(WS_GATES + (size_t)MT * 32 * 4);
constexpr size_t WS_KVS0  = al(WS_KV0 + (size_t)6 * 4 * 2 * 4096 * 64 * 2);
constexpr size_t WS_ACMPS = al(WS_KVS0 + (size_t)6 * 32 * 2 * 4 * 64 * 2);
constexpr size_t WS_HCP   = al(WS_ACMPS + (size_t)2 * 32 * 2 * 8192 * 64 * 2);
constexpr size_t WS_HCS   = al(WS_HCP + (size_t)4096 * 128 * 4);
constexpr size_t WS_MEANS = al(WS_HCS + (size_t)65536 * 128 * 4);
constexpr size_t WS_END0  = al(WS_MEANS + (size_t)32 * 4 * 32 * 64 * 4);
#define XB_TMO      128
#define XB_XCNT(j)  (256  + 64 * (j))
#define XB_XSUB(j)  (1280 + 64 * (j))
#define XB_XGEN(j)  (2304 + 64 * (j))
#define XB_TOP      3328
#define XB_TOPGEN   3392
#define XCD_BAR_WORDS 3456
#define XB_SPIN_CAP (1u << 18)

__device__ __forceinline__ unsigned xb_ld(unsigned* p)              { return __hip_atomic_load(p, __ATOMIC_RELAXED, __HIP_MEMORY_SCOPE_AGENT); }
__device__ __forceinline__ unsigned xb_add(unsigned* p, unsigned v) { return __hip_atomic_fetch_add(p, v, __ATOMIC_RELAXED, __HIP_MEMORY_SCOPE_AGENT); }
__device__ __forceinline__ unsigned xb_xcc_id() { return (unsigned)__builtin_amdgcn_s_getreg((3 << 11) | 20) & 0xFu; }
#define XB_SPIN(cond, bar) do { unsigned _sp = 0; while (cond) { __builtin_amdgcn_s_sleep(1); \
    if ((++_sp & 255u) == 0u) { if (xb_ld(&(bar)[XB_TMO])) break; if (_sp > XB_SPIN_CAP) { atomicAdd(&(bar)[XB_TMO], 1u); break; } } } } while (0)

struct XcdBarrier {
    unsigned* bar; unsigned x;
    volatile LAS unsigned* st;
};

__device__ __forceinline__ XcdBarrier xcd_barrier_post(unsigned* bar, volatile LAS unsigned* st) {
    XcdBarrier b; b.bar = bar; b.x = xb_xcc_id(); b.st = st;
    if (threadIdx.x == 0) (void)xb_add(&bar[XB_XCNT(b.x)], 1u);
    return b;
}
__device__ __forceinline__ void xcd_barrier_complete(unsigned* bar, unsigned x, unsigned& nloc, unsigned& nx) {
    const unsigned G = gridDim.x * gridDim.y * gridDim.z;
    unsigned sum, cnt, mine, sp = 0u;
    for (;;) {
        sum = 0u; cnt = 0u; mine = 0u;
#pragma unroll
        for (unsigned j = 0; j < 16; ++j) { const unsigned c = xb_ld(&bar[XB_XCNT(j)]); sum += c; cnt += (c > 0u) ? 1u : 0u; mine = (j == x) ? c : mine; }
        if (sum == G) break;
        __builtin_amdgcn_s_sleep(1);
        if ((++sp & 255u) == 0u) { if (xb_ld(&bar[XB_TMO])) break; if (sp > XB_SPIN_CAP) { atomicAdd(&bar[XB_TMO], 1u); break; } }
    }
    nloc = mine > 0u ? mine : 1u; nx = cnt > 0u ? cnt : 1u;
}

__device__ __forceinline__ void xcd_barrier(const XcdBarrier& b) {
    asm volatile("s_waitcnt vmcnt(0)" ::: "memory");
    __syncthreads();
    if (threadIdx.x == 0) {
        unsigned* bar = b.bar;
        __builtin_amdgcn_s_waitcnt(0);
        unsigned nloc = b.st[0], nx = b.st[1];
        if (nloc == 0u) { xcd_barrier_complete(bar, b.x, nloc, nx); b.st[0] = nloc; b.st[1] = nx; }
        const unsigned old = xb_add(&bar[XB_XSUB(b.x)], 1u);
        const unsigned gen = old / nloc;
        if (old + 1u == (gen + 1u) * nloc) {
            __builtin_amdgcn_fence(__ATOMIC_RELEASE, "agent");
            asm volatile("s_waitcnt vmcnt(0)" ::: "memory");
            const unsigned og = xb_add(&bar[XB_TOP], 1u);
            const unsigned tg = og / nx;
            if (og + 1u == (tg + 1u) * nx) xb_add(&bar[XB_TOPGEN], 1u);
            else XB_SPIN(xb_ld(&bar[XB_TOPGEN]) == tg, bar);
            __builtin_amdgcn_fence(__ATOMIC_ACQUIRE, "agent");
            xb_add(&bar[XB_XGEN(b.x)], 1u);
            asm volatile("s_waitcnt vmcnt(0)" ::: "memory");
        } else {
            XB_SPIN(xb_ld(&bar[XB_XGEN(b.x)]) == gen, bar);
            __builtin_amdgcn_fence(__ATOMIC_ACQUIRE, "agent");
            asm volatile("s_waitcnt vmcnt(0)" ::: "memory");
        }
    }
    __syncthreads();
}
struct Params { const void* in[33]; float* out; unsigned char* ws; int ph_lo, ph_hi; };
struct Frame { LAS unsigned char* lds; int tid, lane, wave, G, gw, ngw; };
#define INF(i) ((const float*)P.in[i])
constexpr int LDS_BYTES = 147456;
constexpr int RING_BYTES = 131072, MISC_OFF = RING_BYTES + 320;

DI void dsincos(double r, double& s, double& c) {
    const double r2 = r * r; double ss = 1.0, cc = 1.0;
#pragma unroll
    for (int n = 16; n >= 1; --n) { ss = 1.0 - r2 * (1.0 / (double)((2 * n) * (2 * n + 1))) * ss; cc = 1.0 - r2 * (1.0 / (double)((2 * n - 1) * (2 * n))) * cc; }
    s = r * ss; c = cc;
}
DI void p0_rope(const Params& P, const Frame& F) {
    f32x2* tab = (f32x2*)(P.ws + WS_ROPE);
    for (int idx = blockIdx.x * 512 + F.tid; idx < 4100 * 32; idx += F.G * 512) {
        const int pi = idx >> 5, i = idx & 31; const int pos = pi < 4096 ? pi : 8192 + (pi - 4096);
        const float inv = exp2f(-(float)i * 0.41524101186092029f);
        const float ang = (float)pos * inv;
        const double a = (double)ang; const double k = rint(a * 0.15915494309189535); const double r = fma(-k, 6.283185307179586, a);
        double s, c; dsincos(r, s, c);
        tab[idx] = (f32x2){(float)c, (float)s};
    }
}
struct ColRef { const float* p; int ld, klo, khi; };
DI int perm64(int p) { return 32 * ((p >> 4) & 1) + 16 * (p >> 5) + (p & 15); }
DI int logical_col(int n) { return (n & ~63) + perm64(n & 63); }
template <class Src> DI void tr_item(const Src& S, int K, int nphys, bf16* WT, LAS float* scr, int item, int lane) {
    const int nblk = nphys / 32, kb = item / nblk, nb = item % nblk, k0 = 64 * kb, n0 = 32 * nb;
    const ColRef cr = S.col(n0 + (lane & 31));
#pragma unroll 8
    for (int i = 0; i < 32; ++i) { const int kk = 2 * i + (lane >> 5), k = k0 + kk;
        float v = 0.f; if (k >= cr.klo && k < cr.khi) v = cr.p[(size_t)(k - cr.klo) * cr.ld];
        scr[kk * 33 + (lane & 31)] = v; }
    LDS_WAIT(); asm volatile("" ::: "memory");
    const int c = lane & 7;
#pragma unroll
    for (int j = 0; j < 4; ++j) { const int n = (lane >> 3) + 8 * j; const LAS float* s = scr + (8 * c) * 33 + n;
        v4u o; o.x = pk2(s[0 * 33], s[1 * 33]); o.y = pk2(s[2 * 33], s[3 * 33]); o.z = pk2(s[4 * 33], s[5 * 33]); o.w = pk2(s[6 * 33], s[7 * 33]);
        *(v4u*)(WT + (size_t)(n0 + n) * K + k0 + 8 * c) = o; }
    LDS_WAIT(); asm volatile("" ::: "memory");
}
struct SrcPlain { const float* W; int ld, ncols;
    DI ColRef col(int n) const { const int l = logical_col(n); ColRef r; r.p = W + (l < ncols ? l : 0); r.ld = ld; r.klo = 0; r.khi = (l < ncols) ? (1 << 30) : 0; return r; } };
struct SrcGU { const float* Wg; const float* Wu;
    DI ColRef col(int n) const { const int l = logical_col(n), hd = l >> 6, d = l & 63; ColRef r; const uintptr_t a_ = (uintptr_t)Wg, b_ = (uintptr_t)Wu, m_ = (uintptr_t)0 - (uintptr_t)(d >= 32); r.p = (const float*)(a_ ^ ((a_ ^ b_) & m_)) + 32 * hd + (d & 31); r.ld = FF; r.klo = 0; r.khi = 1 << 30; return r; } };
struct SrcLora { const float* wu; const float* au; const float* gu;
    DI ColRef col(int n) const { const int l = logical_col(n), reg = l >> 9, c = l & 511; ColRef r; r.ld = 512;
        if (reg == 0) { r.p = wu + c; r.klo = 0; r.khi = 64; } else if (reg == 1) { r.p = au + c; r.klo = 64; r.khi = 128; } else { r.p = gu + c; r.klo = 128; r.khi = 256; } return r; } };
struct SrcCmp { const float* w1;
    DI ColRef col(int n) const { const int l = logical_col(n), kind = l >> 7, ab = (l >> 6) & 1, e = l & 63; ColRef r; r.p = w1 + (size_t)((kind * 32 + ab * 16) * 64) * 64 + e; r.ld = 64; r.klo = 0; r.khi = 1 << 30; return r; } };

DI void p0_weights(const Params& P, const Frame& F) {
    LAS float* scr = (LAS float*)(F.lds + F.wave * 16384);
    unsigned char* ws = P.ws;
    constexpr int I_IN0 = 16 * 96, I_G0 = 16 * 2, I_O = 16 * 32, I_GU = 16 * 176, I_DN = 44 * 32, I_IN1 = 16 * 48, I_LORA = 4 * 48, I_CMP = 16 * 8;
    constexpr int NIT = I_IN0 + I_G0 + 2 * I_O + 2 * I_GU + 2 * I_DN + I_IN1 + I_LORA + I_CMP;
    for (int it = F.gw; it < NIT; it += F.ngw) {
        int r = it;
        if (r < I_IN0) { tr_item(SrcPlain{INF(11), 3096, 3072}, 1024, 3072, (bf16*)(ws + WS_WIN0), scr, r, F.lane); continue; } r -= I_IN0;
        if (r < I_G0)  { tr_item(SrcPlain{INF(11) + 3072, 3096, 24}, 1024, 64, (bf16*)(ws + WS_WG0), scr, r, F.lane); continue; } r -= I_G0;
        if (r < I_O)   { tr_item(SrcPlain{INF(12), 1024, 1024}, 1024, 1024, (bf16*)(ws + WS_WOUT0), scr, r, F.lane); continue; } r -= I_O;
        if (r < I_O)   { tr_item(SrcPlain{INF(29), 1024, 1024}, 1024, 1024, (bf16*)(ws + WS_WOUT1), scr, r, F.lane); continue; } r -= I_O;
        if (r < I_GU)  { tr_item(SrcGU{INF(30), INF(31)}, 1024, 5632, (bf16*)(ws + WS_WGU0), scr, r, F.lane); continue; } r -= I_GU;
        if (r < I_GU)  { tr_item(SrcGU{INF(30) + (size_t)1024 * FF, INF(31) + (size_t)1024 * FF}, 1024, 5632, (bf16*)(ws + WS_WGU1), scr, r, F.lane); continue; } r -= I_GU;
        if (r < I_DN)  { tr_item(SrcPlain{INF(32), 1024, 1024}, FF, 1024, (bf16*)(ws + WS_WDN0), scr, r, F.lane); continue; } r -= I_DN;
        if (r < I_DN)  { tr_item(SrcPlain{INF(32) + (size_t)FF * 1024, 1024, 1024}, FF, 1024, (bf16*)(ws + WS_WDN1), scr, r, F.lane); continue; } r -= I_DN;
        if (r < I_IN1) { tr_item(SrcPlain{INF(28), 1536, 1536}, 1024, 1536, (bf16*)(ws + WS_WIN1), scr, r, F.lane); continue; } r -= I_IN1;
        if (r < I_LORA){ tr_item(SrcLora{INF(15), INF(17), INF(18)}, 256, 1536, (bf16*)(ws + WS_WLORA), scr, r, F.lane); continue; } r -= I_LORA;
        tr_item(SrcCmp{INF(25)}, 1024, 256, (bf16*)(ws + WS_WCMP), scr, r, F.lane);
    }
}
DI void norm_row_bf16(const float* xrow, const float* gain, bf16* orow, int lane) {
    f32x2 v[8]; float ss = 0.f;
#pragma unroll
    for (int i = 0; i < 8; ++i) { v[i] = *(const f32x2*)(xrow + 128 * i + 2 * lane); ss += v[i].x * v[i].x + v[i].y * v[i].y; }
    const float rs = 1.0f / sqrtf(wave_sum(ss) * (1.0f / 1024.0f) + 1e-6f);
#pragma unroll
    for (int i = 0; i < 8; ++i) { const f32x2 g = *(const f32x2*)(gain + 128 * i + 2 * lane); *(unsigned*)(orow + 128 * i + 2 * lane) = pk2(v[i].x * rs * g.x, v[i].y * rs * g.y); }
}
DI void norm_phase(const Frame& F, const float* src0, const float* src1, const float* gain, bf16* XN) {
    for (int m = F.gw; m < MP + MS; m += F.ngw) { const float* xr = m < MP ? src0 + (size_t)m * D : src1 + (size_t)(m - MP) * D; norm_row_bf16(xr, gain, XN + (size_t)m * D, F.lane); }
}
DI void p0_cache(const Params& P, const Frame& F) {
    const int* ptab = (const int*)P.in[7];
    { const float* cache = INF(2); bf16* A = (bf16*)(P.ws + WS_ACMPS);
      const int kind = F.lane >> 5, g = (F.lane >> 4) & 1, d = (F.lane & 15) * 4;
      for (int it0 = F.gw * 4; it0 < NSQ * PAST; it0 += F.ngw * 4) {
          f32x4 v[4];
#pragma unroll
          for (int j = 0; j < 4; ++j) { const int it = it0 + j, bs = it >> 13, t = it & 8191; const int page = ptab[bs * NPG + (t >> 7)];
              v[j] = *(const f32x4*)(cache + ((size_t)page * PAGE + (t & 127)) * 512 + 4 * F.lane); }
#pragma unroll
          for (int j = 0; j < 4; ++j) { const int it = it0 + j, bs = it >> 13, t = it & 8191;
              *(v2u*)(A + ((((size_t)kind * NSQ + bs) * 2 + g) * PAST + t) * 64 + d) = (v2u){pk2(v[j].x, v[j].y), pk2(v[j].z, v[j].w)}; }
      } }
    { const float* cache = INF(3); float* MEANS = (float*)(P.ws + WS_MEANS); LAS f32x4* red = (LAS f32x4*)F.lds;
      for (int it = blockIdx.x; it < NSQ * 32; it += F.G) { const int bs = it >> 5, nb = it & 31;
          const int page = ptab[bs * NPG + 2 * nb + (F.wave >> 2)], tok0 = (F.wave & 3) * 32;
          const float* src = cache + ((size_t)page * PAGE + tok0) * 512 + 4 * F.lane;
          f32x4 acc = {0.f, 0.f, 0.f, 0.f};
#pragma unroll 8
          for (int i = 0; i < 32; ++i) acc += *(const f32x4*)(src + (size_t)i * 512);
          red[F.wave * 64 + F.lane] = acc;
          __syncthreads();
          if (F.wave == 0) { f32x4 s = red[F.lane];
#pragma unroll
              for (int w = 1; w < 8; ++w) s += red[w * 64 + F.lane];
              s *= (1.0f / 256.0f);
              *(f32x4*)(MEANS + (((size_t)bs * 4 + (F.lane >> 4)) * 32 + nb) * 64 + (F.lane & 15) * 4) = s; }
          __syncthreads();
      } }
    { const f32x4* src = (const f32x4*)INF(4); f32x4* dst = (f32x4*)(P.out + O_WINS);
      for (int i = blockIdx.x * 512 + F.tid; i < NSQ * 508 * 64; i += F.G * 512) { const int bs = i / (508 * 64), r = i % (508 * 64); dst[(size_t)bs * 512 * 64 + r] = src[(size_t)bs * 512 * 64 + 4 * 64 + r]; } }
}

template <class Fn> struct EpiHead {
    static constexpr bool PERM = false, AFTER_DRAIN = false;
    Fn f;
    DI void operator()(const f32x4 (&acc)[2][2][4][2], const pg8::Unit& u, int wr, int wc, int fr, int fq) const {
#pragma unroll
        for (int ai = 0; ai < 2; ++ai)
#pragma unroll
            for (int m = 0; m < 4; ++m) { const int row = u.pm * 256 + ai * 128 + wr * 64 + m * 16 + fr;
#pragma unroll
                for (int bj = 0; bj < 2; ++bj) f(row, u.pn * 4 + bj * 2 + (wc >> 1), 16 * (wc & 1) + 4 * fq, acc[ai][bj][m][0], acc[ai][bj][m][1]); }
    }
};
template <class Fn> DI void skinny_unit(const bf16* A, const bf16* Bt, int K, int row0, int col0, const Fn& f, int wave, int lane) {
    const int fr = lane & 15, fq = lane >> 4;
    const bf16* ap = A + (size_t)(row0 + 16 * wave + fr) * K + 8 * fq;
    const bf16* bp = Bt + (size_t)(col0 + fr) * K + 8 * fq;
    f32x4 acc[4];
#pragma unroll
    for (int nn = 0; nn < 4; ++nn) acc[nn] = (f32x4){0.f, 0.f, 0.f, 0.f};
#pragma unroll 4
    for (int ks = 0; ks < K; ks += 32) { const bf16x8 a = *(const bf16x8*)(ap + ks);
#pragma unroll
        for (int nn = 0; nn < 4; ++nn) { const bf16x8 b = *(const bf16x8*)(bp + (size_t)nn * 16 * K + ks); acc[nn] = __builtin_amdgcn_mfma_f32_16x16x32_bf16(b, a, acc[nn], 0, 0, 0); } }
    const int row = row0 + 16 * wave + fr, head = col0 >> 6;
    f(row, head, 4 * fq, acc[0], acc[1]);
    f(row, head, 16 + 4 * fq, acc[2], acc[3]);
}
DI void st_bf16x4(bf16* p, f32x4 v) { *(v2u*)p = (v2u){pk2(v.x, v.y), pk2(v.z, v.w)}; }

struct EpiIn0 {
    bf16* RW; bf16* Q0; bf16* KV0; bf16* KVS0; const f32x2* rope; float* out;
    DI void operator()(int row, int head, int d4, f32x4 lo, f32x4 hi) const {
        if (row >= MP + MS) return;
        const bool samp = row >= MP; const int sr = row - MP;
        const int b = samp ? (sr >> 2) : (row >> 12), t = samp ? (sr & 3) : (row & 4095), ridx = samp ? 4096 + t : t;
        if (head < 28) {
            bf16* p = RW + (size_t)row * RWC + head * 64 + d4; st_bf16x4(p, lo); st_bf16x4(p + 32, hi);
            const bool last = samp ? (t == 3) : (t == SEQ - 1);
            if (last) { float* o = out + (samp ? O_SHS : O_SHP) + (size_t)b * RWC + head * 64 + d4; *(f32x4*)o = lo; *(f32x4*)(o + 32) = hi; }
            return;
        }
        const bool isq = head < 36; const int idx = head - 36; const int which = idx >> 2, kvsel = (idx >> 1) & 1, g = idx & 1;
        if (isq || kvsel == 0) {
            const f32x2* cs = rope + (size_t)ridx * 32 + d4; const f32x4 a = *(const f32x4*)cs, c2 = *(const f32x4*)(cs + 2);
            const f32x4 co = {a.x, a.z, c2.x, c2.z}, si = {a.y, a.w, c2.y, c2.w};
            const f32x4 x1 = lo, x2 = hi; lo = x1 * co - x2 * si; hi = x2 * co + x1 * si;
        }
        if (isq) { bf16* p = Q0 + (size_t)row * 512 + (head - 28) * 64 + d4; st_bf16x4(p, lo); st_bf16x4(p + 32, hi); return; }
        const int k6 = which * 2 + kvsel;
        bf16* p = samp ? KVS0 + ((((size_t)k6 * NSQ + b) * 2 + g) * 4 + t) * 64 + d4 : KV0 + ((((size_t)k6 * NB + b) * 2 + g) * SEQ + t) * 64 + d4;
        st_bf16x4(p, lo); st_bf16x4(p + 32, hi);
        if (which < 2) { float* o = out + (samp ? O_NSAS + (((size_t)sr * 4 + k6) * 2 + g) * 64 : O_NSAP + (((size_t)row * 4 + k6) * 2 + g) * 64) + d4; *(f32x4*)o = lo; *(f32x4*)(o + 32) = hi; }
        else if (samp) { float* o = out + O_WINS + ((((size_t)b * 512 + 508 + t) * 2 + kvsel) * 2 + g) * 64 + d4; *(f32x4*)o = lo; *(f32x4*)(o + 32) = hi; }
        else if (t >= SEQ - 512) { float* o = out + O_WINP + ((((size_t)b * 512 + (t - (SEQ - 512))) * 2 + kvsel) * 2 + g) * 64 + d4; *(f32x4*)o = lo; *(f32x4*)(o + 32) = hi; }
    }
};
struct EpiGates { float* G; const float* bias;
    DI void operator()(int row, int head, int d4, f32x4 lo, f32x4 hi) const {
        if (d4 >= 24) return; const f32x4 bv = *(const f32x4*)(bias + d4); f32x4 o;
        o.x = sigmoidf_(lo.x + bv.x); o.y = sigmoidf_(lo.y + bv.y); o.z = sigmoidf_(lo.z + bv.z); o.w = sigmoidf_(lo.w + bv.w);
        *(f32x4*)(G + (size_t)row * 32 + d4) = o; } };
struct EpiCmp { float* HC; int half_rows;
    DI void operator()(int row, int head, int d4, f32x4 lo, f32x4 hi) const {
        const int kind = row >= half_rows ? 1 : 0; if ((head >> 1) != kind) return;
        float* o = HC + (size_t)row * 128 + (head & 1) * 64 + d4; *(f32x4*)o = lo; *(f32x4*)(o + 32) = hi; } };
constexpr size_t RWKV_ARR = (size_t)MT * 512 * 4;
constexpr size_t WS_R = WS_END0, WS_K = WS_R + RWKV_ARR, WS_V = WS_K + RWKV_ARR, WS_KK = WS_V + RWKV_ARR, WS_W = WS_KK + RWKV_ARR, WS_KP = WS_W + RWKV_ARR,
                 WS_KKA = WS_KP + RWKV_ARR, WS_G = WS_KKA + RWKV_ARR, WS_Y = WS_G + RWKV_ARR;
constexpr size_t WS_LA = al(WS_Y + RWKV_ARR);
constexpr size_t WS_ATT = al(WS_LA + (size_t)MT * 256 * 2);
constexpr size_t WS_H = al(WS_ATT + (size_t)MT * 1024 * 2);
constexpr size_t WS_HFF = al(WS_H + (size_t)MT * 1024 * 4);
constexpr size_t WS_END1 = al(WS_HFF + (size_t)MT * FF * 2);

DI float red8(float v) {
    v += __builtin_bit_cast(float, __builtin_amdgcn_update_dpp(0, __builtin_bit_cast(int, v), 0xB1, 0xf, 0xf, false));
    v += __builtin_bit_cast(float, __builtin_amdgcn_update_dpp(0, __builtin_bit_cast(int, v), 0x4E, 0xf, 0xf, false));
    v += __builtin_bit_cast(float, __builtin_amdgcn_update_dpp(0, __builtin_bit_cast(int, v), 0x141, 0xf, 0xf, false));
    return v;
}
DI void ld_bf8(const bf16* p, float (&o)[8]) { const v4u u = *(const v4u*)p; o[0] = bflo(u.x); o[1] = bfhi(u.x); o[2] = bflo(u.y); o[3] = bfhi(u.y); o[4] = bflo(u.z); o[5] = bfhi(u.z); o[6] = bflo(u.w); o[7] = bfhi(u.w); }
DI void ld_f8(const float* p, float (&o)[8]) { const f32x4 a = *(const f32x4*)p, b = *(const f32x4*)(p + 4); o[0] = a.x; o[1] = a.y; o[2] = a.z; o[3] = a.w; o[4] = b.x; o[5] = b.y; o[6] = b.z; o[7] = b.w; }
DI void st_f8(float* p, const float (&o)[8]) { *(f32x4*)p = (f32x4){o[0], o[1], o[2], o[3]}; *(f32x4*)(p + 4) = (f32x4){o[4], o[5], o[6], o[7]}; }

DI void rwkv_prep(const Params& P, const Frame& F) {
    unsigned char* ws = P.ws; const bf16* RW = (const bf16*)(ws + WS_RW);
    const float* mu = INF(13); const float* k_k = INF(19); const float* sshift = INF(6);
    float* R_ = (float*)(ws + WS_R); float* K_ = (float*)(ws + WS_K); float* V_ = (float*)(ws + WS_V); float* KK_ = (float*)(ws + WS_KK); bf16* LA = (bf16*)(ws + WS_LA);
    const int lane = F.lane;
    for (int row = F.gw; row < MP + MS; row += F.ngw) {
        const bool samp = row >= MP; const int t = samp ? ((row - MP) & 3) : (row & 4095); const int bs = (row - MP) >> 2;
        const bf16* cur = RW + (size_t)row * RWC; const bf16* prv = cur - RWC;
#pragma unroll
        for (int part = 0; part < 3; ++part) {
            const int c = part * 512 + 8 * lane; float x[8], p[8], m[8];
            ld_bf8(cur + c, x); ld_f8(mu + c, m);
            if (t > 0) ld_bf8(prv + c, p); else if (samp) ld_f8(sshift + (size_t)bs * RWC + c, p); else {
#pragma unroll
                for (int e = 0; e < 8; ++e) p[e] = 0.f; }
#pragma unroll
            for (int e = 0; e < 8; ++e) x[e] = x[e] + (p[e] - x[e]) * m[e];
            float* dst = (part == 0 ? R_ : part == 1 ? K_ : V_) + (size_t)row * 512 + 8 * lane;
            st_f8(dst, x);
            if (part == 1) { float kc[8], q[8]; ld_f8(k_k + 8 * lane, kc); float ss = 0.f;
#pragma unroll
                for (int e = 0; e < 8; ++e) { q[e] = x[e] * kc[e]; ss += q[e] * q[e]; }
                ss = red8(ss); const float inv = 1.0f / fmaxf(sqrtf(ss), 1e-12f);
#pragma unroll
                for (int e = 0; e < 8; ++e) q[e] *= inv;
                st_f8(KK_ + (size_t)row * 512 + 8 * lane, q); }
        }
        { const int c = 1536 + 4 * lane; const v2u uc = *(const v2u*)(cur + c); float x[4] = {bflo(uc.x), bfhi(uc.x), bflo(uc.y), bfhi(uc.y)}, p[4];
          const f32x4 m = *(const f32x4*)(mu + c);
          if (t > 0) { const v2u up = *(const v2u*)(prv + c); p[0] = bflo(up.x); p[1] = bfhi(up.x); p[2] = bflo(up.y); p[3] = bfhi(up.y); }
          else if (samp) { const f32x4 s4 = *(const f32x4*)(sshift + (size_t)bs * RWC + c); p[0] = s4.x; p[1] = s4.y; p[2] = s4.z; p[3] = s4.w; }
          else { p[0] = p[1] = p[2] = p[3] = 0.f; }
          x[0] += (p[0] - x[0]) * m.x; x[1] += (p[1] - x[1]) * m.y; x[2] += (p[2] - x[2]) * m.z; x[3] += (p[3] - x[3]) * m.w;
          const int reg = lane >> 4;
#pragma unroll
          for (int e = 0; e < 4; ++e) { if (reg == 0) x[e] = 1.0f - 2.0f / (__expf(2.0f * x[e]) + 1.0f); else if (reg >= 2) x[e] = sigmoidf_(x[e]); }
          *(v2u*)(LA + (size_t)row * 256 + 4 * lane) = (v2u){pk2(x[0], x[1]), pk2(x[2], x[3])}; }
    }
}
struct EpiLora {
    const float* w0; const float* a0; const float* k_a; const float* K_; const float* KK_; float* W_; float* KP_; float* KKA_; float* G_;
    DI void operator()(int row, int head, int d4, f32x4 lo, f32x4 hi) const {
        if (row >= MP + MS) return;
        const int reg = head >> 3, c0 = (head & 7) * 64 + d4;
#pragma unroll
        for (int hh = 0; hh < 2; ++hh) { const int c = c0 + 32 * hh; const f32x4 x = hh ? hi : lo; const size_t o = (size_t)row * 512 + c;
            if (reg == 0) { const f32x4 b = *(const f32x4*)(w0 + c); f32x4 r;
                r.x = __expf(-0.6065306597126334f * sigmoidf_(b.x + x.x)); r.y = __expf(-0.6065306597126334f * sigmoidf_(b.y + x.y));
                r.z = __expf(-0.6065306597126334f * sigmoidf_(b.z + x.z)); r.w = __expf(-0.6065306597126334f * sigmoidf_(b.w + x.w)); *(f32x4*)(W_ + o) = r; }
            else if (reg == 1) { const f32x4 b = *(const f32x4*)(a0 + c), ka = *(const f32x4*)(k_a + c), k = *(const f32x4*)(K_ + o), kk = *(const f32x4*)(KK_ + o); f32x4 a;
                a.x = sigmoidf_(b.x + x.x); a.y = sigmoidf_(b.y + x.y); a.z = sigmoidf_(b.z + x.z); a.w = sigmoidf_(b.w + x.w);
                *(f32x4*)(KP_ + o) = k * (1.0f + (a - 1.0f) * ka); *(f32x4*)(KKA_ + o) = kk * a; }
            else { *(f32x4*)(G_ + o) = x; } }
    }
};
constexpr int SC_CH = 32, SC_STEP = 384;
DI void scan_chain(const Params& P, const Frame& F, int row0, int h, int nsteps, const float* S0, float* Sout) {
    unsigned char* ws = P.ws;
    const float* a0p = (const float*)(ws + WS_W); const float* a1p = (const float*)(ws + WS_KK); const float* a2p = (const float*)(ws + WS_KKA);
    const float* a3p = (const float*)(ws + WS_KP); const float* a4p = (const float*)(ws + WS_R); const float* a5p = (const float*)(ws + WS_V);
    float* Y_ = (float*)(ws + WS_Y);
    LAS float* buf = (LAS float*)F.lds;
    LAS float* ybuf = (LAS float*)(F.lds + 2 * SC_CH * SC_STEP * 4);
    const int lane = F.lane, i = 8 * F.wave + (lane >> 3), j0 = 8 * (lane & 7);
    float S[8];
    if (S0) ld_f8(S0 + i * 64 + j0, S); else {
#pragma unroll
        for (int e = 0; e < 8; ++e) S[e] = 0.f; }
    f32x4 st0, st1, st2, st3, st4, st5;
    const int lstep = F.tid >> 4, lc4 = (F.tid & 15) * 4;
    const size_t goff = (size_t)(row0 + lstep) * 512 + h * 64 + lc4;
#define SC_GLOAD(step0) do { const bool ok_ = (step0) + lstep < nsteps; const size_t o_ = goff + (size_t)(step0) * 512; const f32x4 z_ = {0.f, 0.f, 0.f, 0.f}; \
        st0 = ok_ ? *(const f32x4*)(a0p + o_) : z_; st1 = ok_ ? *(const f32x4*)(a1p + o_) : z_; st2 = ok_ ? *(const f32x4*)(a2p + o_) : z_; \
        st3 = ok_ ? *(const f32x4*)(a3p + o_) : z_; st4 = ok_ ? *(const f32x4*)(a4p + o_) : z_; st5 = ok_ ? *(const f32x4*)(a5p + o_) : z_; } while (0)
#define SC_LSTORE(bi) do { LAS float* d_ = buf + (bi) * SC_CH * SC_STEP + lstep * SC_STEP + lc4; \
        *(LAS f32x4*)(d_) = st0; *(LAS f32x4*)(d_ + 64) = st1; *(LAS f32x4*)(d_ + 128) = st2; *(LAS f32x4*)(d_ + 192) = st3; *(LAS f32x4*)(d_ + 256) = st4; *(LAS f32x4*)(d_ + 320) = st5; } while (0)
    SC_GLOAD(0); SC_LSTORE(0); __syncthreads();
    const int nch = (nsteps + SC_CH - 1) / SC_CH;
    for (int ch = 0; ch < nch; ++ch) {
        const int bi = ch & 1; if (ch + 1 < nch) SC_GLOAD((ch + 1) * SC_CH);
        const LAS float* cb = buf + bi * SC_CH * SC_STEP;
        const int rem = nsteps - ch * SC_CH, ns = rem < SC_CH ? rem : SC_CH;
        for (int s = 0; s < ns; ++s) { const LAS float* sb = cb + s * SC_STEP;
            const f32x4 w0 = *(const LAS f32x4*)(sb + j0), w1 = *(const LAS f32x4*)(sb + j0 + 4), k0 = *(const LAS f32x4*)(sb + 64 + j0), k1 = *(const LAS f32x4*)(sb + 64 + j0 + 4);
            const f32x4 a0 = *(const LAS f32x4*)(sb + 128 + j0), a1 = *(const LAS f32x4*)(sb + 128 + j0 + 4), p0 = *(const LAS f32x4*)(sb + 192 + j0), p1 = *(const LAS f32x4*)(sb + 192 + j0 + 4);
            const f32x4 r0 = *(const LAS f32x4*)(sb + 256 + j0), r1 = *(const LAS f32x4*)(sb + 256 + j0 + 4); const float vi = sb[320 + i];
            float sk = (S[0] * k0.x + S[1] * k0.y) + (S[2] * k0.z + S[3] * k0.w) + ((S[4] * k1.x + S[5] * k1.y) + (S[6] * k1.z + S[7] * k1.w));
            sk = red8(sk);
            S[0] = S[0] * w0.x + vi * p0.x - sk * a0.x; S[1] = S[1] * w0.y + vi * p0.y - sk * a0.y; S[2] = S[2] * w0.z + vi * p0.z - sk * a0.z; S[3] = S[3] * w0.w + vi * p0.w - sk * a0.w;
            S[4] = S[4] * w1.x + vi * p1.x - sk * a1.x; S[5] = S[5] * w1.y + vi * p1.y - sk * a1.y; S[6] = S[6] * w1.z + vi * p1.z - sk * a1.z; S[7] = S[7] * w1.w + vi * p1.w - sk * a1.w;
            float y = (S[0] * r0.x + S[1] * r0.y) + (S[2] * r0.z + S[3] * r0.w) + ((S[4] * r1.x + S[5] * r1.y) + (S[6] * r1.z + S[7] * r1.w));
            y = red8(y);
            if ((lane & 7) == 0) ybuf[s * 64 + i] = y;
        }
        __syncthreads();
#pragma unroll
        for (int m = 0; m < 4; ++m) { const int q = F.tid + 512 * m, step = q >> 6, c = q & 63; if (step < ns) Y_[(size_t)(row0 + ch * SC_CH + step) * 512 + h * 64 + c] = ybuf[q]; }
        if (ch + 1 < nch) SC_LSTORE(bi ^ 1);
        __syncthreads();
    }
#undef SC_GLOAD
#undef SC_LSTORE
    st_f8(Sout + i * 64 + j0, S);
}
DI void rwkv_post(const Params& P, const Frame& F) {
    unsigned char* ws = P.ws; const float* r_k = INF(21); const float* ln_g = INF(22); const float* ln_b = INF(23);
    const float* R_ = (const float*)(ws + WS_R); const float* KP_ = (const float*)(ws + WS_KP); const float* V_ = (const float*)(ws + WS_V); const float* G_ = (const float*)(ws + WS_G); const float* Y_ = (const float*)(ws + WS_Y);
    bf16* ATT = (bf16*)(ws + WS_ATT); const int lane = F.lane, c = 8 * lane;
    float rk[8], lg[8], lb[8]; ld_f8(r_k + c, rk); ld_f8(ln_g + c, lg); ld_f8(ln_b + c, lb);
    for (int row = F.gw; row < MP + MS; row += F.ngw) { const size_t o = (size_t)row * 512 + c;
        float y[8], r[8], k[8], v[8], g[8]; ld_f8(Y_ + o, y); ld_f8(R_ + o, r); ld_f8(KP_ + o, k); ld_f8(V_ + o, v); ld_f8(G_ + o, g);
        float s = 0.f, bs = 0.f;
#pragma unroll
        for (int e = 0; e < 8; ++e) { s += y[e]; bs += r[e] * k[e] * rk[e]; }
        s = red8(s); bs = red8(bs); const float mean = s * (1.0f / 64.0f); float q = 0.f;
#pragma unroll
        for (int e = 0; e < 8; ++e) { y[e] -= mean; q += y[e] * y[e]; }
        q = red8(q); const float rstd = 1.0f / sqrtf(q * (1.0f / 64.0f) + 64e-5f);
        float o8[8];
#pragma unroll
        for (int e = 0; e < 8; ++e) o8[e] = (y[e] * rstd * lg[e] + lb[e] + bs * v[e]) * g[e];
        *(v4u*)(ATT + (size_t)row * 1024 + c) = (v4u){pk2(o8[0], o8[1]), pk2(o8[2], o8[3]), pk2(o8[4], o8[5]), pk2(o8[6], o8[7])};
    }
}
typedef short v4i16_t __attribute__((ext_vector_type(4)));
DI int crow(int r, int hi) { return (r & 3) + 8 * (r >> 2) + 4 * hi; }
DI float half_max(float v) { auto rr = __builtin_amdgcn_permlane32_swap(__float_as_uint(v), __float_as_uint(v), false, false); return fmaxf(__uint_as_float(rr[0]), __uint_as_float(rr[1])); }
DI float half_sum(float v) { auto rr = __builtin_amdgcn_permlane32_swap(__float_as_uint(v), __float_as_uint(v), false, false); return __uint_as_float(rr[0]) + __uint_as_float(rr[1]); }
DI s16x4 vtr(const LAS unsigned char* p) { return __builtin_bit_cast(s16x4, __builtin_amdgcn_ds_read_tr16_b64_v4i16((LAS v4i16_t*)p)); }
#define MFMA32(a, b, c) __builtin_amdgcn_mfma_f32_32x32x16_bf16((a), (b), (c), 0, 0, 0)
constexpr float ATT_SC = 0.125f * 1.4426950408889634f;
struct AttnAcc { f32x16 o0, o1; float m, l; };
DI void acc_init(AttnAcc& A) {
#pragma unroll
    for (int i = 0; i < 16; ++i) { A.o0[i] = 0.f; A.o1[i] = 0.f; }
    A.m = -INFINITY; A.l = 0.f; }
DI void ld_q(const bf16* qrow, bf16x8 (&qr)[4], int hi) {
#pragma unroll
    for (int d0 = 0; d0 < 4; ++d0) qr[d0] = *(const bf16x8*)(qrow + 16 * d0 + 8 * hi); }
DI void qk_tile(const LAS unsigned char* Kt, const bf16x8 (&qr)[4], f32x16& p0, f32x16& p1, int lane) {
    const LAS unsigned char* kb = Kt + (lane >> 5) * 1024 + (lane & 31) * 16;
#pragma unroll
    for (int i = 0; i < 16; ++i) { p0[i] = 0.f; p1[i] = 0.f; }
#pragma unroll
    for (int d0 = 0; d0 < 4; ++d0) { const bf16x8 b0 = *(const LAS bf16x8*)(kb + d0 * 2048), b1 = *(const LAS bf16x8*)(kb + d0 * 2048 + 512);
        p0 = MFMA32(b0, qr[d0], p0); p1 = MFMA32(b1, qr[d0], p1); }
}
DI bf16x8 pack8(const f32x16& p, int s) { v4u u; u.x = pk2(p[8 * s], p[8 * s + 1]); u.y = pk2(p[8 * s + 2], p[8 * s + 3]); u.z = pk2(p[8 * s + 4], p[8 * s + 5]); u.w = pk2(p[8 * s + 6], p[8 * s + 7]); return __builtin_bit_cast(bf16x8, u); }
DI void pv_tile(const LAS unsigned char* Vt, const f32x16& p0, const f32x16& p1, f32x16& o0, f32x16& o1, int lane) {
    const int hi = lane >> 5;
    const LAS unsigned char* vp = Vt + ((lane >> 4) & 1) * 32 + (lane & 3) * 8 + (4 * hi + ((lane & 15) >> 2)) * 64;
#pragma unroll
    for (int cc = 0; cc < 2; ++cc)
#pragma unroll
        for (int s = 0; s < 2; ++s) { const int ks = 2 * cc + s; const bf16x8 pb = pack8(cc ? p1 : p0, s);
#pragma unroll
            for (int d0 = 0; d0 < 2; ++d0) { const s16x4 lo = vtr(vp + d0 * 4096 + ks * 1024), h4 = vtr(vp + d0 * 4096 + ks * 1024 + 512);
                const bf16x8 a = {lo[0], lo[1], lo[2], lo[3], h4[0], h4[1], h4[2], h4[3]};
                if (d0 == 0) o0 = MFMA32(a, pb, o0); else o1 = MFMA32(a, pb, o1); } }
}
template <int MODE> DI void mask_scale(f32x16& p0, f32x16& p1, bool rowok, int a, int hi) {
#pragma unroll
    for (int i = 0; i < 16; ++i) { const int k0 = crow(i, hi), k1 = k0 + 32;
        bool v0 = rowok, v1 = rowok;
        if (MODE == 1) { v0 = v0 && (k0 <= a); v1 = v1 && (k1 <= a); }
        if (MODE == 2) { v0 = v0 && (k0 > a); v1 = v1 && (k1 > a); }
        p0[i] = v0 ? p0[i] * ATT_SC : -INFINITY; p1[i] = v1 ? p1[i] * ATT_SC : -INFINITY; }
}
template <int MODE> DI void attn_tile(const LAS unsigned char* Kt, const LAS unsigned char* Vt, const bf16x8 (&qr)[4], AttnAcc& A, bool rowok, int a, int lane) {
    f32x16 p0, p1; qk_tile(Kt, qr, p0, p1, lane);
    mask_scale<MODE>(p0, p1, rowok, a, lane >> 5);
    float mx = fmaxf(p0[0], p1[0]);
#pragma unroll
    for (int i = 1; i < 16; ++i) mx = fmaxf(mx, fmaxf(p0[i], p1[i]));
    mx = half_max(mx);
    const float mnew = fmaxf(A.m, mx), muse = (mnew == -INFINITY) ? 0.f : mnew, alpha = __builtin_amdgcn_exp2f(A.m - muse);
    float ls = 0.f;
#pragma unroll
    for (int i = 0; i < 16; ++i) { p0[i] = __builtin_amdgcn_exp2f(p0[i] - muse); p1[i] = __builtin_amdgcn_exp2f(p1[i] - muse); ls += p0[i] + p1[i]; }
    A.l = A.l * alpha + ls; A.m = mnew;
#pragma unroll
    for (int i = 0; i < 16; ++i) { A.o0[i] *= alpha; A.o1[i] *= alpha; }
    pv_tile(Vt, p0, p1, A.o0, A.o1, lane);
}
struct TileRegs { v4u k, v; };
DI void tile_gload(TileRegs& R, const bf16* Kt, const bf16* Vt, int wave, int lane) {
    R.k = *(const v4u*)(Kt + (size_t)lane * 64 + wave * 8);
    R.v = *(const v4u*)(Vt + (size_t)(16 * (wave & 3) + (lane >> 2)) * 64 + 32 * (wave >> 2) + 8 * (lane & 3));
}
DI void tile_lstore(const TileRegs& R, LAS unsigned char* kb, LAS unsigned char* vb, int wave, int lane) {
    *(LAS v4u*)(kb + wave * 1024 + lane * 16) = R.k; *(LAS v4u*)(vb + wave * 1024 + lane * 16) = R.v; }
DI void branch_out(f32x16& out0, f32x16& out1, const AttnAcc& A, float gate) {
    const float lt = half_sum(A.l); const float sc = gate / fmaxf(lt, 1e-30f);
#pragma unroll
    for (int i = 0; i < 16; ++i) { out0[i] += A.o0[i] * sc; out1[i] += A.o1[i] * sc; }
}
template <bool FIRST> DI void branch_out_lds(LAS float* ob, const AttnAcc& A, float gate) {
    const float lt = half_sum(A.l); const float sc = gate / fmaxf(lt, 1e-30f);
#pragma unroll
    for (int i = 0; i < 16; ++i) { if (FIRST) { ob[i] = A.o0[i] * sc; ob[16 + i] = A.o1[i] * sc; } else { ob[i] += A.o0[i] * sc; ob[16 + i] += A.o1[i] * sc; } }
}
DI void store_ot(bf16* dst, const f32x16& o0, const f32x16& o1, int hi) {
#pragma unroll
    for (int gi = 0; gi < 4; ++gi) { *(v2u*)(dst + 8 * gi + 4 * hi) = (v2u){pk2(o0[4 * gi], o0[4 * gi + 1]), pk2(o0[4 * gi + 2], o0[4 * gi + 3])};
        *(v2u*)(dst + 32 + 8 * gi + 4 * hi) = (v2u){pk2(o1[4 * gi], o1[4 * gi + 1]), pk2(o1[4 * gi + 2], o1[4 * gi + 3])}; }
}
constexpr size_t WS_BIASC = WS_END1;
constexpr size_t WS_KCP = al(WS_BIASC + 2 * 64 * 4);
constexpr size_t WS_KCS = al(WS_KCP + (size_t)2 * 8 * 256 * 64 * 2);
constexpr size_t WS_END2 = al(WS_KCS + (size_t)2 * 64 * 512 * 64 * 2);

DI void p0_cmp_bias(const Params& P, const Frame& F) {
    const float* pe = INF(26); const float* w1 = INF(25); float* B = (float*)(P.ws + WS_BIASC);
    for (int it = F.gw; it < 128; it += F.ngw) { const int kind = it >> 6, e = it & 63; float s = 0.f;
        for (int i = 0; i < 32; ++i) { const int idx = F.lane + 64 * i; s += pe[kind * 2048 + idx] * w1[((size_t)kind * 2048 + idx) * 64 + e]; }
        s = wave_sum(s); if (F.lane == 0) B[it] = s; }
}
DI float gelu_tanh(float x) { const float u = 0.7978845608028654f * (x + 0.044715f * x * x * x); const float t = 1.0f - 2.0f / (__expf(2.0f * u) + 1.0f); return 0.5f * x * (1.0f + t); }
DI void cmp_stage2(const Params& P, const Frame& F) {
    unsigned char* ws = P.ws; LAS float* w2s = (LAS float*)F.lds;
    for (int i = F.tid; i < 2 * 64 * 64; i += 512) w2s[i] = INF(27)[i];
    __syncthreads();
    const float* bias = (const float*)(ws + WS_BIASC); const float* HCP = (const float*)(ws + WS_HCP); const float* HCS = (const float*)(ws + WS_HCS);
    bf16* KCP = (bf16*)(ws + WS_KCP); bf16* KCS = (bf16*)(ws + WS_KCS); const int lane = F.lane;
    for (int it = F.gw; it < 4096 + 65536; it += F.ngw) {
        const bool samp = it >= 4096; const int r = samp ? it - 4096 : it; const int half = samp ? 32768 : 2048, nn = samp ? 512 : 256;
        const int kind = r >= half ? 1 : 0, n = r & (nn - 1); const float* HC = samp ? HCS : HCP; bf16* dst = (samp ? KCS : KCP) + (size_t)r * 64 + lane;
        if (n == nn - 1) { *dst = 0; continue; }
        const float h = gelu_tanh(HC[(size_t)r * 128 + lane] + HC[(size_t)(r + 1) * 128 + 64 + lane] + bias[kind * 64 + lane]);
        float acc = 0.f; const LAS float* w2k = w2s + kind * 4096 + lane;
#pragma unroll
        for (int e = 0; e < 64; ++e) acc += __builtin_bit_cast(float, __builtin_amdgcn_readlane(__builtin_bit_cast(int, h), e)) * w2k[e * 64];
        *dst = (bf16)(pk2(acc, 0.f) & 0xffffu);
    }
}
template <class Body> DI void kv_loop(TileRegs& R, int& cur, LAS unsigned char* kvb, int jb, int je, const bf16* KB, const bf16* VB, int wave, int lane, Body&& body) {
    tile_gload(R, KB + (size_t)jb * 4096, VB + (size_t)jb * 4096, wave, lane); tile_lstore(R, kvb + cur * 16384, kvb + cur * 16384 + 8192, wave, lane); __syncthreads();
    for (int j = jb; j <= je; ++j) { if (j < je) tile_gload(R, KB + (size_t)(j + 1) * 4096, VB + (size_t)(j + 1) * 4096, wave, lane);
        { const LAS unsigned char* Kt_ = kvb + cur * 16384; body(j, Kt_, Kt_ + 8192); }
        if (j < je) tile_lstore(R, kvb + (cur ^ 1) * 16384, kvb + (cur ^ 1) * 16384 + 8192, wave, lane); __syncthreads(); cur ^= 1; }
}
constexpr int NSA_KV_OFF = 0, NSA_IMP_OFF = 32768, NSA_SEL_OFF = NSA_IMP_OFF + 2 * 64 * 65 * 4, NSA_OUT_OFF = NSA_SEL_OFF + 512;
DI void nsa_prompt_unit(const Params& P, const Frame& F, int b, int g, int qb) {
    unsigned char* ws = P.ws; int lane_ = F.lane; asm volatile("" : "+v"(lane_));
    const int lane = lane_, wave = F.wave, r32 = lane & 31, hi = lane >> 5;
    const int tl = 8 * wave + (r32 >> 2), hh = r32 & 3, t0 = 64 * qb, tok = t0 + tl, row = b * SEQ + tok, head = g * 4 + hh;
    LAS unsigned char* kvb = F.lds + NSA_KV_OFF;
    LAS float* impM = (LAS float*)(F.lds + NSA_IMP_OFF); LAS float* impS = impM + 64 * 65;
    LAS unsigned long long* selm = (LAS unsigned long long*)(F.lds + NSA_SEL_OFF);
    bf16x8 qr[4]; ld_q((const bf16*)(ws + WS_Q0) + (size_t)row * 512 + head * 64, qr, hi);
    const float* gt = (const float*)(ws + WS_GATES) + (size_t)row * 32 + head * 3; const float g0 = gt[0], g1 = gt[1], g2 = gt[2];
    const bf16* KV0 = (const bf16*)(ws + WS_KV0);
    LAS float* outb = (LAS float*)(F.lds + NSA_OUT_OFF) + (wave * 64 + lane) * 33;
    TileRegs R; int cur = 0;
    const int ncv = tok >= 31 ? ((tok - 15) >> 4) : 0, ntc = (4 * qb + 66) >> 6;
    const bf16* KC = (const bf16*)(ws + WS_KCP) + (size_t)((0 * 4 + b) * 2 + g) * 256 * 64; const bf16* VC = (const bf16*)(ws + WS_KCP) + (size_t)((1 * 4 + b) * 2 + g) * 256 * 64;
    AttnAcc A; acc_init(A);
    kv_loop(R, cur, kvb, 0, ntc - 1, KC, VC, wave, lane, [&](int j, const LAS unsigned char* Kt_, const LAS unsigned char* Vt_) { attn_tile<1>(Kt_, Vt_, qr, A, true, ncv - 1 - 64 * j, lane); });
    branch_out_lds<true>(outb, A, g0);
    {
      const float lt = half_sum(A.l), rl = 1.0f / fmaxf(lt, 1e-30f), mfin = (A.m == -INFINITY) ? 0.f : A.m;
      for (int i = lane; i < 8 * 65; i += 64) { impM[wave * 8 * 65 + i] = 0.f; impS[wave * 8 * 65 + i] = 0.f; }
      kv_loop(R, cur, kvb, 0, ntc - 1, KC, VC, wave, lane, [&](int j, const LAS unsigned char* Kt_, const LAS unsigned char* Vt_) {
          f32x16 p0, p1; qk_tile(Kt_, qr, p0, p1, lane); mask_scale<1>(p0, p1, true, ncv - 1 - 64 * j, hi);
#pragma unroll
          for (int cc = 0; cc < 2; ++cc)
#pragma unroll
              for (int gi = 0; gi < 4; ++gi) { const f32x16& p = cc ? p1 : p0;
                  const float e0 = __builtin_amdgcn_exp2f(p[4 * gi] - mfin) * rl, e1 = __builtin_amdgcn_exp2f(p[4 * gi + 1] - mfin) * rl, e2 = __builtin_amdgcn_exp2f(p[4 * gi + 2] - mfin) * rl, e3 = __builtin_amdgcn_exp2f(p[4 * gi + 3] - mfin) * rl;
                  float mn = e0 + e1 + e2 + 0.5f * e3, sp = 0.5f * e3;
                  mn += __builtin_bit_cast(float, __builtin_amdgcn_update_dpp(0, __builtin_bit_cast(int, mn), 0xB1, 0xf, 0xf, false)); mn += __builtin_bit_cast(float, __builtin_amdgcn_update_dpp(0, __builtin_bit_cast(int, mn), 0x4E, 0xf, 0xf, false));
                  sp += __builtin_bit_cast(float, __builtin_amdgcn_update_dpp(0, __builtin_bit_cast(int, sp), 0xB1, 0xf, 0xf, false)); sp += __builtin_bit_cast(float, __builtin_amdgcn_update_dpp(0, __builtin_bit_cast(int, sp), 0x4E, 0xf, 0xf, false));
                  const int jj = 16 * j + 8 * cc + 2 * gi + hi;
                  if (hh == 0) { impM[tl * 65 + jj] = mn; impS[tl * 65 + jj + 1] = sp; } } });
    }
    {
#pragma unroll 1
      for (int tt = 0; tt < 8; ++tt) { const int tq = 8 * wave + tt;
          float sc = -INFINITY;
          if (lane <= qb) { sc = impM[tq * 65 + lane] + impS[tq * 65 + lane]; if (lane == qb || lane == qb - 1 || lane == 0) sc += 100.0f; }
          int cnt = 0; int ln = lane; asm volatile("" : "+v"(ln));
#pragma unroll
          for (int jp = 0; jp < 64; ++jp) { const float o = __builtin_bit_cast(float, __builtin_amdgcn_readlane(__builtin_bit_cast(int, sc), jp)); cnt += (o > sc || (o == sc && jp < ln)) ? 1 : 0; }
          const unsigned long long m = __ballot(lane <= qb && cnt < 16);
          if (lane == 0) selm[tq] = m; }
    }
    __syncthreads();
    const unsigned long long mysel = selm[tl];
    { const bf16* KS = KV0 + (size_t)((2 * 4 + b) * 2 + g) * SEQ * 64; const bf16* VS = KV0 + (size_t)((3 * 4 + b) * 2 + g) * SEQ * 64;
      acc_init(A);
      kv_loop(R, cur, kvb, 0, qb, KS, VS, wave, lane, [&](int j, const LAS unsigned char* Kt_, const LAS unsigned char* Vt_) { const bool ok = (mysel >> j) & 1ull; if (j == qb) attn_tile<1>(Kt_, Vt_, qr, A, ok, tl, lane); else attn_tile<0>(Kt_, Vt_, qr, A, ok, 0, lane); });
      branch_out_lds<false>(outb, A, g1); }
    { const bf16* KW = KV0 + (size_t)((4 * 4 + b) * 2 + g) * SEQ * 64; const bf16* VW = KV0 + (size_t)((5 * 4 + b) * 2 + g) * SEQ * 64;
      acc_init(A); const int jlo = qb >= 8 ? qb - 8 : 0;
      kv_loop(R, cur, kvb, jlo, qb, KW, VW, wave, lane, [&](int j, const LAS unsigned char* Kt_, const LAS unsigned char* Vt_) { if (j == qb) attn_tile<1>(Kt_, Vt_, qr, A, true, tl, lane); else if (j == qb - 8) attn_tile<2>(Kt_, Vt_, qr, A, true, tl, lane); else attn_tile<0>(Kt_, Vt_, qr, A, true, 0, lane); });
      branch_out_lds<false>(outb, A, g2); }
    { f32x16 out0, out1;
#pragma unroll
      for (int i = 0; i < 16; ++i) { out0[i] = outb[i]; out1[i] = outb[16 + i]; }
      store_ot((bf16*)(ws + WS_ATT) + (size_t)row * 1024 + 512 + head * 64, out0, out1, hi); }
}
constexpr size_t WS_Q1 = WS_END2;
constexpr size_t WS_K1 = al(WS_Q1 + (size_t)MT * 1024 * 2);
constexpr size_t WS_V1 = al(WS_K1 + (size_t)16 * SEQ * 64 * 2);
constexpr size_t WS_K1S = al(WS_V1 + (size_t)16 * SEQ * 64 * 2);
constexpr size_t WS_V1S = al(WS_K1S + (size_t)NSQ * 4 * 4 * 64 * 2);
constexpr size_t WS_MEANH = al(WS_V1S + (size_t)NSQ * 4 * 4 * 64 * 2);
constexpr size_t WS_MEANL = al(WS_MEANH + (size_t)16 * 64 * 64 * 2);
constexpr size_t WS_END3 = al(WS_MEANL + (size_t)16 * 64 * 64 * 2);

struct EpiResid { const float* base0; const float* base1; float* H;
    DI void operator()(int row, int head, int d4, f32x4 lo, f32x4 hi) const {
        if (row >= MP + MS) return;
        const float* b = (row < MP ? base0 + (size_t)row * D : base1 + (size_t)(row - MP) * D) + head * 64 + d4; float* o = H + (size_t)row * D + head * 64 + d4;
        const f32x4 b0 = *(const f32x4*)b, b1 = *(const f32x4*)(b + 32); *(f32x4*)o = b0 + lo; *(f32x4*)(o + 32) = b1 + hi; } };
struct EpiSwiglu { bf16* HFF;
    DI void operator()(int row, int head, int d4, f32x4 lo, f32x4 hi) const {
        if (row >= MP + MS) return;
        f32x4 r; r.x = lo.x * sigmoidf_(lo.x) * hi.x; r.y = lo.y * sigmoidf_(lo.y) * hi.y; r.z = lo.z * sigmoidf_(lo.z) * hi.z; r.w = lo.w * sigmoidf_(lo.w) * hi.w;
        st_bf16x4(HFF + (size_t)row * FF + 32 * head + d4, r); } };
struct EpiIn1 { bf16* Q1; bf16* K1; bf16* K1S; const f32x2* rope; float* out;
    DI void operator()(int row, int head, int d4, f32x4 lo, f32x4 hi) const {
        if (row >= MP + MS) return;
        const bool samp = row >= MP; const int sr = row - MP; const int b = samp ? (sr >> 2) : (row >> 12), t = samp ? (sr & 3) : (row & 4095), ridx = samp ? 4096 + t : t;
        if (head < 20) { const f32x2* cs = rope + (size_t)ridx * 32 + d4; const f32x4 a = *(const f32x4*)cs, c2 = *(const f32x4*)(cs + 2);
            const f32x4 co = {a.x, a.z, c2.x, c2.z}, si = {a.y, a.w, c2.y, c2.w}; const f32x4 x1 = lo, x2 = hi; lo = x1 * co - x2 * si; hi = x2 * co + x1 * si; }
        if (head < 16) { bf16* p = Q1 + (size_t)row * 1024 + head * 64 + d4; st_bf16x4(p, lo); st_bf16x4(p + 32, hi); return; }
        const int kv = head >= 20 ? 1 : 0, kvh = (head - 16) & 3;
        bf16* p = samp ? K1S + (size_t)kv * ((WS_V1S - WS_K1S) / 2) + (((size_t)b * 4 + kvh) * 4 + t) * 64 + d4 : K1 + (size_t)kv * ((WS_V1 - WS_K1) / 2) + (((size_t)b * 4 + kvh) * SEQ + t) * 64 + d4;
        st_bf16x4(p, lo); st_bf16x4(p + 32, hi);
        float* o = out + (samp ? O_MOBS + (((size_t)sr * 2 + kv) * 4 + kvh) * 64 : O_MOBP + (((size_t)row * 2 + kv) * 4 + kvh) * 64) + d4; *(f32x4*)o = lo; *(f32x4*)(o + 32) = hi; } };
DI void final_norm(const Params& P, const Frame& F) {
    const float* H = (const float*)(P.ws + WS_H); const float* gain = INF(10);
    for (int m = F.gw; m < MP + MS; m += F.ngw) { const float* xr = H + (size_t)m * D; float* o = P.out + (m < MP ? O_YP + (size_t)m * D : O_YS + (size_t)(m - MP) * D);
        f32x4 v[4]; float ss = 0.f;
#pragma unroll
        for (int i = 0; i < 4; ++i) { v[i] = *(const f32x4*)(xr + 256 * i + 4 * F.lane); ss += v[i].x * v[i].x + v[i].y * v[i].y + v[i].z * v[i].z + v[i].w * v[i].w; }
        const float rs = 1.0f / sqrtf(wave_sum(ss) * (1.0f / 1024.0f) + 1e-6f);
#pragma unroll
        for (int i = 0; i < 4; ++i) { const f32x4 g = *(const f32x4*)(gain + 256 * i + 4 * F.lane); *(f32x4*)(o + 256 * i + 4 * F.lane) = v[i] * rs * g; } }
}
DI void moba_means(const Params& P, const Frame& F) {
    unsigned char* ws = P.ws; const bf16* K1 = (const bf16*)(ws + WS_K1); bf16* MH = (bf16*)(ws + WS_MEANH); bf16* ML = (bf16*)(ws + WS_MEANL); const int lane = F.lane;
    for (int it = F.gw; it < 256; it += F.ngw) { const int bk = it >> 4, blk = it & 15; const bf16* src = K1 + ((size_t)bk * SEQ + blk * 256) * 64;
        float acc[8];
#pragma unroll
        for (int e = 0; e < 8; ++e) acc[e] = 0.f;
        for (int i = 0; i < 32; ++i) { float x[8]; ld_bf8(src + (size_t)(8 * i + (lane >> 3)) * 64 + (lane & 7) * 8, x);
#pragma unroll
            for (int e = 0; e < 8; ++e) acc[e] += x[e]; }
#pragma unroll
        for (int e = 0; e < 8; ++e) { acc[e] += __shfl_xor(acc[e], 8); acc[e] += __shfl_xor(acc[e], 16); acc[e] += __shfl_xor(acc[e], 32); acc[e] *= (1.0f / 256.0f); }
        if (lane < 8) { unsigned h[4], l[4];
#pragma unroll
            for (int e = 0; e < 4; ++e) { h[e] = pk2(acc[2 * e], acc[2 * e + 1]); l[e] = pk2(acc[2 * e] - bflo(h[e]), acc[2 * e + 1] - bfhi(h[e])); }
            *(v4u*)(MH + ((size_t)bk * 64 + blk) * 64 + lane * 8) = (v4u){h[0], h[1], h[2], h[3]}; *(v4u*)(ML + ((size_t)bk * 64 + blk) * 64 + lane * 8) = (v4u){l[0], l[1], l[2], l[3]}; }
    }
    for (int i = blockIdx.x * 512 + F.tid; i < 16 * 48 * 8; i += F.G * 512) { const int bk = i / (48 * 8), r = i % (48 * 8); const size_t o = ((size_t)bk * 64 + 16) * 64 + (size_t)r * 8;
        *(v4u*)(MH + o) = (v4u){0u, 0u, 0u, 0u}; *(v4u*)(ML + o) = (v4u){0u, 0u, 0u, 0u}; }
}
DI void moba_prompt_unit(const Params& P, const Frame& F, int b, int kvh, int qb) {
    unsigned char* ws = P.ws; int lane_ = F.lane; asm volatile("" : "+v"(lane_));
    const int lane = lane_, wave = F.wave, r32 = lane & 31, hi = lane >> 5;
    const int tl = 8 * wave + (r32 >> 2), hh = r32 & 3, row = b * SEQ + 64 * qb + tl, head = kvh * 4 + hh, cur = qb >> 2;
    LAS unsigned char* kvb = F.lds;
    bf16x8 qr[4]; ld_q((const bf16*)(ws + WS_Q1) + (size_t)row * 1024 + head * 64, qr, hi);
    TileRegs R; int cb = 0; unsigned rowmask = 1u << cur;
    if (cur > 0) {
        const bf16* MH = (const bf16*)(ws + WS_MEANH) + (size_t)(b * 4 + kvh) * 4096; const bf16* ML = (const bf16*)(ws + WS_MEANL) + (size_t)(b * 4 + kvh) * 4096;
        tile_gload(R, MH, ML, wave, lane); { v4u k2 = *(const v4u*)(ML + (size_t)lane * 64 + wave * 8); tile_lstore(R, kvb, kvb + 8192, wave, lane); *(LAS v4u*)(kvb + 16384 + wave * 1024 + lane * 16) = k2; }
        __syncthreads();
        f32x16 p0, p1, q0, q1; qk_tile(kvb, qr, p0, p1, lane); qk_tile(kvb + 16384, qr, q0, q1, lane);
        float gs[16];
#pragma unroll
        for (int i = 0; i < 8; ++i) { const float v = p0[i] + q0[i]; auto rr = __builtin_amdgcn_permlane32_swap(__float_as_uint(v), __float_as_uint(v), false, false);
            gs[8 * (i >> 2) + (i & 3)] = __uint_as_float(rr[0]); gs[8 * (i >> 2) + 4 + (i & 3)] = __uint_as_float(rr[1]); }
        unsigned taken = 0;
#pragma unroll
        for (int pass = 0; pass < 3; ++pass) { float best = -INFINITY; int bi = -1;
#pragma unroll
            for (int n = 0; n < 16; ++n) { const bool c = (n < cur) && !((taken >> n) & 1u) && (gs[n] > best); best = c ? gs[n] : best; bi = c ? n : bi; }
            if (bi >= 0) taken |= 1u << bi; }
        rowmask |= taken;
        __syncthreads();
    }
    const bf16* KB = (const bf16*)(ws + WS_K1) + (size_t)(b * 4 + kvh) * SEQ * 64; const bf16* VB = (const bf16*)(ws + WS_V1) + (size_t)(b * 4 + kvh) * SEQ * 64;
    AttnAcc A; acc_init(A);
    kv_loop(R, cb, kvb, 0, qb, KB, VB, wave, lane, [&](int j, const LAS unsigned char* Kt_, const LAS unsigned char* Vt_) { const bool ok = (rowmask >> (j >> 2)) & 1u;
        if (j == qb) attn_tile<1>(Kt_, Vt_, qr, A, ok, tl, lane); else attn_tile<0>(Kt_, Vt_, qr, A, ok, 0, lane); });
    const float lt = half_sum(A.l), sc = 1.0f / fmaxf(lt, 1e-30f);
#pragma unroll
    for (int i = 0; i < 16; ++i) { A.o0[i] *= sc; A.o1[i] *= sc; }
    store_ot((bf16*)(ws + WS_ATT) + (size_t)row * 1024 + head * 64, A.o0, A.o1, hi);
}
constexpr int SM_MO = 0, SM_MM = 69632, SM_ML = 70656, SM_TAB = RING_BYTES + 1024;
DI void wave_fence() { asm volatile("s_waitcnt lgkmcnt(0)" ::: "memory"); __builtin_amdgcn_wave_barrier(); asm volatile("" ::: "memory"); }
DI void stage_row_f32(LAS unsigned char* kb, LAS unsigned char* vb, const float* kp, const float* vp, int lane) {
#pragma unroll
    for (int c = 0; c < 8; ++c) { if ((c & 1) == 0) asm volatile("" ::: "memory");
        v4u ku = {0u, 0u, 0u, 0u}, vu = {0u, 0u, 0u, 0u};
        if (kp) { const f32x4 a = *(const f32x4*)(kp + 8 * c), b2 = *(const f32x4*)(kp + 8 * c + 4); ku = (v4u){pk2(a.x, a.y), pk2(a.z, a.w), pk2(b2.x, b2.y), pk2(b2.z, b2.w)}; }
        if (vp) { const f32x4 a = *(const f32x4*)(vp + 8 * c), b2 = *(const f32x4*)(vp + 8 * c + 4); vu = (v4u){pk2(a.x, a.y), pk2(a.z, a.w), pk2(b2.x, b2.y), pk2(b2.z, b2.w)}; }
        *(LAS v4u*)(kb + c * 1024 + lane * 16) = ku; *(LAS v4u*)(vb + (c >> 2) * 4096 + lane * 64 + (c & 3) * 16) = vu; }
}
DI void stage_row_bf16(LAS unsigned char* kb, LAS unsigned char* vb, const bf16* kp, const bf16* vp, int lane) {
#pragma unroll
    for (int c = 0; c < 8; ++c) { v4u ku = {0u, 0u, 0u, 0u}, vu = {0u, 0u, 0u, 0u};
        if (kp) ku = *(const v4u*)(kp + 8 * c);
        if (vp) vu = *(const v4u*)(vp + 8 * c);
        *(LAS v4u*)(kb + c * 1024 + lane * 16) = ku; *(LAS v4u*)(vb + (c >> 2) * 4096 + lane * 64 + (c & 3) * 16) = vu; }
}
DI void merge_waves(const Frame& F, AttnAcc& A, int lane, int wave) {
    LAS float* mo = (LAS float*)(F.lds + SM_MO); LAS float* mm = (LAS float*)(F.lds + SM_MM); LAS float* ml = (LAS float*)(F.lds + SM_ML);
    const float lt = half_sum(A.l);
    __syncthreads();
#pragma unroll
    for (int i = 0; i < 16; ++i) { mo[(wave * 64 + lane) * 33 + i] = A.o0[i]; mo[(wave * 64 + lane) * 33 + 16 + i] = A.o1[i]; }
    if (lane < 32) { mm[wave * 32 + lane] = A.m; ml[wave * 32 + lane] = lt; }
    __syncthreads();
    const int r32 = lane & 31; float M = -INFINITY;
#pragma unroll
    for (int w = 0; w < 8; ++w) M = fmaxf(M, mm[w * 32 + r32]);
    const float Mu = (M == -INFINITY) ? 0.f : M; float L = 0.f;
#pragma unroll
    for (int i = 0; i < 16; ++i) { A.o0[i] = 0.f; A.o1[i] = 0.f; }
#pragma unroll 1
    for (int w = 0; w < 8; ++w) { const float sc = __builtin_amdgcn_exp2f(mm[w * 32 + r32] - Mu); L += ml[w * 32 + r32] * sc;
#pragma unroll
        for (int i = 0; i < 16; ++i) { A.o0[i] += mo[(w * 64 + lane) * 33 + i] * sc; A.o1[i] += mo[(w * 64 + lane) * 33 + 16 + i] * sc; } }
    A.m = M; A.l = 0.5f * L;
    __syncthreads();
}
DI void nsa_sample_unit(const Params& P, const Frame& F, int bs, int g) {
    unsigned char* ws = P.ws; int lane_ = F.lane; asm volatile("" : "+v"(lane_));
    const int lane = lane_, wave = F.wave, r32 = lane & 31, hi = lane >> 5, ts = r32 >> 2, hh = r32 & 3, head = g * 4 + hh; const bool rowv = ts < 4;
    const int row = MP + bs * 4 + (ts & 3);
    LAS unsigned char* kb = F.lds + wave * 16384; LAS unsigned char* vb = kb + 8192;
    LAS float* impM = (LAS float*)(F.lds + SM_TAB); LAS float* impS = impM + 4 * 132; LAS unsigned long long* selS = (LAS unsigned long long*)(F.lds + SM_TAB + 2 * 4 * 132 * 4);
    const int* ptab = (const int*)P.in[7] + bs * NPG;
    bf16x8 qr[4]; ld_q((const bf16*)(ws + WS_Q0) + (size_t)row * 512 + head * 64, qr, hi);
    const float* gt = (const float*)(ws + WS_GATES) + (size_t)row * 32 + head * 3; const float g0 = gt[0], g1 = gt[1], g2 = gt[2];
    const bf16* KVS0 = (const bf16*)(ws + WS_KVS0);
    LAS float* outb = (LAS float*)(F.lds + SM_TAB + 4608) + lane * 33;
    const bf16* KC = (const bf16*)(ws + WS_KCS) + ((size_t)((0 * NSQ + bs) * 2 + g) * 512 + 64 * wave + lane) * 64;
    const bf16* VC = (const bf16*)(ws + WS_KCS) + ((size_t)((1 * NSQ + bs) * 2 + g) * 512 + 64 * wave + lane) * 64;
    for (int i = F.tid; i < 2 * 4 * 132; i += 512) impM[i] = 0.f;
    AttnAcc A; acc_init(A);
    stage_row_bf16(kb, vb, KC, VC, lane); wave_fence();
    attn_tile<1>(kb, vb, qr, A, rowv, 510 - 64 * wave, lane);
    merge_waves(F, A, lane, wave);
    if (wave == 0) branch_out_lds<true>(outb, A, g0);
    { const float lt = half_sum(A.l), rl = 1.0f / fmaxf(lt, 1e-30f), mfin = (A.m == -INFINITY) ? 0.f : A.m;
      stage_row_bf16(kb, vb, KC, nullptr, lane); wave_fence();
      f32x16 p0, p1; qk_tile(kb, qr, p0, p1, lane); mask_scale<1>(p0, p1, rowv, 510 - 64 * wave, hi);
#pragma unroll
      for (int cc = 0; cc < 2; ++cc)
#pragma unroll
          for (int gi = 0; gi < 4; ++gi) { const f32x16& p = cc ? p1 : p0;
              const float e0 = __builtin_amdgcn_exp2f(p[4 * gi] - mfin) * rl, e1 = __builtin_amdgcn_exp2f(p[4 * gi + 1] - mfin) * rl, e2 = __builtin_amdgcn_exp2f(p[4 * gi + 2] - mfin) * rl, e3 = __builtin_amdgcn_exp2f(p[4 * gi + 3] - mfin) * rl;
              float mn = e0 + e1 + e2 + 0.5f * e3, sp = 0.5f * e3;
              mn += __builtin_bit_cast(float, __builtin_amdgcn_update_dpp(0, __builtin_bit_cast(int, mn), 0xB1, 0xf, 0xf, false)); mn += __builtin_bit_cast(float, __builtin_amdgcn_update_dpp(0, __builtin_bit_cast(int, mn), 0x4E, 0xf, 0xf, false));
              sp += __builtin_bit_cast(float, __builtin_amdgcn_update_dpp(0, __builtin_bit_cast(int, sp), 0xB1, 0xf, 0xf, false)); sp += __builtin_bit_cast(float, __builtin_amdgcn_update_dpp(0, __builtin_bit_cast(int, sp), 0x4E, 0xf, 0xf, false));
              const int jj = 16 * wave + 8 * cc + 2 * gi + hi;
              if (hh == 0 && rowv) { impM[ts * 132 + jj] = mn; impS[ts * 132 + jj + 1] = sp; } } }
    __syncthreads();
    if (wave < 4) { const int tq = wave;
        float s0 = impM[tq * 132 + lane] + impS[tq * 132 + lane], s1 = impM[tq * 132 + 64 + lane] + impS[tq * 132 + 64 + lane];
        float s2 = (lane == 0) ? impM[tq * 132 + 128] + impS[tq * 132 + 128] + 100.0f : -INFINITY;
        if (lane == 0) s0 += 100.0f; if (lane == 63) s1 += 100.0f;
        int c0 = 0, c1 = 0, c2 = 0; int ln = lane; asm volatile("" : "+v"(ln));
#pragma unroll 8
        for (int jp = 0; jp < 64; ++jp) { const float o = __shfl(s0, jp); c0 += (o > s0 || (o == s0 && jp < ln)) ? 1 : 0; c1 += (o >= s1) ? 1 : 0; c2 += (o >= s2) ? 1 : 0; }
#pragma unroll 8
        for (int jp = 0; jp < 64; ++jp) { const float o = __shfl(s1, jp); c0 += (o > s0) ? 1 : 0; c1 += (o > s1 || (o == s1 && jp < ln)) ? 1 : 0; c2 += (o >= s2) ? 1 : 0; }
        { const float o = __shfl(s2, 0); c0 += (o > s0) ? 1 : 0; c1 += (o > s1) ? 1 : 0; }
        const unsigned long long m0 = __ballot(c0 < 16), m1 = __ballot(c1 < 16), m2 = __ballot(lane == 0 && c2 < 16);
        if (lane == 0) { selS[tq * 4 + 0] = m0; selS[tq * 4 + 1] = m1; selS[tq * 4 + 2] = m2; } }
    __syncthreads();
    const unsigned long long my0 = selS[(ts & 3) * 4 + 0], my1 = selS[(ts & 3) * 4 + 1], my2 = selS[(ts & 3) * 4 + 2];
    const unsigned long long u0v = selS[0] | selS[4] | selS[8] | selS[12], u1v = selS[1] | selS[5] | selS[9] | selS[13];
    const unsigned long long u0 = ((unsigned long long)(unsigned)__builtin_amdgcn_readfirstlane((int)(u0v >> 32)) << 32) | (unsigned)__builtin_amdgcn_readfirstlane((int)u0v);
    const unsigned long long u1 = ((unsigned long long)(unsigned)__builtin_amdgcn_readfirstlane((int)(u1v >> 32)) << 32) | (unsigned)__builtin_amdgcn_readfirstlane((int)u1v);
    { acc_init(A); const float* cache = INF(2); int k = 0;
      for (int j = 0; j < 129; ++j) { const bool inu = j < 64 ? ((u0 >> j) & 1ull) : j < 128 ? ((u1 >> (j - 64)) & 1ull) : true; if (!inu) continue;
          if ((k++ & 7) != wave) continue;
          const bool ok = rowv && (j < 64 ? ((my0 >> j) & 1ull) : j < 128 ? ((my1 >> (j - 64)) & 1ull) : (my2 & 1ull));
          if (j < 128) { const int page = ptab[j >> 1]; const float* base = cache + ((size_t)page * PAGE + (j & 1) * 64 + lane) * 512 + g * 64;
              stage_row_f32(kb, vb, base + 256, base + 384, lane); wave_fence(); attn_tile<0>(kb, vb, qr, A, ok, 0, lane); }
          else { const bf16* kn = lane < 4 ? KVS0 + ((((size_t)2 * NSQ + bs) * 2 + g) * 4 + lane) * 64 : nullptr; const bf16* vn = lane < 4 ? KVS0 + ((((size_t)3 * NSQ + bs) * 2 + g) * 4 + lane) * 64 : nullptr;
              stage_row_bf16(kb, vb, kn, vn, lane); wave_fence(); attn_tile<1>(kb, vb, qr, A, ok, ts, lane); }
          wave_fence(); }
      merge_waves(F, A, lane, wave); if (wave == 0) branch_out_lds<false>(outb, A, g1); }
    { acc_init(A); const float* wbuf = INF(4) + (size_t)bs * 512 * 256;
      for (int tile = wave; tile < 9; tile += 8) { const int idx = 64 * tile + lane;
          if (tile < 8) { const float* base = wbuf + (size_t)idx * 256 + g * 64; stage_row_f32(kb, vb, base, base + 128, lane); }
          else { const bf16* kn = lane < 4 ? KVS0 + ((((size_t)4 * NSQ + bs) * 2 + g) * 4 + lane) * 64 : nullptr; const bf16* vn = lane < 4 ? KVS0 + ((((size_t)5 * NSQ + bs) * 2 + g) * 4 + lane) * 64 : nullptr;
              stage_row_bf16(kb, vb, kn, vn, lane); }
          wave_fence();
          if (tile == 0) attn_tile<2>(kb, vb, qr, A, rowv, ts, lane); else if (tile == 8) attn_tile<1>(kb, vb, qr, A, rowv, ts, lane); else attn_tile<0>(kb, vb, qr, A, rowv, 0, lane);
          wave_fence(); }
      merge_waves(F, A, lane, wave); if (wave == 0) branch_out_lds<false>(outb, A, g2); }
    if (wave == 0) { f32x16 out0, out1;
#pragma unroll
        for (int i = 0; i < 16; ++i) { out0[i] = outb[i]; out1[i] = outb[16 + i]; }
        if (rowv) store_ot((bf16*)(ws + WS_ATT) + (size_t)row * 1024 + 512 + head * 64, out0, out1, hi); }
}
DI void moba_sample_unit(const Params& P, const Frame& F, int bs, int kvh) {
    unsigned char* ws = P.ws; int lane_ = F.lane; asm volatile("" : "+v"(lane_));
    const int lane = lane_, wave = F.wave, r32 = lane & 31, hi = lane >> 5, ts = r32 >> 2, hh = r32 & 3, head = kvh * 4 + hh; const bool rowv = ts < 4;
    const int row = MP + bs * 4 + (ts & 3);
    LAS unsigned char* kb = F.lds + wave * 16384; LAS unsigned char* vb = kb + 8192;
    const int* ptab = (const int*)P.in[7] + bs * NPG;
    bf16x8 qr[4]; ld_q((const bf16*)(ws + WS_Q1) + (size_t)row * 1024 + head * 64, qr, hi);
    unsigned long long rowmask = 1ull << 32;
    { const float* mp = (const float*)(ws + WS_MEANS) + (((size_t)bs * 4 + kvh) * 32 + (lane & 31)) * 64;
#pragma unroll
      for (int c = 0; c < 8; ++c) { v4u hu = {0u, 0u, 0u, 0u}, lu = {0u, 0u, 0u, 0u};
          if (lane < 32) { const f32x4 a = *(const f32x4*)(mp + 8 * c), b2 = *(const f32x4*)(mp + 8 * c + 4);
              hu = (v4u){pk2(a.x, a.y), pk2(a.z, a.w), pk2(b2.x, b2.y), pk2(b2.z, b2.w)};
              lu = (v4u){pk2(a.x - bflo(hu.x), a.y - bfhi(hu.x)), pk2(a.z - bflo(hu.y), a.w - bfhi(hu.y)), pk2(b2.x - bflo(hu.z), b2.y - bfhi(hu.z)), pk2(b2.z - bflo(hu.w), b2.w - bfhi(hu.w))}; }
          *(LAS v4u*)(kb + c * 1024 + lane * 16) = hu; *(LAS v4u*)(vb + c * 1024 + lane * 16) = lu; }
      wave_fence();
      f32x16 p0, p1, q0, q1; qk_tile(kb, qr, p0, p1, lane); qk_tile(vb, qr, q0, q1, lane);
      float gs[32];
#pragma unroll
      for (int i = 0; i < 16; ++i) { const float v = p0[i] + q0[i]; auto rr = __builtin_amdgcn_permlane32_swap(__float_as_uint(v), __float_as_uint(v), false, false);
          gs[8 * (i >> 2) + (i & 3)] = __uint_as_float(rr[0]); gs[8 * (i >> 2) + 4 + (i & 3)] = __uint_as_float(rr[1]); }
      unsigned taken = 0;
#pragma unroll
      for (int pass = 0; pass < 3; ++pass) { float best = -INFINITY; int bi = -1;
#pragma unroll
          for (int n = 0; n < 32; ++n) { const bool c = !((taken >> n) & 1u) && (gs[n] > best); best = c ? gs[n] : best; bi = c ? n : bi; }
          if (bi >= 0) taken |= 1u << bi; }
      rowmask |= (unsigned long long)taken;
      wave_fence(); }
    unsigned umask = 0;
#pragma unroll
    for (int n = 0; n < 32; ++n) if (__ballot(rowv && ((rowmask >> n) & 1ull)) != 0ull) umask |= 1u << n;
    AttnAcc A; acc_init(A); const float* cache = INF(3); int k = 0;
    for (int blk = 0; blk < 32; ++blk) { if (!((umask >> blk) & 1u)) continue;
        const bool ok = rowv && ((rowmask >> blk) & 1ull);
        for (int q4 = 0; q4 < 4; ++q4) { if ((k++ & 7) != wave) continue;
            const int page = ptab[2 * blk + (q4 >> 1)]; const float* base = cache + ((size_t)page * PAGE + (q4 & 1) * 64 + lane) * 512 + kvh * 64;
            stage_row_f32(kb, vb, base, base + 256, lane); wave_fence(); attn_tile<0>(kb, vb, qr, A, ok, 0, lane); wave_fence(); } }
    if ((k & 7) == wave) { const bf16* kn = lane < 4 ? (const bf16*)(ws + WS_K1S) + (((size_t)bs * 4 + kvh) * 4 + lane) * 64 : nullptr; const bf16* vn = lane < 4 ? (const bf16*)(ws + WS_V1S) + (((size_t)bs * 4 + kvh) * 4 + lane) * 64 : nullptr;
        stage_row_bf16(kb, vb, kn, vn, lane); wave_fence(); attn_tile<1>(kb, vb, qr, A, rowv, ts, lane); wave_fence(); }
    merge_waves(F, A, lane, wave);
    const float lt = half_sum(A.l), sc = 1.0f / fmaxf(lt, 1e-30f);
#pragma unroll
    for (int i = 0; i < 16; ++i) { A.o0[i] *= sc; A.o1[i] *= sc; }
    if (wave == 0 && rowv) store_ot((bf16*)(ws + WS_ATT) + (size_t)row * 1024 + head * 64, A.o0, A.o1, hi);
}
constexpr int N_PHASES = 19;
__global__ void __launch_bounds__(512, 2) mk_fwd(Params P) {
    extern __shared__ __attribute__((aligned(16))) unsigned char lds_raw[];
    Frame F;
    F.lds = (LAS unsigned char*)lds_raw;
    F.tid = threadIdx.x; F.lane = F.tid & 63; F.wave = __builtin_amdgcn_readfirstlane(F.tid >> 6);
    F.G = gridDim.x; F.gw = blockIdx.x * NWAVES + F.wave; F.ngw = F.G * NWAVES;
    volatile LAS unsigned* MISC = (volatile LAS unsigned*)(F.lds + MISC_OFF);
    for (int u = F.tid; u < (LDS_BYTES - RING_BYTES) / 4; u += 512) ((LAS unsigned*)(F.lds + RING_BYTES))[u] = 0u;
    __syncthreads();
    unsigned char* ws = P.ws;
    unsigned* ctl = (unsigned*)(ws + WS_CTL);
    XcdBarrier bar = xcd_barrier_post(ctl + 4096, MISC + 8);
    const int lo = P.ph_lo, hi = P.ph_hi;
#define IN(k) (lo <= (k) && (k) < hi)
#define SEAM(k) do { if (IN(k) && IN((k) + 1)) xcd_barrier(bar); } while (0)

    if (IN(0)) {
        p0_rope(P, F);
        p0_weights(P, F);
        __syncthreads();
        norm_phase(F, INF(0), INF(1), INF(8), (bf16*)(ws + WS_XN));
        p0_cache(P, F);
        p0_cmp_bias(P, F);
    }
    SEAM(0);
    if (IN(1)) {
        EpiIn0 e0{(bf16*)(ws + WS_RW), (bf16*)(ws + WS_Q0), (bf16*)(ws + WS_KV0), (bf16*)(ws + WS_KVS0), (const f32x2*)(ws + WS_ROPE), P.out};
        { pg8::Gemm g{(const bf16*)(ws + WS_XN), (const bf16*)(ws + WS_WIN0), MP, 3072, 1024}; pg8::StaticOrder S; S.init(MP, 3072, F.G, (int)blockIdx.x);
          EpiHead<EpiIn0> E{e0};
          pg8::gemm_phase<EpiHead<EpiIn0>, pg8::StaticOrder, PG8_ALIGN, PG8_SP2>(F.lds, g, S, E); }
        __syncthreads();
        { pg8::Gemm g{(const bf16*)(ws + WS_ACMPS), (const bf16*)(ws + WS_WCMP), 65536, 256, 1024}; pg8::StaticOrder S; S.init(65536, 256, F.G, (int)blockIdx.x);
          EpiHead<EpiCmp> E{EpiCmp{(float*)(ws + WS_HCS), 32768}};
          pg8::gemm_phase<EpiHead<EpiCmp>, pg8::StaticOrder, PG8_ALIGN, PG8_SP2>(F.lds, g, S, E); }
        __syncthreads();
        for (int u = F.G - 1 - (int)blockIdx.x; u < 48 + 129; u += F.G) {
            if (u < 48) skinny_unit((const bf16*)(ws + WS_XN), (const bf16*)(ws + WS_WIN0), 1024, MP, 64 * u, e0, F.wave, F.lane);
            else skinny_unit((const bf16*)(ws + WS_XN), (const bf16*)(ws + WS_WG0), 1024, 128 * (u - 48), 0, EpiGates{(float*)(ws + WS_GATES), INF(24)}, F.wave, F.lane);
        }
    }
    SEAM(1);
    if (IN(2)) {
        { pg8::Gemm g{(const bf16*)(ws + WS_KV0), (const bf16*)(ws + WS_WCMP), 4096, 256, 1024}; pg8::StaticOrder S; S.init(4096, 256, F.G, (int)blockIdx.x);
          EpiHead<EpiCmp> E{EpiCmp{(float*)(ws + WS_HCP), 2048}};
          pg8::gemm_phase<EpiHead<EpiCmp>, pg8::StaticOrder, PG8_ALIGN, PG8_SP2>(F.lds, g, S, E); }
        __syncthreads();
        rwkv_prep(P, F);
    }
    SEAM(2);
    if (IN(3)) {
        EpiLora el{INF(14), INF(16), INF(20), (const float*)(ws + WS_K), (const float*)(ws + WS_KK), (float*)(ws + WS_W), (float*)(ws + WS_KP), (float*)(ws + WS_KKA), (float*)(ws + WS_G)};
        { pg8::Gemm g{(const bf16*)(ws + WS_LA), (const bf16*)(ws + WS_WLORA), MP, 1536, 256}; pg8::StaticOrder S; S.init(MP, 1536, F.G, (int)blockIdx.x);
          EpiHead<EpiLora> E{el};
          pg8::gemm_phase<EpiHead<EpiLora>, pg8::StaticOrder, PG8_ALIGN, PG8_SP2>(F.lds, g, S, E); }
        __syncthreads();
        for (int u = F.G - 1 - (int)blockIdx.x; u < 24; u += F.G) skinny_unit((const bf16*)(ws + WS_LA), (const bf16*)(ws + WS_WLORA), 256, MP, 64 * u, el, F.wave, F.lane);
        cmp_stage2(P, F);
    }
    SEAM(3);
    if (IN(4)) {
        if ((int)blockIdx.x < 32 && F.G >= 64) { const int b = blockIdx.x >> 3, h = blockIdx.x & 7; scan_chain(P, F, b * SEQ, h, SEQ, nullptr, P.out + O_WKVP + (size_t)blockIdx.x * 4096); }
        else { const int first = F.G >= 64 ? 32 : 0, nb = F.G - first;
            for (int c = (int)blockIdx.x - first; c < 256 + (F.G >= 64 ? 0 : 32); c += nb) {
                if (c < 256) { const int bs = c >> 3, h = c & 7; scan_chain(P, F, MP + bs * 4, h, 4, INF(5) + (size_t)c * 4096, P.out + O_WKVS + (size_t)c * 4096); }
                else { const int cc = c - 256; scan_chain(P, F, (cc >> 3) * SEQ, cc & 7, SEQ, nullptr, P.out + O_WKVP + (size_t)cc * 4096); }
                __syncthreads(); }
            __syncthreads();
            for (int i = (int)blockIdx.x - first; i < 512; i += nb) { const int bg = i >> 6, k = i & 63, qb = (k & 1) ? 63 - (k >> 1) : (k >> 1); nsa_prompt_unit(P, F, bg >> 1, bg & 1, qb); __syncthreads(); }
            for (int i = nb - 1 - ((int)blockIdx.x - first); i < 64; i += nb) { nsa_sample_unit(P, F, i >> 1, i & 1); __syncthreads(); }
        }
    }
    SEAM(4);
    if (IN(5)) { rwkv_post(P, F); }
    SEAM(5);
#define GEMM_PHASE(EPI_T, epi, Aptr, Bptr, N_, K_, nskinny) do { \
        { pg8::Gemm g{(const bf16*)(Aptr), (const bf16*)(Bptr), MP, (N_), (K_)}; pg8::StaticOrder S; S.init(MP, (N_), F.G, (int)blockIdx.x); EpiHead<EPI_T> E{epi}; \
          pg8::gemm_phase<EpiHead<EPI_T>, pg8::StaticOrder, PG8_ALIGN, PG8_SP2>(F.lds, g, S, E); } \
        __syncthreads(); \
        for (int u = F.G - 1 - (int)blockIdx.x; u < (nskinny); u += F.G) skinny_unit((const bf16*)(Aptr), (const bf16*)(Bptr), (K_), MP, 64 * u, epi, F.wave, F.lane); } while (0)
    float* Hres = (float*)(ws + WS_H);
    if (IN(6)) { EpiResid e{INF(0), INF(1), Hres}; GEMM_PHASE(EpiResid, e, ws + WS_ATT, ws + WS_WOUT0, 1024, 1024, 16); }
    SEAM(6);
    if (IN(7)) { norm_phase(F, Hres, Hres + (size_t)MP * D, INF(9), (bf16*)(ws + WS_XN)); }
    SEAM(7);
    if (IN(8)) { EpiSwiglu e{(bf16*)(ws + WS_HFF)}; GEMM_PHASE(EpiSwiglu, e, ws + WS_XN, ws + WS_WGU0, 5632, 1024, 88); }
    SEAM(8);
    if (IN(9)) { EpiResid e{Hres, Hres + (size_t)MP * D, Hres}; GEMM_PHASE(EpiResid, e, ws + WS_HFF, ws + WS_WDN0, 1024, FF, 16); }
    SEAM(9);
    if (IN(10)) { norm_phase(F, Hres, Hres + (size_t)MP * D, INF(8) + D, (bf16*)(ws + WS_XN)); }
    SEAM(10);
    if (IN(11)) { EpiIn1 e{(bf16*)(ws + WS_Q1), (bf16*)(ws + WS_K1), (bf16*)(ws + WS_K1S), (const f32x2*)(ws + WS_ROPE), P.out};
        GEMM_PHASE(EpiIn1, e, ws + WS_XN, ws + WS_WIN1, 1536, 1024, 24); }
    SEAM(11);
    if (IN(12)) { moba_means(P, F); }
    SEAM(12);
    if (IN(13)) {
        for (int i = (int)blockIdx.x; i < 1024; i += F.G) { const int bk = i >> 6, k = i & 63, qb = (k & 1) ? 63 - (k >> 1) : (k >> 1); moba_prompt_unit(P, F, bk >> 2, bk & 3, qb); __syncthreads(); }
        for (int i = F.G - 1 - (int)blockIdx.x; i < 128; i += F.G) { moba_sample_unit(P, F, i >> 2, i & 3); __syncthreads(); }
    }
    SEAM(13);
    if (IN(14)) { EpiResid e{Hres, Hres + (size_t)MP * D, Hres}; GEMM_PHASE(EpiResid, e, ws + WS_ATT, ws + WS_WOUT1, 1024, 1024, 16); }
    SEAM(14);
    if (IN(15)) { norm_phase(F, Hres, Hres + (size_t)MP * D, INF(9) + D, (bf16*)(ws + WS_XN)); }
    SEAM(15);
    if (IN(16)) { EpiSwiglu e{(bf16*)(ws + WS_HFF)}; GEMM_PHASE(EpiSwiglu, e, ws + WS_XN, ws + WS_WGU1, 5632, 1024, 88); }
    SEAM(16);
    if (IN(17)) { EpiResid e{Hres, Hres + (size_t)MP * D, Hres}; GEMM_PHASE(EpiResid, e, ws + WS_HFF, ws + WS_WDN1, 1024, FF, 16); }
    SEAM(17);
    if (IN(18)) { final_norm(P, F); }
#undef GEMM_PHASE
#undef IN
#undef SEAM
}

extern "C" void kernel_launch(void* const* d_in, const int* in_sizes, int n_in, void* d_out, int out_size, void* d_ws, size_t ws_size, hipStream_t stream) {
    static int grid = 0;
    if (grid == 0) {
        if (n_in != 33 || (size_t)out_size != O_END || ws_size < WS_END3) { fprintf(stderr, "kernel_launch: unexpected shapes n_in %d out %d ws %zu (need %zu)\n", n_in, out_size, ws_size, (size_t)WS_END3); grid = -1; return; }
        int dev = 0, cus = 0, per_cu = 0;
        if (hipGetDevice(&dev) != hipSuccess || hipDeviceGetAttribute(&cus, hipDeviceAttributeMultiprocessorCount, dev) != hipSuccess) { grid = -1; return; }
        if (hipFuncSetAttribute((const void*)mk_fwd, hipFuncAttributeMaxDynamicSharedMemorySize, LDS_BYTES) != hipSuccess) { fprintf(stderr, "kernel_launch: hipFuncSetAttribute failed\n"); grid = -1; return; }
        if (hipOccupancyMaxActiveBlocksPerMultiprocessor(&per_cu, (const void*)mk_fwd, 512, LDS_BYTES) != hipSuccess || per_cu < 1) fprintf(stderr, "kernel_launch: occupancy query says %d\n", per_cu);
        (void)hipGetLastError();
        grid = cus;
    }
    if (grid < 0) return;
    if (hipMemsetAsync((char*)d_ws + WS_CTL, 0, CTL_BYTES, stream) != hipSuccess) return;
    Params p{};
    for (int i = 0; i < 33; ++i) p.in[i] = d_in[i];
    p.out = (float*)d_out; p.ws = (unsigned char*)d_ws;
#ifndef MK_LAUNCH_PER_PHASE
#define MK_LAUNCH_PER_PHASE 1
#endif
#if MK_LAUNCH_PER_PHASE
    for (int k = 0; k < N_PHASES; ++k) { p.ph_lo = k; p.ph_hi = k + 1; hipLaunchKernelGGL(mk_fwd, dim3(grid), dim3(512), LDS_BYTES, stream, p); }
#else
    p.ph_lo = 0; p.ph_hi = N_PHASES; hipLaunchKernelGGL(mk_fwd, dim3(grid), dim3(512), LDS_BYTES, stream, p);
#endif
}
```

```cpp
#include <hip/hip_runtime.h>
#include <cstdio>
#include <cstdint>
namespace pg8 {
#define PG8_LAS __attribute__((address_space(3)))
typedef unsigned short bf16_t;
typedef short bf16x8 __attribute__((ext_vector_type(8)));
typedef float f32x4 __attribute__((ext_vector_type(4)));
typedef unsigned u32x4 __attribute__((ext_vector_type(4)));
constexpr int BM = 256, BK = 64, HALF = 128, HTB = HALF * BK * 2  , STAGE_BYTES = 8 * HTB, NXCD = 8, WGM = 8;

__host__ __device__ __forceinline__ int lds_byte(int r, int c) { const int st = (r >> 4) * 2 + (c >> 5), rr = r & 15, cc = c & 31, ob = rr * 64 + cc * 2; return st * 1024 + (ob ^ (((ob >> 9) & 1) << 5)); }
__host__ __device__ __forceinline__ void stage_rc(int b, int& R, int& C) { const int st = b / 1024, sb = b % 1024, swz = sb ^ (((sb >> 9) & 1) << 5); R = (st >> 1) * 16 + swz / 64; C = (st & 1) * 32 + (swz % 64) / 2; }
__host__ __device__ __forceinline__ int perm32(int rho) { const int n = rho >> 4, i = rho & 15; return 8 * (i >> 2) + 4 * n + (i & 3); }

struct Unit { int pm, pn; };
struct Gemm { const bf16_t* A; const bf16_t* Bt; int M, N, K; };

struct StaticOrder {
    int nM, nN, nwg, G, c;
    __host__ __device__ void init(int M, int N, int G_, int c_) { nM = M / BM; nN = N / BM; nwg = nM * nN; G = G_; c = c_; }
    __host__ __device__ bool next(int i, Unit& u) const {
        const long L = (long)i * G + c; if (L >= nwg) return false;
        int wgid = (int)L; { const int q = nwg / NXCD, r = nwg % NXCD, xcd = wgid % NXCD, off = wgid / NXCD; wgid = (xcd < r ? xcd * (q + 1) : r * (q + 1) + (xcd - r) * q) + off; }
        const int nig = WGM * nN, gid = wgid / nig, fm = gid * WGM, gsz = (nM - fm) < WGM ? (nM - fm) : WGM;
        u.pm = fm + ((wgid % nig) % gsz); u.pn = (wgid % nig) / gsz; return true;
    }
    __device__ __forceinline__ void a_ready(const Unit&) const {}
    __device__ __forceinline__ void done(const Unit&) const {}
};

template <class Epi, class Sched, bool ALIGN_EPI = false, bool SP2 = false>
__device__ __forceinline__ void gemm_phase(PG8_LAS unsigned char* lds, const Gemm g, const Sched& S, const Epi& E) {
    const int tid = threadIdx.x, wid = __builtin_amdgcn_readfirstlane(tid >> 6), lane = tid & 63, wr = wid >> 2, wc = wid & 3, fr = lane & 15, fq = lane >> 4;
    const int K = g.K, nt = K / BK;
    unsigned voffA[2], voffB[2];
#pragma unroll
    for (int i = 0; i < 2; ++i) { int R, C; stage_rc(tid * 16 + i * 8192, R, C); const int Rb = Epi::PERM ? ((R & ~31) + perm32(R & 31)) : R;
        voffA[i] = (unsigned)(R * K + C) * 2u; voffB[i] = (unsigned)(Rb * K + C) * 2u; }
    const size_t kstep = (size_t)(BK * 2);
    const size_t hstep = (size_t)HALF * K * 2;
    const size_t tstep = 2 * hstep;
    const unsigned ldsw = (unsigned)wid * 1024u;
    const int aoff = lds_byte(wr * 64 + fr, fq * 8), boff = lds_byte(wc * 32 + fr, fq * 8);
#define PG8_SA(b, h) (((b) * 2 + (h)) * HTB)
#define PG8_SB(b, h) ((4 + (b) * 2 + (h)) * HTB)
#define PG8_STAGE(bufoff, gbase, voff) do { _Pragma("unroll") for (int _i = 0; _i < 2; ++_i) \
        __builtin_amdgcn_global_load_lds((const unsigned*)((const char*)(gbase) + (voff)[_i]), (PG8_LAS unsigned*)(lds + (bufoff) + ldsw + _i * 8192), 16, 0, 0); } while (0)
#define PG8_LDA(dst, b, h) do { _Pragma("unroll") for (int m = 0; m < 4; ++m) _Pragma("unroll") for (int k = 0; k < 2; ++k) dst[m][k] = *(const PG8_LAS bf16x8*)(lds + PG8_SA(b, h) + aoff + m * 2048 + k * 1024); } while (0)
#define PG8_LDB(dst, b, h) do { _Pragma("unroll") for (int n = 0; n < 2; ++n) _Pragma("unroll") for (int k = 0; k < 2; ++k) dst[n][k] = *(const PG8_LAS bf16x8*)(lds + PG8_SB(b, h) + boff + n * 2048 + k * 1024); } while (0)
#define PG8_MMA(ai, bj, At, Bt) do { __builtin_amdgcn_s_setprio(1); _Pragma("unroll") for (int m = 0; m < 4; ++m) _Pragma("unroll") for (int n = 0; n < 2; ++n) _Pragma("unroll") for (int k = 0; k < 2; ++k) \
        acc[ai][bj][m][n] = __builtin_amdgcn_mfma_f32_16x16x32_bf16(Bt[n][k], At[m][k], acc[ai][bj][m][n], 0, 0, 0); __builtin_amdgcn_s_setprio(0); } while (0)
#define PG8_WAIT_V(n) asm volatile("s_waitcnt vmcnt(" #n ")" ::: "memory")
#define PG8_WAIT_L(n) asm volatile("s_waitcnt lgkmcnt(" #n ")" ::: "memory")
#define PG8_BAR __builtin_amdgcn_s_barrier()
#define PG8_SCHED __builtin_amdgcn_sched_barrier(0)
    Unit cur, nxt; int ui = 0;
    if (!S.next(0, cur)) return;
    f32x4 acc[2][2][4][2];
#pragma unroll
    for (int a = 0; a < 2; ++a)
#pragma unroll
        for (int b = 0; b < 2; ++b)
#pragma unroll
            for (int m = 0; m < 4; ++m)
#pragma unroll
                for (int n = 0; n < 2; ++n) acc[a][b][m][n] = (f32x4){0.f, 0.f, 0.f, 0.f};
    bf16x8 At[4][2], B0[2][2], B1[2][2];
    const char* cA = (const char*)g.A + (size_t)cur.pm * tstep; const char* cB = (const char*)g.Bt + (size_t)cur.pn * tstep;
    S.a_ready(cur);
    if constexpr (SP2) {
        PG8_STAGE(PG8_SB(0, 0), cB, voffB); PG8_STAGE(PG8_SB(0, 1), cB + hstep, voffB); PG8_STAGE(PG8_SA(0, 0), cA, voffA); PG8_STAGE(PG8_SA(0, 1), cA + hstep, voffA);
        if (wr == 1) PG8_BAR;
        PG8_WAIT_V(2); PG8_BAR;
        PG8_STAGE(PG8_SB(1, 0), cB + kstep, voffB); PG8_STAGE(PG8_SA(1, 0), cA + kstep, voffA); PG8_STAGE(PG8_SB(1, 1), cB + hstep + kstep, voffB);
        PG8_WAIT_V(6); PG8_BAR;
    } else {
        PG8_STAGE(PG8_SB(0, 0), cB, voffB); PG8_STAGE(PG8_SA(0, 0), cA, voffA); PG8_STAGE(PG8_SB(0, 1), cB + hstep, voffB); PG8_STAGE(PG8_SA(0, 1), cA + hstep, voffA);
        if (wr == 1) PG8_BAR;
        PG8_WAIT_V(4); PG8_BAR;
        PG8_STAGE(PG8_SB(1, 0), cB + kstep, voffB); PG8_STAGE(PG8_SA(1, 0), cA + kstep, voffA); PG8_STAGE(PG8_SB(1, 1), cB + hstep + kstep, voffB);
        PG8_WAIT_V(6); PG8_BAR;
    }
    for (;;) {
        const bool has_next = S.next(ui + 1, nxt);
        const char* nA = has_next ? (const char*)g.A + (size_t)nxt.pm * tstep : cA; const char* nB = has_next ? (const char*)g.Bt + (size_t)nxt.pn * tstep : cB;
        for (int t = 0; t < nt; t += 2) {
            const bool last = (t == nt - 2);
            const char* a1 = cA + (size_t)(t + 1) * kstep;
            const char* a2 = last ? nA : cA + (size_t)(t + 2) * kstep; const char* b2 = last ? nB : cB + (size_t)(t + 2) * kstep;
            const char* a3 = a2 + kstep; const char* b3 = b2 + kstep;
            if (last && has_next) S.a_ready(nxt);
            if constexpr (SP2) {
            PG8_LDB(B0, 0, 0); PG8_LDB(B1, 0, 1); PG8_SCHED; PG8_LDA(At, 0, 0); PG8_STAGE(PG8_SA(1, 1), a1 + hstep, voffA);
            PG8_WAIT_V(8); PG8_WAIT_L(0); PG8_BAR; PG8_MMA(0, 0, At, B0); PG8_MMA(0, 1, At, B1); PG8_BAR; PG8_SCHED;
            PG8_LDA(At, 0, 1); PG8_STAGE(PG8_SB(0, 0), b2, voffB); PG8_STAGE(PG8_SB(0, 1), b2 + hstep, voffB); PG8_STAGE(PG8_SA(0, 0), a2, voffA);
            PG8_WAIT_V(8); PG8_WAIT_L(0); PG8_BAR; PG8_MMA(1, 0, At, B0); PG8_MMA(1, 1, At, B1); PG8_BAR; PG8_SCHED;
            PG8_LDB(B0, 1, 0); PG8_LDB(B1, 1, 1); PG8_SCHED; PG8_LDA(At, 1, 0); PG8_STAGE(PG8_SA(0, 1), a2 + hstep, voffA);
            PG8_WAIT_V(8); PG8_WAIT_L(0); PG8_BAR; PG8_MMA(0, 0, At, B0); PG8_MMA(0, 1, At, B1); PG8_BAR; PG8_SCHED;
            PG8_LDA(At, 1, 1); PG8_STAGE(PG8_SB(1, 0), b3, voffB); PG8_STAGE(PG8_SB(1, 1), b3 + hstep, voffB); PG8_STAGE(PG8_SA(1, 0), a3, voffA);
            PG8_WAIT_V(8); PG8_WAIT_L(0); PG8_BAR; PG8_MMA(1, 0, At, B0); PG8_MMA(1, 1, At, B1); PG8_BAR; PG8_SCHED;
            } else {
            PG8_LDB(B0, 0, 0); PG8_SCHED; PG8_LDA(At, 0, 0); PG8_STAGE(PG8_SA(1, 1), a1 + hstep, voffA);
            PG8_WAIT_L(8); PG8_BAR; PG8_WAIT_L(0); PG8_MMA(0, 0, At, B0); PG8_BAR; PG8_SCHED;
            PG8_LDB(B1, 0, 1); PG8_STAGE(PG8_SB(0, 0), b2, voffB);
            PG8_BAR; PG8_WAIT_L(0); PG8_MMA(0, 1, At, B1); PG8_BAR;
            PG8_LDA(At, 0, 1); PG8_STAGE(PG8_SA(0, 0), a2, voffA);
            PG8_BAR; PG8_WAIT_L(0); PG8_MMA(1, 0, At, B0); PG8_BAR; PG8_SCHED;
            PG8_STAGE(PG8_SB(0, 1), b2 + hstep, voffB);
            PG8_WAIT_V(6); PG8_BAR; PG8_MMA(1, 1, At, B1); PG8_BAR;
            PG8_LDB(B0, 1, 0); PG8_SCHED; PG8_LDA(At, 1, 0); PG8_STAGE(PG8_SA(0, 1), a2 + hstep, voffA);
            PG8_WAIT_L(8); PG8_BAR; PG8_WAIT_L(0); PG8_MMA(0, 0, At, B0); PG8_BAR; PG8_SCHED;
            PG8_LDB(B1, 1, 1); PG8_STAGE(PG8_SB(1, 0), b3, voffB);
            PG8_BAR; PG8_WAIT_L(0); PG8_MMA(0, 1, At, B1); PG8_BAR;
            PG8_LDA(At, 1, 1); PG8_STAGE(PG8_SA(1, 0), a3, voffA);
            PG8_BAR; PG8_WAIT_L(0); PG8_MMA(1, 0, At, B0); PG8_BAR; PG8_SCHED;
            PG8_STAGE(PG8_SB(1, 1), b3 + hstep, voffB);
            PG8_WAIT_V(6); PG8_BAR; PG8_MMA(1, 1, At, B1); PG8_BAR;
            }
        }
        if constexpr (ALIGN_EPI) { if (wr == 0) PG8_BAR; }
        if constexpr (!Epi::AFTER_DRAIN) { E(acc, cur, wr, wc, fr, fq); S.done(cur); }
        if (!has_next) break;
#pragma unroll
        for (int a = 0; a < 2; ++a)
#pragma unroll
            for (int b = 0; b < 2; ++b)
#pragma unroll
                for (int m = 0; m < 4; ++m)
#pragma unroll
                    for (int n = 0; n < 2; ++n) acc[a][b][m][n] = (f32x4){0.f, 0.f, 0.f, 0.f};
        cur = nxt; cA = nA; cB = nB; ++ui;
        if constexpr (ALIGN_EPI) { if (wr == 1) PG8_BAR; }
    }
    PG8_WAIT_V(0);
    if constexpr (!ALIGN_EPI) { if (wr == 0) PG8_BAR; }
    PG8_BAR;
    if constexpr (Epi::AFTER_DRAIN) { E.fused(acc, cur, wr, wc, fr, fq, lds, wid, lane); S.done(cur); }
#undef PG8_SA
#undef PG8_SB
#undef PG8_STAGE
#undef PG8_LDA
#undef PG8_LDB
#undef PG8_MMA
#undef PG8_WAIT_V
#undef PG8_WAIT_L
#undef PG8_BAR
#undef PG8_SCHED
}
}
#define PG8_SP2 true
#define PG8_ALIGN true
#define GAS __attribute__((address_space(1)))
#define LAS __attribute__((address_space(3)))
typedef unsigned short bf16;
typedef unsigned v4u __attribute__((ext_vector_type(4)));
typedef unsigned v2u __attribute__((ext_vector_type(2)));
typedef float f32x4 __attribute__((ext_vector_type(4)));
typedef float f32x2 __attribute__((ext_vector_type(2)));
typedef float f32x16 __attribute__((ext_vector_type(16)));
typedef short bf16x8 __attribute__((ext_vector_type(8)));
typedef short s16x4 __attribute__((ext_vector_type(4)));
typedef __bf16 bf16x2_t __attribute__((ext_vector_type(2)));
#define DI __device__ __forceinline__
#define LDS_WAIT() asm volatile("s_waitcnt lgkmcnt(0)" ::: "memory")
#define VM_WAIT() asm volatile("s_waitcnt vmcnt(0)" ::: "memory")

DI unsigned pk2(float lo, float hi) { f32x2 v = {lo, hi}; bf16x2_t b = __builtin_convertvector(v, bf16x2_t); return __builtin_bit_cast(unsigned, b); }
DI float bflo(unsigned u) { return __uint_as_float(u << 16); }
DI float bfhi(unsigned u) { return __uint_as_float(u & 0xffff0000u); }
DI float bf2f(bf16 u) { return __uint_as_float((unsigned)u << 16); }
DI float wave_sum(float v) {
#pragma unroll
    for (int o = 1; o < 64; o <<= 1) v += __shfl_xor(v, o);
    return v;
}
DI float sigmoidf_(float x) { return 1.0f / (1.0f + __expf(-x)); }

constexpr int D = 1024, MP = 16384, MS = 128, MT = 16640, SEQ = 4096, NB = 4, NSQ = 32, TS = 4;
constexpr int RWC = 1792, FF = 2816, NPG = 64, PAGE = 128, PAST = 8192;
constexpr int NWAVES = 8;
constexpr size_t O_YP = 0, O_YS = O_YP + (size_t)MP * D, O_NSAP = O_YS + (size_t)MS * D, O_NSAS = O_NSAP + (size_t)MP * 512,
                 O_MOBP = O_NSAS + (size_t)MS * 512, O_MOBS = O_MOBP + (size_t)MP * 512, O_WINP = O_MOBS + (size_t)MS * 512,
                 O_WINS = O_WINP + (size_t)NB * 512 * 256, O_WKVP = O_WINS + (size_t)NSQ * 512 * 256, O_WKVS = O_WKVP + (size_t)NB * 8 * 4096,
                 O_SHP = O_WKVS + (size_t)NSQ * 8 * 4096, O_SHS = O_SHP + (size_t)NB * RWC, O_END = O_SHS + (size_t)NSQ * RWC;
constexpr size_t al(size_t x) { return (x + 4095) & ~(size_t)4095; }
constexpr size_t WS_CTL = 0, CTL_BYTES = 1u << 20;
constexpr size_t WS_ROPE  = CTL_BYTES;
constexpr size_t WS_WIN0  = al(WS_ROPE + (size_t)4100 * 32 * 8);
constexpr size_t WS_WG0   = al(WS_WIN0 + (size_t)3072 * 1024 * 2);
constexpr size_t WS_WOUT0 = al(WS_WG0 + (size_t)64 * 1024 * 2);
constexpr size_t WS_WGU0  = al(WS_WOUT0 + (size_t)1024 * 1024 * 2);
constexpr size_t WS_WDN0  = al(WS_WGU0 + (size_t)5632 * 1024 * 2);
constexpr size_t WS_WIN1  = al(WS_WDN0 + (size_t)1024 * 2816 * 2);
constexpr size_t WS_WOUT1 = al(WS_WIN1 + (size_t)1536 * 1024 * 2);
constexpr size_t WS_WGU1  = al(WS_WOUT1 + (size_t)1024 * 1024 * 2);
constexpr size_t WS_WDN1  = al(WS_WGU1 + (size_t)5632 * 1024 * 2);
constexpr size_t WS_WLORA = al(WS_WDN1 + (size_t)1024 * 2816 * 2);
constexpr size_t WS_WCMP  = al(WS_WLORA + (size_t)1536 * 256 * 2);
constexpr size_t WS_XN    = al(WS_WCMP + (size_t)256 * 1024 * 2);
constexpr size_t WS_RW    = al(WS_XN + (size_t)MT * 1024 * 2);
constexpr size_t WS_Q0    = al(WS_RW + (size_t)MT * RWC * 2);
constexpr size_t WS_GATES = al(WS_Q0 + (size_t)MT * 512 * 2);
constexpr size_t WS_KV0   = al(WS_GATES + (size_t)MT * 32 * 4);
constexpr size_t WS_KVS0  = al(WS_KV0 + (size_t)6 * 4 * 2 * 4096 * 64 * 2);
constexpr size_t WS_ACMPS = al(WS_KVS0 + (size_t)6 * 32 * 2 * 4 * 64 * 2);
constexpr size_t WS_HCP   = al(WS_ACMPS + (size_t)2 * 32 * 2 * 8192 * 64 * 2);
constexpr size_t WS_HCS   = al(WS_HCP + (size_t)4096 * 128 * 4);
constexpr size_t WS_MEANS = al(WS_HCS + (size_t)65536 * 128 * 4);
constexpr size_t WS_END0  = al(WS_MEANS + (size_t)32 * 4 * 32 * 64 * 4);
#define XB_TMO      128
#define XB_XCNT(j)  (256  + 64 * (j))
#define XB_XSUB(j)  (1280 + 64 * (j))
#define XB_XGEN(j)  (2304 + 64 * (j))
#define XB_TOP      3328
#define XB_TOPGEN   3392
#define XCD_BAR_WORDS 3456
#define XB_SPIN_CAP (1u << 18)

__device__ __forceinline__ unsigned xb_ld(unsigned* p)              { return __hip_atomic_load(p, __ATOMIC_RELAXED, __HIP_MEMORY_SCOPE_AGENT); }
__device__ __forceinline__ unsigned xb_add(unsigned* p, unsigned v) { return __hip_atomic_fetch_add(p, v, __ATOMIC_RELAXED, __HIP_MEMORY_SCOPE_AGENT); }
__device__ __forceinline__ unsigned xb_xcc_id() { return (unsigned)__builtin_amdgcn_s_getreg((3 << 11) | 20) & 0xFu; }
#define XB_SPIN(cond, bar) do { unsigned _sp = 0; while (cond) { __builtin_amdgcn_s_sleep(1); \
    if ((++_sp & 255u) == 0u) { if (xb_ld(&(bar)[XB_TMO])) break; if (_sp > XB_SPIN_CAP) { atomicAdd(&(bar)[XB_TMO], 1u); break; } } } } while (0)

struct XcdBarrier {
    unsigned* bar; unsigned x;
    volatile LAS unsigned* st;
};

__device__ __forceinline__ XcdBarrier xcd_barrier_post(unsigned* bar, volatile LAS unsigned* st) {
    XcdBarrier b; b.bar = bar; b.x = xb_xcc_id(); b.st = st;
    if (threadIdx.x == 0) (void)xb_add(&bar[XB_XCNT(b.x)], 1u);
    return b;
}
__device__ __forceinline__ void xcd_barrier_complete(unsigned* bar, unsigned x, unsigned& nloc, unsigned& nx) {
    const unsigned G = gridDim.x * gridDim.y * gridDim.z;
    unsigned sum, cnt, mine, sp = 0u;
    for (;;) {
        sum = 0u; cnt = 0u; mine = 0u;
#pragma unroll
        for (unsigned j = 0; j < 16; ++j) { const unsigned c = xb_ld(&bar[XB_XCNT(j)]); sum += c; cnt += (c > 0u) ? 1u : 0u; mine = (j == x) ? c : mine; }
        if (sum == G) break;
        __builtin_amdgcn_s_sleep(1);
        if ((++sp & 255u) == 0u) { if (xb_ld(&bar[XB_TMO])) break; if (sp > XB_SPIN_CAP) { atomicAdd(&bar[XB_TMO], 1u); break; } }
    }
    nloc = mine > 0u ? mine : 1u; nx = cnt > 0u ? cnt : 1u;
}

__device__ __forceinline__ void xcd_barrier(const XcdBarrier& b) {
    asm volatile("s_waitcnt vmcnt(0)" ::: "memory");
    __syncthreads();
    if (threadIdx.x == 0) {
        unsigned* bar = b.bar;
        __builtin_amdgcn_s_waitcnt(0);
        unsigned nloc = b.st[0], nx = b.st[1];
        if (nloc == 0u) { xcd_barrier_complete(bar, b.x, nloc, nx); b.st[0] = nloc; b.st[1] = nx; }
        const unsigned old = xb_add(&bar[XB_XSUB(b.x)], 1u);
        const unsigned gen = old / nloc;
        if (old + 1u == (gen + 1u) * nloc) {
            __builtin_amdgcn_fence(__ATOMIC_RELEASE, "agent");
            asm volatile("s_waitcnt vmcnt(0)" ::: "memory");
            const unsigned og = xb_add(&bar[XB_TOP], 1u);
            const unsigned tg = og / nx;
            if (og + 1u == (tg + 1u) * nx) xb_add(&bar[XB_TOPGEN], 1u);
            else XB_SPIN(xb_ld(&bar[XB_TOPGEN]) == tg, bar);
            __builtin_amdgcn_fence(__ATOMIC_ACQUIRE, "agent");
            xb_add(&bar[XB_XGEN(b.x)], 1u);
            asm volatile("s_waitcnt vmcnt(0)" ::: "memory");
        } else {
            XB_SPIN(xb_ld(&bar[XB_XGEN(b.x)]) == gen, bar);
            __builtin_amdgcn_fence(__ATOMIC_ACQUIRE, "agent");
            asm volatile("s_waitcnt vmcnt(0)" ::: "memory");
        }
    }
    __syncthreads();
}
struct Params { const void* in[33]; float* out; unsigned char* ws; int ph_lo, ph_hi; };
struct Frame { LAS unsigned char* lds; int tid, lane, wave, G, gw, ngw; };
#define INF(i) ((const float*)P.in[i])
constexpr int LDS_BYTES = 147456;
constexpr int RING_BYTES = 131072, MISC_OFF = LDS_BYTES - 128;

DI void dsincos(double r, double& s, double& c) {
    const double r2 = r * r; double ss = 1.0, cc = 1.0;
#pragma unroll
    for (int n = 16; n >= 1; --n) { ss = 1.0 - r2 * (1.0 / (double)((2 * n) * (2 * n + 1))) * ss; cc = 1.0 - r2 * (1.0 / (double)((2 * n - 1) * (2 * n))) * cc; }
    s = r * ss; c = cc;
}
DI void p0_rope(const Params& P, const Frame& F) {
    f32x2* tab = (f32x2*)(P.ws + WS_ROPE);
    for (int idx = blockIdx.x * 512 + F.tid; idx < 4100 * 32; idx += F.G * 512) {
        const int pi = idx >> 5, i = idx & 31; const int pos = pi < 4096 ? pi : 8192 + (pi - 4096);
        const float inv = exp2f(-(float)i * 0.41524101186092029f);
        const float ang = (float)pos * inv;
        const double a = (double)ang; const double k = rint(a * 0.15915494309189535); const double r = fma(-k, 6.283185307179586, a);
        double s, c; dsincos(r, s, c);
        tab[idx] = (f32x2){(float)c, (float)s};
    }
}
struct ColRef { const float* p; int ld, klo, khi; };
DI int perm64(int p) { return 32 * ((p >> 4) & 1) + 16 * (p >> 5) + (p & 15); }
DI int logical_col(int n) { return (n & ~63) + perm64(n & 63); }
template <class Src> DI void tr_item(const Src& S, int K, int nphys, bf16* WT, LAS float* scr, int item, int lane) {
    const int nblk = nphys / 32, kb = item / nblk, nb = item % nblk, k0 = 64 * kb, n0 = 32 * nb;
    const ColRef cr = S.col(n0 + (lane & 31));
#pragma unroll 8
    for (int i = 0; i < 32; ++i) { const int kk = 2 * i + (lane >> 5), k = k0 + kk;
        float v = 0.f; if (k >= cr.klo && k < cr.khi) v = cr.p[(size_t)(k - cr.klo) * cr.ld];
        scr[kk * 33 + (lane & 31)] = v; }
    LDS_WAIT(); asm volatile("" ::: "memory");
    const int c = lane & 7;
#pragma unroll
    for (int j = 0; j < 4; ++j) { const int n = (lane >> 3) + 8 * j; const LAS float* s = scr + (8 * c) * 33 + n;
        v4u o; o.x = pk2(s[0 * 33], s[1 * 33]); o.y = pk2(s[2 * 33], s[3 * 33]); o.z = pk2(s[4 * 33], s[5 * 33]); o.w = pk2(s[6 * 33], s[7 * 33]);
        *(v4u*)(WT + (size_t)(n0 + n) * K + k0 + 8 * c) = o; }
    LDS_WAIT(); asm volatile("" ::: "memory");
}
struct SrcPlain { const float* W; int ld, ncols;
    DI ColRef col(int n) const { const int l = logical_col(n); ColRef r; r.p = W + (l < ncols ? l : 0); r.ld = ld; r.klo = 0; r.khi = (l < ncols) ? (1 << 30) : 0; return r; } };
struct SrcGU { const float* Wg; const float* Wu;
    DI ColRef col(int n) const { const int l = logical_col(n), hd = l >> 6, d = l & 63; ColRef r; const uintptr_t a_ = (uintptr_t)Wg, b_ = (uintptr_t)Wu, m_ = (uintptr_t)0 - (uintptr_t)(d >= 32); r.p = (const float*)(a_ ^ ((a_ ^ b_) & m_)) + 32 * hd + (d & 31); r.ld = FF; r.klo = 0; r.khi = 1 << 30; return r; } };
struct SrcLora { const float* wu; const float* au; const float* gu;
    DI ColRef col(int n) const { const int l = logical_col(n), reg = l >> 9, c = l & 511; ColRef r; r.ld = 512;
        if (reg == 0) { r.p = wu + c; r.klo = 0; r.khi = 64; } else if (reg == 1) { r.p = au + c; r.klo = 64; r.khi = 128; } else { r.p = gu + c; r.klo = 128; r.khi = 256; } return r; } };
struct SrcCmp { const float* w1;
    DI ColRef col(int n) const { const int l = logical_col(n), kind = l >> 7, ab = (l >> 6) & 1, e = l & 63; ColRef r; r.p = w1 + (size_t)((kind * 32 + ab * 16) * 64) * 64 + e; r.ld = 64; r.klo = 0; r.khi = 1 << 30; return r; } };

DI void p0_weights(const Params& P, const Frame& F) {
    LAS float* scr = (LAS float*)(F.lds + F.wave * 16384);
    unsigned char* ws = P.ws;
    constexpr int I_IN0 = 16 * 96, I_G0 = 16 * 2, I_O = 16 * 32, I_GU = 16 * 176, I_DN = 44 * 32, I_IN1 = 16 * 48, I_LORA = 4 * 48, I_CMP = 16 * 8;
    constexpr int NIT = I_IN0 + I_G0 + 2 * I_O + 2 * I_GU + 2 * I_DN + I_IN1 + I_LORA + I_CMP;
    for (int it = F.gw; it < NIT; it += F.ngw) {
        int r = it;
        if (r < I_IN0) { tr_item(SrcPlain{INF(11), 3096, 3072}, 1024, 3072, (bf16*)(ws + WS_WIN0), scr, r, F.lane); continue; } r -= I_IN0;
        if (r < I_G0)  { tr_item(SrcPlain{INF(11) + 3072, 3096, 24}, 1024, 64, (bf16*)(ws + WS_WG0), scr, r, F.lane); continue; } r -= I_G0;
        if (r < I_O)   { tr_item(SrcPlain{INF(12), 1024, 1024}, 1024, 1024, (bf16*)(ws + WS_WOUT0), scr, r, F.lane); continue; } r -= I_O;
        if (r < I_O)   { tr_item(SrcPlain{INF(29), 1024, 1024}, 1024, 1024, (bf16*)(ws + WS_WOUT1), scr, r, F.lane); continue; } r -= I_O;
        if (r < I_GU)  { tr_item(SrcGU{INF(30), INF(31)}, 1024, 5632, (bf16*)(ws + WS_WGU0), scr, r, F.lane); continue; } r -= I_GU;
        if (r < I_GU)  { tr_item(SrcGU{INF(30) + (size_t)1024 * FF, INF(31) + (size_t)1024 * FF}, 1024, 5632, (bf16*)(ws + WS_WGU1), scr, r, F.lane); continue; } r -= I_GU;
        if (r < I_DN)  { tr_item(SrcPlain{INF(32), 1024, 1024}, FF, 1024, (bf16*)(ws + WS_WDN0), scr, r, F.lane); continue; } r -= I_DN;
        if (r < I_DN)  { tr_item(SrcPlain{INF(32) + (size_t)FF * 1024, 1024, 1024}, FF, 1024, (bf16*)(ws + WS_WDN1), scr, r, F.lane); continue; } r -= I_DN;
        if (r < I_IN1) { tr_item(SrcPlain{INF(28), 1536, 1536}, 1024, 1536, (bf16*)(ws + WS_WIN1), scr, r, F.lane); continue; } r -= I_IN1;
        if (r < I_LORA){ tr_item(SrcLora{INF(15), INF(17), INF(18)}, 256, 1536, (bf16*)(ws + WS_WLORA), scr, r, F.lane); continue; } r -= I_LORA;
        tr_item(SrcCmp{INF(25)}, 1024, 256, (bf16*)(ws + WS_WCMP), scr, r, F.lane);
    }
}
DI void norm_row_bf16(const float* xrow, const float* gain, bf16* orow, int lane) {
    f32x2 v[8]; float ss = 0.f;
#pragma unroll
    for (int i = 0; i < 8; ++i) { v[i] = *(const f32x2*)(xrow + 128 * i + 2 * lane); ss += v[i].x * v[i].x + v[i].y * v[i].y; }
    const float rs = 1.0f / sqrtf(wave_sum(ss) * (1.0f / 1024.0f) + 1e-6f);
#pragma unroll
    for (int i = 0; i < 8; ++i) { const f32x2 g = *(const f32x2*)(gain + 128 * i + 2 * lane); *(unsigned*)(orow + 128 * i + 2 * lane) = pk2(v[i].x * rs * g.x, v[i].y * rs * g.y); }
}
DI void norm_phase(const Frame& F, const float* src0, const float* src1, const float* gain, bf16* XN) {
    for (int m = F.gw; m < MP + MS; m += F.ngw) { const float* xr = m < MP ? src0 + (size_t)m * D : src1 + (size_t)(m - MP) * D; norm_row_bf16(xr, gain, XN + (size_t)m * D, F.lane); }
}
DI void p0_cache(const Params& P, const Frame& F) {
    const int* ptab = (const int*)P.in[7];
    { const float* cache = INF(2); bf16* A = (bf16*)(P.ws + WS_ACMPS);
      const int kind = F.lane >> 5, g = (F.lane >> 4) & 1, d = (F.lane & 15) * 4;
      for (int it0 = F.gw * 4; it0 < NSQ * PAST; it0 += F.ngw * 4) {
          f32x4 v[4];
#pragma unroll
          for (int j = 0; j < 4; ++j) { const int it = it0 + j, bs = it >> 13, t = it & 8191; const int page = ptab[bs * NPG + (t >> 7)];
              v[j] = *(const f32x4*)(cache + ((size_t)page * PAGE + (t & 127)) * 512 + 4 * F.lane); }
#pragma unroll
          for (int j = 0; j < 4; ++j) { const int it = it0 + j, bs = it >> 13, t = it & 8191;
              *(v2u*)(A + ((((size_t)kind * NSQ + bs) * 2 + g) * PAST + t) * 64 + d) = (v2u){pk2(v[j].x, v[j].y), pk2(v[j].z, v[j].w)}; }
      } }
    { const float* cache = INF(3); float* MEANS = (float*)(P.ws + WS_MEANS); LAS f32x4* red = (LAS f32x4*)F.lds;
      for (int it = blockIdx.x; it < NSQ * 32; it += F.G) { const int bs = it >> 5, nb = it & 31;
          const int page = ptab[bs * NPG + 2 * nb + (F.wave >> 2)], tok0 = (F.wave & 3) * 32;
          const float* src = cache + ((size_t)page * PAGE + tok0) * 512 + 4 * F.lane;
          f32x4 acc = {0.f, 0.f, 0.f, 0.f};
#pragma unroll 8
          for (int i = 0; i < 32; ++i) acc += *(const f32x4*)(src + (size_t)i * 512);
          red[F.wave * 64 + F.lane] = acc;
          __syncthreads();
          if (F.wave == 0) { f32x4 s = red[F.lane];
#pragma unroll
              for (int w = 1; w < 8; ++w) s += red[w * 64 + F.lane];
              s *= (1.0f / 256.0f);
              *(f32x4*)(MEANS + (((size_t)bs * 4 + (F.lane >> 4)) * 32 + nb) * 64 + (F.lane & 15) * 4) = s; }
          __syncthreads();
      } }
    { const f32x4* src = (const f32x4*)INF(4); f32x4* dst = (f32x4*)(P.out + O_WINS);
      for (int i = blockIdx.x * 512 + F.tid; i < NSQ * 508 * 64; i += F.G * 512) { const int bs = i / (508 * 64), r = i % (508 * 64); dst[(size_t)bs * 512 * 64 + r] = src[(size_t)bs * 512 * 64 + 4 * 64 + r]; } }
}

template <class Fn> struct EpiHead {
    static constexpr bool PERM = false, AFTER_DRAIN = false;
    Fn f;
    DI void operator()(const f32x4 (&acc)[2][2][4][2], const pg8::Unit& u, int wr, int wc, int fr, int fq) const {
#pragma unroll
        for (int ai = 0; ai < 2; ++ai)
#pragma unroll
            for (int m = 0; m < 4; ++m) { const int row = u.pm * 256 + ai * 128 + wr * 64 + m * 16 + fr;
#pragma unroll
                for (int bj = 0; bj < 2; ++bj) f(row, u.pn * 4 + bj * 2 + (wc >> 1), 16 * (wc & 1) + 4 * fq, acc[ai][bj][m][0], acc[ai][bj][m][1]); }
    }
};
template <class Fn> DI void skinny_unit(const bf16* A, const bf16* Bt, int K, int row0, int col0, const Fn& f, int wave, int lane) {
    const int fr = lane & 15, fq = lane >> 4;
    const bf16* ap = A + (size_t)(row0 + 16 * wave + fr) * K + 8 * fq;
    const bf16* bp = Bt + (size_t)(col0 + fr) * K + 8 * fq;
    f32x4 acc[4];
#pragma unroll
    for (int nn = 0; nn < 4; ++nn) acc[nn] = (f32x4){0.f, 0.f, 0.f, 0.f};
#pragma unroll 4
    for (int ks = 0; ks < K; ks += 32) { const bf16x8 a = *(const bf16x8*)(ap + ks);
#pragma unroll
        for (int nn = 0; nn < 4; ++nn) { const bf16x8 b = *(const bf16x8*)(bp + (size_t)nn * 16 * K + ks); acc[nn] = __builtin_amdgcn_mfma_f32_16x16x32_bf16(b, a, acc[nn], 0, 0, 0); } }
    const int row = row0 + 16 * wave + fr, head = col0 >> 6;
    f(row, head, 4 * fq, acc[0], acc[1]);
    f(row, head, 16 + 4 * fq, acc[2], acc[3]);
}
DI void st_bf16x4(bf16* p, f32x4 v) { *(v2u*)p = (v2u){pk2(v.x, v.y), pk2(v.z, v.w)}; }

struct EpiIn0 {
    bf16* RW; bf16* Q0; bf16* KV0; bf16* KVS0; const f32x2* rope; float* out;
    DI void operator()(int row, int head, int d4, f32x4 lo, f32x4 hi) const {
        if (row >= MP + MS) return;
        const bool samp = row >= MP; const int sr = row - MP;
        const int b = samp ? (sr >> 2) : (row >> 12), t = samp ? (sr & 3) : (row & 4095), ridx = samp ? 4096 + t : t;
        if (head < 28) {
            bf16* p = RW + (size_t)row * RWC + head * 64 + d4; st_bf16x4(p, lo); st_bf16x4(p + 32, hi);
            const bool last = samp ? (t == 3) : (t == SEQ - 1);
            if (last) { float* o = out + (samp ? O_SHS : O_SHP) + (size_t)b * RWC + head * 64 + d4; *(f32x4*)o = lo; *(f32x4*)(o + 32) = hi; }
            return;
        }
        const bool isq = head < 36; const int idx = head - 36; const int which = idx >> 2, kvsel = (idx >> 1) & 1, g = idx & 1;
        if (isq || kvsel == 0) {
            const f32x2* cs = rope + (size_t)ridx * 32 + d4; const f32x4 a = *(const f32x4*)cs, c2 = *(const f32x4*)(cs + 2);
            const f32x4 co = {a.x, a.z, c2.x, c2.z}, si = {a.y, a.w, c2.y, c2.w};
            const f32x4 x1 = lo, x2 = hi; lo = x1 * co - x2 * si; hi = x2 * co + x1 * si;
        }
        if (isq) { bf16* p = Q0 + (size_t)row * 512 + (head - 28) * 64 + d4; st_bf16x4(p, lo); st_bf16x4(p + 32, hi); return; }
        const int k6 = which * 2 + kvsel;
        bf16* p = samp ? KVS0 + ((((size_t)k6 * NSQ + b) * 2 + g) * 4 + t) * 64 + d4 : KV0 + ((((size_t)k6 * NB + b) * 2 + g) * SEQ + t) * 64 + d4;
        st_bf16x4(p, lo); st_bf16x4(p + 32, hi);
        if (which < 2) { float* o = out + (samp ? O_NSAS + (((size_t)sr * 4 + k6) * 2 + g) * 64 : O_NSAP + (((size_t)row * 4 + k6) * 2 + g) * 64) + d4; *(f32x4*)o = lo; *(f32x4*)(o + 32) = hi; }
        else if (samp) { float* o = out + O_WINS + ((((size_t)b * 512 + 508 + t) * 2 + kvsel) * 2 + g) * 64 + d4; *(f32x4*)o = lo; *(f32x4*)(o + 32) = hi; }
        else if (t >= SEQ - 512) { float* o = out + O_WINP + ((((size_t)b * 512 + (t - (SEQ - 512))) * 2 + kvsel) * 2 + g) * 64 + d4; *(f32x4*)o = lo; *(f32x4*)(o + 32) = hi; }
    }
};
struct EpiGates { float* G; const float* bias;
    DI void operator()(int row, int head, int d4, f32x4 lo, f32x4 hi) const {
        if (d4 >= 24) return; const f32x4 bv = *(const f32x4*)(bias + d4); f32x4 o;
        o.x = sigmoidf_(lo.x + bv.x); o.y = sigmoidf_(lo.y + bv.y); o.z = sigmoidf_(lo.z + bv.z); o.w = sigmoidf_(lo.w + bv.w);
        *(f32x4*)(G + (size_t)row * 32 + d4) = o; } };
struct EpiCmp { float* HC; int half_rows;
    DI void operator()(int row, int head, int d4, f32x4 lo, f32x4 hi) const {
        const int kind = row >= half_rows ? 1 : 0; if ((head >> 1) != kind) return;
        float* o = HC + (size_t)row * 128 + (head & 1) * 64 + d4; *(f32x4*)o = lo; *(f32x4*)(o + 32) = hi; } };
constexpr size_t RWKV_ARR = (size_t)MT * 512 * 4;
constexpr size_t WS_R = WS_END0, WS_K = WS_R + RWKV_ARR, WS_V = WS_K + RWKV_ARR, WS_KK = WS_V + RWKV_ARR, WS_W = WS_KK + RWKV_ARR, WS_KP = WS_W + RWKV_ARR,
                 WS_KKA = WS_KP + RWKV_ARR, WS_G = WS_KKA + RWKV_ARR, WS_Y = WS_G + RWKV_ARR;
constexpr size_t WS_LA = al(WS_Y + RWKV_ARR);
constexpr size_t WS_ATT = al(WS_LA + (size_t)MT * 256 * 2);
constexpr size_t WS_H = al(WS_ATT + (size_t)MT * 1024 * 2);
constexpr size_t WS_HFF = al(WS_H + (size_t)MT * 1024 * 4);
constexpr size_t WS_END1 = al(WS_HFF + (size_t)MT * FF * 2);

DI float red8(float v) {
    v += __builtin_bit_cast(float, __builtin_amdgcn_update_dpp(0, __builtin_bit_cast(int, v), 0xB1, 0xf, 0xf, false));
    v += __builtin_bit_cast(float, __builtin_amdgcn_update_dpp(0, __builtin_bit_cast(int, v), 0x4E, 0xf, 0xf, false));
    v += __builtin_bit_cast(float, __builtin_amdgcn_update_dpp(0, __builtin_bit_cast(int, v), 0x141, 0xf, 0xf, false));
    return v;
}
DI void ld_bf8(const bf16* p, float (&o)[8]) { const v4u u = *(const v4u*)p; o[0] = bflo(u.x); o[1] = bfhi(u.x); o[2] = bflo(u.y); o[3] = bfhi(u.y); o[4] = bflo(u.z); o[5] = bfhi(u.z); o[6] = bflo(u.w); o[7] = bfhi(u.w); }
DI void ld_f8(const float* p, float (&o)[8]) { const f32x4 a = *(const f32x4*)p, b = *(const f32x4*)(p + 4); o[0] = a.x; o[1] = a.y; o[2] = a.z; o[3] = a.w; o[4] = b.x; o[5] = b.y; o[6] = b.z; o[7] = b.w; }
DI void st_f8(float* p, const float (&o)[8]) { *(f32x4*)p = (f32x4){o[0], o[1], o[2], o[3]}; *(f32x4*)(p + 4) = (f32x4){o[4], o[5], o[6], o[7]}; }

DI void rwkv_prep(const Params& P, const Frame& F) {
    unsigned char* ws = P.ws; const bf16* RW = (const bf16*)(ws + WS_RW);
    const float* mu = INF(13); const float* k_k = INF(19); const float* sshift = INF(6);
    float* R_ = (float*)(ws + WS_R); float* K_ = (float*)(ws + WS_K); float* V_ = (float*)(ws + WS_V); float* KK_ = (float*)(ws + WS_KK); bf16* LA = (bf16*)(ws + WS_LA);
    const int lane = F.lane;
    for (int row = F.gw; row < MP + MS; row += F.ngw) {
        const bool samp = row >= MP; const int t = samp ? ((row - MP) & 3) : (row & 4095); const int bs = (row - MP) >> 2;
        const bf16* cur = RW + (size_t)row * RWC; const bf16* prv = cur - RWC;
#pragma unroll
        for (int part = 0; part < 3; ++part) {
            const int c = part * 512 + 8 * lane; float x[8], p[8], m[8];
            ld_bf8(cur + c, x); ld_f8(mu + c, m);
            if (t > 0) ld_bf8(prv + c, p); else if (samp) ld_f8(sshift + (size_t)bs * RWC + c, p); else {
#pragma unroll
                for (int e = 0; e < 8; ++e) p[e] = 0.f; }
#pragma unroll
            for (int e = 0; e < 8; ++e) x[e] = x[e] + (p[e] - x[e]) * m[e];
            float* dst = (part == 0 ? R_ : part == 1 ? K_ : V_) + (size_t)row * 512 + 8 * lane;
            st_f8(dst, x);
            if (part == 1) { float kc[8], q[8]; ld_f8(k_k + 8 * lane, kc); float ss = 0.f;
#pragma unroll
                for (int e = 0; e < 8; ++e) { q[e] = x[e] * kc[e]; ss += q[e] * q[e]; }
                ss = red8(ss); const float inv = 1.0f / fmaxf(sqrtf(ss), 1e-12f);
#pragma unroll
                for (int e = 0; e < 8; ++e) q[e] *= inv;
                st_f8(KK_ + (size_t)row * 512 + 8 * lane, q); }
        }
        { const int c = 1536 + 4 * lane; const v2u uc = *(const v2u*)(cur + c); float x[4] = {bflo(uc.x), bfhi(uc.x), bflo(uc.y), bfhi(uc.y)}, p[4];
          const f32x4 m = *(const f32x4*)(mu + c);
          if (t > 0) { const v2u up = *(const v2u*)(prv + c); p[0] = bflo(up.x); p[1] = bfhi(up.x); p[2] = bflo(up.y); p[3] = bfhi(up.y); }
          else if (samp) { const f32x4 s4 = *(const f32x4*)(sshift + (size_t)bs * RWC + c); p[0] = s4.x; p[1] = s4.y; p[2] = s4.z; p[3] = s4.w; }
          else { p[0] = p[1] = p[2] = p[3] = 0.f; }
          x[0] += (p[0] - x[0]) * m.x; x[1] += (p[1] - x[1]) * m.y; x[2] += (p[2] - x[2]) * m.z; x[3] += (p[3] - x[3]) * m.w;
          const int reg = lane >> 4;
#pragma unroll
          for (int e = 0; e < 4; ++e) { if (reg == 0) x[e] = 1.0f - 2.0f / (__expf(2.0f * x[e]) + 1.0f); else if (reg >= 2) x[e] = sigmoidf_(x[e]); }
          *(v2u*)(LA + (size_t)row * 256 + 4 * lane) = (v2u){pk2(x[0], x[1]), pk2(x[2], x[3])}; }
    }
}
struct EpiLora {
    const float* w0; const float* a0; const float* k_a; const float* K_; const float* KK_; float* W_; float* KP_; float* KKA_; float* G_;
    DI void operator()(int row, int head, int d4, f32x4 lo, f32x4 hi) const {
        if (row >= MP + MS) return;
        const int reg = head >> 3, c0 = (head & 7) * 64 + d4;
#pragma unroll
        for (int hh = 0; hh < 2; ++hh) { const int c = c0 + 32 * hh; const f32x4 x = hh ? hi : lo; const size_t o = (size_t)row * 512 + c;
            if (reg == 0) { const f32x4 b = *(const f32x4*)(w0 + c); f32x4 r;
                r.x = __expf(-0.6065306597126334f * sigmoidf_(b.x + x.x)); r.y = __expf(-0.6065306597126334f * sigmoidf_(b.y + x.y));
                r.z = __expf(-0.6065306597126334f * sigmoidf_(b.z + x.z)); r.w = __expf(-0.6065306597126334f * sigmoidf_(b.w + x.w)); *(f32x4*)(W_ + o) = r; }
            else if (reg == 1) { const f32x4 b = *(const f32x4*)(a0 + c), ka = *(const f32x4*)(k_a + c), k = *(const f32x4*)(K_ + o), kk = *(const f32x4*)(KK_ + o); f32x4 a;
                a.x = sigmoidf_(b.x + x.x); a.y = sigmoidf_(b.y + x.y); a.z = sigmoidf_(b.z + x.z); a.w = sigmoidf_(b.w + x.w);
                *(f32x4*)(KP_ + o) = k * (1.0f + (a - 1.0f) * ka); *(f32x4*)(KKA_ + o) = kk * a; }
            else { *(f32x4*)(G_ + o) = x; } }
    }
};
constexpr int SC_CH = 32, SC_STEP = 384;
DI void scan_chain(const Params& P, const Frame& F, int row0, int h, int nsteps, const float* S0, float* Sout) {
    unsigned char* ws = P.ws;
    const float* a0p = (const float*)(ws + WS_W); const float* a1p = (const float*)(ws + WS_KK); const float* a2p = (const float*)(ws + WS_KKA);
    const float* a3p = (const float*)(ws + WS_KP); const float* a4p = (const float*)(ws + WS_R); const float* a5p = (const float*)(ws + WS_V);
    float* Y_ = (float*)(ws + WS_Y);
    LAS float* buf = (LAS float*)F.lds;
    LAS float* ybuf = (LAS float*)(F.lds + 2 * SC_CH * SC_STEP * 4);
    const int lane = F.lane, i = 8 * F.wave + (lane >> 3), j0 = 8 * (lane & 7);
    float S[8];
    if (S0) ld_f8(S0 + i * 64 + j0, S); else {
#pragma unroll
        for (int e = 0; e < 8; ++e) S[e] = 0.f; }
    f32x4 st0, st1, st2, st3, st4, st5;
    const int lstep = F.tid >> 4, lc4 = (F.tid & 15) * 4;
    const size_t goff = (size_t)(row0 + lstep) * 512 + h * 64 + lc4;
#define SC_GLOAD(step0) do { const bool ok_ = (step0) + lstep < nsteps; const size_t o_ = goff + (size_t)(step0) * 512; const f32x4 z_ = {0.f, 0.f, 0.f, 0.f}; \
        st0 = ok_ ? *(const f32x4*)(a0p + o_) : z_; st1 = ok_ ? *(const f32x4*)(a1p + o_) : z_; st2 = ok_ ? *(const f32x4*)(a2p + o_) : z_; \
        st3 = ok_ ? *(const f32x4*)(a3p + o_) : z_; st4 = ok_ ? *(const f32x4*)(a4p + o_) : z_; st5 = ok_ ? *(const f32x4*)(a5p + o_) : z_; } while (0)
#define SC_LSTORE(bi) do { LAS float* d_ = buf + (bi) * SC_CH * SC_STEP + lstep * SC_STEP + lc4; \
        *(LAS f32x4*)(d_) = st0; *(LAS f32x4*)(d_ + 64) = st1; *(LAS f32x4*)(d_ + 128) = st2; *(LAS f32x4*)(d_ + 192) = st3; *(LAS f32x4*)(d_ + 256) = st4; *(LAS f32x4*)(d_ + 320) = st5; } while (0)
    SC_GLOAD(0); SC_LSTORE(0); __syncthreads();
    const int nch = (nsteps + SC_CH - 1) / SC_CH;
    for (int ch = 0; ch < nch; ++ch) {
        const int bi = ch & 1; if (ch + 1 < nch) SC_GLOAD((ch + 1) * SC_CH);
        const LAS float* cb = buf + bi * SC_CH * SC_STEP;
        const int rem = nsteps - ch * SC_CH, ns = rem < SC_CH ? rem : SC_CH;
        for (int s = 0; s < ns; ++s) { const LAS float* sb = cb + s * SC_STEP;
            const f32x4 w0 = *(const LAS f32x4*)(sb + j0), w1 = *(const LAS f32x4*)(sb + j0 + 4), k0 = *(const LAS f32x4*)(sb + 64 + j0), k1 = *(const LAS f32x4*)(sb + 64 + j0 + 4);
            const f32x4 a0 = *(const LAS f32x4*)(sb + 128 + j0), a1 = *(const LAS f32x4*)(sb + 128 + j0 + 4), p0 = *(const LAS f32x4*)(sb + 192 + j0), p1 = *(const LAS f32x4*)(sb + 192 + j0 + 4);
            const f32x4 r0 = *(const LAS f32x4*)(sb + 256 + j0), r1 = *(const LAS f32x4*)(sb + 256 + j0 + 4); const float vi = sb[320 + i];
            float sk = (S[0] * k0.x + S[1] * k0.y) + (S[2] * k0.z + S[3] * k0.w) + ((S[4] * k1.x + S[5] * k1.y) + (S[6] * k1.z + S[7] * k1.w));
            sk = red8(sk);
            S[0] = S[0] * w0.x + vi * p0.x - sk * a0.x; S[1] = S[1] * w0.y + vi * p0.y - sk * a0.y; S[2] = S[2] * w0.z + vi * p0.z - sk * a0.z; S[3] = S[3] * w0.w + vi * p0.w - sk * a0.w;
            S[4] = S[4] * w1.x + vi * p1.x - sk * a1.x; S[5] = S[5] * w1.y + vi * p1.y - sk * a1.y; S[6] = S[6] * w1.z + vi * p1.z - sk * a1.z; S[7] = S[7] * w1.w + vi * p1.w - sk * a1.w;
            float y = (S[0] * r0.x + S[1] * r0.y) + (S[2] * r0.z + S[3] * r0.w) + ((S[4] * r1.x + S[5] * r1.y) + (S[6] * r1.z + S[7] * r1.w));
            y = red8(y);
            if ((lane & 7) == 0) ybuf[s * 64 + i] = y;
        }
        __syncthreads();
#pragma unroll
        for (int m = 0; m < 4; ++m) { const int q = F.tid + 512 * m, step = q >> 6, c = q & 63; if (step < ns) Y_[(size_t)(row0 + ch * SC_CH + step) * 512 + h * 64 + c] = ybuf[q]; }
        if (ch + 1 < nch) SC_LSTORE(bi ^ 1);
        __syncthreads();
    }
#undef SC_GLOAD
#undef SC_LSTORE
    st_f8(Sout + i * 64 + j0, S);
}
DI void rwkv_post(const Params& P, const Frame& F) {
    unsigned char* ws = P.ws; const float* r_k = INF(21); const float* ln_g = INF(22); const float* ln_b = INF(23);
    const float* R_ = (const float*)(ws + WS_R); const float* KP_ = (const float*)(ws + WS_KP); const float* V_ = (const float*)(ws + WS_V); const float* G_ = (const float*)(ws + WS_G); const float* Y_ = (const float*)(ws + WS_Y);
    bf16* ATT = (bf16*)(ws + WS_ATT); const int lane = F.lane, c = 8 * lane;
    float rk[8], lg[8], lb[8]; ld_f8(r_k + c, rk); ld_f8(ln_g + c, lg); ld_f8(ln_b + c, lb);
    for (int row = F.gw; row < MP + MS; row += F.ngw) { const size_t o = (size_t)row * 512 + c;
        float y[8], r[8], k[8], v[8], g[8]; ld_f8(Y_ + o, y); ld_f8(R_ + o, r); ld_f8(KP_ + o, k); ld_f8(V_ + o, v); ld_f8(G_ + o, g);
        float s = 0.f, bs = 0.f;
#pragma unroll
        for (int e = 0; e < 8; ++e) { s += y[e]; bs += r[e] * k[e] * rk[e]; }
        s = red8(s); bs = red8(bs); const float mean = s * (1.0f / 64.0f); float q = 0.f;
#pragma unroll
        for (int e = 0; e < 8; ++e) { y[e] -= mean; q += y[e] * y[e]; }
        q = red8(q); const float rstd = 1.0f / sqrtf(q * (1.0f / 64.0f) + 64e-5f);
        float o8[8];
#pragma unroll
        for (int e = 0; e < 8; ++e) o8[e] = (y[e] * rstd * lg[e] + lb[e] + bs * v[e]) * g[e];
        *(v4u*)(ATT + (size_t)row * 1024 + c) = (v4u){pk2(o8[0], o8[1]), pk2(o8[2], o8[3]), pk2(o8[4], o8[5]), pk2(o8[6], o8[7])};
    }
}
typedef short v4i16_t __attribute__((ext_vector_type(4)));
DI int crow(int r, int hi) { return (r & 3) + 8 * (r >> 2) + 4 * hi; }
DI float half_max(float v) { auto rr = __builtin_amdgcn_permlane32_swap(__float_as_uint(v), __float_as_uint(v), false, false); return fmaxf(__uint_as_float(rr[0]), __uint_as_float(rr[1])); }
DI float half_sum(float v) { auto rr = __builtin_amdgcn_permlane32_swap(__float_as_uint(v), __float_as_uint(v), false, false); return __uint_as_float(rr[0]) + __uint_as_float(rr[1]); }
DI s16x4 vtr(const LAS unsigned char* p) { return __builtin_bit_cast(s16x4, __builtin_amdgcn_ds_read_tr16_b64_v4i16((LAS v4i16_t*)p)); }
#define MFMA32(a, b, c) __builtin_amdgcn_mfma_f32_32x32x16_bf16((a), (b), (c), 0, 0, 0)
constexpr float ATT_SC = 0.125f * 1.4426950408889634f;
struct AttnAcc { f32x16 o0, o1; float m, l; };
DI void acc_init(AttnAcc& A) {
#pragma unroll
    for (int i = 0; i < 16; ++i) { A.o0[i] = 0.f; A.o1[i] = 0.f; }
    A.m = -INFINITY; A.l = 0.f; }
DI void ld_q(const bf16* qrow, bf16x8 (&qr)[4], int hi) {
#pragma unroll
    for (int d0 = 0; d0 < 4; ++d0) qr[d0] = *(const bf16x8*)(qrow + 16 * d0 + 8 * hi); }
DI void qk_tile(const LAS unsigned char* Kt, const bf16x8 (&qr)[4], f32x16& p0, f32x16& p1, int lane) {
    const LAS unsigned char* kb = Kt + (lane >> 5) * 1024 + (lane & 31) * 16;
#pragma unroll
    for (int i = 0; i < 16; ++i) { p0[i] = 0.f; p1[i] = 0.f; }
#pragma unroll
    for (int d0 = 0; d0 < 4; ++d0) { const bf16x8 b0 = *(const LAS bf16x8*)(kb + d0 * 2048), b1 = *(const LAS bf16x8*)(kb + d0 * 2048 + 512);
        p0 = MFMA32(b0, qr[d0], p0); p1 = MFMA32(b1, qr[d0], p1); }
}
DI bf16x8 pack8(const f32x16& p, int s) { v4u u; u.x = pk2(p[8 * s], p[8 * s + 1]); u.y = pk2(p[8 * s + 2], p[8 * s + 3]); u.z = pk2(p[8 * s + 4], p[8 * s + 5]); u.w = pk2(p[8 * s + 6], p[8 * s + 7]); return __builtin_bit_cast(bf16x8, u); }
DI void pv_tile(const LAS unsigned char* Vt, const f32x16& p0, const f32x16& p1, f32x16& o0, f32x16& o1, int lane) {
    const int hi = lane >> 5;
    const LAS unsigned char* vp = Vt + ((lane >> 4) & 1) * 32 + (lane & 3) * 8 + (4 * hi + ((lane & 15) >> 2)) * 64;
#pragma unroll
    for (int cc = 0; cc < 2; ++cc)
#pragma unroll
        for (int s = 0; s < 2; ++s) { const int ks = 2 * cc + s; const bf16x8 pb = pack8(cc ? p1 : p0, s);
#pragma unroll
            for (int d0 = 0; d0 < 2; ++d0) { const s16x4 lo = vtr(vp + d0 * 4096 + ks * 1024), h4 = vtr(vp + d0 * 4096 + ks * 1024 + 512);
                const bf16x8 a = {lo[0], lo[1], lo[2], lo[3], h4[0], h4[1], h4[2], h4[3]};
                if (d0 == 0) o0 = MFMA32(a, pb, o0); else o1 = MFMA32(a, pb, o1); } }
}
template <int MODE> DI void mask_scale(f32x16& p0, f32x16& p1, bool rowok, int a, int hi) {
#pragma unroll
    for (int i = 0; i < 16; ++i) { const int k0 = crow(i, hi), k1 = k0 + 32;
        bool v0 = rowok, v1 = rowok;
        if (MODE == 1) { v0 = v0 && (k0 <= a); v1 = v1 && (k1 <= a); }
        if (MODE == 2) { v0 = v0 && (k0 > a); v1 = v1 && (k1 > a); }
        p0[i] = v0 ? p0[i] * ATT_SC : -INFINITY; p1[i] = v1 ? p1[i] * ATT_SC : -INFINITY; }
}
template <int MODE> DI void attn_tile(const LAS unsigned char* Kt, const LAS unsigned char* Vt, const bf16x8 (&qr)[4], AttnAcc& A, bool rowok, int a, int lane) {
    f32x16 p0, p1; qk_tile(Kt, qr, p0, p1, lane);
    mask_scale<MODE>(p0, p1, rowok, a, lane >> 5);
    float mx = fmaxf(p0[0], p1[0]);
#pragma unroll
    for (int i = 1; i < 16; ++i) mx = fmaxf(mx, fmaxf(p0[i], p1[i]));
    mx = half_max(mx);
    const float mnew = fmaxf(A.m, mx), muse = (mnew == -INFINITY) ? 0.f : mnew, alpha = __builtin_amdgcn_exp2f(A.m - muse);
    float ls = 0.f;
#pragma unroll
    for (int i = 0; i < 16; ++i) { p0[i] = __builtin_amdgcn_exp2f(p0[i] - muse); p1[i] = __builtin_amdgcn_exp2f(p1[i] - muse); ls += p0[i] + p1[i]; }
    A.l = A.l * alpha + ls; A.m = mnew;
#pragma unroll
    for (int i = 0; i < 16; ++i) { A.o0[i] *= alpha; A.o1[i] *= alpha; }
    pv_tile(Vt, p0, p1, A.o0, A.o1, lane);
}
struct TileRegs { v4u k, v; };
DI void tile_gload(TileRegs& R, const bf16* Kt, const bf16* Vt, int wave, int lane) {
    R.k = *(const v4u*)(Kt + (size_t)lane * 64 + wave * 8);
    R.v = *(const v4u*)(Vt + (size_t)(16 * (wave & 3) + (lane >> 2)) * 64 + 32 * (wave >> 2) + 8 * (lane & 3));
}
DI void tile_lstore(const TileRegs& R, LAS unsigned char* kb, LAS unsigned char* vb, int wave, int lane) {
    *(LAS v4u*)(kb + wave * 1024 + lane * 16) = R.k; *(LAS v4u*)(vb + wave * 1024 + lane * 16) = R.v; }
DI void branch_out(f32x16& out0, f32x16& out1, const AttnAcc& A, float gate) {
    const float lt = half_sum(A.l); const float sc = gate / fmaxf(lt, 1e-30f);
#pragma unroll
    for (int i = 0; i < 16; ++i) { out0[i] += A.o0[i] * sc; out1[i] += A.o1[i] * sc; }
}
template <bool FIRST> DI void branch_out_lds(LAS float* ob, const AttnAcc& A, float gate) {
    const float lt = half_sum(A.l); const float sc = gate / fmaxf(lt, 1e-30f);
#pragma unroll
    for (int i = 0; i < 16; ++i) { if (FIRST) { ob[i] = A.o0[i] * sc; ob[16 + i] = A.o1[i] * sc; } else { ob[i] += A.o0[i] * sc; ob[16 + i] += A.o1[i] * sc; } }
}
DI void store_ot(bf16* dst, const f32x16& o0, const f32x16& o1, int hi) {
#pragma unroll
    for (int gi = 0; gi < 4; ++gi) { *(v2u*)(dst + 8 * gi + 4 * hi) = (v2u){pk2(o0[4 * gi], o0[4 * gi + 1]), pk2(o0[4 * gi + 2], o0[4 * gi + 3])};
        *(v2u*)(dst + 32 + 8 * gi + 4 * hi) = (v2u){pk2(o1[4 * gi], o1[4 * gi + 1]), pk2(o1[4 * gi + 2], o1[4 * gi + 3])}; }
}
constexpr size_t WS_BIASC = WS_END1;
constexpr size_t WS_KCP = al(WS_BIASC + 2 * 64 * 4);
constexpr size_t WS_KCS = al(WS_KCP + (size_t)2 * 8 * 256 * 64 * 2);
constexpr size_t WS_END2 = al(WS_KCS + (size_t)2 * 64 * 512 * 64 * 2);

DI void p0_cmp_bias(const Params& P, const Frame& F) {
    const float* pe = INF(26); const float* w1 = INF(25); float* B = (float*)(P.ws + WS_BIASC);
    for (int it = F.gw; it < 128; it += F.ngw) { const int kind = it >> 6, e = it & 63; float s = 0.f;
        for (int i = 0; i < 32; ++i) { const int idx = F.lane + 64 * i; s += pe[kind * 2048 + idx] * w1[((size_t)kind * 2048 + idx) * 64 + e]; }
        s = wave_sum(s); if (F.lane == 0) B[it] = s; }
}
DI float gelu_tanh(float x) { const float u = 0.7978845608028654f * (x + 0.044715f * x * x * x); const float t = 1.0f - 2.0f / (__expf(2.0f * u) + 1.0f); return 0.5f * x * (1.0f + t); }
DI void cmp_stage2(const Params& P, const Frame& F) {
    unsigned char* ws = P.ws; LAS float* w2s = (LAS float*)F.lds;
    for (int i = F.tid; i < 2 * 64 * 64; i += 512) w2s[i] = INF(27)[i];
    __syncthreads();
    const float* bias = (const float*)(ws + WS_BIASC); const float* HCP = (const float*)(ws + WS_HCP); const float* HCS = (const float*)(ws + WS_HCS);
    bf16* KCP = (bf16*)(ws + WS_KCP); bf16* KCS = (bf16*)(ws + WS_KCS); const int lane = F.lane;
    for (int it = F.gw; it < 4096 + 65536; it += F.ngw) {
        const bool samp = it >= 4096; const int r = samp ? it - 4096 : it; const int half = samp ? 32768 : 2048, nn = samp ? 512 : 256;
        const int kind = r >= half ? 1 : 0, n = r & (nn - 1); const float* HC = samp ? HCS : HCP; bf16* dst = (samp ? KCS : KCP) + (size_t)r * 64 + lane;
        if (n == nn - 1) { *dst = 0; continue; }
        const float h = gelu_tanh(HC[(size_t)r * 128 + lane] + HC[(size_t)(r + 1) * 128 + 64 + lane] + bias[kind * 64 + lane]);
        float acc = 0.f; const LAS float* w2k = w2s + kind * 4096 + lane;
#pragma unroll
        for (int e = 0; e < 64; ++e) acc += __builtin_bit_cast(float, __builtin_amdgcn_readlane(__builtin_bit_cast(int, h), e)) * w2k[e * 64];
        *dst = (bf16)(pk2(acc, 0.f) & 0xffffu);
    }
}
template <class Body> DI void kv_loop(TileRegs& R, int& cur, LAS unsigned char* kvb, int jb, int je, const bf16* KB, const bf16* VB, int wave, int lane, Body&& body) {
    tile_gload(R, KB + (size_t)jb * 4096, VB + (size_t)jb * 4096, wave, lane); tile_lstore(R, kvb + cur * 16384, kvb + cur * 16384 + 8192, wave, lane); __syncthreads();
    for (int j = jb; j <= je; ++j) { if (j < je) tile_gload(R, KB + (size_t)(j + 1) * 4096, VB + (size_t)(j + 1) * 4096, wave, lane);
        { const LAS unsigned char* Kt_ = kvb + cur * 16384; body(j, Kt_, Kt_ + 8192); }
        if (j < je) tile_lstore(R, kvb + (cur ^ 1) * 16384, kvb + (cur ^ 1) * 16384 + 8192, wave, lane); __syncthreads(); cur ^= 1; }
}
constexpr int NSA_KV_OFF = 0, NSA_IMP_OFF = 32768, NSA_SEL_OFF = NSA_IMP_OFF + 2 * 64 * 65 * 4, NSA_OUT_OFF = NSA_SEL_OFF + 512;
DI void nsa_prompt_unit(const Params& P, const Frame& F, int b, int g, int qb) {
    unsigned char* ws = P.ws; int lane_ = F.lane; asm volatile("" : "+v"(lane_));
    const int lane = lane_, wave = F.wave, r32 = lane & 31, hi = lane >> 5;
    const int tl = 8 * wave + (r32 >> 2), hh = r32 & 3, t0 = 64 * qb, tok = t0 + tl, row = b * SEQ + tok, head = g * 4 + hh;
    LAS unsigned char* kvb = F.lds + NSA_KV_OFF;
    LAS float* impM = (LAS float*)(F.lds + NSA_IMP_OFF); LAS float* impS = impM + 64 * 65;
    LAS unsigned long long* selm = (LAS unsigned long long*)(F.lds + NSA_SEL_OFF);
    bf16x8 qr[4]; ld_q((const bf16*)(ws + WS_Q0) + (size_t)row * 512 + head * 64, qr, hi);
    const float* gt = (const float*)(ws + WS_GATES) + (size_t)row * 32 + head * 3; const float g0 = gt[0], g1 = gt[1], g2 = gt[2];
    const bf16* KV0 = (const bf16*)(ws + WS_KV0);
    LAS float* outb = (LAS float*)(F.lds + NSA_OUT_OFF) + (wave * 64 + lane) * 33;
    TileRegs R; int cur = 0;
    const int ncv = tok >= 31 ? ((tok - 15) >> 4) : 0, ntc = (4 * qb + 66) >> 6;
    const bf16* KC = (const bf16*)(ws + WS_KCP) + (size_t)((0 * 4 + b) * 2 + g) * 256 * 64; const bf16* VC = (const bf16*)(ws + WS_KCP) + (size_t)((1 * 4 + b) * 2 + g) * 256 * 64;
    AttnAcc A; acc_init(A);
    kv_loop(R, cur, kvb, 0, ntc - 1, KC, VC, wave, lane, [&](int j, const LAS unsigned char* Kt_, const LAS unsigned char* Vt_) { attn_tile<1>(Kt_, Vt_, qr, A, true, ncv - 1 - 64 * j, lane); });
    branch_out_lds<true>(outb, A, g0);
    {
      const float lt = half_sum(A.l), rl = 1.0f / fmaxf(lt, 1e-30f), mfin = (A.m == -INFINITY) ? 0.f : A.m;
      for (int i = lane; i < 8 * 65; i += 64) { impM[wave * 8 * 65 + i] = 0.f; impS[wave * 8 * 65 + i] = 0.f; }
      kv_loop(R, cur, kvb, 0, ntc - 1, KC, VC, wave, lane, [&](int j, const LAS unsigned char* Kt_, const LAS unsigned char* Vt_) {
          f32x16 p0, p1; qk_tile(Kt_, qr, p0, p1, lane); mask_scale<1>(p0, p1, true, ncv - 1 - 64 * j, hi);
#pragma unroll
          for (int cc = 0; cc < 2; ++cc)
#pragma unroll
              for (int gi = 0; gi < 4; ++gi) { const f32x16& p = cc ? p1 : p0;
                  const float e0 = __builtin_amdgcn_exp2f(p[4 * gi] - mfin) * rl, e1 = __builtin_amdgcn_exp2f(p[4 * gi + 1] - mfin) * rl, e2 = __builtin_amdgcn_exp2f(p[4 * gi + 2] - mfin) * rl, e3 = __builtin_amdgcn_exp2f(p[4 * gi + 3] - mfin) * rl;
                  float mn = e0 + e1 + e2 + 0.5f * e3, sp = 0.5f * e3;
                  mn += __builtin_bit_cast(float, __builtin_amdgcn_update_dpp(0, __builtin_bit_cast(int, mn), 0xB1, 0xf, 0xf, false)); mn += __builtin_bit_cast(float, __builtin_amdgcn_update_dpp(0, __builtin_bit_cast(int, mn), 0x4E, 0xf, 0xf, false));
                  sp += __builtin_bit_cast(float, __builtin_amdgcn_update_dpp(0, __builtin_bit_cast(int, sp), 0xB1, 0xf, 0xf, false)); sp += __builtin_bit_cast(float, __builtin_amdgcn_update_dpp(0, __builtin_bit_cast(int, sp), 0x4E, 0xf, 0xf, false));
                  const int jj = 16 * j + 8 * cc + 2 * gi + hi;
                  if (hh == 0) { impM[tl * 65 + jj] = mn; impS[tl * 65 + jj + 1] = sp; } } });
    }
    {
#pragma unroll 1
      for (int tt = 0; tt < 8; ++tt) { const int tq = 8 * wave + tt;
          float sc = -INFINITY;
          if (lane <= qb) { sc = impM[tq * 65 + lane] + impS[tq * 65 + lane]; if (lane == qb || lane == qb - 1 || lane == 0) sc += 100.0f; }
          int cnt = 0; int ln = lane; asm volatile("" : "+v"(ln));
#pragma unroll
          for (int jp = 0; jp < 64; ++jp) { const float o = __builtin_bit_cast(float, __builtin_amdgcn_readlane(__builtin_bit_cast(int, sc), jp)); cnt += (o > sc || (o == sc && jp < ln)) ? 1 : 0; }
          const unsigned long long m = __ballot(lane <= qb && cnt < 16);
          if (lane == 0) selm[tq] = m; }
    }
    __syncthreads();
    const unsigned long long mysel = selm[tl];
    { const bf16* KS = KV0 + (size_t)((2 * 4 + b) * 2 + g) * SEQ * 64; const bf16* VS = KV0 + (size_t)((3 * 4 + b) * 2 + g) * SEQ * 64;
      acc_init(A);
      kv_loop(R, cur, kvb, 0, qb, KS, VS, wave, lane, [&](int j, const LAS unsigned char* Kt_, const LAS unsigned char* Vt_) { const bool ok = (mysel >> j) & 1ull; if (j == qb) attn_tile<1>(Kt_, Vt_, qr, A, ok, tl, lane); else attn_tile<0>(Kt_, Vt_, qr, A, ok, 0, lane); });
      branch_out_lds<false>(outb, A, g1); }
    { const bf16* KW = KV0 + (size_t)((4 * 4 + b) * 2 + g) * SEQ * 64; const bf16* VW = KV0 + (size_t)((5 * 4 + b) * 2 + g) * SEQ * 64;
      acc_init(A); const int jlo = qb >= 8 ? qb - 8 : 0;
      kv_loop(R, cur, kvb, jlo, qb, KW, VW, wave, lane, [&](int j, const LAS unsigned char* Kt_, const LAS unsigned char* Vt_) { if (j == qb) attn_tile<1>(Kt_, Vt_, qr, A, true, tl, lane); else if (j == qb - 8) attn_tile<2>(Kt_, Vt_, qr, A, true, tl, lane); else attn_tile<0>(Kt_, Vt_, qr, A, true, 0, lane); });
      branch_out_lds<false>(outb, A, g2); }
    { f32x16 out0, out1;
#pragma unroll
      for (int i = 0; i < 16; ++i) { out0[i] = outb[i]; out1[i] = outb[16 + i]; }
      store_ot((bf16*)(ws + WS_ATT) + (size_t)row * 1024 + 512 + head * 64, out0, out1, hi); }
}
constexpr size_t WS_Q1 = WS_END2;
constexpr size_t WS_K1 = al(WS_Q1 + (size_t)MT * 1024 * 2);
constexpr size_t WS_V1 = al(WS_K1 + (size_t)16 * SEQ * 64 * 2);
constexpr size_t WS_K1S = al(WS_V1 + (size_t)16 * SEQ * 64 * 2);
constexpr size_t WS_V1S = al(WS_K1S + (size_t)NSQ * 4 * 4 * 64 * 2);
constexpr size_t WS_MEANH = al(WS_V1S + (size_t)NSQ * 4 * 4 * 64 * 2);
constexpr size_t WS_MEANL = al(WS_MEANH + (size_t)16 * 64 * 64 * 2);
constexpr size_t WS_END3 = al(WS_MEANL + (size_t)16 * 64 * 64 * 2);

struct EpiResid { const float* base0; const float* base1; float* H;
    DI void operator()(int row, int head, int d4, f32x4 lo, f32x4 hi) const {
        if (row >= MP + MS) return;
        const float* b = (row < MP ? base0 + (size_t)row * D : base1 + (size_t)(row - MP) * D) + head * 64 + d4; float* o = H + (size_t)row * D + head * 64 + d4;
        const f32x4 b0 = *(const f32x4*)b, b1 = *(const f32x4*)(b + 32); *(f32x4*)o = b0 + lo; *(f32x4*)(o + 32) = b1 + hi; } };
struct EpiSwiglu { bf16* HFF;
    DI void operator()(int row, int head, int d4, f32x4 lo, f32x4 hi) const {
        if (row >= MP + MS) return;
        f32x4 r; r.x = lo.x * sigmoidf_(lo.x) * hi.x; r.y = lo.y * sigmoidf_(lo.y) * hi.y; r.z = lo.z * sigmoidf_(lo.z) * hi.z; r.w = lo.w * sigmoidf_(lo.w) * hi.w;
        st_bf16x4(HFF + (size_t)row * FF + 32 * head + d4, r); } };
struct EpiIn1 { bf16* Q1; bf16* K1; bf16* K1S; const f32x2* rope; float* out;
    DI void operator()(int row, int head, int d4, f32x4 lo, f32x4 hi) const {
        if (row >= MP + MS) return;
        const bool samp = row >= MP; const int sr = row - MP; const int b = samp ? (sr >> 2) : (row >> 12), t = samp ? (sr & 3) : (row & 4095), ridx = samp ? 4096 + t : t;
        if (head < 20) { const f32x2* cs = rope + (size_t)ridx * 32 + d4; const f32x4 a = *(const f32x4*)cs, c2 = *(const f32x4*)(cs + 2);
            const f32x4 co = {a.x, a.z, c2.x, c2.z}, si = {a.y, a.w, c2.y, c2.w}; const f32x4 x1 = lo, x2 = hi; lo = x1 * co - x2 * si; hi = x2 * co + x1 * si; }
        if (head < 16) { bf16* p = Q1 + (size_t)row * 1024 + head * 64 + d4; st_bf16x4(p, lo); st_bf16x4(p + 32, hi); return; }
        const int kv = head >= 20 ? 1 : 0, kvh = (head - 16) & 3;
        bf16* p = samp ? K1S + (size_t)kv * ((WS_V1S - WS_K1S) / 2) + (((size_t)b * 4 + kvh) * 4 + t) * 64 + d4 : K1 + (size_t)kv * ((WS_V1 - WS_K1) / 2) + (((size_t)b * 4 + kvh) * SEQ + t) * 64 + d4;
        st_bf16x4(p, lo); st_bf16x4(p + 32, hi);
        float* o = out + (samp ? O_MOBS + (((size_t)sr * 2 + kv) * 4 + kvh) * 64 : O_MOBP + (((size_t)row * 2 + kv) * 4 + kvh) * 64) + d4; *(f32x4*)o = lo; *(f32x4*)(o + 32) = hi; } };
DI void final_norm(const Params& P, const Frame& F) {
    const float* H = (const float*)(P.ws + WS_H); const float* gain = INF(10);
    for (int m = F.gw; m < MP + MS; m += F.ngw) { const float* xr = H + (size_t)m * D; float* o = P.out + (m < MP ? O_YP + (size_t)m * D : O_YS + (size_t)(m - MP) * D);
        f32x4 v[4]; float ss = 0.f;
#pragma unroll
        for (int i = 0; i < 4; ++i) { v[i] = *(const f32x4*)(xr + 256 * i + 4 * F.lane); ss += v[i].x * v[i].x + v[i].y * v[i].y + v[i].z * v[i].z + v[i].w * v[i].w; }
        const float rs = 1.0f / sqrtf(wave_sum(ss) * (1.0f / 1024.0f) + 1e-6f);
#pragma unroll
        for (int i = 0; i < 4; ++i) { const f32x4 g = *(const f32x4*)(gain + 256 * i + 4 * F.lane); *(f32x4*)(o + 256 * i + 4 * F.lane) = v[i] * rs * g; } }
}
DI void moba_means(const Params& P, const Frame& F) {
    unsigned char* ws = P.ws; const bf16* K1 = (const bf16*)(ws + WS_K1); bf16* MH = (bf16*)(ws + WS_MEANH); bf16* ML = (bf16*)(ws + WS_MEANL); const int lane = F.lane;
    for (int it = F.gw; it < 256; it += F.ngw) { const int bk = it >> 4, blk = it & 15; const bf16* src = K1 + ((size_t)bk * SEQ + blk * 256) * 64;
        float acc[8];
#pragma unroll
        for (int e = 0; e < 8; ++e) acc[e] = 0.f;
        for (int i = 0; i < 32; ++i) { float x[8]; ld_bf8(src + (size_t)(8 * i + (lane >> 3)) * 64 + (lane & 7) * 8, x);
#pragma unroll
            for (int e = 0; e < 8; ++e) acc[e] += x[e]; }
#pragma unroll
        for (int e = 0; e < 8; ++e) { acc[e] += __shfl_xor(acc[e], 8); acc[e] += __shfl_xor(acc[e], 16); acc[e] += __shfl_xor(acc[e], 32); acc[e] *= (1.0f / 256.0f); }
        if (lane < 8) { unsigned h[4], l[4];
#pragma unroll
            for (int e = 0; e < 4; ++e) { h[e] = pk2(acc[2 * e], acc[2 * e + 1]); l[e] = pk2(acc[2 * e] - bflo(h[e]), acc[2 * e + 1] - bfhi(h[e])); }
            *(v4u*)(MH + ((size_t)bk * 64 + blk) * 64 + lane * 8) = (v4u){h[0], h[1], h[2], h[3]}; *(v4u*)(ML + ((size_t)bk * 64 + blk) * 64 + lane * 8) = (v4u){l[0], l[1], l[2], l[3]}; }
    }
    for (int i = blockIdx.x * 512 + F.tid; i < 16 * 48 * 8; i += F.G * 512) { const int bk = i / (48 * 8), r = i % (48 * 8); const size_t o = ((size_t)bk * 64 + 16) * 64 + (size_t)r * 8;
        *(v4u*)(MH + o) = (v4u){0u, 0u, 0u, 0u}; *(v4u*)(ML + o) = (v4u){0u, 0u, 0u, 0u}; }
}
DI void moba_prompt_unit(const Params& P, const Frame& F, int b, int kvh, int qb) {
    unsigned char* ws = P.ws; int lane_ = F.lane; asm volatile("" : "+v"(lane_));
    const int lane = lane_, wave = F.wave, r32 = lane & 31, hi = lane >> 5;
    const int tl = 8 * wave + (r32 >> 2), hh = r32 & 3, row = b * SEQ + 64 * qb + tl, head = kvh * 4 + hh, cur = qb >> 2;
    LAS unsigned char* kvb = F.lds;
    bf16x8 qr[4]; ld_q((const bf16*)(ws + WS_Q1) + (size_t)row * 1024 + head * 64, qr, hi);
    TileRegs R; int cb = 0; unsigned rowmask = 1u << cur;
    if (cur > 0) {
        const bf16* MH = (const bf16*)(ws + WS_MEANH) + (size_t)(b * 4 + kvh) * 4096; const bf16* ML = (const bf16*)(ws + WS_MEANL) + (size_t)(b * 4 + kvh) * 4096;
        tile_gload(R, MH, ML, wave, lane); { v4u k2 = *(const v4u*)(ML + (size_t)lane * 64 + wave * 8); tile_lstore(R, kvb, kvb + 8192, wave, lane); *(LAS v4u*)(kvb + 16384 + wave * 1024 + lane * 16) = k2; }
        __syncthreads();
        f32x16 p0, p1, q0, q1; qk_tile(kvb, qr, p0, p1, lane); qk_tile(kvb + 16384, qr, q0, q1, lane);
        float gs[16];
#pragma unroll
        for (int i = 0; i < 8; ++i) { const float v = p0[i] + q0[i]; auto rr = __builtin_amdgcn_permlane32_swap(__float_as_uint(v), __float_as_uint(v), false, false);
            gs[8 * (i >> 2) + (i & 3)] = __uint_as_float(rr[0]); gs[8 * (i >> 2) + 4 + (i & 3)] = __uint_as_float(rr[1]); }
        unsigned taken = 0;
#pragma unroll
        for (int pass = 0; pass < 3; ++pass) { float best = -INFINITY; int bi = -1;
#pragma unroll
            for (int n = 0; n < 16; ++n) { const bool c = (n < cur) && !((taken >> n) & 1u) && (gs[n] > best); best = c ? gs[n] : best; bi = c ? n : bi; }
            if (bi >= 0) taken |= 1u << bi; }
        rowmask |= taken;
        __syncthreads();
    }
    const bf16* KB = (const bf16*)(ws + WS_K1) + (size_t)(b * 4 + kvh) * SEQ * 64; const bf16* VB = (const bf16*)(ws + WS_V1) + (size_t)(b * 4 + kvh) * SEQ * 64;
    AttnAcc A; acc_init(A);
    kv_loop(R, cb, kvb, 0, qb, KB, VB, wave, lane, [&](int j, const LAS unsigned char* Kt_, const LAS unsigned char* Vt_) { const bool ok = (rowmask >> (j >> 2)) & 1u;
        if (j == qb) attn_tile<1>(Kt_, Vt_, qr, A, ok, tl, lane); else attn_tile<0>(Kt_, Vt_, qr, A, ok, 0, lane); });
    const float lt = half_sum(A.l), sc = 1.0f / fmaxf(lt, 1e-30f);
#pragma unroll
    for (int i = 0; i < 16; ++i) { A.o0[i] *= sc; A.o1[i] *= sc; }
    store_ot((bf16*)(ws + WS_ATT) + (size_t)row * 1024 + head * 64, A.o0, A.o1, hi);
}
constexpr int SM_MO = 0, SM_MM = 69632, SM_ML = 70656, SM_TAB = RING_BYTES + 1024;
DI void wave_fence() { asm volatile("s_waitcnt lgkmcnt(0)" ::: "memory"); __builtin_amdgcn_wave_barrier(); asm volatile("" ::: "memory"); }
DI void stage_row_f32(LAS unsigned char* kb, LAS unsigned char* vb, const float* kp, const float* vp, int lane) {
#pragma unroll
    for (int c = 0; c < 8; ++c) { if ((c & 1) == 0) asm volatile("" ::: "memory");
        v4u ku = {0u, 0u, 0u, 0u}, vu = {0u, 0u, 0u, 0u};
        if (kp) { const f32x4 a = *(const f32x4*)(kp + 8 * c), b2 = *(const f32x4*)(kp + 8 * c + 4); ku = (v4u){pk2(a.x, a.y), pk2(a.z, a.w), pk2(b2.x, b2.y), pk2(b2.z, b2.w)}; }
        if (vp) { const f32x4 a = *(const f32x4*)(vp + 8 * c), b2 = *(const f32x4*)(vp + 8 * c + 4); vu = (v4u){pk2(a.x, a.y), pk2(a.z, a.w), pk2(b2.x, b2.y), pk2(b2.z, b2.w)}; }
        *(LAS v4u*)(kb + c * 1024 + lane * 16) = ku; *(LAS v4u*)(vb + (c >> 2) * 4096 + lane * 64 + (c & 3) * 16) = vu; }
}
DI void stage_row_bf16(LAS unsigned char* kb, LAS unsigned char* vb, const bf16* kp, const bf16* vp, int lane) {
#pragma unroll
    for (int c = 0; c < 8; ++c) { v4u ku = {0u, 0u, 0u, 0u}, vu = {0u, 0u, 0u, 0u};
        if (kp) ku = *(const v4u*)(kp + 8 * c);
        if (vp) vu = *(const v4u*)(vp + 8 * c);
        *(LAS v4u*)(kb + c * 1024 + lane * 16) = ku; *(LAS v4u*)(vb + (c >> 2) * 4096 + lane * 64 + (c & 3) * 16) = vu; }
}
DI void merge_waves(const Frame& F, AttnAcc& A, int lane, int wave) {
    LAS float* mo = (LAS float*)(F.lds + SM_MO); LAS float* mm = (LAS float*)(F.lds + SM_MM); LAS float* ml = (LAS float*)(F.lds + SM_ML);
    const float lt = half_sum(A.l);
    __syncthreads();
#pragma unroll
    for (int i = 0; i < 16; ++i) { mo[(wave * 64 + lane) * 33 + i] = A.o0[i]; mo[(wave * 64 + lane) * 33 + 16 + i] = A.o1[i]; }
    if (lane < 32) { mm[wave * 32 + lane] = A.m; ml[wave * 32 + lane] = lt; }
    __syncthreads();
    const int r32 = lane & 31; float M = -INFINITY;
#pragma unroll
    for (int w = 0; w < 8; ++w) M = fmaxf(M, mm[w * 32 + r32]);
    const float Mu = (M == -INFINITY) ? 0.f : M; float L = 0.f;
#pragma unroll
    for (int i = 0; i < 16; ++i) { A.o0[i] = 0.f; A.o1[i] = 0.f; }
#pragma unroll 1
    for (int w = 0; w < 8; ++w) { const float sc = __builtin_amdgcn_exp2f(mm[w * 32 + r32] - Mu); L += ml[w * 32 + r32] * sc;
#pragma unroll
        for (int i = 0; i < 16; ++i) { A.o0[i] += mo[(w * 64 + lane) * 33 + i] * sc; A.o1[i] += mo[(w * 64 + lane) * 33 + 16 + i] * sc; } }
    A.m = M; A.l = 0.5f * L;
    __syncthreads();
}
DI void nsa_sample_unit(const Params& P, const Frame& F, int bs, int g) {
    unsigned char* ws = P.ws; int lane_ = F.lane; asm volatile("" : "+v"(lane_));
    const int lane = lane_, wave = F.wave, r32 = lane & 31, hi = lane >> 5, ts = r32 >> 2, hh = r32 & 3, head = g * 4 + hh; const bool rowv = ts < 4;
    const int row = MP + bs * 4 + (ts & 3);
    LAS unsigned char* kb = F.lds + wave * 16384; LAS unsigned char* vb = kb + 8192;
    LAS float* impM = (LAS float*)(F.lds + SM_TAB); LAS float* impS = impM + 4 * 132; LAS unsigned long long* selS = (LAS unsigned long long*)(F.lds + SM_TAB + 2 * 4 * 132 * 4);
    const int* ptab = (const int*)P.in[7] + bs * NPG;
    bf16x8 qr[4]; ld_q((const bf16*)(ws + WS_Q0) + (size_t)row * 512 + head * 64, qr, hi);
    const float* gt = (const float*)(ws + WS_GATES) + (size_t)row * 32 + head * 3; const float g0 = gt[0], g1 = gt[1], g2 = gt[2];
    const bf16* KVS0 = (const bf16*)(ws + WS_KVS0);
    LAS float* outb = (LAS float*)(F.lds + SM_TAB + 4608) + lane * 33;
    const bf16* KC = (const bf16*)(ws + WS_KCS) + ((size_t)((0 * NSQ + bs) * 2 + g) * 512 + 64 * wave + lane) * 64;
    const bf16* VC = (const bf16*)(ws + WS_KCS) + ((size_t)((1 * NSQ + bs) * 2 + g) * 512 + 64 * wave + lane) * 64;
    for (int i = F.tid; i < 2 * 4 * 132; i += 512) impM[i] = 0.f;
    AttnAcc A; acc_init(A);
    stage_row_bf16(kb, vb, KC, VC, lane); wave_fence();
    attn_tile<1>(kb, vb, qr, A, rowv, 510 - 64 * wave, lane);
    merge_waves(F, A, lane, wave);
    if (wave == 0) branch_out_lds<true>(outb, A, g0);
    { const float lt = half_sum(A.l), rl = 1.0f / fmaxf(lt, 1e-30f), mfin = (A.m == -INFINITY) ? 0.f : A.m;
      stage_row_bf16(kb, vb, KC, nullptr, lane); wave_fence();
      f32x16 p0, p1; qk_tile(kb, qr, p0, p1, lane); mask_scale<1>(p0, p1, rowv, 510 - 64 * wave, hi);
#pragma unroll
      for (int cc = 0; cc < 2; ++cc)
#pragma unroll
          for (int gi = 0; gi < 4; ++gi) { const f32x16& p = cc ? p1 : p0;
              const float e0 = __builtin_amdgcn_exp2f(p[4 * gi] - mfin) * rl, e1 = __builtin_amdgcn_exp2f(p[4 * gi + 1] - mfin) * rl, e2 = __builtin_amdgcn_exp2f(p[4 * gi + 2] - mfin) * rl, e3 = __builtin_amdgcn_exp2f(p[4 * gi + 3] - mfin) * rl;
              float mn = e0 + e1 + e2 + 0.5f * e3, sp = 0.5f * e3;
              mn += __builtin_bit_cast(float, __builtin_amdgcn_update_dpp(0, __builtin_bit_cast(int, mn), 0xB1, 0xf, 0xf, false)); mn += __builtin_bit_cast(float, __builtin_amdgcn_update_dpp(0, __builtin_bit_cast(int, mn), 0x4E, 0xf, 0xf, false));
              sp += __builtin_bit_cast(float, __builtin_amdgcn_update_dpp(0, __builtin_bit_cast(int, sp), 0xB1, 0xf, 0xf, false)); sp += __builtin_bit_cast(float, __builtin_amdgcn_update_dpp(0, __builtin_bit_cast(int, sp), 0x4E, 0xf, 0xf, false));
              const int jj = 16 * wave + 8 * cc + 2 * gi + hi;
              if (hh == 0 && rowv) { impM[ts * 132 + jj] = mn; impS[ts * 132 + jj + 1] = sp; } } }
    __syncthreads();
    if (wave < 4) { const int tq = wave;
        float s0 = impM[tq * 132 + lane] + impS[tq * 132 + lane], s1 = impM[tq * 132 + 64 + lane] + impS[tq * 132 + 64 + lane];
        float s2 = (lane == 0) ? impM[tq * 132 + 128] + impS[tq * 132 + 128] + 100.0f : -INFINITY;
        if (lane == 0) s0 += 100.0f; if (lane == 63) s1 += 100.0f;
        int c0 = 0, c1 = 0, c2 = 0; int ln = lane; asm volatile("" : "+v"(ln));
#pragma unroll 8
        for (int jp = 0; jp < 64; ++jp) { const float o = __shfl(s0, jp); c0 += (o > s0 || (o == s0 && jp < ln)) ? 1 : 0; c1 += (o >= s1) ? 1 : 0; c2 += (o >= s2) ? 1 : 0; }
#pragma unroll 8
        for (int jp = 0; jp < 64; ++jp) { const float o = __shfl(s1, jp); c0 += (o > s0) ? 1 : 0; c1 += (o > s1 || (o == s1 && jp < ln)) ? 1 : 0; c2 += (o >= s2) ? 1 : 0; }
        { const float o = __shfl(s2, 0); c0 += (o > s0) ? 1 : 0; c1 += (o > s1) ? 1 : 0; }
        const unsigned long long m0 = __ballot(c0 < 16), m1 = __ballot(c1 < 16), m2 = __ballot(lane == 0 && c2 < 16);
        if (lane == 0) { selS[tq * 4 + 0] = m0; selS[tq * 4 + 1] = m1; selS[tq * 4 + 2] = m2; } }
    __syncthreads();
    const unsigned long long my0 = selS[(ts & 3) * 4 + 0], my1 = selS[(ts & 3) * 4 + 1], my2 = selS[(ts & 3) * 4 + 2];
    const unsigned long long u0v = selS[0] | selS[4] | selS[8] | selS[12], u1v = selS[1] | selS[5] | selS[9] | selS[13];
    const unsigned long long u0 = ((unsigned long long)(unsigned)__builtin_amdgcn_readfirstlane((int)(u0v >> 32)) << 32) | (unsigned)__builtin_amdgcn_readfirstlane((int)u0v);
    const unsigned long long u1 = ((unsigned long long)(unsigned)__builtin_amdgcn_readfirstlane((int)(u1v >> 32)) << 32) | (unsigned)__builtin_amdgcn_readfirstlane((int)u1v);
    { acc_init(A); const float* cache = INF(2); int k = 0;
      for (int j = 0; j < 129; ++j) { const bool inu = j < 64 ? ((u0 >> j) & 1ull) : j < 128 ? ((u1 >> (j - 64)) & 1ull) : true; if (!inu) continue;
          if ((k++ & 7) != wave) continue;
          const bool ok = rowv && (j < 64 ? ((my0 >> j) & 1ull) : j < 128 ? ((my1 >> (j - 64)) & 1ull) : (my2 & 1ull));
          if (j < 128) { const int page = ptab[j >> 1]; const float* base = cache + ((size_t)page * PAGE + (j & 1) * 64 + lane) * 512 + g * 64;
              stage_row_f32(kb, vb, base + 256, base + 384, lane); wave_fence(); attn_tile<0>(kb, vb, qr, A, ok, 0, lane); }
          else { const bf16* kn = lane < 4 ? KVS0 + ((((size_t)2 * NSQ + bs) * 2 + g) * 4 + lane) * 64 : nullptr; const bf16* vn = lane < 4 ? KVS0 + ((((size_t)3 * NSQ + bs) * 2 + g) * 4 + lane) * 64 : nullptr;
              stage_row_bf16(kb, vb, kn, vn, lane); wave_fence(); attn_tile<1>(kb, vb, qr, A, ok, ts, lane); }
          wave_fence(); }
      merge_waves(F, A, lane, wave); if (wave == 0) branch_out_lds<false>(outb, A, g1); }
    { acc_init(A); const float* wbuf = INF(4) + (size_t)bs * 512 * 256;
      for (int tile = wave; tile < 9; tile += 8) { const int idx = 64 * tile + lane;
          if (tile < 8) { const float* base = wbuf + (size_t)idx * 256 + g * 64; stage_row_f32(kb, vb, base, base + 128, lane); }
          else { const bf16* kn = lane < 4 ? KVS0 + ((((size_t)4 * NSQ + bs) * 2 + g) * 4 + lane) * 64 : nullptr; const bf16* vn = lane < 4 ? KVS0 + ((((size_t)5 * NSQ + bs) * 2 + g) * 4 + lane) * 64 : nullptr;
              stage_row_bf16(kb, vb, kn, vn, lane); }
          wave_fence();
          if (tile == 0) attn_tile<2>(kb, vb, qr, A, rowv, ts, lane); else if (tile == 8) attn_tile<1>(kb, vb, qr, A, rowv, ts, lane); else attn_tile<0>(kb, vb, qr, A, rowv, 0, lane);
          wave_fence(); }
      merge_waves(F, A, lane, wave); if (wave == 0) branch_out_lds<false>(outb, A, g2); }
    if (wave == 0) { f32x16 out0, out1;
#pragma unroll
        for (int i = 0; i < 16; ++i) { out0[i] = outb[i]; out1[i] = outb[16 + i]; }
        if (rowv) store_ot((bf16*)(ws + WS_ATT) + (size_t)row * 1024 + 512 + head * 64, out0, out1, hi); }
}
DI void moba_sample_unit(const Params& P, const Frame& F, int bs, int kvh) {
    unsigned char* ws = P.ws; int lane_ = F.lane; asm volatile("" : "+v"(lane_));
    const int lane = lane_, wave = F.wave, r32 = lane & 31, hi = lane >> 5, ts = r32 >> 2, hh = r32 & 3, head = kvh * 4 + hh; const bool rowv = ts < 4;
    const int row = MP + bs * 4 + (ts & 3);
    LAS unsigned char* kb = F.lds + wave * 16384; LAS unsigned char* vb = kb + 8192;
    const int* ptab = (const int*)P.in[7] + bs * NPG;
    bf16x8 qr[4]; ld_q((const bf16*)(ws + WS_Q1) + (size_t)row * 1024 + head * 64, qr, hi);
    unsigned long long rowmask = 1ull << 32;
    { const float* mp = (const float*)(ws + WS_MEANS) + (((size_t)bs * 4 + kvh) * 32 + (lane & 31)) * 64;
#pragma unroll
      for (int c = 0; c < 8; ++c) { v4u hu = {0u, 0u, 0u, 0u}, lu = {0u, 0u, 0u, 0u};
          if (lane < 32) { const f32x4 a = *(const f32x4*)(mp + 8 * c), b2 = *(const f32x4*)(mp + 8 * c + 4);
              hu = (v4u){pk2(a.x, a.y), pk2(a.z, a.w), pk2(b2.x, b2.y), pk2(b2.z, b2.w)};
              lu = (v4u){pk2(a.x - bflo(hu.x), a.y - bfhi(hu.x)), pk2(a.z - bflo(hu.y), a.w - bfhi(hu.y)), pk2(b2.x - bflo(hu.z), b2.y - bfhi(hu.z)), pk2(b2.z - bflo(hu.w), b2.w - bfhi(hu.w))}; }
          *(LAS v4u*)(kb + c * 1024 + lane * 16) = hu; *(LAS v4u*)(vb + c * 1024 + lane * 16) = lu; }
      wave_fence();
      f32x16 p0, p1, q0, q1; qk_tile(kb, qr, p0, p1, lane); qk_tile(vb, qr, q0, q1, lane);
      float gs[32];
#pragma unroll
      for (int i = 0; i < 16; ++i) { const float v = p0[i] + q0[i]; auto rr = __builtin_amdgcn_permlane32_swap(__float_as_uint(v), __float_as_uint(v), false, false);
          gs[8 * (i >> 2) + (i & 3)] = __uint_as_float(rr[0]); gs[8 * (i >> 2) + 4 + (i & 3)] = __uint_as_float(rr[1]); }
      unsigned taken = 0;
#pragma unroll
      for (int pass = 0; pass < 3; ++pass) { float best = -INFINITY; int bi = -1;
#pragma unroll
          for (int n = 0; n < 32; ++n) { const bool c = !((taken >> n) & 1u) && (gs[n] > best); best = c ? gs[n] : best; bi = c ? n : bi; }
          if (bi >= 0) taken |= 1u << bi; }
      rowmask |= (unsigned long long)taken;
      wave_fence(); }
    unsigned umask = 0;
#pragma unroll
    for (int n = 0; n < 32; ++n) if (__ballot(rowv && ((rowmask >> n) & 1ull)) != 0ull) umask |= 1u << n;
    AttnAcc A; acc_init(A); const float* cache = INF(3); int k = 0;
    for (int blk = 0; blk < 32; ++blk) { if (!((umask >> blk) & 1u)) continue;
        const bool ok = rowv && ((rowmask >> blk) & 1ull);
        for (int q4 = 0; q4 < 4; ++q4) { if ((k++ & 7) != wave) continue;
            const int page = ptab[2 * blk + (q4 >> 1)]; const float* base = cache + ((size_t)page * PAGE + (q4 & 1) * 64 + lane) * 512 + kvh * 64;
            stage_row_f32(kb, vb, base, base + 256, lane); wave_fence(); attn_tile<0>(kb, vb, qr, A, ok, 0, lane); wave_fence(); } }
    if ((k & 7) == wave) { const bf16* kn = lane < 4 ? (const bf16*)(ws + WS_K1S) + (((size_t)bs * 4 + kvh) * 4 + lane) * 64 : nullptr; const bf16* vn = lane < 4 ? (const bf16*)(ws + WS_V1S) + (((size_t)bs * 4 + kvh) * 4 + lane) * 64 : nullptr;
        stage_row_bf16(kb, vb, kn, vn, lane); wave_fence(); attn_tile<1>(kb, vb, qr, A, rowv, ts, lane); wave_fence(); }
    merge_waves(F, A, lane, wave);
    const float lt = half_sum(A.l), sc = 1.0f / fmaxf(lt, 1e-30f);
#pragma unroll
    for (int i = 0; i < 16; ++i) { A.o0[i] *= sc; A.o1[i] *= sc; }
    if (wave == 0 && rowv) store_ot((bf16*)(ws + WS_ATT) + (size_t)row * 1024 + head * 64, A.o0, A.o1, hi);
}
constexpr int N_PHASES = 19;
__global__ void __launch_bounds__(512, 2) mk_fwd(Params P) {
    extern __shared__ __attribute__((aligned(16))) unsigned char lds_raw[];
    Frame F;
    F.lds = (LAS unsigned char*)lds_raw;
    F.tid = threadIdx.x; F.lane = F.tid & 63; F.wave = __builtin_amdgcn_readfirstlane(F.tid >> 6);
    F.G = gridDim.x; F.gw = blockIdx.x * NWAVES + F.wave; F.ngw = F.G * NWAVES;
    volatile LAS unsigned* MISC = (volatile LAS unsigned*)(F.lds + MISC_OFF);
    for (int u = F.tid; u < (LDS_BYTES - RING_BYTES) / 4; u += 512) ((LAS unsigned*)(F.lds + RING_BYTES))[u] = 0u;
    __syncthreads();
    unsigned char* ws = P.ws;
    unsigned* ctl = (unsigned*)(ws + WS_CTL);
    XcdBarrier bar = xcd_barrier_post(ctl + 4096, MISC + 8);
    const int lo = P.ph_lo, hi = P.ph_hi;
#define IN(k) (lo <= (k) && (k) < hi)
#define SEAM(k) do { if (IN(k) && IN((k) + 1)) xcd_barrier(bar); } while (0)

    if (IN(0)) {
        p0_rope(P, F);
        p0_weights(P, F);
        __syncthreads();
        norm_phase(F, INF(0), INF(1), INF(8), (bf16*)(ws + WS_XN));
        p0_cache(P, F);
        p0_cmp_bias(P, F);
    }
    SEAM(0);
    if (IN(1)) {
        EpiIn0 e0{(bf16*)(ws + WS_RW), (bf16*)(ws + WS_Q0), (bf16*)(ws + WS_KV0), (bf16*)(ws + WS_KVS0), (const f32x2*)(ws + WS_ROPE), P.out};
        { pg8::Gemm g{(const bf16*)(ws + WS_XN), (const bf16*)(ws + WS_WIN0), MP, 3072, 1024}; pg8::StaticOrder S; S.init(MP, 3072, F.G, (int)blockIdx.x);
          EpiHead<EpiIn0> E{e0};
          pg8::gemm_phase<EpiHead<EpiIn0>, pg8::StaticOrder, PG8_ALIGN, PG8_SP2>(F.lds, g, S, E); }
        __syncthreads();
        { pg8::Gemm g{(const bf16*)(ws + WS_ACMPS), (const bf16*)(ws + WS_WCMP), 65536, 256, 1024}; pg8::StaticOrder S; S.init(65536, 256, F.G, (int)blockIdx.x);
          EpiHead<EpiCmp> E{EpiCmp{(float*)(ws + WS_HCS), 32768}};
          pg8::gemm_phase<EpiHead<EpiCmp>, pg8::StaticOrder, PG8_ALIGN, PG8_SP2>(F.lds, g, S, E); }
        __syncthreads();
        for (int u = F.G - 1 - (int)blockIdx.x; u < 48 + 129; u += F.G) {
            if (u < 48) skinny_unit((const bf16*)(ws + WS_XN), (const bf16*)(ws + WS_WIN0), 1024, MP, 64 * u, e0, F.wave, F.lane);
            else skinny_unit((const bf16*)(ws + WS_XN), (const bf16*)(ws + WS_WG0), 1024, 128 * (u - 48), 0, EpiGates{(float*)(ws + WS_GATES), INF(24)}, F.wave, F.lane);
        }
    }
    SEAM(1);
    if (IN(2)) {
        { pg8::Gemm g{(const bf16*)(ws + WS_KV0), (const bf16*)(ws + WS_WCMP), 4096, 256, 1024}; pg8::StaticOrder S; S.init(4096, 256, F.G, (int)blockIdx.x);
          EpiHead<EpiCmp> E{EpiCmp{(float*)(ws + WS_HCP), 2048}};
          pg8::gemm_phase<EpiHead<EpiCmp>, pg8::StaticOrder, PG8_ALIGN, PG8_SP2>(F.lds, g, S, E); }
        __syncthreads();
        rwkv_prep(P, F);
    }
    SEAM(2);
    if (IN(3)) {
        EpiLora el{INF(14), INF(16), INF(20), (const float*)(ws + WS_K), (const float*)(ws + WS_KK), (float*)(ws + WS_W), (float*)(ws + WS_KP), (float*)(ws + WS_KKA), (float*)(ws + WS_G)};
        { pg8::Gemm g{(const bf16*)(ws + WS_LA), (const bf16*)(ws + WS_WLORA), MP, 1536, 256}; pg8::StaticOrder S; S.init(MP, 1536, F.G, (int)blockIdx.x);
          EpiHead<EpiLora> E{el};
          pg8::gemm_phase<EpiHead<EpiLora>, pg8::StaticOrder, PG8_ALIGN, PG8_SP2>(F.lds, g, S, E); }
        __syncthreads();
        for (int u = F.G - 1 - (int)blockIdx.x; u < 24; u += F.G) skinny_unit((const bf16*)(ws + WS_LA), (const bf16*)(ws + WS_WLORA), 256, MP, 64 * u, el, F.wave, F.lane);
        cmp_stage2(P, F);
    }
    SEAM(3);
    if (IN(4)) {
        if ((int)blockIdx.x < 32 && F.G >= 64) { const int b = blockIdx.x >> 3, h = blockIdx.x & 7; scan_chain(P, F, b * SEQ, h, SEQ, nullptr, P.out + O_WKVP + (size_t)blockIdx.x * 4096); }
        else { const int first = F.G >= 64 ? 32 : 0, nb = F.G - first;
            for (int c = (int)blockIdx.x - first; c < 256 + (F.G >= 64 ? 0 : 32); c += nb) {
                if (c < 256) { const int bs = c >> 3, h = c & 7; scan_chain(P, F, MP + bs * 4, h, 4, INF(5) + (size_t)c * 4096, P.out + O_WKVS + (size_t)c * 4096); }
                else { const int cc = c - 256; scan_chain(P, F, (cc >> 3) * SEQ, cc & 7, SEQ, nullptr, P.out + O_WKVP + (size_t)cc * 4096); }
                __syncthreads(); }
            __syncthreads();
            for (int i = (int)blockIdx.x - first; i < 512; i += nb) { const int bg = i >> 6, k = i & 63, qb = (k & 1) ? 63 - (k >> 1) : (k >> 1); nsa_prompt_unit(P, F, bg >> 1, bg & 1, qb); __syncthreads(); }
            for (int i = nb - 1 - ((int)blockIdx.x - first); i < 64; i += nb) { nsa_sample_unit(P, F, i >> 1, i & 1); __syncthreads(); }
        }
    }
    SEAM(4);
    if (IN(5)) { rwkv_post(P, F); }
    SEAM(5);
#define GEMM_PHASE(EPI_T, epi, Aptr, Bptr, N_, K_, nskinny) do { \
        { pg8::Gemm g{(const bf16*)(Aptr), (const bf16*)(Bptr), MP, (N_), (K_)}; pg8::StaticOrder S; S.init(MP, (N_), F.G, (int)blockIdx.x); EpiHead<EPI_T> E{epi}; \
          pg8::gemm_phase<EpiHead<EPI_T>, pg8::StaticOrder, PG8_ALIGN, PG8_SP2>(F.lds, g, S, E); } \
        __syncthreads(); \
        for (int u = F.G - 1 - (int)blockIdx.x; u < (nskinny); u += F.G) skinny_unit((const bf16*)(Aptr), (const bf16*)(Bptr), (K_), MP, 64 * u, epi, F.wave, F.lane); } while (0)
    float* Hres = (float*)(ws + WS_H);
    if (IN(6)) { EpiResid e{INF(0), INF(1), Hres}; GEMM_PHASE(EpiResid, e, ws + WS_ATT, ws + WS_WOUT0, 1024, 1024, 16); }
    SEAM(6);
    if (IN(7)) { norm_phase(F, Hres, Hres + (size_t)MP * D, INF(9), (bf16*)(ws + WS_XN)); }
    SEAM(7);
    if (IN(8)) { EpiSwiglu e{(bf16*)(ws + WS_HFF)}; GEMM_PHASE(EpiSwiglu, e, ws + WS_XN, ws + WS_WGU0, 5632, 1024, 88); }
    SEAM(8);
    if (IN(9)) { EpiResid e{Hres, Hres + (size_t)MP * D, Hres}; GEMM_PHASE(EpiResid, e, ws + WS_HFF, ws + WS_WDN0, 1024, FF, 16); }
    SEAM(9);
    if (IN(10)) { norm_phase(F, Hres, Hres + (size_t)MP * D, INF(8) + D, (bf16*)(ws + WS_XN)); }
    SEAM(10);
    if (IN(11)) { EpiIn1 e{(bf16*)(ws + WS_Q1), (bf16*)(ws + WS_K1), (bf16*)(ws + WS_K1S), (const f32x2*)(ws + WS_ROPE), P.out};
        GEMM_PHASE(EpiIn1, e, ws + WS_XN, ws + WS_WIN1, 1536, 1024, 24); }
    SEAM(11);
    if (IN(12)) { moba_means(P, F); }
    SEAM(12);
    if (IN(13)) {
        for (int i = (int)blockIdx.x; i < 1024; i += F.G) { const int bk = i >> 6, k = i & 63, qb = (k & 1) ? 63 - (k >> 1) : (k >> 1); moba_prompt_unit(P, F, bk >> 2, bk & 3, qb); __syncthreads(); }
        for (int i = F.G - 1 - (int)blockIdx.x; i < 128; i += F.G) { moba_sample_unit(P, F, i >> 2, i & 3); __syncthreads(); }
    }
    SEAM(13);
    if (IN(14)) { EpiResid e{Hres, Hres + (size_t)MP * D, Hres}; GEMM_PHASE(EpiResid, e, ws + WS_ATT, ws + WS_WOUT1, 1024, 1024, 16); }
    SEAM(14);
    if (IN(15)) { norm_phase(F, Hres, Hres + (size_t)MP * D, INF(9) + D, (bf16*)(ws + WS_XN)); }
    SEAM(15);
    if (IN(16)) { EpiSwiglu e{(bf16*)(ws + WS_HFF)}; GEMM_PHASE(EpiSwiglu, e, ws + WS_XN, ws + WS_WGU1, 5632, 1024, 88); }
    SEAM(16);
    if (IN(17)) { EpiResid e{Hres, Hres + (size_t)MP * D, Hres}; GEMM_PHASE(EpiResid, e, ws + WS_HFF, ws + WS_WDN1, 1024, FF, 16); }
    SEAM(17);
    if (IN(18)) { final_norm(P, F); }
#undef GEMM_PHASE
#undef IN
#undef SEAM
}

extern "C" void kernel_launch(void* const* d_in, const int* in_sizes, int n_in, void* d_out, int out_size, void* d_ws, size_t ws_size, hipStream_t stream) {
    static int grid = 0;
    if (grid == 0) {
        if (n_in != 33 || (size_t)out_size != O_END || ws_size < WS_END3) { fprintf(stderr, "kernel_launch: unexpected shapes n_in %d out %d ws %zu (need %zu)\n", n_in, out_size, ws_size, (size_t)WS_END3); grid = -1; return; }
        int dev = 0, cus = 0, per_cu = 0;
        if (hipGetDevice(&dev) != hipSuccess || hipDeviceGetAttribute(&cus, hipDeviceAttributeMultiprocessorCount, dev) != hipSuccess) { grid = -1; return; }
        if (hipFuncSetAttribute((const void*)mk_fwd, hipFuncAttributeMaxDynamicSharedMemorySize, LDS_BYTES) != hipSuccess) { fprintf(stderr, "kernel_launch: hipFuncSetAttribute failed\n"); grid = -1; return; }
        if (hipOccupancyMaxActiveBlocksPerMultiprocessor(&per_cu, (const void*)mk_fwd, 512, LDS_BYTES) != hipSuccess || per_cu < 1) fprintf(stderr, "kernel_launch: occupancy query says %d\n", per_cu);
        (void)hipGetLastError();
        grid = cus;
    }
    if (grid < 0) return;
    if (hipMemsetAsync((char*)d_ws + WS_CTL, 0, CTL_BYTES, stream) != hipSuccess) return;
    Params p{};
    for (int i = 0; i < 33; ++i) p.in[i] = d_in[i];
    p.out = (float*)d_out; p.ws = (unsigned char*)d_ws;
#ifndef MK_LAUNCH_PER_PHASE
#define MK_LAUNCH_PER_PHASE 0
#endif
#if MK_LAUNCH_PER_PHASE
    for (int k = 0; k < N_PHASES; ++k) { p.ph_lo = k; p.ph_hi = k + 1; hipLaunchKernelGGL(mk_fwd, dim3(grid), dim3(512), LDS_BYTES, stream, p); }
#else
    p.ph_lo = 0; p.ph_hi = N_PHASES; hipLaunchKernelGGL(mk_fwd, dim3(grid), dim3(512), LDS_BYTES, stream, p);
#endif
}
```

```cpp
#include <hip/hip_runtime.h>
#include <cstdio>
#include <cstdint>
namespace pg8 {
#define PG8_LAS __attribute__((address_space(3)))
typedef unsigned short bf16_t;
typedef short bf16x8 __attribute__((ext_vector_type(8)));
typedef float f32x4 __attribute__((ext_vector_type(4)));
typedef unsigned u32x4 __attribute__((ext_vector_type(4)));
constexpr int BM = 256, BK = 64, HALF = 128, HTB = HALF * BK * 2  , STAGE_BYTES = 8 * HTB, NXCD = 8, WGM = 8;

__host__ __device__ __forceinline__ int lds_byte(int r, int c) { const int st = (r >> 4) * 2 + (c >> 5), rr = r & 15, cc = c & 31, ob = rr * 64 + cc * 2; return st * 1024 + (ob ^ (((ob >> 9) & 1) << 5)); }
__host__ __device__ __forceinline__ void stage_rc(int b, int& R, int& C) { const int st = b / 1024, sb = b % 1024, swz = sb ^ (((sb >> 9) & 1) << 5); R = (st >> 1) * 16 + swz / 64; C = (st & 1) * 32 + (swz % 64) / 2; }
__host__ __device__ __forceinline__ int perm32(int rho) { const int n = rho >> 4, i = rho & 15; return 8 * (i >> 2) + 4 * n + (i & 3); }

struct Unit { int pm, pn; };
struct Gemm { const bf16_t* A; const bf16_t* Bt; int M, N, K; };

struct StaticOrder {
    int nM, nN, nwg, G, c;
    __host__ __device__ void init(int M, int N, int G_, int c_) { nM = M / BM; nN = N / BM; nwg = nM * nN; G = G_; c = c_; }
    __host__ __device__ bool next(int i, Unit& u) const {
        const long L = (long)i * G + c; if (L >= nwg) return false;
        int wgid = (int)L; { const int q = nwg / NXCD, r = nwg % NXCD, xcd = wgid % NXCD, off = wgid / NXCD; wgid = (xcd < r ? xcd * (q + 1) : r * (q + 1) + (xcd - r) * q) + off; }
        const int nig = WGM * nN, gid = wgid / nig, fm = gid * WGM, gsz = (nM - fm) < WGM ? (nM - fm) : WGM;
        u.pm = fm + ((wgid % nig) % gsz); u.pn = (wgid % nig) / gsz; return true;
    }
    __device__ __forceinline__ void a_ready(const Unit&) const {}
    __device__ __forceinline__ void done(const Unit&) const {}
};

template <class Epi, class Sched, bool ALIGN_EPI = false, bool SP2 = false>
__device__ __forceinline__ void gemm_phase(PG8_LAS unsigned char* lds, const Gemm g, const Sched& S, const Epi& E) {
    const int tid = threadIdx.x, wid = __builtin_amdgcn_readfirstlane(tid >> 6), lane = tid & 63, wr = wid >> 2, wc = wid & 3, fr = lane & 15, fq = lane >> 4;
    const int K = g.K, nt = K / BK;
    unsigned voffA[2], voffB[2];
#pragma unroll
    for (int i = 0; i < 2; ++i) { int R, C; stage_rc(tid * 16 + i * 8192, R, C); const int Rb = Epi::PERM ? ((R & ~31) + perm32(R & 31)) : R;
        voffA[i] = (unsigned)(R * K + C) * 2u; voffB[i] = (unsigned)(Rb * K + C) * 2u; }
    const size_t kstep = (size_t)(BK * 2);
    const size_t hstep = (size_t)HALF * K * 2;
    const size_t tstep = 2 * hstep;
    const unsigned ldsw = (unsigned)wid * 1024u;
    const int aoff = lds_byte(wr * 64 + fr, fq * 8), boff = lds_byte(wc * 32 + fr, fq * 8);
#define PG8_SA(b, h) (((b) * 2 + (h)) * HTB)
#define PG8_SB(b, h) ((4 + (b) * 2 + (h)) * HTB)
#define PG8_STAGE(bufoff, gbase, voff) do { _Pragma("unroll") for (int _i = 0; _i < 2; ++_i) \
        __builtin_amdgcn_global_load_lds((const unsigned*)((const char*)(gbase) + (voff)[_i]), (PG8_LAS unsigned*)(lds + (bufoff) + ldsw + _i * 8192), 16, 0, 0); } while (0)
#define PG8_LDA(dst, b, h) do { _Pragma("unroll") for (int m = 0; m < 4; ++m) _Pragma("unroll") for (int k = 0; k < 2; ++k) dst[m][k] = *(const PG8_LAS bf16x8*)(lds + PG8_SA(b, h) + aoff + m * 2048 + k * 1024); } while (0)
#define PG8_LDB(dst, b, h) do { _Pragma("unroll") for (int n = 0; n < 2; ++n) _Pragma("unroll") for (int k = 0; k < 2; ++k) dst[n][k] = *(const PG8_LAS bf16x8*)(lds + PG8_SB(b, h) + boff + n * 2048 + k * 1024); } while (0)
#define PG8_MMA(ai, bj, At, Bt) do { __builtin_amdgcn_s_setprio(1); _Pragma("unroll") for (int m = 0; m < 4; ++m) _Pragma("unroll") for (int n = 0; n < 2; ++n) _Pragma("unroll") for (int k = 0; k < 2; ++k) \
        acc[ai][bj][m][n] = __builtin_amdgcn_mfma_f32_16x16x32_bf16(Bt[n][k], At[m][k], acc[ai][bj][m][n], 0, 0, 0); __builtin_amdgcn_s_setprio(0); } while (0)
#define PG8_WAIT_V(n) asm volatile("s_waitcnt vmcnt(" #n ")" ::: "memory")
#define PG8_WAIT_L(n) asm volatile("s_waitcnt lgkmcnt(" #n ")" ::: "memory")
#define PG8_BAR __builtin_amdgcn_s_barrier()
#define PG8_SCHED __builtin_amdgcn_sched_barrier(0)
    Unit cur, nxt; int ui = 0;
    if (!S.next(0, cur)) return;
    f32x4 acc[2][2][4][2];
#pragma unroll
    for (int a = 0; a < 2; ++a)
#pragma unroll
        for (int b = 0; b < 2; ++b)
#pragma unroll
            for (int m = 0; m < 4; ++m)
#pragma unroll
                for (int n = 0; n < 2; ++n) acc[a][b][m][n] = (f32x4){0.f, 0.f, 0.f, 0.f};
    bf16x8 At[4][2], B0[2][2], B1[2][2];
    const char* cA = (const char*)g.A + (size_t)cur.pm * tstep; const char* cB = (const char*)g.Bt + (size_t)cur.pn * tstep;
    S.a_ready(cur);
    if constexpr (SP2) {
        PG8_STAGE(PG8_SB(0, 0), cB, voffB); PG8_STAGE(PG8_SB(0, 1), cB + hstep, voffB); PG8_STAGE(PG8_SA(0, 0), cA, voffA); PG8_STAGE(PG8_SA(0, 1), cA + hstep, voffA);
        if (wr == 1) PG8_BAR;
        PG8_WAIT_V(2); PG8_BAR;
        PG8_STAGE(PG8_SB(1, 0), cB + kstep, voffB); PG8_STAGE(PG8_SA(1, 0), cA + kstep, voffA); PG8_STAGE(PG8_SB(1, 1), cB + hstep + kstep, voffB);
        PG8_WAIT_V(6); PG8_BAR;
    } else {
        PG8_STAGE(PG8_SB(0, 0), cB, voffB); PG8_STAGE(PG8_SA(0, 0), cA, voffA); PG8_STAGE(PG8_SB(0, 1), cB + hstep, voffB); PG8_STAGE(PG8_SA(0, 1), cA + hstep, voffA);
        if (wr == 1) PG8_BAR;
        PG8_WAIT_V(4); PG8_BAR;
        PG8_STAGE(PG8_SB(1, 0), cB + kstep, voffB); PG8_STAGE(PG8_SA(1, 0), cA + kstep, voffA); PG8_STAGE(PG8_SB(1, 1), cB + hstep + kstep, voffB);
        PG8_WAIT_V(6); PG8_BAR;
    }
    for (;;) {
        const bool has_next = S.next(ui + 1, nxt);
        const char* nA = has_next ? (const char*)g.A + (size_t)nxt.pm * tstep : cA; const char* nB = has_next ? (const char*)g.Bt + (size_t)nxt.pn * tstep : cB;
        for (int t = 0; t < nt; t += 2) {
            const bool last = (t == nt - 2);
            const char* a1 = cA + (size_t)(t + 1) * kstep;
            const char* a2 = last ? nA : cA + (size_t)(t + 2) * kstep; const char* b2 = last ? nB : cB + (size_t)(t + 2) * kstep;
            const char* a3 = a2 + kstep; const char* b3 = b2 + kstep;
            if (last && has_next) S.a_ready(nxt);
            if constexpr (SP2) {
            PG8_LDB(B0, 0, 0); PG8_LDB(B1, 0, 1); PG8_SCHED; PG8_LDA(At, 0, 0); PG8_STAGE(PG8_SA(1, 1), a1 + hstep, voffA);
            PG8_WAIT_V(8); PG8_WAIT_L(0); PG8_BAR; PG8_MMA(0, 0, At, B0); PG8_MMA(0, 1, At, B1); PG8_BAR; PG8_SCHED;
            PG8_LDA(At, 0, 1); PG8_STAGE(PG8_SB(0, 0), b2, voffB); PG8_STAGE(PG8_SB(0, 1), b2 + hstep, voffB); PG8_STAGE(PG8_SA(0, 0), a2, voffA);
            PG8_WAIT_V(8); PG8_WAIT_L(0); PG8_BAR; PG8_MMA(1, 0, At, B0); PG8_MMA(1, 1, At, B1); PG8_BAR; PG8_SCHED;
            PG8_LDB(B0, 1, 0); PG8_LDB(B1, 1, 1); PG8_SCHED; PG8_LDA(At, 1, 0); PG8_STAGE(PG8_SA(0, 1), a2 + hstep, voffA);
            PG8_WAIT_V(8); PG8_WAIT_L(0); PG8_BAR; PG8_MMA(0, 0, At, B0); PG8_MMA(0, 1, At, B1); PG8_BAR; PG8_SCHED;
            PG8_LDA(At, 1, 1); PG8_STAGE(PG8_SB(1, 0), b3, voffB); PG8_STAGE(PG8_SB(1, 1), b3 + hstep, voffB); PG8_STAGE(PG8_SA(1, 0), a3, voffA);
            PG8_WAIT_V(8); PG8_WAIT_L(0); PG8_BAR; PG8_MMA(1, 0, At, B0); PG8_MMA(1, 1, At, B1); PG8_BAR; PG8_SCHED;
            } else {
            PG8_LDB(B0, 0, 0); PG8_SCHED; PG8_LDA(At, 0, 0); PG8_STAGE(PG8_SA(1, 1), a1 + hstep, voffA);
            PG8_WAIT_L(8); PG8_BAR; PG8_WAIT_L(0); PG8_MMA(0, 0, At, B0); PG8_BAR; PG8_SCHED;
            PG8_LDB(B1, 0, 1); PG8_STAGE(PG8_SB(0, 0), b2, voffB);
            PG8_BAR; PG8_WAIT_L(0); PG8_MMA(0, 1, At, B1); PG8_BAR;
            PG8_LDA(At, 0, 1); PG8_STAGE(PG8_SA(0, 0), a2, voffA);
            PG8_BAR; PG8_WAIT_L(0); PG8_MMA(1, 0, At, B0); PG8_BAR; PG8_SCHED;
            PG8_STAGE(PG8_SB(0, 1), b2 + hstep, voffB);
            PG8_WAIT_V(6); PG8_BAR; PG8_MMA(1, 1, At, B1); PG8_BAR;
            PG8_LDB(B0, 1, 0); PG8_SCHED; PG8_LDA(At, 1, 0); PG8_STAGE(PG8_SA(0, 1), a2 + hstep, voffA);
            PG8_WAIT_L(8); PG8_BAR; PG8_WAIT_L(0); PG8_MMA(0, 0, At, B0); PG8_BAR; PG8_SCHED;
            PG8_LDB(B1, 1, 1); PG8_STAGE(PG8_SB(1, 0), b3, voffB);
            PG8_BAR; PG8_WAIT_L(0); PG8_MMA(0, 1, At, B1); PG8_BAR;
            PG8_LDA(At, 1, 1); PG8_STAGE(PG8_SA(1, 0), a3, voffA);
            PG8_BAR; PG8_WAIT_L(0); PG8_MMA(1, 0, At, B0); PG8_BAR; PG8_SCHED;
            PG8_STAGE(PG8_SB(1, 1), b3 + hstep, voffB);
            PG8_WAIT_V(6); PG8_BAR; PG8_MMA(1, 1, At, B1); PG8_BAR;
            }
        }
        if constexpr (ALIGN_EPI) { if (wr == 0) PG8_BAR; }
        if constexpr (!Epi::AFTER_DRAIN) { E(acc, cur, wr, wc, fr, fq); S.done(cur); }
        if (!has_next) break;
#pragma unroll
        for (int a = 0; a < 2; ++a)
#pragma unroll
            for (int b = 0; b < 2; ++b)
#pragma unroll
                for (int m = 0; m < 4; ++m)
#pragma unroll
                    for (int n = 0; n < 2; ++n) acc[a][b][m][n] = (f32x4){0.f, 0.f, 0.f, 0.f};
        cur = nxt; cA = nA; cB = nB; ++ui;
        if constexpr (ALIGN_EPI) { if (wr == 1) PG8_BAR; }
    }
    PG8_WAIT_V(0);
    if constexpr (!ALIGN_EPI) { if (wr == 0) PG8_BAR; }
    PG8_BAR;
    if constexpr (Epi::AFTER_DRAIN) { E.fused(acc, cur, wr, wc, fr, fq, lds, wid, lane); S.done(cur); }
#undef PG8_SA
#undef PG8_SB
#undef PG8_STAGE
#undef PG8_LDA
#undef PG8_LDB
#undef PG8_MMA
#undef PG8_WAIT_V
#undef PG8_WAIT_L
#undef PG8_BAR
#undef PG8_SCHED
}
}
#define PG8_SP2 true
#define PG8_ALIGN true
#define GAS __attribute__((address_space(1)))
#define LAS __attribute__((address_space(3)))
#define MK_DIAG 0
typedef unsigned short bf16;
typedef unsigned v4u __attribute__((ext_vector_type(4)));
typedef unsigned v2u __attribute__((ext_vector_type(2)));
typedef float f32x4 __attribute__((ext_vector_type(4)));
typedef float f32x2 __attribute__((ext_vector_type(2)));
typedef float f32x16 __attribute__((ext_vector_type(16)));
typedef short bf16x8 __attribute__((ext_vector_type(8)));
typedef short s16x4 __attribute__((ext_vector_type(4)));
typedef __bf16 bf16x2_t __attribute__((ext_vector_type(2)));
#define DI __device__ __forceinline__
#define LDS_WAIT() asm volatile("s_waitcnt lgkmcnt(0)" ::: "memory")
#define VM_WAIT() asm volatile("s_waitcnt vmcnt(0)" ::: "memory")

DI unsigned pk2(float lo, float hi) { f32x2 v = {lo, hi}; bf16x2_t b = __builtin_convertvector(v, bf16x2_t); return __builtin_bit_cast(unsigned, b); }
DI float bflo(unsigned u) { return __uint_as_float(u << 16); }
DI float bfhi(unsigned u) { return __uint_as_float(u & 0xffff0000u); }
DI float bf2f(bf16 u) { return __uint_as_float((unsigned)u << 16); }
DI float wave_sum(float v) {
#pragma unroll
    for (int o = 1; o < 64; o <<= 1) v += __shfl_xor(v, o);
    return v;
}
DI float sigmoidf_(float x) { return 1.0f / (1.0f + __expf(-x)); }
constexpr float ATT_SC = 0.125f * 1.4426950408889634f;

constexpr int D = 1024, MP = 16384, MS = 128, MT = 16640, SEQ = 4096, NB = 4, NSQ = 32, TS = 4;
constexpr int RWC = 1792, FF = 2816, NPG = 64, PAGE = 128, PAST = 8192;
constexpr int NWAVES = 8;
constexpr size_t O_YP = 0, O_YS = O_YP + (size_t)MP * D, O_NSAP = O_YS + (size_t)MS * D, O_NSAS = O_NSAP + (size_t)MP * 512,
                 O_MOBP = O_NSAS + (size_t)MS * 512, O_MOBS = O_MOBP + (size_t)MP * 512, O_WINP = O_MOBS + (size_t)MS * 512,
                 O_WINS = O_WINP + (size_t)NB * 512 * 256, O_WKVP = O_WINS + (size_t)NSQ * 512 * 256, O_WKVS = O_WKVP + (size_t)NB * 8 * 4096,
                 O_SHP = O_WKVS + (size_t)NSQ * 8 * 4096, O_SHS = O_SHP + (size_t)NB * RWC, O_END = O_SHS + (size_t)NSQ * RWC;
constexpr size_t al(size_t x) { return (x + 4095) & ~(size_t)4095; }
constexpr size_t WS_CTL = 0, CTL_BYTES = 1u << 20;
constexpr size_t WS_ROPE  = CTL_BYTES;
constexpr size_t WS_WIN0  = al(WS_ROPE + (size_t)4100 * 32 * 8);
constexpr size_t WS_WG0   = al(WS_WIN0 + (size_t)3072 * 1024 * 2);
constexpr size_t WS_WOUT0 = al(WS_WG0 + (size_t)64 * 1024 * 2);
constexpr size_t WS_WGU0  = al(WS_WOUT0 + (size_t)1024 * 1024 * 2);
constexpr size_t WS_WDN0  = al(WS_WGU0 + (size_t)5632 * 1024 * 2);
constexpr size_t WS_WIN1  = al(WS_WDN0 + (size_t)1024 * 2816 * 2);
constexpr size_t WS_WOUT1 = al(WS_WIN1 + (size_t)1536 * 1024 * 2);
constexpr size_t WS_WGU1  = al(WS_WOUT1 + (size_t)1024 * 1024 * 2);
constexpr size_t WS_WDN1  = al(WS_WGU1 + (size_t)5632 * 1024 * 2);
constexpr size_t WS_WLORA = al(WS_WDN1 + (size_t)1024 * 2816 * 2);
constexpr size_t WS_WCMP  = al(WS_WLORA + (size_t)1536 * 256 * 2);
constexpr size_t WS_XN    = al(WS_WCMP + (size_t)256 * 1024 * 2);
constexpr size_t WS_RW    = al(WS_XN + (size_t)MT * 1024 * 2);
constexpr size_t WS_Q0    = al(WS_RW + (size_t)MT * RWC * 2);
constexpr size_t WS_GATES = al(WS_Q0 + (size_t)MT * 512 * 2);
constexpr size_t WS_KV0   = al(WS_GATES + (size_t)MT * 32 * 4);
constexpr size_t WS_KVS0  = al(WS_KV0 + (size_t)6 * 4 * 2 * 4096 * 64 * 2);
constexpr size_t WS_ACMPS = al(WS_KVS0 + (size_t)6 * 32 * 2 * 4 * 64 * 2);
constexpr size_t WS_HCP   = al(WS_ACMPS + (size_t)2 * 32 * 2 * 8192 * 64 * 2);
constexpr size_t WS_HCS   = al(WS_HCP + (size_t)4096 * 128 * 4);
constexpr size_t WS_MEANS = al(WS_HCS + (size_t)65536 * 128 * 4);
constexpr size_t WS_END0  = al(WS_MEANS + (size_t)32 * 4 * 32 * 64 * 4);
#define XB_TMO      128
#define XB_XCNT(j)  (256  + 64 * (j))
#define XB_XSUB(j)  (1280 + 64 * (j))
#define XB_XGEN(j)  (2304 + 64 * (j))
#define XB_TOP      3328
#define XB_TOPGEN   3392
#define XCD_BAR_WORDS 3456
#define XB_SPIN_CAP (1u << 18)

__device__ __forceinline__ unsigned xb_ld(unsigned* p)              { return __hip_atomic_load(p, __ATOMIC_RELAXED, __HIP_MEMORY_SCOPE_AGENT); }
__device__ __forceinline__ unsigned xb_add(unsigned* p, unsigned v) { return __hip_atomic_fetch_add(p, v, __ATOMIC_RELAXED, __HIP_MEMORY_SCOPE_AGENT); }
__device__ __forceinline__ unsigned xb_xcc_id() { return (unsigned)__builtin_amdgcn_s_getreg((3 << 11) | 20) & 0xFu; }
#define XB_SPIN(cond, bar) do { unsigned _sp = 0; while (cond) { __builtin_amdgcn_s_sleep(1); \
    if ((++_sp & 255u) == 0u) { if (xb_ld(&(bar)[XB_TMO])) break; if (_sp > XB_SPIN_CAP) { atomicAdd(&(bar)[XB_TMO], 1u); break; } } } } while (0)

struct XcdBarrier {
    unsigned* bar; unsigned x;
    volatile LAS unsigned* st;
};

__device__ __forceinline__ XcdBarrier xcd_barrier_post(unsigned* bar, volatile LAS unsigned* st) {
    XcdBarrier b; b.bar = bar; b.x = xb_xcc_id(); b.st = st;
    if (threadIdx.x == 0) (void)xb_add(&bar[XB_XCNT(b.x)], 1u);
    return b;
}
__device__ __forceinline__ void xcd_barrier_complete(unsigned* bar, unsigned x, unsigned& nloc, unsigned& nx) {
    const unsigned G = gridDim.x * gridDim.y * gridDim.z;
    unsigned sum, cnt, mine, sp = 0u;
    for (;;) {
        sum = 0u; cnt = 0u; mine = 0u;
#pragma unroll
        for (unsigned j = 0; j < 16; ++j) { const unsigned c = xb_ld(&bar[XB_XCNT(j)]); sum += c; cnt += (c > 0u) ? 1u : 0u; mine = (j == x) ? c : mine; }
        if (sum == G) break;
        __builtin_amdgcn_s_sleep(1);
        if ((++sp & 255u) == 0u) { if (xb_ld(&bar[XB_TMO])) break; if (sp > XB_SPIN_CAP) { atomicAdd(&bar[XB_TMO], 1u); break; } }
    }
    nloc = mine > 0u ? mine : 1u; nx = cnt > 0u ? cnt : 1u;
}

__device__ __forceinline__ void xcd_barrier(const XcdBarrier& b) {
    asm volatile("s_waitcnt vmcnt(0)" ::: "memory");
    __syncthreads();
    if (threadIdx.x == 0) {
        unsigned* bar = b.bar;
        __builtin_amdgcn_s_waitcnt(0);
        unsigned nloc = b.st[0], nx = b.st[1];
        if (nloc == 0u) { xcd_barrier_complete(bar, b.x, nloc, nx); b.st[0] = nloc; b.st[1] = nx; }
        const unsigned old = xb_add(&bar[XB_XSUB(b.x)], 1u);
        const unsigned gen = old / nloc;
        if (old + 1u == (gen + 1u) * nloc) {
            __builtin_amdgcn_fence(__ATOMIC_RELEASE, "agent");
            asm volatile("s_waitcnt vmcnt(0)" ::: "memory");
            const unsigned og = xb_add(&bar[XB_TOP], 1u);
            const unsigned tg = og / nx;
            if (og + 1u == (tg + 1u) * nx) xb_add(&bar[XB_TOPGEN], 1u);
            else XB_SPIN(xb_ld(&bar[XB_TOPGEN]) == tg, bar);
            __builtin_amdgcn_fence(__ATOMIC_ACQUIRE, "agent");
            xb_add(&bar[XB_XGEN(b.x)], 1u);
            asm volatile("s_waitcnt vmcnt(0)" ::: "memory");
        } else {
            XB_SPIN(xb_ld(&bar[XB_XGEN(b.x)]) == gen, bar);
            __builtin_amdgcn_fence(__ATOMIC_ACQUIRE, "agent");
            asm volatile("s_waitcnt vmcnt(0)" ::: "memory");
        }
    }
    __syncthreads();
}
struct Params { const void* in[33]; float* out; unsigned char* ws; int ph_lo, ph_hi; };
struct Frame { LAS unsigned char* lds; int tid, lane, wave, G, gw, ngw; };
#define INF(i) ((const float*)P.in[i])
constexpr int LDS_BYTES = 147456;
constexpr int RING_BYTES = 131072, MISC_OFF = LDS_BYTES - 128;

DI void dsincos(double r, double& s, double& c) {
    const double r2 = r * r; double ss = 1.0, cc = 1.0;
#pragma unroll
    for (int n = 16; n >= 1; --n) { ss = 1.0 - r2 * (1.0 / (double)((2 * n) * (2 * n + 1))) * ss; cc = 1.0 - r2 * (1.0 / (double)((2 * n - 1) * (2 * n))) * cc; }
    s = r * ss; c = cc;
}
DI void p0_rope(const Params& P, const Frame& F) {
    f32x2* tab = (f32x2*)(P.ws + WS_ROPE);
    for (int idx = blockIdx.x * 512 + F.tid; idx < 4100 * 32; idx += F.G * 512) {
        const int pi = idx >> 5, i = idx & 31; const int pos = pi < 4096 ? pi : 8192 + (pi - 4096);
        const float inv = exp2f(-(float)i * 0.41524101186092029f);
        const float ang = (float)pos * inv;
        const double a = (double)ang; const double k = rint(a * 0.15915494309189535); const double r = fma(-k, 6.283185307179586, a);
        double s, c; dsincos(r, s, c);
        tab[idx] = (f32x2){(float)c, (float)s};
    }
}
struct ColRef { const float* p; int ld, klo, khi; };
DI int perm64(int p) { return 32 * ((p >> 4) & 1) + 16 * (p >> 5) + (p & 15); }
DI int logical_col(int n) { return (n & ~63) + perm64(n & 63); }
template <class Src> DI void tr_item(const Src& S, int K, int nphys, bf16* WT, LAS float* scr, int item, int lane, const float* gain = nullptr) {
    const int nblk = nphys / 32, kb = item / nblk, nb = item % nblk, k0 = 64 * kb, n0 = 32 * nb;
    const int kr = lane >> 3, q = lane & 7;
    const ColRef cr = S.col(n0 + 4 * q);
    f32x4 v[8];
#pragma unroll
    for (int i = 0; i < 8; ++i) { const int k = k0 + 8 * i + kr; v[i] = (f32x4){0.f, 0.f, 0.f, 0.f};
        if (k >= cr.klo && k < cr.khi) v[i] = *(const f32x4*)(cr.p + (size_t)(k - cr.klo) * cr.ld);
        if (gain) v[i] *= gain[k]; }
#pragma unroll
    for (int i = 0; i < 8; ++i) *(LAS f32x4*)(scr + (8 * i + kr) * 36 + 4 * q) = v[i];
    LDS_WAIT(); asm volatile("" ::: "memory");
    const int c = lane & 7;
#pragma unroll
    for (int j = 0; j < 4; ++j) { const int n = (lane >> 3) + 8 * j; const LAS float* s = scr + (8 * c) * 36 + n;
        v4u o; o.x = pk2(s[0 * 36], s[1 * 36]); o.y = pk2(s[2 * 36], s[3 * 36]); o.z = pk2(s[4 * 36], s[5 * 36]); o.w = pk2(s[6 * 36], s[7 * 36]);
        *(v4u*)(WT + (size_t)(n0 + n) * K + k0 + 8 * c) = o; }
    LDS_WAIT(); asm volatile("" ::: "memory");
}
struct SrcPlain { const float* W; int ld, ncols;
    DI ColRef col(int n) const { const int l = logical_col(n); ColRef r; r.p = W + (l < ncols ? l : 0); r.ld = ld; r.klo = 0; r.khi = (l < ncols) ? (1 << 30) : 0; return r; } };
struct SrcGate { const float* W;
    DI ColRef col(int n) const { const int l = logical_col(n); const bool ok = l < 16 || (l >= 32 && l < 40); const int c = l < 16 ? l : l - 16; ColRef r; r.p = W + (ok ? c : 0); r.ld = 3096; r.klo = 0; r.khi = ok ? (1 << 30) : 0; return r; } };
struct SrcGU { const float* Wg; const float* Wu;
    DI ColRef col(int n) const { const int l = logical_col(n), hd = l >> 6, d = l & 63; ColRef r; const uintptr_t a_ = (uintptr_t)Wg, b_ = (uintptr_t)Wu, m_ = (uintptr_t)0 - (uintptr_t)(d >= 32); r.p = (const float*)(a_ ^ ((a_ ^ b_) & m_)) + 32 * hd + (d & 31); r.ld = FF; r.klo = 0; r.khi = 1 << 30; return r; } };
struct SrcLora { const float* wu; const float* au; const float* gu;
    DI ColRef col(int n) const { const int l = logical_col(n), reg = l >> 9, c = l & 511; ColRef r; r.ld = 512;
        if (reg == 0) { r.p = wu + c; r.klo = 0; r.khi = 64; } else if (reg == 1) { r.p = au + c; r.klo = 64; r.khi = 128; } else { r.p = gu + c; r.klo = 128; r.khi = 256; } return r; } };
struct SrcCmp { const float* w1;
    DI ColRef col(int n) const { const int l = logical_col(n), kind = l >> 7, ab = (l >> 6) & 1, e = l & 63; ColRef r; r.p = w1 + (size_t)((kind * 32 + ab * 16) * 64) * 64 + e; r.ld = 64; r.klo = 0; r.khi = 1 << 30; return r; } };

constexpr int WI_IN0 = 16 * 96, WI_G0 = 16 * 1, WI_O = 16 * 32, WI_GU = 16 * 176, WI_DN = 44 * 32, WI_IN1 = 16 * 48, WI_LORA = 4 * 48, WI_CMP = 16 * 8;
constexpr int WI_EARLY = WI_IN0 + WI_G0, WI_ALL = WI_EARLY + 2 * WI_O + 2 * WI_GU + 2 * WI_DN + WI_IN1 + WI_LORA + WI_CMP;
constexpr int WI_L1 = WI_O + WI_GU + WI_DN + WI_IN1, WI_L0 = WI_ALL - WI_L1;
constexpr int WO_O0 = WI_EARLY, WO_O1 = WO_O0 + WI_O, WO_GU0 = WO_O1 + WI_O, WO_GU1 = WO_GU0 + WI_GU, WO_DN0 = WO_GU1 + WI_GU, WO_DN1 = WO_DN0 + WI_DN, WO_IN1 = WO_DN1 + WI_DN, WO_LORA = WO_IN1 + WI_IN1;
DI int wi_l0(int i) { if (i < WI_EARLY + WI_O) return i; i -= WI_EARLY + WI_O; if (i < WI_GU) return WO_GU0 + i; i -= WI_GU; if (i < WI_DN) return WO_DN0 + i; i -= WI_DN; return WO_LORA + i; }
DI int wi_l1(int i) { if (i < WI_O) return WO_O1 + i; i -= WI_O; if (i < WI_GU) return WO_GU1 + i; i -= WI_GU; if (i < WI_DN) return WO_DN1 + i; i -= WI_DN; return WO_IN1 + i; }
DI void weight_item(const Params& P, LAS float* scr, int it, int lane) {
    unsigned char* ws = P.ws; int r = it;
    if (r < WI_IN0) { tr_item(SrcPlain{INF(11), 3096, 3072}, 1024, 3072, (bf16*)(ws + WS_WIN0), scr, r, lane); return; } r -= WI_IN0;
    if (r < WI_G0)  { tr_item(SrcGate{INF(11) + 3072}, 1024, 32, (bf16*)(ws + WS_WG0), scr, r, lane); return; } r -= WI_G0;
    if (r < WI_O)   { tr_item(SrcPlain{INF(12), 1024, 1024}, 1024, 1024, (bf16*)(ws + WS_WOUT0), scr, r, lane); return; } r -= WI_O;
    if (r < WI_O)   { tr_item(SrcPlain{INF(29), 1024, 1024}, 1024, 1024, (bf16*)(ws + WS_WOUT1), scr, r, lane); return; } r -= WI_O;
    if (r < WI_GU)  { tr_item(SrcGU{INF(30), INF(31)}, 1024, 5632, (bf16*)(ws + WS_WGU0), scr, r, lane, INF(9)); return; } r -= WI_GU;
    if (r < WI_GU)  { tr_item(SrcGU{INF(30) + (size_t)1024 * FF, INF(31) + (size_t)1024 * FF}, 1024, 5632, (bf16*)(ws + WS_WGU1), scr, r, lane, INF(9) + D); return; } r -= WI_GU;
    if (r < WI_DN)  { tr_item(SrcPlain{INF(32), 1024, 1024}, FF, 1024, (bf16*)(ws + WS_WDN0), scr, r, lane); return; } r -= WI_DN;
    if (r < WI_DN)  { tr_item(SrcPlain{INF(32) + (size_t)FF * 1024, 1024, 1024}, FF, 1024, (bf16*)(ws + WS_WDN1), scr, r, lane); return; } r -= WI_DN;
    if (r < WI_IN1) { tr_item(SrcPlain{INF(28), 1536, 1536}, 1024, 1536, (bf16*)(ws + WS_WIN1), scr, r, lane, INF(8) + D); return; } r -= WI_IN1;
    if (r < WI_LORA){ tr_item(SrcLora{INF(15), INF(17), INF(18)}, 256, 1536, (bf16*)(ws + WS_WLORA), scr, r, lane); return; } r -= WI_LORA;
    tr_item(SrcCmp{INF(25)}, 1024, 256, (bf16*)(ws + WS_WCMP), scr, r, lane);
}
DI void st_bf16x4(bf16* p, f32x4 v) { *(v2u*)p = (v2u){pk2(v.x, v.y), pk2(v.z, v.w)}; }
DI void norm_rows2_bf16(const float* x0, const float* x1, const float* gain, bf16* o0, bf16* o1, int lane_in) {
    int lane = lane_in; asm volatile("" : "+v"(lane));
    f32x4 v[2][4]; float ss0 = 0.f, ss1 = 0.f;
#pragma unroll
    for (int i = 0; i < 4; ++i) { v[0][i] = *(const f32x4*)(x0 + 256 * i + 4 * lane); v[1][i] = *(const f32x4*)(x1 + 256 * i + 4 * lane); }
#pragma unroll
    for (int i = 0; i < 4; ++i) { ss0 += (v[0][i].x * v[0][i].x + v[0][i].y * v[0][i].y) + (v[0][i].z * v[0][i].z + v[0][i].w * v[0][i].w); ss1 += (v[1][i].x * v[1][i].x + v[1][i].y * v[1][i].y) + (v[1][i].z * v[1][i].z + v[1][i].w * v[1][i].w); }
    const float rs0 = 1.0f / sqrtf(wave_sum(ss0) * (1.0f / 1024.0f) + 1e-6f), rs1 = 1.0f / sqrtf(wave_sum(ss1) * (1.0f / 1024.0f) + 1e-6f);
#pragma unroll
    for (int i = 0; i < 4; ++i) { const f32x4 g = *(const f32x4*)(gain + 256 * i + 4 * lane); st_bf16x4(o0 + 256 * i + 4 * lane, v[0][i] * rs0 * g); st_bf16x4(o1 + 256 * i + 4 * lane, v[1][i] * rs1 * g); }
}
DI void norm_phase(const Frame& F, const float* src0, const float* src1, const float* gain, bf16* XN) {
    for (int m = 2 * F.gw; m < MP + MS; m += 2 * F.ngw) { const float* xr = m < MP ? src0 + (size_t)m * D : src1 + (size_t)(m - MP) * D; norm_rows2_bf16(xr, xr + D, gain, XN + (size_t)m * D, XN + (size_t)(m + 1) * D, F.lane); }
}
DI void prep_conv_unit(const Params& P, const Frame& F, int u) {
    const int* ptab = (const int*)P.in[7]; const float* cache = INF(2); bf16* A = (bf16*)(P.ws + WS_ACMPS);
    const int kind = F.lane >> 5, g = (F.lane >> 4) & 1, d = (F.lane & 15) * 4;
    for (int i8 = 0; i8 < 8; ++i8) { const int it0 = u * 1024 + F.wave * 128 + i8 * 16; f32x4 v[16];
#pragma unroll
        for (int j = 0; j < 16; ++j) { const int it = it0 + j, bs = it >> 13, t = it & 8191; const int page = ptab[bs * NPG + (t >> 7)];
            v[j] = *(const f32x4*)(cache + ((size_t)page * PAGE + (t & 127)) * 512 + 4 * F.lane); }
#pragma unroll
        for (int j = 0; j < 16; ++j) { const int it = it0 + j, bs = it >> 13, t = it & 8191;
            *(v2u*)(A + ((((size_t)kind * NSQ + bs) * 2 + g) * PAST + t) * 64 + d) = (v2u){pk2(v[j].x, v[j].y), pk2(v[j].z, v[j].w)}; } }
}
DI void prep_means_unit(const Params& P, const Frame& F, int it) {
    const int* ptab = (const int*)P.in[7]; const float* cache = INF(3); float* MEANS = (float*)(P.ws + WS_MEANS); LAS f32x4* red = (LAS f32x4*)F.lds;
    const int bs = it >> 5, nb = it & 31;
    const int page = ptab[bs * NPG + 2 * nb + (F.wave >> 2)], tok0 = (F.wave & 3) * 32;
    const float* src = cache + ((size_t)page * PAGE + tok0) * 512 + 4 * F.lane;
    f32x4 acc = {0.f, 0.f, 0.f, 0.f};
#pragma unroll
    for (int i = 0; i < 32; ++i) acc += *(const f32x4*)(src + (size_t)i * 512);
    red[F.wave * 64 + F.lane] = acc;
    __syncthreads();
    if (F.wave == 0) { f32x4 s = red[F.lane];
#pragma unroll
        for (int w = 1; w < 8; ++w) s += red[w * 64 + F.lane];
        s *= (1.0f / 256.0f);
        *(f32x4*)(MEANS + (((size_t)bs * 4 + (F.lane >> 4)) * 32 + nb) * 64 + (F.lane & 15) * 4) = s; }
    __syncthreads();
}
DI void p0_wincopy(const Params& P, const Frame& F) {
    const f32x4* src = (const f32x4*)INF(4); f32x4* dst = (f32x4*)(P.out + O_WINS);
    for (int i = blockIdx.x * 512 + F.tid; i < NSQ * 508 * 64; i += F.G * 512) { const int bs = i / (508 * 64), r = i % (508 * 64); dst[(size_t)bs * 512 * 64 + r] = src[(size_t)bs * 512 * 64 + 4 * 64 + r]; }
}

template <class Fn> struct EpiHead {
    static constexpr bool PERM = false, AFTER_DRAIN = false;
    Fn f;
    DI void operator()(const f32x4 (&acc)[2][2][4][2], const pg8::Unit& u, int wr, int wc, int fr, int fq) const {
#pragma unroll
        for (int ai = 0; ai < 2; ++ai)
#pragma unroll
            for (int m = 0; m < 4; ++m) { const int row = u.pm * 256 + ai * 128 + wr * 64 + m * 16 + fr;
#pragma unroll
                for (int bj = 0; bj < 2; ++bj) f(row, u.pn * 4 + bj * 2 + (wc >> 1), 16 * (wc & 1) + 4 * fq, acc[ai][bj][m][0], acc[ai][bj][m][1]); }
    }
};
template <class Fn> DI void skinny_unit(LAS unsigned char* lds, const bf16* A, const bf16* Bt, int K, int row0, int col0, const Fn& f, int wave, int lane_in) {
    int lane = lane_in; asm volatile("" : "+v"(lane));
    const int fr = lane & 15, fq = lane >> 4, kw = K >> 3, nk = kw >> 5;
    const bf16* ap = A + (size_t)(row0 + fr) * K + wave * kw + 8 * fq;
    const bf16* bp = Bt + (size_t)(col0 + fr) * K + wave * kw + 8 * fq;
    f32x4 acc[8][2];
#pragma unroll
    for (int rb = 0; rb < 8; ++rb) { acc[rb][0] = (f32x4){0.f, 0.f, 0.f, 0.f}; acc[rb][1] = (f32x4){0.f, 0.f, 0.f, 0.f}; }
    bf16x8 a0[8], b0[2], a1[8], b1[2], a2[8], b2[2];
#define SK_LOAD(AA, BB, ks) do { _Pragma("unroll") for (int rb = 0; rb < 8; ++rb) AA[rb] = *(const bf16x8*)(ap + (size_t)rb * 16 * K + 32 * (ks)); BB[0] = *(const bf16x8*)(bp + 32 * (ks)); BB[1] = *(const bf16x8*)(bp + (size_t)16 * K + 32 * (ks)); } while (0)
#define SK_MMA(AA, BB) do { _Pragma("unroll") for (int rb = 0; rb < 8; ++rb) { acc[rb][0] = __builtin_amdgcn_mfma_f32_16x16x32_bf16(BB[0], AA[rb], acc[rb][0], 0, 0, 0); acc[rb][1] = __builtin_amdgcn_mfma_f32_16x16x32_bf16(BB[1], AA[rb], acc[rb][1], 0, 0, 0); } } while (0)
    SK_LOAD(a0, b0, 0); if (nk > 1) SK_LOAD(a1, b1, 1);
    for (int ks = 0; ks < nk; ks += 3) {
        if (ks + 2 < nk) SK_LOAD(a2, b2, ks + 2);
        SK_MMA(a0, b0);
        if (ks + 1 < nk) { if (ks + 3 < nk) SK_LOAD(a0, b0, ks + 3); SK_MMA(a1, b1); }
        if (ks + 2 < nk) { if (ks + 4 < nk) SK_LOAD(a1, b1, ks + 4); SK_MMA(a2, b2); }
    }
#undef SK_LOAD
#undef SK_MMA
    LAS float* red = (LAS float*)lds;
#pragma unroll
    for (int rb = 0; rb < 8; ++rb) { *(LAS f32x4*)(red + (wave * 128 + 16 * rb + fr) * 32 + 4 * fq) = acc[rb][0]; *(LAS f32x4*)(red + (wave * 128 + 16 * rb + fr) * 32 + 16 + 4 * fq) = acc[rb][1]; }
    __syncthreads();
    f32x4 lo = {0.f, 0.f, 0.f, 0.f}, hi = {0.f, 0.f, 0.f, 0.f};
#pragma unroll
    for (int w = 0; w < 8; ++w) { lo += *(const LAS f32x4*)(red + (w * 128 + 16 * wave + fr) * 32 + 4 * fq); hi += *(const LAS f32x4*)(red + (w * 128 + 16 * wave + fr) * 32 + 16 + 4 * fq); }
    f(row0 + 16 * wave + fr, col0 >> 6, 16 * ((col0 >> 5) & 1) + 4 * fq, lo, hi);
    __syncthreads();
}

struct EpiIn0 {
    bf16* RW; bf16* Q0; bf16* KV0; bf16* KVS0; const f32x2* rope; float* out;
    DI void operator()(int row, int head, int d4, f32x4 lo, f32x4 hi) const {
        if (row >= MP + MS) return;
        const bool samp = row >= MP; const int sr = row - MP;
        const int b = samp ? (sr >> 2) : (row >> 12), t = samp ? (sr & 3) : (row & 4095), ridx = samp ? 4096 + t : t;
        if (head < 28) {
            bf16* p = RW + (size_t)row * RWC + head * 64 + d4; st_bf16x4(p, lo); st_bf16x4(p + 32, hi);
            const bool last = samp ? (t == 3) : (t == SEQ - 1);
            if (last) { float* o = out + (samp ? O_SHS : O_SHP) + (size_t)b * RWC + head * 64 + d4; *(f32x4*)o = lo; *(f32x4*)(o + 32) = hi; }
            return;
        }
        const bool isq = head < 36; const int idx = head - 36; const int which = idx >> 2, kvsel = (idx >> 1) & 1, g = idx & 1;
        if (isq || kvsel == 0) {
            const f32x2* cs = rope + (size_t)ridx * 32 + d4; const f32x4 a = *(const f32x4*)cs, c2 = *(const f32x4*)(cs + 2);
            const f32x4 co = {a.x, a.z, c2.x, c2.z}, si = {a.y, a.w, c2.y, c2.w};
            const f32x4 x1 = lo, x2 = hi; lo = x1 * co - x2 * si; hi = x2 * co + x1 * si;
        }
        if (isq) { bf16* p = Q0 + (size_t)row * 512 + (head - 28) * 64 + d4; st_bf16x4(p, lo * ATT_SC); st_bf16x4(p + 32, hi * ATT_SC); return; }
        const int k6 = which * 2 + kvsel;
        bf16* p = samp ? KVS0 + ((((size_t)k6 * NSQ + b) * 2 + g) * 4 + t) * 64 + d4 : KV0 + ((((size_t)k6 * NB + b) * 2 + g) * SEQ + t) * 64 + d4;
        st_bf16x4(p, lo); st_bf16x4(p + 32, hi);
        if (which < 2) { float* o = out + (samp ? O_NSAS + (((size_t)sr * 4 + k6) * 2 + g) * 64 : O_NSAP + (((size_t)row * 4 + k6) * 2 + g) * 64) + d4; *(f32x4*)o = lo; *(f32x4*)(o + 32) = hi; }
        else if (samp) { float* o = out + O_WINS + ((((size_t)b * 512 + 508 + t) * 2 + kvsel) * 2 + g) * 64 + d4; *(f32x4*)o = lo; *(f32x4*)(o + 32) = hi; }
        else if (t >= SEQ - 512) { float* o = out + O_WINP + ((((size_t)b * 512 + (t - (SEQ - 512))) * 2 + kvsel) * 2 + g) * 64 + d4; *(f32x4*)o = lo; *(f32x4*)(o + 32) = hi; }
    }
};
struct EpiGates { float* G; const float* bias;
    DI void operator()(int row, int head, int d4, f32x4 lo, f32x4 hi) const {
        { const f32x4 bv = *(const f32x4*)(bias + d4); f32x4 o;
          o.x = sigmoidf_(lo.x + bv.x); o.y = sigmoidf_(lo.y + bv.y); o.z = sigmoidf_(lo.z + bv.z); o.w = sigmoidf_(lo.w + bv.w);
          *(f32x4*)(G + (size_t)row * 32 + d4) = o; }
        if (d4 < 8) { const f32x4 bv = *(const f32x4*)(bias + 16 + d4); f32x4 o;
          o.x = sigmoidf_(hi.x + bv.x); o.y = sigmoidf_(hi.y + bv.y); o.z = sigmoidf_(hi.z + bv.z); o.w = sigmoidf_(hi.w + bv.w);
          *(f32x4*)(G + (size_t)row * 32 + 16 + d4) = o; } } };
struct EpiCmp { float* HC; int half_rows;
    DI void operator()(int row, int head, int d4, f32x4 lo, f32x4 hi) const {
        const int kind = row >= half_rows ? 1 : 0; if ((head >> 1) != kind) return;
        float* o = HC + (size_t)row * 128 + (head & 1) * 64 + d4; *(f32x4*)o = lo; *(f32x4*)(o + 32) = hi; } };
constexpr size_t RWKV_ARR = (size_t)MT * 512 * 4;
constexpr size_t WS_R = WS_END0, WS_K = WS_R + RWKV_ARR, WS_V = WS_K + RWKV_ARR, WS_KK = WS_V + RWKV_ARR, WS_W = WS_KK + RWKV_ARR, WS_KP = WS_W + RWKV_ARR,
                 WS_KKA = WS_KP + RWKV_ARR, WS_G = WS_KKA + RWKV_ARR, WS_Y = WS_G + RWKV_ARR;
constexpr size_t WS_LA = al(WS_Y + RWKV_ARR);
constexpr size_t WS_ATT = al(WS_LA + (size_t)MT * 256 * 2);
constexpr size_t WS_H = al(WS_ATT + (size_t)MT * 1024 * 2);
constexpr size_t WS_HFF = al(WS_H + (size_t)MT * 1024 * 4);
constexpr size_t WS_END1 = al(WS_HFF + (size_t)MT * FF * 2);

DI float red8(float v) {
    v += __builtin_bit_cast(float, __builtin_amdgcn_update_dpp(0, __builtin_bit_cast(int, v), 0xB1, 0xf, 0xf, false));
    v += __builtin_bit_cast(float, __builtin_amdgcn_update_dpp(0, __builtin_bit_cast(int, v), 0x4E, 0xf, 0xf, false));
    v += __builtin_bit_cast(float, __builtin_amdgcn_update_dpp(0, __builtin_bit_cast(int, v), 0x141, 0xf, 0xf, false));
    return v;
}
DI void ld_bf8(const bf16* p, float (&o)[8]) { const v4u u = *(const v4u*)p; o[0] = bflo(u.x); o[1] = bfhi(u.x); o[2] = bflo(u.y); o[3] = bfhi(u.y); o[4] = bflo(u.z); o[5] = bfhi(u.z); o[6] = bflo(u.w); o[7] = bfhi(u.w); }
DI void ld_f8(const float* p, float (&o)[8]) { const f32x4 a = *(const f32x4*)p, b = *(const f32x4*)(p + 4); o[0] = a.x; o[1] = a.y; o[2] = a.z; o[3] = a.w; o[4] = b.x; o[5] = b.y; o[6] = b.z; o[7] = b.w; }
DI f32x4 ld_bf4(const bf16* p) { const v2u u = *(const v2u*)p; return (f32x4){bflo(u.x), bfhi(u.x), bflo(u.y), bfhi(u.y)}; }
DI void st_bf8(bf16* p, const float (&o)[8]) { *(v4u*)p = (v4u){pk2(o[0], o[1]), pk2(o[2], o[3]), pk2(o[4], o[5]), pk2(o[6], o[7])}; }
DI void st_f8(float* p, const float (&o)[8]) { *(f32x4*)p = (f32x4){o[0], o[1], o[2], o[3]}; *(f32x4*)(p + 4) = (f32x4){o[4], o[5], o[6], o[7]}; }

DI void rwkv_prep(const Params& P, const Frame& F, int skip_blocks) {
    unsigned char* ws = P.ws; const bf16* RW = (const bf16*)(ws + WS_RW);
    const float* mu = INF(13); const float* k_k = INF(19); const float* sshift = INF(6);
    bf16* R_ = (bf16*)(ws + WS_R); bf16* K_ = (bf16*)(ws + WS_K); bf16* V_ = (bf16*)(ws + WS_V); bf16* KK_ = (bf16*)(ws + WS_KK); bf16* LA = (bf16*)(ws + WS_LA);
    const int lane = F.lane;
    if ((int)blockIdx.x < skip_blocks) return;
    for (int row = F.gw - skip_blocks * NWAVES; row < MP + MS; row += F.ngw - skip_blocks * NWAVES) {
        const bool samp = row >= MP; const int t = samp ? ((row - MP) & 3) : (row & 4095); const int bs = (row - MP) >> 2;
        const bf16* cur = RW + (size_t)row * RWC; const bf16* prv = cur - RWC;
#pragma unroll
        for (int part = 0; part < 3; ++part) {
            const int c = part * 512 + 8 * lane; float x[8], p[8], m[8];
            ld_bf8(cur + c, x); ld_f8(mu + c, m);
            if (t > 0) ld_bf8(prv + c, p); else if (samp) ld_f8(sshift + (size_t)bs * RWC + c, p); else {
#pragma unroll
                for (int e = 0; e < 8; ++e) p[e] = 0.f; }
#pragma unroll
            for (int e = 0; e < 8; ++e) x[e] = x[e] + (p[e] - x[e]) * m[e];
            bf16* dst = (part == 0 ? R_ : part == 1 ? K_ : V_) + (size_t)row * 512 + 8 * lane;
            st_bf8(dst, x);
            if (part == 1) { float kc[8], q[8]; ld_f8(k_k + 8 * lane, kc); float ss = 0.f;
#pragma unroll
                for (int e = 0; e < 8; ++e) { q[e] = x[e] * kc[e]; ss += q[e] * q[e]; }
                ss = red8(ss); const float inv = 1.0f / fmaxf(sqrtf(ss), 1e-12f);
#pragma unroll
                for (int e = 0; e < 8; ++e) q[e] *= inv;
                st_bf8(KK_ + (size_t)row * 512 + 8 * lane, q); }
        }
        { const int c = 1536 + 4 * lane; const v2u uc = *(const v2u*)(cur + c); float x[4] = {bflo(uc.x), bfhi(uc.x), bflo(uc.y), bfhi(uc.y)}, p[4];
          const f32x4 m = *(const f32x4*)(mu + c);
          if (t > 0) { const v2u up = *(const v2u*)(prv + c); p[0] = bflo(up.x); p[1] = bfhi(up.x); p[2] = bflo(up.y); p[3] = bfhi(up.y); }
          else if (samp) { const f32x4 s4 = *(const f32x4*)(sshift + (size_t)bs * RWC + c); p[0] = s4.x; p[1] = s4.y; p[2] = s4.z; p[3] = s4.w; }
          else { p[0] = p[1] = p[2] = p[3] = 0.f; }
          x[0] += (p[0] - x[0]) * m.x; x[1] += (p[1] - x[1]) * m.y; x[2] += (p[2] - x[2]) * m.z; x[3] += (p[3] - x[3]) * m.w;
          const int reg = lane >> 4;
#pragma unroll
          for (int e = 0; e < 4; ++e) { if (reg == 0) x[e] = 1.0f - 2.0f / (__expf(2.0f * x[e]) + 1.0f); else if (reg >= 2) x[e] = sigmoidf_(x[e]); }
          *(v2u*)(LA + (size_t)row * 256 + 4 * lane) = (v2u){pk2(x[0], x[1]), pk2(x[2], x[3])}; }
    }
}
struct EpiLora {
    const float* w0; const float* a0; const float* k_a; const bf16* K_; const bf16* KK_; float* W_; bf16* KP_; bf16* KKA_; bf16* G_;
    DI void operator()(int row, int head, int d4, f32x4 lo, f32x4 hi) const {
        if (row >= MP + MS) return;
        const int reg = head >> 3, c0 = (head & 7) * 64 + d4;
#pragma unroll
        for (int hh = 0; hh < 2; ++hh) { const int c = c0 + 32 * hh; const f32x4 x = hh ? hi : lo; const size_t o = (size_t)row * 512 + c;
            if (reg == 0) { const f32x4 b = *(const f32x4*)(w0 + c); f32x4 r;
                r.x = -0.6065306597126334f * sigmoidf_(b.x + x.x); r.y = -0.6065306597126334f * sigmoidf_(b.y + x.y);
                r.z = -0.6065306597126334f * sigmoidf_(b.z + x.z); r.w = -0.6065306597126334f * sigmoidf_(b.w + x.w); *(f32x4*)(W_ + o) = r; }
            else if (reg == 1) { const f32x4 b = *(const f32x4*)(a0 + c), ka = *(const f32x4*)(k_a + c); const v2u ku = *(const v2u*)(K_ + o), kku = *(const v2u*)(KK_ + o);
                const f32x4 k = {bflo(ku.x), bfhi(ku.x), bflo(ku.y), bfhi(ku.y)}, kk = {bflo(kku.x), bfhi(kku.x), bflo(kku.y), bfhi(kku.y)}; f32x4 a;
                a.x = sigmoidf_(b.x + x.x); a.y = sigmoidf_(b.y + x.y); a.z = sigmoidf_(b.z + x.z); a.w = sigmoidf_(b.w + x.w);
                st_bf16x4(KP_ + o, k * (1.0f + (a - 1.0f) * ka)); st_bf16x4(KKA_ + o, kk * a); }
            else { st_bf16x4(G_ + o, x); } }
    }
};
constexpr int SC_CH = 32, SC_STEP = 384;
DI void scan_chain(const Params& P, const Frame& F, int row0, int h, int ihalf, int nsteps, const float* S0, float* Sout) {
    unsigned char* ws = P.ws;
    const float* a0p = (const float*)(ws + WS_W); const bf16* a1p = (const bf16*)(ws + WS_KK); const bf16* a2p = (const bf16*)(ws + WS_KKA);
    const bf16* a3p = (const bf16*)(ws + WS_KP); const bf16* a4p = (const bf16*)(ws + WS_R); const bf16* a5p = (const bf16*)(ws + WS_V);
    float* Y_ = (float*)(ws + WS_Y);
    LAS float* buf = (LAS float*)F.lds;
    LAS float* ybuf = (LAS float*)(F.lds + 2 * SC_CH * SC_STEP * 4);
    const int lane = F.lane, il = 8 * (F.wave & 3) + (lane >> 3), i = 32 * ihalf + il, j0 = 8 * (lane & 7); const bool comp = F.wave < 4;
    f32x2 S[4];
    if (S0) { const f32x4 a = *(const f32x4*)(S0 + i * 64 + j0), b = *(const f32x4*)(S0 + i * 64 + j0 + 4); S[0] = (f32x2){a.x, a.y}; S[1] = (f32x2){a.z, a.w}; S[2] = (f32x2){b.x, b.y}; S[3] = (f32x2){b.z, b.w}; }
    else { S[0] = S[1] = S[2] = S[3] = (f32x2){0.f, 0.f}; }
    f32x4 st0, st1, st2, st3, st4, st5;
    const int lstep = F.tid >> 4, lc4 = (F.tid & 15) * 4;
    const size_t goff = (size_t)(row0 + lstep) * 512 + h * 64 + lc4;
#define SC_GLOAD(step0) do { const bool ok_ = (step0) + lstep < nsteps; const size_t o_ = goff + (size_t)(step0) * 512; const f32x4 z_ = {0.f, 0.f, 0.f, 0.f}; \
        st0 = ok_ ? *(const f32x4*)(a0p + o_) : z_; st0.x = __expf(st0.x); st0.y = __expf(st0.y); st0.z = __expf(st0.z); st0.w = __expf(st0.w); \
        st1 = ok_ ? ld_bf4(a1p + o_) : z_; st2 = ok_ ? ld_bf4(a2p + o_) : z_; st3 = ok_ ? ld_bf4(a3p + o_) : z_; st4 = ok_ ? ld_bf4(a4p + o_) : z_; st5 = ok_ ? ld_bf4(a5p + o_) : z_; } while (0)
#define SC_LSTORE(bi) do { LAS float* d_ = buf + (bi) * SC_CH * SC_STEP + lstep * SC_STEP + lc4; \
        *(LAS f32x4*)(d_) = st0; *(LAS f32x4*)(d_ + 64) = st1; *(LAS f32x4*)(d_ + 128) = st2; *(LAS f32x4*)(d_ + 192) = st3; *(LAS f32x4*)(d_ + 256) = st4; *(LAS f32x4*)(d_ + 320) = st5; } while (0)
    SC_GLOAD(0); SC_LSTORE(0); __syncthreads();
    const int nch = (nsteps + SC_CH - 1) / SC_CH;
    for (int ch = 0; ch < nch; ++ch) {
        const int bi = ch & 1; if (ch + 1 < nch) SC_GLOAD((ch + 1) * SC_CH);
        const LAS float* cb = buf + bi * SC_CH * SC_STEP;
        const int rem = nsteps - ch * SC_CH, ns = rem < SC_CH ? rem : SC_CH;
        if (comp) {
            f32x4 w0, w1, k0, k1, a0, a1, p0, p1, r0, r1; float vi;
#define SC_LD(s_) do { const LAS float* sb_ = cb + (s_) * SC_STEP; w0 = *(const LAS f32x4*)(sb_ + j0); w1 = *(const LAS f32x4*)(sb_ + j0 + 4); k0 = *(const LAS f32x4*)(sb_ + 64 + j0); k1 = *(const LAS f32x4*)(sb_ + 64 + j0 + 4); \
                a0 = *(const LAS f32x4*)(sb_ + 128 + j0); a1 = *(const LAS f32x4*)(sb_ + 128 + j0 + 4); p0 = *(const LAS f32x4*)(sb_ + 192 + j0); p1 = *(const LAS f32x4*)(sb_ + 192 + j0 + 4); \
                r0 = *(const LAS f32x4*)(sb_ + 256 + j0); r1 = *(const LAS f32x4*)(sb_ + 256 + j0 + 4); vi = sb_[320 + i]; } while (0)
            SC_LD(0);
            for (int s = 0; s < ns; ++s) {
                const f32x4 cw0 = w0, cw1 = w1, ck0 = k0, ck1 = k1, ca0 = a0, ca1 = a1, cp0 = p0, cp1 = p1, cr0 = r0, cr1 = r1; const float cvi = vi;
                SC_LD(s + 1 < SC_CH ? s + 1 : s);
                f32x2 d2 = S[0] * (f32x2){ck0.x, ck0.y}; d2 = __builtin_elementwise_fma(S[1], (f32x2){ck0.z, ck0.w}, d2); f32x2 e2 = S[2] * (f32x2){ck1.x, ck1.y}; e2 = __builtin_elementwise_fma(S[3], (f32x2){ck1.z, ck1.w}, e2);
                d2 += e2; float sk = red8(d2.x + d2.y);
                const f32x2 vv = {cvi, cvi}, nsk = {-sk, -sk};
                S[0] = __builtin_elementwise_fma(nsk, (f32x2){ca0.x, ca0.y}, __builtin_elementwise_fma(vv, (f32x2){cp0.x, cp0.y}, S[0] * (f32x2){cw0.x, cw0.y}));
                S[1] = __builtin_elementwise_fma(nsk, (f32x2){ca0.z, ca0.w}, __builtin_elementwise_fma(vv, (f32x2){cp0.z, cp0.w}, S[1] * (f32x2){cw0.z, cw0.w}));
                S[2] = __builtin_elementwise_fma(nsk, (f32x2){ca1.x, ca1.y}, __builtin_elementwise_fma(vv, (f32x2){cp1.x, cp1.y}, S[2] * (f32x2){cw1.x, cw1.y}));
                S[3] = __builtin_elementwise_fma(nsk, (f32x2){ca1.z, ca1.w}, __builtin_elementwise_fma(vv, (f32x2){cp1.z, cp1.w}, S[3] * (f32x2){cw1.z, cw1.w}));
                f32x2 y2 = S[0] * (f32x2){cr0.x, cr0.y}; y2 = __builtin_elementwise_fma(S[1], (f32x2){cr0.z, cr0.w}, y2); f32x2 z2 = S[2] * (f32x2){cr1.x, cr1.y}; z2 = __builtin_elementwise_fma(S[3], (f32x2){cr1.z, cr1.w}, z2);
                y2 += z2; const float y = red8(y2.x + y2.y);
                if ((lane & 7) == 0) ybuf[s * 32 + il] = y;
            }
#undef SC_LD
        }
        __syncthreads();
#pragma unroll
        for (int m = 0; m < 2; ++m) { const int q = F.tid + 512 * m, step = q >> 5, c = q & 31; if (step < ns) Y_[(size_t)(row0 + ch * SC_CH + step) * 512 + h * 64 + 32 * ihalf + c] = ybuf[q]; }
        if (ch + 1 < nch) SC_LSTORE(bi ^ 1);
        __syncthreads();
    }
#undef SC_GLOAD
#undef SC_LSTORE
    if (comp) { *(f32x4*)(Sout + i * 64 + j0) = (f32x4){S[0].x, S[0].y, S[1].x, S[1].y}; *(f32x4*)(Sout + i * 64 + j0 + 4) = (f32x4){S[2].x, S[2].y, S[3].x, S[3].y}; }
}
DI void scan_sample_wave(const Params& P, int wid, int lane_in) {
    int lane = lane_in; asm volatile("" : "+v"(lane));
    unsigned char* ws = P.ws; const int c = wid >> 3, rg = wid & 7, h = c & 7, row0 = MP + (c >> 3) * 4, i = 8 * rg + (lane >> 3), j0 = 8 * (lane & 7);
    const float* LW = (const float*)(ws + WS_W); const bf16* KK = (const bf16*)(ws + WS_KK); const bf16* KKA = (const bf16*)(ws + WS_KKA); const bf16* KP = (const bf16*)(ws + WS_KP);
    const bf16* RR = (const bf16*)(ws + WS_R); const bf16* VV = (const bf16*)(ws + WS_V); float* Y_ = (float*)(ws + WS_Y);
    float S[8]; ld_f8(INF(5) + (size_t)c * 4096 + i * 64 + j0, S);
    float w[4][8], kk[4][8], ka[4][8], kp[4][8], r[4][8], vi[4];
#pragma unroll
    for (int st = 0; st < 4; ++st) { const size_t o = (size_t)(row0 + st) * 512 + h * 64; ld_f8(LW + o + j0, w[st]); ld_bf8(KK + o + j0, kk[st]); ld_bf8(KKA + o + j0, ka[st]); ld_bf8(KP + o + j0, kp[st]); ld_bf8(RR + o + j0, r[st]); vi[st] = bf2f(VV[o + i]); }
#pragma unroll
    for (int st = 0; st < 4; ++st) { float sk = 0.f;
#pragma unroll
        for (int e = 0; e < 8; ++e) sk += S[e] * kk[st][e];
        sk = red8(sk); float y = 0.f;
#pragma unroll
        for (int e = 0; e < 8; ++e) { S[e] = S[e] * __expf(w[st][e]) + vi[st] * kp[st][e] - sk * ka[st][e]; y += S[e] * r[st][e]; }
        y = red8(y);
        if ((lane & 7) == 0) Y_[(size_t)(row0 + st) * 512 + h * 64 + i] = y; }
    st_f8(P.out + O_WKVS + (size_t)c * 4096 + i * 64 + j0, S);
}
template <int NR, bool YLDS> DI void rwkv_post_rows(const Params& P, int row0, int rstride, int lane_in, const LAS float* ylds, int yrow0) {
    int lane = lane_in; asm volatile("" : "+v"(lane));
    unsigned char* ws = P.ws; const float* r_k = INF(21); const float* ln_g = INF(22); const float* ln_b = INF(23);
    const bf16* R_ = (const bf16*)(ws + WS_R); const bf16* KP_ = (const bf16*)(ws + WS_KP); const bf16* V_ = (const bf16*)(ws + WS_V); const bf16* G_ = (const bf16*)(ws + WS_G); const float* Y_ = (const float*)(ws + WS_Y);
    bf16* ATT = (bf16*)(ws + WS_ATT); const int c = 8 * lane;
    float rk[8], lg[8], lb[8]; ld_f8(r_k + c, rk); ld_f8(ln_g + c, lg); ld_f8(ln_b + c, lb);
    float y[NR][8]; v4u ru[NR], ku[NR], vu[NR], gu[NR];
#pragma unroll
    for (int q = 0; q < NR; ++q) { const size_t o = (size_t)(row0 + q * rstride) * 512 + c;
        if (YLDS) { const f32x4 a = *(const LAS f32x4*)(ylds + (yrow0 + q * rstride) * 512 + c), b2 = *(const LAS f32x4*)(ylds + (yrow0 + q * rstride) * 512 + c + 4); y[q][0] = a.x; y[q][1] = a.y; y[q][2] = a.z; y[q][3] = a.w; y[q][4] = b2.x; y[q][5] = b2.y; y[q][6] = b2.z; y[q][7] = b2.w; }
        else ld_f8(Y_ + o, y[q]); ru[q] = *(const v4u*)(R_ + o); ku[q] = *(const v4u*)(KP_ + o); vu[q] = *(const v4u*)(V_ + o); gu[q] = *(const v4u*)(G_ + o); }
#pragma unroll
    for (int q = 0; q < NR; ++q) {
        float r[8] = {bflo(ru[q].x), bfhi(ru[q].x), bflo(ru[q].y), bfhi(ru[q].y), bflo(ru[q].z), bfhi(ru[q].z), bflo(ru[q].w), bfhi(ru[q].w)};
        float k[8] = {bflo(ku[q].x), bfhi(ku[q].x), bflo(ku[q].y), bfhi(ku[q].y), bflo(ku[q].z), bfhi(ku[q].z), bflo(ku[q].w), bfhi(ku[q].w)};
        float v[8] = {bflo(vu[q].x), bfhi(vu[q].x), bflo(vu[q].y), bfhi(vu[q].y), bflo(vu[q].z), bfhi(vu[q].z), bflo(vu[q].w), bfhi(vu[q].w)};
        float g[8] = {bflo(gu[q].x), bfhi(gu[q].x), bflo(gu[q].y), bfhi(gu[q].y), bflo(gu[q].z), bfhi(gu[q].z), bflo(gu[q].w), bfhi(gu[q].w)};
        float s = 0.f, bs = 0.f;
#pragma unroll
        for (int e = 0; e < 8; ++e) { s += y[q][e]; bs += r[e] * k[e] * rk[e]; }
        s = red8(s); bs = red8(bs); const float mean = s * (1.0f / 64.0f); float qq = 0.f;
#pragma unroll
        for (int e = 0; e < 8; ++e) { y[q][e] -= mean; qq += y[q][e] * y[q][e]; }
        qq = red8(qq); const float rstd = 1.0f / sqrtf(qq * (1.0f / 64.0f) + 64e-5f);
        float o8[8];
#pragma unroll
        for (int e = 0; e < 8; ++e) o8[e] = (y[q][e] * rstd * lg[e] + lb[e] + bs * v[e]) * g[e];
        *(v4u*)(ATT + (size_t)(row0 + q * rstride) * 1024 + c) = (v4u){pk2(o8[0], o8[1]), pk2(o8[2], o8[3]), pk2(o8[4], o8[5]), pk2(o8[6], o8[7])}; }
}
DI void rwkv_post(const Params& P, const Frame& F) {
    unsigned char* ws = P.ws; const float* r_k = INF(21); const float* ln_g = INF(22); const float* ln_b = INF(23);
    const bf16* R_ = (const bf16*)(ws + WS_R); const bf16* KP_ = (const bf16*)(ws + WS_KP); const bf16* V_ = (const bf16*)(ws + WS_V); const bf16* G_ = (const bf16*)(ws + WS_G); const float* Y_ = (const float*)(ws + WS_Y);
    bf16* ATT = (bf16*)(ws + WS_ATT); const int lane = F.lane, c = 8 * lane;
    float rk[8], lg[8], lb[8]; ld_f8(r_k + c, rk); ld_f8(ln_g + c, lg); ld_f8(ln_b + c, lb);
    for (int row = F.gw; row < MP + MS; row += F.ngw) { const size_t o = (size_t)row * 512 + c;
        float y[8], r[8], k[8], v[8], g[8]; ld_f8(Y_ + o, y); ld_bf8(R_ + o, r); ld_bf8(KP_ + o, k); ld_bf8(V_ + o, v); ld_bf8(G_ + o, g);
        float s = 0.f, bs = 0.f;
#pragma unroll
        for (int e = 0; e < 8; ++e) { s += y[e]; bs += r[e] * k[e] * rk[e]; }
        s = red8(s); bs = red8(bs); const float mean = s * (1.0f / 64.0f); float q = 0.f;
#pragma unroll
        for (int e = 0; e < 8; ++e) { y[e] -= mean; q += y[e] * y[e]; }
        q = red8(q); const float rstd = 1.0f / sqrtf(q * (1.0f / 64.0f) + 64e-5f);
        float o8[8];
#pragma unroll
        for (int e = 0; e < 8; ++e) o8[e] = (y[e] * rstd * lg[e] + lb[e] + bs * v[e]) * g[e];
        *(v4u*)(ATT + (size_t)row * 1024 + c) = (v4u){pk2(o8[0], o8[1]), pk2(o8[2], o8[3]), pk2(o8[4], o8[5]), pk2(o8[6], o8[7])};
    }
}
typedef short v4i16_t __attribute__((ext_vector_type(4)));
DI int crow(int r, int hi) { return (r & 3) + 8 * (r >> 2) + 4 * hi; }
DI float half_max(float v) { auto rr = __builtin_amdgcn_permlane32_swap(__float_as_uint(v), __float_as_uint(v), false, false); return fmaxf(__uint_as_float(rr[0]), __uint_as_float(rr[1])); }
DI float half_sum(float v) { auto rr = __builtin_amdgcn_permlane32_swap(__float_as_uint(v), __float_as_uint(v), false, false); return __uint_as_float(rr[0]) + __uint_as_float(rr[1]); }
DI s16x4 vtr(const LAS unsigned char* p) { return __builtin_bit_cast(s16x4, __builtin_amdgcn_ds_read_tr16_b64_v4i16((LAS v4i16_t*)p)); }
#define MFMA32(a, b, c) __builtin_amdgcn_mfma_f32_32x32x16_bf16((a), (b), (c), 0, 0, 0)
struct AttnAcc { f32x16 o0, o1; float m, l; };
DI void acc_init(AttnAcc& A) {
#pragma unroll
    for (int i = 0; i < 16; ++i) { A.o0[i] = 0.f; A.o1[i] = 0.f; }
    A.m = 0.f; A.l = 0.f; }
DI void ld_q(const bf16* qrow, bf16x8 (&qr)[4], int hi) {
#pragma unroll
    for (int d0 = 0; d0 < 4; ++d0) qr[d0] = *(const bf16x8*)(qrow + 16 * d0 + 8 * hi); }
DI void qk_tile(const LAS unsigned char* Kt, const bf16x8 (&qr)[4], f32x16& p0, f32x16& p1, int lane, float init = 0.f) {
    const LAS unsigned char* kb = Kt + (lane >> 5) * 1024 + (lane & 31) * 16;
#pragma unroll
    for (int i = 0; i < 16; ++i) { p0[i] = init; p1[i] = init; }
#pragma unroll
    for (int d0 = 0; d0 < 4; ++d0) { const bf16x8 b0 = *(const LAS bf16x8*)(kb + d0 * 2048), b1 = *(const LAS bf16x8*)(kb + d0 * 2048 + 512);
        p0 = MFMA32(b0, qr[d0], p0); p1 = MFMA32(b1, qr[d0], p1); }
}
DI float max3f(float a, float b, float c) { float r; asm("v_max3_f32 %0, %1, %2, %3" : "=v"(r) : "v"(a), "v"(b), "v"(c)); return r; }
DI bf16x8 pack8(const f32x16& p, int s) { v4u u; u.x = pk2(p[8 * s], p[8 * s + 1]); u.y = pk2(p[8 * s + 2], p[8 * s + 3]); u.z = pk2(p[8 * s + 4], p[8 * s + 5]); u.w = pk2(p[8 * s + 6], p[8 * s + 7]); return __builtin_bit_cast(bf16x8, u); }
DI void pv_tile(const LAS unsigned char* Vt, const f32x16& p0, const f32x16& p1, f32x16& o0, f32x16& o1, int lane) {
    const int hi = lane >> 5;
    const LAS unsigned char* vp = Vt + ((lane >> 4) & 1) * 32 + (lane & 3) * 8 + (4 * hi + ((lane & 15) >> 2)) * 64;
#pragma unroll
    for (int cc = 0; cc < 2; ++cc)
#pragma unroll
        for (int s = 0; s < 2; ++s) { const int ks = 2 * cc + s; const bf16x8 pb = pack8(cc ? p1 : p0, s);
#pragma unroll
            for (int d0 = 0; d0 < 2; ++d0) { const s16x4 lo = vtr(vp + d0 * 4096 + ks * 1024), h4 = vtr(vp + d0 * 4096 + ks * 1024 + 512);
                const bf16x8 a = {lo[0], lo[1], lo[2], lo[3], h4[0], h4[1], h4[2], h4[3]};
                if (d0 == 0) o0 = MFMA32(a, pb, o0); else o1 = MFMA32(a, pb, o1); } }
}
template <int MODE> DI void mask_scale(f32x16& p0, f32x16& p1, bool rowok, int a, int hi) {
#pragma unroll
    for (int i = 0; i < 16; ++i) { const int k0 = crow(i, hi), k1 = k0 + 32;
        bool v0 = rowok, v1 = rowok;
        if (MODE == 1) { v0 = v0 && (k0 <= a); v1 = v1 && (k1 <= a); }
        if (MODE == 2) { v0 = v0 && (k0 > a); v1 = v1 && (k1 > a); }
        p0[i] = v0 ? p0[i] : -INFINITY; p1[i] = v1 ? p1[i] : -INFINITY; }
}
template <int MODE> DI void attn_tile(const LAS unsigned char* Kt, const LAS unsigned char* Vt, const bf16x8 (&qr)[4], AttnAcc& A, bool rowok, int a, int lane) {
    f32x16 p0, p1; qk_tile(Kt, qr, p0, p1, lane, rowok ? -A.m : -INFINITY);
    const int hi = lane >> 5;
    if (MODE != 0) {
#pragma unroll
        for (int i = 0; i < 16; ++i) { const int k0 = crow(i, hi), k1 = k0 + 32; const bool v0 = MODE == 1 ? (k0 <= a) : (k0 > a), v1 = MODE == 1 ? (k1 <= a) : (k1 > a);
            p0[i] = v0 ? p0[i] : -INFINITY; p1[i] = v1 ? p1[i] : -INFINITY; } }
    float mx = max3f(p0[0], p0[1], p1[0]); mx = max3f(mx, p1[1], p0[2]);
#pragma unroll
    for (int i = 2; i < 16; i += 2) mx = max3f(mx, max3f(p0[i], p0[i + 1], p1[i]), p1[i + 1]);
    mx = half_max(mx);
    if (__any(mx > 8.0f)) {
        const float dl = mx > 8.0f ? mx : 0.f, alpha = __builtin_amdgcn_exp2f(-dl);
        A.m += dl; A.l *= alpha;
#pragma unroll
        for (int i = 0; i < 16; ++i) { A.o0[i] *= alpha; A.o1[i] *= alpha; p0[i] -= dl; p1[i] -= dl; } }
    float ls = 0.f;
#pragma unroll
    for (int i = 0; i < 16; ++i) { p0[i] = __builtin_amdgcn_exp2f(p0[i]); p1[i] = __builtin_amdgcn_exp2f(p1[i]); ls += p0[i] + p1[i]; }
    A.l += ls;
    pv_tile(Vt, p0, p1, A.o0, A.o1, lane);
}
DI void mask_rt(f32x16& p0, f32x16& p1, int mode, int a, int hi) {
    if (mode != 0) {
#pragma unroll
        for (int i = 0; i < 16; ++i) { const int k0 = crow(i, hi), k1 = k0 + 32; const bool v0 = mode == 1 ? (k0 <= a) : (k0 > a), v1 = mode == 1 ? (k1 <= a) : (k1 > a);
            p0[i] = v0 ? p0[i] : -INFINITY; p1[i] = v1 ? p1[i] : -INFINITY; } }
}
DI void attn_tile2(const LAS unsigned char* Ka, const LAS unsigned char* Va, const LAS unsigned char* Kb, const LAS unsigned char* Vb, const bf16x8 (&qr)[4], AttnAcc& A,
                   bool ok_a, int mode_a, int a_a, bool ok_b, int mode_b, int a_b, int lane) {
    f32x16 p0, p1, p2, p3; qk_tile(Ka, qr, p0, p1, lane, ok_a ? -A.m : -INFINITY); qk_tile(Kb, qr, p2, p3, lane, ok_b ? -A.m : -INFINITY);
    const int hi = lane >> 5;
    mask_rt(p0, p1, mode_a, a_a, hi); mask_rt(p2, p3, mode_b, a_b, hi);
    float mx = max3f(p0[0], p1[0], p2[0]); mx = fmaxf(mx, p3[0]);
#pragma unroll
    for (int i = 1; i < 16; ++i) mx = max3f(mx, max3f(p0[i], p1[i], p2[i]), p3[i]);
    mx = half_max(mx);
    if (__any(mx > 8.0f)) {
        const float dl = mx > 8.0f ? mx : 0.f, alpha = __builtin_amdgcn_exp2f(-dl);
        A.m += dl; A.l *= alpha;
#pragma unroll
        for (int i = 0; i < 16; ++i) { A.o0[i] *= alpha; A.o1[i] *= alpha; p0[i] -= dl; p1[i] -= dl; p2[i] -= dl; p3[i] -= dl; } }
    float ls = 0.f;
#pragma unroll
    for (int i = 0; i < 16; ++i) { p0[i] = __builtin_amdgcn_exp2f(p0[i]); p1[i] = __builtin_amdgcn_exp2f(p1[i]); p2[i] = __builtin_amdgcn_exp2f(p2[i]); p3[i] = __builtin_amdgcn_exp2f(p3[i]); ls += (p0[i] + p1[i]) + (p2[i] + p3[i]); }
    A.l += ls;
    pv_tile(Va, p0, p1, A.o0, A.o1, lane); pv_tile(Vb, p2, p3, A.o0, A.o1, lane);
}
struct TileRegs { v4u k, v; };
DI void tile_gload(TileRegs& R, const bf16* Kt, const bf16* Vt, int wave, int lane) {
    R.k = *(const v4u*)(Kt + (size_t)lane * 64 + wave * 8);
    R.v = *(const v4u*)(Vt + (size_t)(16 * (wave & 3) + (lane >> 2)) * 64 + 32 * (wave >> 2) + 8 * (lane & 3));
}
DI void tile_lstore(const TileRegs& R, LAS unsigned char* kb, LAS unsigned char* vb, int wave, int lane) {
    *(LAS v4u*)(kb + wave * 1024 + lane * 16) = R.k; *(LAS v4u*)(vb + wave * 1024 + lane * 16) = R.v; }
DI void branch_out(f32x16& out0, f32x16& out1, const AttnAcc& A, float gate) {
    const float lt = half_sum(A.l); const float sc = gate / fmaxf(lt, 1e-30f);
#pragma unroll
    for (int i = 0; i < 16; ++i) { out0[i] += A.o0[i] * sc; out1[i] += A.o1[i] * sc; }
}
template <bool FIRST> DI void branch_out_lds(LAS float* ob, const AttnAcc& A, float gate) {
    const float lt = half_sum(A.l); const float sc = gate / fmaxf(lt, 1e-30f);
#pragma unroll
    for (int i = 0; i < 16; ++i) { if (FIRST) { ob[i] = A.o0[i] * sc; ob[16 + i] = A.o1[i] * sc; } else { ob[i] += A.o0[i] * sc; ob[16 + i] += A.o1[i] * sc; } }
}
DI void store_ot(bf16* dst, const f32x16& o0, const f32x16& o1, int hi) {
#pragma unroll
    for (int gi = 0; gi < 4; ++gi) { *(v2u*)(dst + 8 * gi + 4 * hi) = (v2u){pk2(o0[4 * gi], o0[4 * gi + 1]), pk2(o0[4 * gi + 2], o0[4 * gi + 3])};
        *(v2u*)(dst + 32 + 8 * gi + 4 * hi) = (v2u){pk2(o1[4 * gi], o1[4 * gi + 1]), pk2(o1[4 * gi + 2], o1[4 * gi + 3])}; }
}
constexpr size_t WS_BIASC = WS_END1;
constexpr size_t WS_KCP = al(WS_BIASC + 2 * 64 * 4);
constexpr size_t WS_KCS = al(WS_KCP + (size_t)2 * 8 * 256 * 64 * 2);
constexpr size_t WS_END2 = al(WS_KCS + (size_t)2 * 64 * 512 * 64 * 2);

DI void p0_cmp_bias(const Params& P, const Frame& F) {
    const float* pe = INF(26); const float* w1 = INF(25); float* B = (float*)(P.ws + WS_BIASC);
    for (int it = F.gw; it < 128; it += F.ngw) { const int kind = it >> 6, e = it & 63; float s = 0.f;
        for (int i = 0; i < 32; ++i) { const int idx = F.lane + 64 * i; s += pe[kind * 2048 + idx] * w1[((size_t)kind * 2048 + idx) * 64 + e]; }
        s = wave_sum(s); if (F.lane == 0) B[it] = s; }
}
DI float gelu_tanh(float x) { const float u = 0.7978845608028654f * (x + 0.044715f * x * x * x); const float t = 1.0f - 2.0f / (__expf(2.0f * u) + 1.0f); return 0.5f * x * (1.0f + t); }
DI void cmp_stage2(const Params& P, const Frame& F) {
    unsigned char* ws = P.ws; LAS bf16* w2t = (LAS bf16*)F.lds;
    for (int i = F.tid; i < 2 * 64 * 64; i += 512) { const int kind = i >> 12, e = (i >> 6) & 63, f = i & 63; w2t[(kind * 64 + f) * 64 + e] = (bf16)(pk2(INF(27)[i], 0.f) & 0xffffu); }
    __syncthreads();
    const float* bias = (const float*)(ws + WS_BIASC); const float* HCP = (const float*)(ws + WS_HCP); const float* HCS = (const float*)(ws + WS_HCS);
    bf16* KCP = (bf16*)(ws + WS_KCP); bf16* KCS = (bf16*)(ws + WS_KCS); int lane_ = F.lane; asm volatile("" : "+v"(lane_)); const int lane = lane_, r32 = lane & 31, hi = lane >> 5;
    for (int tile = F.gw; tile < (4096 + 65536) / 32; tile += F.ngw) {
        const bool samp = tile >= 128; const int r0 = (samp ? tile - 128 : tile) * 32; const int half = samp ? 32768 : 2048, nn = samp ? 512 : 256;
        const int kind = r0 >= half ? 1 : 0, r = r0 + r32, n = r & (nn - 1); const float* HC = samp ? HCS : HCP; bf16* dst = (samp ? KCS : KCP) + (size_t)r0 * 64;
        const bool zrow = (n == nn - 1); const float* pa = HC + (size_t)r * 128 + 8 * hi; const float* pb = HC + (size_t)(zrow ? r : r + 1) * 128 + 64 + 8 * hi; const float* bp = bias + kind * 64 + 8 * hi;
        bf16x8 af[4];
#pragma unroll
        for (int ks = 0; ks < 4; ++ks) { if (ks == 2) asm volatile("" ::: "memory"); float x[8], y[8], z[8]; ld_f8(pa + 16 * ks, x); ld_f8(pb + 16 * ks, y); ld_f8(bp + 16 * ks, z);
#pragma unroll
            for (int j = 0; j < 8; ++j) x[j] = gelu_tanh(x[j] + y[j] + z[j]);
            af[ks] = __builtin_bit_cast(bf16x8, (v4u){pk2(x[0], x[1]), pk2(x[2], x[3]), pk2(x[4], x[5]), pk2(x[6], x[7])}); }
#pragma unroll
        for (int cb = 0; cb < 2; ++cb) { f32x16 acc;
#pragma unroll
            for (int i = 0; i < 16; ++i) acc[i] = 0.f;
#pragma unroll
            for (int ks = 0; ks < 4; ++ks) acc = MFMA32(af[ks], *(const LAS bf16x8*)(w2t + (kind * 64 + 32 * cb + r32) * 64 + 16 * ks + 8 * hi), acc);
#pragma unroll
            for (int i = 0; i < 16; ++i) { const int rw = crow(i, hi); const bool zr = ((r0 + rw) & (nn - 1)) == nn - 1; dst[(size_t)rw * 64 + 32 * cb + r32] = zr ? (bf16)0 : (bf16)(pk2(acc[i], 0.f) & 0xffffu); } }
    }
}
struct TileRegs2 { TileRegs a, b; };
DI void kv_prefetch(TileRegs2& R, int jb, int je, const bf16* KB, const bf16* VB, int wave, int lane) {
    tile_gload(R.a, KB + (size_t)jb * 4096, VB + (size_t)jb * 4096, wave, lane);
    if (jb + 1 <= je) tile_gload(R.b, KB + (size_t)(jb + 1) * 4096, VB + (size_t)(jb + 1) * 4096, wave, lane);
}
template <class Body> DI void kv_loop(TileRegs2& R, int& cur, LAS unsigned char* kvb, int jb, int je, const bf16* KB, const bf16* VB, int wave, int lane, Body&& body, bool pre = false) {
    if (!pre) kv_prefetch(R, jb, je, KB, VB, wave, lane);
    tile_lstore(R.a, kvb + (2 * cur) * 16384, kvb + (2 * cur) * 16384 + 8192, wave, lane);
    if (jb + 1 <= je) tile_lstore(R.b, kvb + (2 * cur + 1) * 16384, kvb + (2 * cur + 1) * 16384 + 8192, wave, lane);
    __syncthreads();
    for (int j = jb; j <= je; j += 2) {
        const bool n0 = j + 2 <= je, n1 = j + 3 <= je;
        if (n0) tile_gload(R.a, KB + (size_t)(j + 2) * 4096, VB + (size_t)(j + 2) * 4096, wave, lane);
        if (n1) tile_gload(R.b, KB + (size_t)(j + 3) * 4096, VB + (size_t)(j + 3) * 4096, wave, lane);
        { const LAS unsigned char* Kt_ = kvb + (2 * cur) * 16384; body(j, Kt_, Kt_ + 8192); }
        if (j + 1 <= je) { const LAS unsigned char* Kt_ = kvb + (2 * cur + 1) * 16384; body(j + 1, Kt_, Kt_ + 8192); }
        if (n0) tile_lstore(R.a, kvb + (2 * (cur ^ 1)) * 16384, kvb + (2 * (cur ^ 1)) * 16384 + 8192, wave, lane);
        if (n1) tile_lstore(R.b, kvb + (2 * (cur ^ 1) + 1) * 16384, kvb + (2 * (cur ^ 1) + 1) * 16384 + 8192, wave, lane);
        __syncthreads(); cur ^= 1; }
}
template <class Body2> DI void kv_loop2(TileRegs2& R, int& cur, LAS unsigned char* kvb, int jb, int je, const bf16* KB, const bf16* VB, int wave, int lane, Body2&& body2, bool pre = false) {
    if (!pre) kv_prefetch(R, jb, je, KB, VB, wave, lane);
    tile_lstore(R.a, kvb + (2 * cur) * 16384, kvb + (2 * cur) * 16384 + 8192, wave, lane);
    if (jb + 1 <= je) tile_lstore(R.b, kvb + (2 * cur + 1) * 16384, kvb + (2 * cur + 1) * 16384 + 8192, wave, lane);
    __syncthreads();
    for (int j = jb; j <= je; j += 2) {
        const bool n0 = j + 2 <= je, n1 = j + 3 <= je;
        if (n0) tile_gload(R.a, KB + (size_t)(j + 2) * 4096, VB + (size_t)(j + 2) * 4096, wave, lane);
        if (n1) tile_gload(R.b, KB + (size_t)(j + 3) * 4096, VB + (size_t)(j + 3) * 4096, wave, lane);
        { const LAS unsigned char* Ka_ = kvb + (2 * cur) * 16384; body2(j, Ka_, Ka_ + 8192, Ka_ + 16384, Ka_ + 16384 + 8192, j + 1 <= je); }
        if (n0) tile_lstore(R.a, kvb + (2 * (cur ^ 1)) * 16384, kvb + (2 * (cur ^ 1)) * 16384 + 8192, wave, lane);
        if (n1) tile_lstore(R.b, kvb + (2 * (cur ^ 1) + 1) * 16384, kvb + (2 * (cur ^ 1) + 1) * 16384 + 8192, wave, lane);
        __syncthreads(); cur ^= 1; }
}
constexpr int NSA_KV_OFF = 0, NSA_SEL_OFF = 65536, NSA_OUT_OFF = NSA_SEL_OFF + 512, NSA_IMP_OFF = NSA_OUT_OFF;
DI void nsa_prompt_unit(const Params& P, const Frame& F, int b, int g, int qb) {
    unsigned char* ws = P.ws; int lane_ = F.lane; asm volatile("" : "+v"(lane_));
    const int lane = lane_, wave = F.wave, r32 = lane & 31, hi = lane >> 5;
    const int tl = 8 * wave + (r32 >> 2), hh = r32 & 3, t0 = 64 * qb, tok = t0 + tl, row = b * SEQ + tok, head = g * 4 + hh;
    LAS unsigned char* kvb = F.lds + NSA_KV_OFF;
    LAS float* impM = (LAS float*)(F.lds + NSA_IMP_OFF); LAS float* impS = impM + 64 * 65;
    LAS unsigned long long* selm = (LAS unsigned long long*)(F.lds + NSA_SEL_OFF);
    bf16x8 qr[4]; ld_q((const bf16*)(ws + WS_Q0) + (size_t)row * 512 + head * 64, qr, hi);
    const float* gt = (const float*)(ws + WS_GATES) + (size_t)row * 32 + head * 3; const float g0 = gt[0], g1 = gt[1], g2 = gt[2];
    const bf16* KV0 = (const bf16*)(ws + WS_KV0);
    LAS float* outb = (LAS float*)(F.lds + NSA_OUT_OFF) + (wave * 64 + lane) * 33;
    TileRegs2 R; int cur = 0;
    const int ncv = tok >= 31 ? ((tok - 15) >> 4) : 0, ntc = (4 * qb + 66) >> 6;
    const bf16* KC = (const bf16*)(ws + WS_KCP) + (size_t)((0 * 4 + b) * 2 + g) * 256 * 64; const bf16* VC = (const bf16*)(ws + WS_KCP) + (size_t)((1 * 4 + b) * 2 + g) * 256 * 64;
    AttnAcc A; acc_init(A);
    kv_loop(R, cur, kvb, 0, ntc - 1, KC, VC, wave, lane, [&](int j, const LAS unsigned char* Kt_, const LAS unsigned char* Vt_) { attn_tile<1>(Kt_, Vt_, qr, A, true, ncv - 1 - 64 * j, lane); });
    {
      const float lt = half_sum(A.l), rl = 1.0f / fmaxf(lt, 1e-30f), mfin = (A.m == -INFINITY) ? 0.f : A.m;
      for (int i = lane; i < 8 * 65; i += 64) { impM[wave * 8 * 65 + i] = 0.f; impS[wave * 8 * 65 + i] = 0.f; }
      kv_loop(R, cur, kvb, 0, ntc - 1, KC, VC, wave, lane, [&](int j, const LAS unsigned char* Kt_, const LAS unsigned char* Vt_) {
          f32x16 p0, p1; qk_tile(Kt_, qr, p0, p1, lane); mask_scale<1>(p0, p1, true, ncv - 1 - 64 * j, hi);
#pragma unroll
          for (int cc = 0; cc < 2; ++cc)
#pragma unroll
              for (int gi = 0; gi < 4; ++gi) { const f32x16& p = cc ? p1 : p0;
                  const float e0 = __builtin_amdgcn_exp2f(p[4 * gi] - mfin) * rl, e1 = __builtin_amdgcn_exp2f(p[4 * gi + 1] - mfin) * rl, e2 = __builtin_amdgcn_exp2f(p[4 * gi + 2] - mfin) * rl, e3 = __builtin_amdgcn_exp2f(p[4 * gi + 3] - mfin) * rl;
                  float mn = e0 + e1 + e2 + 0.5f * e3, sp = 0.5f * e3;
                  mn += __builtin_bit_cast(float, __builtin_amdgcn_update_dpp(0, __builtin_bit_cast(int, mn), 0xB1, 0xf, 0xf, false)); mn += __builtin_bit_cast(float, __builtin_amdgcn_update_dpp(0, __builtin_bit_cast(int, mn), 0x4E, 0xf, 0xf, false));
                  sp += __builtin_bit_cast(float, __builtin_amdgcn_update_dpp(0, __builtin_bit_cast(int, sp), 0xB1, 0xf, 0xf, false)); sp += __builtin_bit_cast(float, __builtin_amdgcn_update_dpp(0, __builtin_bit_cast(int, sp), 0x4E, 0xf, 0xf, false));
                  const int jj = 16 * j + 8 * cc + 2 * gi + hi;
                  if (hh == 0) { impM[tl * 65 + jj] = mn; impS[tl * 65 + jj + 1] = sp; } } });
    }
    const bf16* KS = KV0 + (size_t)((2 * 4 + b) * 2 + g) * SEQ * 64; const bf16* VS = KV0 + (size_t)((3 * 4 + b) * 2 + g) * SEQ * 64;
    kv_prefetch(R, 0, qb, KS, VS, wave, lane);
    {
#pragma unroll 1
      for (int tt = 0; tt < 8; ++tt) { const int tq = 8 * wave + tt;
          float sc = -INFINITY;
          if (lane <= qb) { sc = impM[tq * 65 + lane] + impS[tq * 65 + lane]; if (lane == qb || lane == qb - 1 || lane == 0) sc += 100.0f; }
          int cnt = 0; int ln = lane; asm volatile("" : "+v"(ln));
#pragma unroll
          for (int jp = 0; jp < 64; ++jp) { const float o = __builtin_bit_cast(float, __builtin_amdgcn_readlane(__builtin_bit_cast(int, sc), jp)); cnt += (o > sc || (o == sc && jp < ln)) ? 1 : 0; }
          const unsigned long long m = __ballot(lane <= qb && cnt < 16);
          if (lane == 0) selm[tq] = m; }
    }
    __syncthreads();
    branch_out_lds<true>(outb, A, g0);
    const unsigned long long mysel = selm[tl];
    { acc_init(A);
      kv_loop2(R, cur, kvb, 0, qb, KS, VS, wave, lane, [&](int j, const LAS unsigned char* Ka_, const LAS unsigned char* Va_, const LAS unsigned char* Kb_, const LAS unsigned char* Vb_, bool has_b) {
          const bool oka = (mysel >> j) & 1ull, okb = (mysel >> (j + 1)) & 1ull;
          if (has_b) attn_tile2(Ka_, Va_, Kb_, Vb_, qr, A, oka, 0, 0, okb, (j + 1 == qb) ? 1 : 0, tl, lane);
          else attn_tile<1>(Ka_, Va_, qr, A, oka, tl, lane); }, true);
      branch_out_lds<false>(outb, A, g1); }
    { const bf16* KW = KV0 + (size_t)((4 * 4 + b) * 2 + g) * SEQ * 64; const bf16* VW = KV0 + (size_t)((5 * 4 + b) * 2 + g) * SEQ * 64;
      acc_init(A); const int jlo = qb >= 8 ? qb - 8 : 0;
      kv_loop2(R, cur, kvb, jlo, qb, KW, VW, wave, lane, [&](int j, const LAS unsigned char* Ka_, const LAS unsigned char* Va_, const LAS unsigned char* Kb_, const LAS unsigned char* Vb_, bool has_b) {
          const int ma = (j == qb) ? 1 : (j == qb - 8) ? 2 : 0, mb = (j + 1 == qb) ? 1 : (j + 1 == qb - 8) ? 2 : 0;
          if (has_b) attn_tile2(Ka_, Va_, Kb_, Vb_, qr, A, true, ma, tl, true, mb, tl, lane);
          else if (ma == 1) attn_tile<1>(Ka_, Va_, qr, A, true, tl, lane); else if (ma == 2) attn_tile<2>(Ka_, Va_, qr, A, true, tl, lane); else attn_tile<0>(Ka_, Va_, qr, A, true, 0, lane); });
      branch_out_lds<false>(outb, A, g2); }
    { f32x16 out0, out1;
#pragma unroll
      for (int i = 0; i < 16; ++i) { out0[i] = outb[i]; out1[i] = outb[16 + i]; }
      store_ot((bf16*)(ws + WS_ATT) + (size_t)row * 1024 + 512 + head * 64, out0, out1, hi); }
}
constexpr size_t WS_Q1 = WS_END2;
constexpr size_t WS_K1 = al(WS_Q1 + (size_t)MT * 1024 * 2);
constexpr size_t WS_V1 = al(WS_K1 + (size_t)16 * SEQ * 64 * 2);
constexpr size_t WS_K1S = al(WS_V1 + (size_t)16 * SEQ * 64 * 2);
constexpr size_t WS_V1S = al(WS_K1S + (size_t)NSQ * 4 * 4 * 64 * 2);
constexpr size_t WS_MEANH = al(WS_V1S + (size_t)NSQ * 4 * 4 * 64 * 2);
constexpr size_t WS_MEANL = al(WS_MEANH + (size_t)16 * 64 * 64 * 2);
constexpr size_t WS_SS = al(WS_MEANL + (size_t)16 * 64 * 64 * 2);
constexpr size_t WS_END3 = al(WS_SS + (size_t)4 * MT * 4);

template <bool BASE_F32> struct EpiResidN {
    static constexpr bool PERM = false, AFTER_DRAIN = false;
    const void* base; bf16* Hb; float* ss;
    DI void operator()(const f32x4 (&acc)[2][2][4][2], const pg8::Unit& u, int wr, int wc, int fr, int fq) const {
#pragma unroll
        for (int ai = 0; ai < 2; ++ai)
#pragma unroll
            for (int m = 0; m < 4; ++m) { const int row = u.pm * 256 + ai * 128 + wr * 64 + m * 16 + fr; float sq = 0.f;
#pragma unroll
                for (int bj = 0; bj < 2; ++bj) { const int c = (u.pn * 4 + bj * 2 + (wc >> 1)) * 64 + 16 * (wc & 1) + 4 * fq; const size_t o = (size_t)row * D + c;
                    f32x4 b0, b1;
                    if (BASE_F32) { b0 = *(const f32x4*)((const float*)base + o); b1 = *(const f32x4*)((const float*)base + o + 32); }
                    else { b0 = ld_bf4((const bf16*)base + o); b1 = ld_bf4((const bf16*)base + o + 32); }
                    const f32x4 h0 = b0 + acc[ai][bj][m][0], h1 = b1 + acc[ai][bj][m][1];
                    st_bf16x4(Hb + o, h0); st_bf16x4(Hb + o + 32, h1);
                    sq += (h0.x * h0.x + h0.y * h0.y) + (h0.z * h0.z + h0.w * h0.w) + (h1.x * h1.x + h1.y * h1.y) + (h1.z * h1.z + h1.w * h1.w); }
                sq += __shfl_xor(sq, 16); sq += __shfl_xor(sq, 32);
                if (fq == 0) atomicAdd(ss + row, sq); }
    }
};
template <bool BASE_F32> struct EpiResidNS { const void* base1; bf16* Hb; float* ss;
    DI void operator()(int row, int head, int d4, f32x4 lo, f32x4 hi) const {
        const int c = head * 64 + d4; const size_t o = (size_t)row * D + c, ob = (size_t)(row - MP) * D + c; f32x4 b0, b1;
        if (BASE_F32) { b0 = *(const f32x4*)((const float*)base1 + ob); b1 = *(const f32x4*)((const float*)base1 + ob + 32); }
        else { b0 = ld_bf4((const bf16*)base1 + ob); b1 = ld_bf4((const bf16*)base1 + ob + 32); }
        const f32x4 h0 = b0 + lo, h1 = b1 + hi; st_bf16x4(Hb + o, h0); st_bf16x4(Hb + o + 32, h1);
        atomicAdd(ss + row, (h0.x * h0.x + h0.y * h0.y) + (h0.z * h0.z + h0.w * h0.w) + (h1.x * h1.x + h1.y * h1.y) + (h1.z * h1.z + h1.w * h1.w)); } };
template <class Fn> struct RowScaled { Fn f; const float* ss;
    DI void operator()(int row, int head, int d4, f32x4 lo, f32x4 hi) const { const float rs = __builtin_amdgcn_rsqf(ss[row] * (1.0f / 1024.0f) + 1e-6f); f(row, head, d4, lo * rs, hi * rs); } };
template <class Fn> struct EpiHeadScaled {
    static constexpr bool PERM = false, AFTER_DRAIN = false;
    Fn f; const float* ss;
    DI void operator()(const f32x4 (&acc)[2][2][4][2], const pg8::Unit& u, int wr, int wc, int fr, int fq) const {
        float rs[2][4];
#pragma unroll
        for (int ai = 0; ai < 2; ++ai)
#pragma unroll
            for (int m = 0; m < 4; ++m) rs[ai][m] = ss[u.pm * 256 + ai * 128 + wr * 64 + m * 16 + fr];
#pragma unroll
        for (int ai = 0; ai < 2; ++ai)
#pragma unroll
            for (int m = 0; m < 4; ++m) { const int row = u.pm * 256 + ai * 128 + wr * 64 + m * 16 + fr; const float r = __builtin_amdgcn_rsqf(rs[ai][m] * (1.0f / 1024.0f) + 1e-6f);
#pragma unroll
                for (int bj = 0; bj < 2; ++bj) f(row, u.pn * 4 + bj * 2 + (wc >> 1), 16 * (wc & 1) + 4 * fq, acc[ai][bj][m][0] * r, acc[ai][bj][m][1] * r); }
    }
};
struct EpiResid { const float* base0; const float* base1; float* H;
    DI void operator()(int row, int head, int d4, f32x4 lo, f32x4 hi) const {
        if (row >= MP + MS) return;
        const float* b = (row < MP ? base0 + (size_t)row * D : base1 + (size_t)(row - MP) * D) + head * 64 + d4; float* o = H + (size_t)row * D + head * 64 + d4;
        const f32x4 b0 = *(const f32x4*)b, b1 = *(const f32x4*)(b + 32); *(f32x4*)o = b0 + lo; *(f32x4*)(o + 32) = b1 + hi; } };
struct EpiSwiglu { bf16* HFF;
    DI void operator()(int row, int head, int d4, f32x4 lo, f32x4 hi) const {
        if (row >= MP + MS) return;
        f32x4 r; r.x = lo.x * sigmoidf_(lo.x) * hi.x; r.y = lo.y * sigmoidf_(lo.y) * hi.y; r.z = lo.z * sigmoidf_(lo.z) * hi.z; r.w = lo.w * sigmoidf_(lo.w) * hi.w;
        st_bf16x4(HFF + (size_t)row * FF + 32 * head + d4, r); } };
struct EpiIn1 { bf16* Q1; bf16* K1; bf16* K1S; const f32x2* rope; float* out;
    DI void operator()(int row, int head, int d4, f32x4 lo, f32x4 hi) const {
        if (row >= MP + MS) return;
        const bool samp = row >= MP; const int sr = row - MP; const int b = samp ? (sr >> 2) : (row >> 12), t = samp ? (sr & 3) : (row & 4095), ridx = samp ? 4096 + t : t;
        if (head < 20) { const f32x2* cs = rope + (size_t)ridx * 32 + d4; const f32x4 a = *(const f32x4*)cs, c2 = *(const f32x4*)(cs + 2);
            const f32x4 co = {a.x, a.z, c2.x, c2.z}, si = {a.y, a.w, c2.y, c2.w}; const f32x4 x1 = lo, x2 = hi; lo = x1 * co - x2 * si; hi = x2 * co + x1 * si; }
        if (head < 16) { bf16* p = Q1 + (size_t)row * 1024 + head * 64 + d4; st_bf16x4(p, lo * ATT_SC); st_bf16x4(p + 32, hi * ATT_SC); return; }
        const int kv = head >= 20 ? 1 : 0, kvh = (head - 16) & 3;
        bf16* p = samp ? K1S + (size_t)kv * ((WS_V1S - WS_K1S) / 2) + (((size_t)b * 4 + kvh) * 4 + t) * 64 + d4 : K1 + (size_t)kv * ((WS_V1 - WS_K1) / 2) + (((size_t)b * 4 + kvh) * SEQ + t) * 64 + d4;
        st_bf16x4(p, lo); st_bf16x4(p + 32, hi);
        float* o = out + (samp ? O_MOBS + (((size_t)sr * 2 + kv) * 4 + kvh) * 64 : O_MOBP + (((size_t)row * 2 + kv) * 4 + kvh) * 64) + d4; *(f32x4*)o = lo; *(f32x4*)(o + 32) = hi; } };
DI void final_norm(const Params& P, const Frame& F) {
    const bf16* H = (const bf16*)(P.ws + WS_H); const float* gain = INF(10); const float* ss = (const float*)(P.ws + WS_SS) + (size_t)3 * MT;
    for (int m = F.gw; m < MP + MS; m += F.ngw) { const bf16* xr = H + (size_t)m * D; float* o = P.out + (m < MP ? O_YP + (size_t)m * D : O_YS + (size_t)(m - MP) * D);
        const float rs = 1.0f / sqrtf(ss[m] * (1.0f / 1024.0f) + 1e-6f);
#pragma unroll
        for (int i = 0; i < 4; ++i) { const f32x4 v = ld_bf4(xr + 256 * i + 4 * F.lane), g = *(const f32x4*)(gain + 256 * i + 4 * F.lane); *(f32x4*)(o + 256 * i + 4 * F.lane) = v * rs * g; } }
}
DI void moba_means(const Params& P, const Frame& F) {
    unsigned char* ws = P.ws; const bf16* K1 = (const bf16*)(ws + WS_K1); bf16* MH = (bf16*)(ws + WS_MEANH); bf16* ML = (bf16*)(ws + WS_MEANL); const int lane = F.lane;
    for (int it = F.gw; it < 256; it += F.ngw) { const int bk = it >> 4, blk = it & 15; const bf16* src = K1 + ((size_t)bk * SEQ + blk * 256) * 64;
        float acc[8];
#pragma unroll
        for (int e = 0; e < 8; ++e) acc[e] = 0.f;
        for (int i = 0; i < 32; ++i) { float x[8]; ld_bf8(src + (size_t)(8 * i + (lane >> 3)) * 64 + (lane & 7) * 8, x);
#pragma unroll
            for (int e = 0; e < 8; ++e) acc[e] += x[e]; }
#pragma unroll
        for (int e = 0; e < 8; ++e) { acc[e] += __shfl_xor(acc[e], 8); acc[e] += __shfl_xor(acc[e], 16); acc[e] += __shfl_xor(acc[e], 32); acc[e] *= (1.0f / 256.0f); }
        if (lane < 8) { unsigned h[4], l[4];
#pragma unroll
            for (int e = 0; e < 4; ++e) { h[e] = pk2(acc[2 * e], acc[2 * e + 1]); l[e] = pk2(acc[2 * e] - bflo(h[e]), acc[2 * e + 1] - bfhi(h[e])); }
            *(v4u*)(MH + ((size_t)bk * 64 + blk) * 64 + lane * 8) = (v4u){h[0], h[1], h[2], h[3]}; *(v4u*)(ML + ((size_t)bk * 64 + blk) * 64 + lane * 8) = (v4u){l[0], l[1], l[2], l[3]}; }
    }
    for (int i = blockIdx.x * 512 + F.tid; i < 16 * 48 * 8; i += F.G * 512) { const int bk = i / (48 * 8), r = i % (48 * 8); const size_t o = ((size_t)bk * 64 + 16) * 64 + (size_t)r * 8;
        *(v4u*)(MH + o) = (v4u){0u, 0u, 0u, 0u}; *(v4u*)(ML + o) = (v4u){0u, 0u, 0u, 0u}; }
}
DI void moba_prompt_unit(const Params& P, const Frame& F, int b, int kvh, int qb) {
    unsigned char* ws = P.ws; int lane_ = F.lane; asm volatile("" : "+v"(lane_));
    const int lane = lane_, wave = F.wave, r32 = lane & 31, hi = lane >> 5;
    const int tl = 8 * wave + (r32 >> 2), hh = r32 & 3, row = b * SEQ + 64 * qb + tl, head = kvh * 4 + hh, cur = qb >> 2;
    LAS unsigned char* kvb = F.lds;
    bf16x8 qr[4]; ld_q((const bf16*)(ws + WS_Q1) + (size_t)row * 1024 + head * 64, qr, hi);
    TileRegs2 R; int cb = 0; unsigned rowmask = 1u << cur;
    const bf16* KB = (const bf16*)(ws + WS_K1) + (size_t)(b * 4 + kvh) * SEQ * 64; const bf16* VB = (const bf16*)(ws + WS_V1) + (size_t)(b * 4 + kvh) * SEQ * 64;
    kv_prefetch(R, 0, qb, KB, VB, wave, lane);
    if (cur > 0) {
        const bf16* MH = (const bf16*)(ws + WS_MEANH) + (size_t)(b * 4 + kvh) * 4096; const bf16* ML = (const bf16*)(ws + WS_MEANL) + (size_t)(b * 4 + kvh) * 4096;
        { const v4u k1 = *(const v4u*)(MH + (size_t)lane * 64 + wave * 8), k2 = *(const v4u*)(ML + (size_t)lane * 64 + wave * 8); *(LAS v4u*)(kvb + wave * 1024 + lane * 16) = k1; *(LAS v4u*)(kvb + 16384 + wave * 1024 + lane * 16) = k2; }
        __syncthreads();
        f32x16 p0, p1, q0, q1; qk_tile(kvb, qr, p0, p1, lane); qk_tile(kvb + 16384, qr, q0, q1, lane);
        float gs[16];
#pragma unroll
        for (int i = 0; i < 8; ++i) { const float v = p0[i] + q0[i]; auto rr = __builtin_amdgcn_permlane32_swap(__float_as_uint(v), __float_as_uint(v), false, false);
            gs[8 * (i >> 2) + (i & 3)] = __uint_as_float(rr[0]); gs[8 * (i >> 2) + 4 + (i & 3)] = __uint_as_float(rr[1]); }
        unsigned taken = 0;
#pragma unroll
        for (int pass = 0; pass < 3; ++pass) { float best = -INFINITY; int bi = -1;
#pragma unroll
            for (int n = 0; n < 16; ++n) { const bool c = (n < cur) && !((taken >> n) & 1u) && (gs[n] > best); best = c ? gs[n] : best; bi = c ? n : bi; }
            if (bi >= 0) taken |= 1u << bi; }
        rowmask |= taken;
        __syncthreads();
    }
    AttnAcc A; acc_init(A);
    kv_loop2(R, cb, kvb, 0, qb, KB, VB, wave, lane, [&](int j, const LAS unsigned char* Ka_, const LAS unsigned char* Va_, const LAS unsigned char* Kb_, const LAS unsigned char* Vb_, bool has_b) {
        const bool ok = (rowmask >> (j >> 2)) & 1u;
        if (has_b) attn_tile2(Ka_, Va_, Kb_, Vb_, qr, A, ok, 0, 0, ok, (j + 1 == qb) ? 1 : 0, tl, lane);
        else attn_tile<1>(Ka_, Va_, qr, A, ok, tl, lane); }, true);
    const float lt = half_sum(A.l), sc = 1.0f / fmaxf(lt, 1e-30f);
#pragma unroll
    for (int i = 0; i < 16; ++i) { A.o0[i] *= sc; A.o1[i] *= sc; }
    store_ot((bf16*)(ws + WS_ATT) + (size_t)row * 1024 + head * 64, A.o0, A.o1, hi);
}
constexpr int SM_MO = 0, SM_MM = 69632, SM_ML = 70656, SM_TAB = RING_BYTES + 1024;
DI void wave_fence() { asm volatile("s_waitcnt lgkmcnt(0)" ::: "memory"); __builtin_amdgcn_wave_barrier(); asm volatile("" ::: "memory"); }
DI void stage_row_f32(LAS unsigned char* kb, LAS unsigned char* vb, const float* kp, const float* vp, int lane) {
    { f32x4 x[16];
#pragma unroll
      for (int c = 0; c < 16; ++c) x[c] = kp ? *(const f32x4*)(kp + 4 * c) : (f32x4){0.f, 0.f, 0.f, 0.f};
#pragma unroll
      for (int c = 0; c < 8; ++c) *(LAS v4u*)(kb + c * 1024 + lane * 16) = (v4u){pk2(x[2 * c].x, x[2 * c].y), pk2(x[2 * c].z, x[2 * c].w), pk2(x[2 * c + 1].x, x[2 * c + 1].y), pk2(x[2 * c + 1].z, x[2 * c + 1].w)}; }
    asm volatile("" ::: "memory");
    { f32x4 x[16];
#pragma unroll
      for (int c = 0; c < 16; ++c) x[c] = vp ? *(const f32x4*)(vp + 4 * c) : (f32x4){0.f, 0.f, 0.f, 0.f};
#pragma unroll
      for (int c = 0; c < 8; ++c) *(LAS v4u*)(vb + (c >> 2) * 4096 + lane * 64 + (c & 3) * 16) = (v4u){pk2(x[2 * c].x, x[2 * c].y), pk2(x[2 * c].z, x[2 * c].w), pk2(x[2 * c + 1].x, x[2 * c + 1].y), pk2(x[2 * c + 1].z, x[2 * c + 1].w)}; }
}
DI void stage_row_bf16(LAS unsigned char* kb, LAS unsigned char* vb, const bf16* kp, const bf16* vp, int lane) {
#pragma unroll
    for (int c = 0; c < 8; ++c) { v4u ku = {0u, 0u, 0u, 0u}, vu = {0u, 0u, 0u, 0u};
        if (kp) ku = *(const v4u*)(kp + 8 * c);
        if (vp) vu = *(const v4u*)(vp + 8 * c);
        *(LAS v4u*)(kb + c * 1024 + lane * 16) = ku; *(LAS v4u*)(vb + (c >> 2) * 4096 + lane * 64 + (c & 3) * 16) = vu; }
}
DI void stage_tile_f32(LAS unsigned char* kb, LAS unsigned char* vb, const float* kp0, const float* vp0, size_t stride, int lane) {
    const int rsub = lane >> 4, piece = lane & 15;
#pragma unroll
    for (int hf = 0; hf < 2; ++hf) { f32x4 x[8]; asm volatile("" ::: "memory");
#pragma unroll
      for (int it = 0; it < 8; ++it) x[it] = *(const f32x4*)(kp0 + (size_t)(4 * (8 * hf + it) + rsub) * stride + 4 * piece);
#pragma unroll
      for (int it = 0; it < 8; ++it) *(LAS v2u*)(kb + (piece >> 1) * 1024 + (4 * (8 * hf + it) + rsub) * 16 + (piece & 1) * 8) = (v2u){pk2(x[it].x, x[it].y), pk2(x[it].z, x[it].w)}; }
#pragma unroll
    for (int hf = 0; hf < 2; ++hf) { f32x4 x[8]; asm volatile("" ::: "memory");
#pragma unroll
      for (int it = 0; it < 8; ++it) x[it] = *(const f32x4*)(vp0 + (size_t)(4 * (8 * hf + it) + rsub) * stride + 4 * piece);
#pragma unroll
      for (int it = 0; it < 8; ++it) *(LAS v2u*)(vb + (piece >> 3) * 4096 + (4 * (8 * hf + it) + rsub) * 64 + (piece & 7) * 8) = (v2u){pk2(x[it].x, x[it].y), pk2(x[it].z, x[it].w)}; }
}
DI void merge_waves(const Frame& F, AttnAcc& A, int lane, int wave) {
    LAS float* mo = (LAS float*)(F.lds + SM_MO); LAS float* mm = (LAS float*)(F.lds + SM_MM); LAS float* ml = (LAS float*)(F.lds + SM_ML);
    const float lt = half_sum(A.l);
    __syncthreads();
#pragma unroll
    for (int i = 0; i < 16; ++i) { mo[(wave * 64 + lane) * 33 + i] = A.o0[i]; mo[(wave * 64 + lane) * 33 + 16 + i] = A.o1[i]; }
    if (lane < 32) { mm[wave * 32 + lane] = A.m; ml[wave * 32 + lane] = lt; }
    __syncthreads();
    const int r32 = lane & 31; float M = -INFINITY;
#pragma unroll
    for (int w = 0; w < 8; ++w) M = fmaxf(M, mm[w * 32 + r32]);
    const float Mu = (M == -INFINITY) ? 0.f : M; float L = 0.f;
#pragma unroll
    for (int i = 0; i < 16; ++i) { A.o0[i] = 0.f; A.o1[i] = 0.f; }
#pragma unroll 1
    for (int w = 0; w < 8; ++w) { const float sc = __builtin_amdgcn_exp2f(mm[w * 32 + r32] - Mu); L += ml[w * 32 + r32] * sc;
#pragma unroll
        for (int i = 0; i < 16; ++i) { A.o0[i] += mo[(w * 64 + lane) * 33 + i] * sc; A.o1[i] += mo[(w * 64 + lane) * 33 + 16 + i] * sc; } }
    A.m = M; A.l = 0.5f * L;
    __syncthreads();
}
DI void nsa_sample_unit(const Params& P, const Frame& F, int bs, int g) {
    unsigned char* ws = P.ws; int lane_ = F.lane; asm volatile("" : "+v"(lane_));
    const int lane = lane_, wave = F.wave, r32 = lane & 31, hi = lane >> 5, ts = r32 >> 2, hh = r32 & 3, head = g * 4 + hh; const bool rowv = ts < 4;
    const int row = MP + bs * 4 + (ts & 3);
    LAS unsigned char* kb = F.lds + wave * 16384; LAS unsigned char* vb = kb + 8192;
    LAS float* impM = (LAS float*)(F.lds + SM_TAB); LAS float* impS = impM + 4 * 132; LAS unsigned long long* selS = (LAS unsigned long long*)(F.lds + SM_TAB + 2 * 4 * 132 * 4);
    const int* ptab = (const int*)P.in[7] + bs * NPG;
    bf16x8 qr[4]; ld_q((const bf16*)(ws + WS_Q0) + (size_t)row * 512 + head * 64, qr, hi);
    const float* gt = (const float*)(ws + WS_GATES) + (size_t)row * 32 + head * 3; const float g0 = gt[0], g1 = gt[1], g2 = gt[2];
    const bf16* KVS0 = (const bf16*)(ws + WS_KVS0);
    LAS float* outb = (LAS float*)(F.lds + SM_TAB + 4608) + lane * 33;
    const bf16* KC = (const bf16*)(ws + WS_KCS) + ((size_t)((0 * NSQ + bs) * 2 + g) * 512 + 64 * wave + lane) * 64;
    const bf16* VC = (const bf16*)(ws + WS_KCS) + ((size_t)((1 * NSQ + bs) * 2 + g) * 512 + 64 * wave + lane) * 64;
    { int tid_ = F.tid; asm volatile("" : "+v"(tid_)); for (int i = tid_; i < 2 * 4 * 132; i += 512) impM[i] = 0.f; }
    AttnAcc A; acc_init(A);
    stage_row_bf16(kb, vb, KC, VC, lane); wave_fence();
    attn_tile<1>(kb, vb, qr, A, rowv, 510 - 64 * wave, lane);
    merge_waves(F, A, lane, wave);
    if (wave == 0) branch_out_lds<true>(outb, A, g0);
    { const float lt = half_sum(A.l), rl = 1.0f / fmaxf(lt, 1e-30f), mfin = (A.m == -INFINITY) ? 0.f : A.m;
      stage_row_bf16(kb, vb, KC, nullptr, lane); wave_fence();
      f32x16 p0, p1; qk_tile(kb, qr, p0, p1, lane); mask_scale<1>(p0, p1, rowv, 510 - 64 * wave, hi);
#pragma unroll
      for (int cc = 0; cc < 2; ++cc)
#pragma unroll
          for (int gi = 0; gi < 4; ++gi) { const f32x16& p = cc ? p1 : p0;
              const float e0 = __builtin_amdgcn_exp2f(p[4 * gi] - mfin) * rl, e1 = __builtin_amdgcn_exp2f(p[4 * gi + 1] - mfin) * rl, e2 = __builtin_amdgcn_exp2f(p[4 * gi + 2] - mfin) * rl, e3 = __builtin_amdgcn_exp2f(p[4 * gi + 3] - mfin) * rl;
              float mn = e0 + e1 + e2 + 0.5f * e3, sp = 0.5f * e3;
              mn += __builtin_bit_cast(float, __builtin_amdgcn_update_dpp(0, __builtin_bit_cast(int, mn), 0xB1, 0xf, 0xf, false)); mn += __builtin_bit_cast(float, __builtin_amdgcn_update_dpp(0, __builtin_bit_cast(int, mn), 0x4E, 0xf, 0xf, false));
              sp += __builtin_bit_cast(float, __builtin_amdgcn_update_dpp(0, __builtin_bit_cast(int, sp), 0xB1, 0xf, 0xf, false)); sp += __builtin_bit_cast(float, __builtin_amdgcn_update_dpp(0, __builtin_bit_cast(int, sp), 0x4E, 0xf, 0xf, false));
              const int jj = 16 * wave + 8 * cc + 2 * gi + hi;
              if (hh == 0 && rowv) { impM[ts * 132 + jj] = mn; impS[ts * 132 + jj + 1] = sp; } } }
    __syncthreads();
    if (wave < 4) { const int tq = wave;
        float s0 = impM[tq * 132 + lane] + impS[tq * 132 + lane], s1 = impM[tq * 132 + 64 + lane] + impS[tq * 132 + 64 + lane];
        float s2 = (lane == 0) ? impM[tq * 132 + 128] + impS[tq * 132 + 128] + 100.0f : -INFINITY;
        if (lane == 0) s0 += 100.0f; if (lane == 63) s1 += 100.0f;
        int c0 = 0, c1 = 0, c2 = 0; int ln = lane; asm volatile("" : "+v"(ln));
#pragma unroll 8
        for (int jp = 0; jp < 64; ++jp) { const float o = __shfl(s0, jp); c0 += (o > s0 || (o == s0 && jp < ln)) ? 1 : 0; c1 += (o >= s1) ? 1 : 0; c2 += (o >= s2) ? 1 : 0; }
#pragma unroll 8
        for (int jp = 0; jp < 64; ++jp) { const float o = __shfl(s1, jp); c0 += (o > s0) ? 1 : 0; c1 += (o > s1 || (o == s1 && jp < ln)) ? 1 : 0; c2 += (o >= s2) ? 1 : 0; }
        { const float o = __shfl(s2, 0); c0 += (o > s0) ? 1 : 0; c1 += (o > s1) ? 1 : 0; }
        const unsigned long long m0 = __ballot(c0 < 16), m1 = __ballot(c1 < 16), m2 = __ballot(lane == 0 && c2 < 16);
        if (lane == 0) { selS[tq * 4 + 0] = m0; selS[tq * 4 + 1] = m1; selS[tq * 4 + 2] = m2; } }
    __syncthreads();
    const unsigned long long my0 = selS[(ts & 3) * 4 + 0], my1 = selS[(ts & 3) * 4 + 1], my2 = selS[(ts & 3) * 4 + 2];
    const unsigned long long u0v = selS[0] | selS[4] | selS[8] | selS[12], u1v = selS[1] | selS[5] | selS[9] | selS[13];
    const unsigned long long u0 = ((unsigned long long)(unsigned)__builtin_amdgcn_readfirstlane((int)(u0v >> 32)) << 32) | (unsigned)__builtin_amdgcn_readfirstlane((int)u0v);
    const unsigned long long u1 = ((unsigned long long)(unsigned)__builtin_amdgcn_readfirstlane((int)(u1v >> 32)) << 32) | (unsigned)__builtin_amdgcn_readfirstlane((int)u1v);
    { acc_init(A); const float* cache = INF(2); int k = 0;
      for (int j = 0; j < 129; ++j) { const bool inu = j < 64 ? ((u0 >> j) & 1ull) : j < 128 ? ((u1 >> (j - 64)) & 1ull) : true; if (!inu) continue;
          if ((k++ & 7) != wave) continue;
          const bool ok = rowv && (j < 64 ? ((my0 >> j) & 1ull) : j < 128 ? ((my1 >> (j - 64)) & 1ull) : (my2 & 1ull));
          if (j < 128) { const int page = ptab[j >> 1]; const float* base = cache + ((size_t)page * PAGE + (j & 1) * 64) * 512 + g * 64;
              stage_tile_f32(kb, vb, base + 256, base + 384, 512, lane); wave_fence(); attn_tile<0>(kb, vb, qr, A, ok, 0, lane); }
          else { const bf16* kn = lane < 4 ? KVS0 + ((((size_t)2 * NSQ + bs) * 2 + g) * 4 + lane) * 64 : nullptr; const bf16* vn = lane < 4 ? KVS0 + ((((size_t)3 * NSQ + bs) * 2 + g) * 4 + lane) * 64 : nullptr;
              stage_row_bf16(kb, vb, kn, vn, lane); wave_fence(); attn_tile<1>(kb, vb, qr, A, ok, ts, lane); }
          wave_fence(); }
      merge_waves(F, A, lane, wave); if (wave == 0) branch_out_lds<false>(outb, A, g1); }
    { acc_init(A); const float* wbuf = INF(4) + (size_t)bs * 512 * 256;
      for (int tile = wave; tile < 9; tile += 8) { const int idx = 64 * tile + lane;
          if (tile < 8) { const float* base = wbuf + (size_t)(64 * tile) * 256 + g * 64; stage_tile_f32(kb, vb, base, base + 128, 256, lane); }
          else { const bf16* kn = lane < 4 ? KVS0 + ((((size_t)4 * NSQ + bs) * 2 + g) * 4 + lane) * 64 : nullptr; const bf16* vn = lane < 4 ? KVS0 + ((((size_t)5 * NSQ + bs) * 2 + g) * 4 + lane) * 64 : nullptr;
              stage_row_bf16(kb, vb, kn, vn, lane); }
          wave_fence();
          if (tile == 0) attn_tile<2>(kb, vb, qr, A, rowv, ts, lane); else if (tile == 8) attn_tile<1>(kb, vb, qr, A, rowv, ts, lane); else attn_tile<0>(kb, vb, qr, A, rowv, 0, lane);
          wave_fence(); }
      merge_waves(F, A, lane, wave); if (wave == 0) branch_out_lds<false>(outb, A, g2); }
    if (wave == 0) { f32x16 out0, out1;
#pragma unroll
        for (int i = 0; i < 16; ++i) { out0[i] = outb[i]; out1[i] = outb[16 + i]; }
        if (rowv) store_ot((bf16*)(ws + WS_ATT) + (size_t)row * 1024 + 512 + head * 64, out0, out1, hi); }
}
DI void moba_sample_unit(const Params& P, const Frame& F, int bs, int kvh) {
    unsigned char* ws = P.ws; int lane_ = F.lane; asm volatile("" : "+v"(lane_));
    const int lane = lane_, wave = F.wave, r32 = lane & 31, hi = lane >> 5, ts = r32 >> 2, hh = r32 & 3, head = kvh * 4 + hh; const bool rowv = ts < 4;
    const int row = MP + bs * 4 + (ts & 3);
    LAS unsigned char* kb = F.lds + wave * 16384; LAS unsigned char* vb = kb + 8192;
    const int* ptab = (const int*)P.in[7] + bs * NPG;
    bf16x8 qr[4]; ld_q((const bf16*)(ws + WS_Q1) + (size_t)row * 1024 + head * 64, qr, hi);
    unsigned long long rowmask = 1ull << 32;
    { const float* mp = (const float*)(ws + WS_MEANS) + (((size_t)bs * 4 + kvh) * 32 + (lane & 31)) * 64;
#pragma unroll
      for (int c = 0; c < 8; ++c) { v4u hu = {0u, 0u, 0u, 0u}, lu = {0u, 0u, 0u, 0u};
          if (lane < 32) { const f32x4 a = *(const f32x4*)(mp + 8 * c), b2 = *(const f32x4*)(mp + 8 * c + 4);
              hu = (v4u){pk2(a.x, a.y), pk2(a.z, a.w), pk2(b2.x, b2.y), pk2(b2.z, b2.w)};
              lu = (v4u){pk2(a.x - bflo(hu.x), a.y - bfhi(hu.x)), pk2(a.z - bflo(hu.y), a.w - bfhi(hu.y)), pk2(b2.x - bflo(hu.z), b2.y - bfhi(hu.z)), pk2(b2.z - bflo(hu.w), b2.w - bfhi(hu.w))}; }
          *(LAS v4u*)(kb + c * 1024 + lane * 16) = hu; *(LAS v4u*)(vb + c * 1024 + lane * 16) = lu; }
      wave_fence();
      f32x16 p0, p1, q0, q1; qk_tile(kb, qr, p0, p1, lane); qk_tile(vb, qr, q0, q1, lane);
      float gs[32];
#pragma unroll
      for (int i = 0; i < 16; ++i) { const float v = p0[i] + q0[i]; auto rr = __builtin_amdgcn_permlane32_swap(__float_as_uint(v), __float_as_uint(v), false, false);
          gs[8 * (i >> 2) + (i & 3)] = __uint_as_float(rr[0]); gs[8 * (i >> 2) + 4 + (i & 3)] = __uint_as_float(rr[1]); }
      unsigned taken = 0;
#pragma unroll
      for (int pass = 0; pass < 3; ++pass) { float best = -INFINITY; int bi = -1;
#pragma unroll
          for (int n = 0; n < 32; ++n) { const bool c = !((taken >> n) & 1u) && (gs[n] > best); best = c ? gs[n] : best; bi = c ? n : bi; }
          if (bi >= 0) taken |= 1u << bi; }
      rowmask |= (unsigned long long)taken;
      wave_fence(); }
    unsigned umask = 0;
#pragma unroll
    for (int n = 0; n < 32; ++n) if (__ballot(rowv && ((rowmask >> n) & 1ull)) != 0ull) umask |= 1u << n;
    AttnAcc A; acc_init(A); const float* cache = INF(3); int k = 0;
    for (int blk = 0; blk < 32; ++blk) { if (!((umask >> blk) & 1u)) continue;
        const bool ok = rowv && ((rowmask >> blk) & 1ull);
        for (int q4 = 0; q4 < 4; ++q4) { if ((k++ & 7) != wave) continue;
            const int page = ptab[2 * blk + (q4 >> 1)]; const float* base = cache + ((size_t)page * PAGE + (q4 & 1) * 64) * 512 + kvh * 64;
            stage_tile_f32(kb, vb, base, base + 256, 512, lane); wave_fence(); attn_tile<0>(kb, vb, qr, A, ok, 0, lane); wave_fence(); } }
    if ((k & 7) == wave) { const bf16* kn = lane < 4 ? (const bf16*)(ws + WS_K1S) + (((size_t)bs * 4 + kvh) * 4 + lane) * 64 : nullptr; const bf16* vn = lane < 4 ? (const bf16*)(ws + WS_V1S) + (((size_t)bs * 4 + kvh) * 4 + lane) * 64 : nullptr;
        stage_row_bf16(kb, vb, kn, vn, lane); wave_fence(); attn_tile<1>(kb, vb, qr, A, rowv, ts, lane); wave_fence(); }
    merge_waves(F, A, lane, wave);
    const float lt = half_sum(A.l), sc = 1.0f / fmaxf(lt, 1e-30f);
#pragma unroll
    for (int i = 0; i < 16; ++i) { A.o0[i] *= sc; A.o1[i] *= sc; }
    if (wave == 0 && rowv) store_ot((bf16*)(ws + WS_ATT) + (size_t)row * 1024 + head * 64, A.o0, A.o1, hi);
}
constexpr int CKN = 4096;
constexpr size_t WS_CK_AT = WS_END3;
constexpr size_t WS_CK_BT = WS_CK_AT + (size_t)CKN * 4096, WS_CK_KT = WS_CK_BT + (size_t)CKN * 4096, WS_CK_RT = WS_CK_KT + (size_t)CKN * 4096;
constexpr size_t WS_CK_ATT = WS_CK_RT + (size_t)CKN * 4096;
constexpr size_t WS_CK_VT = WS_CK_ATT + (size_t)CKN * 4096;
constexpr size_t WS_CK_KH = WS_CK_VT + (size_t)CKN * 4096;
constexpr size_t WS_CK_PC = WS_CK_KH + (size_t)CKN * 8192;
constexpr size_t WS_CK_GT = WS_CK_PC + (size_t)CKN * 256;
constexpr size_t WS_CK_HT = WS_CK_GT + (size_t)CKN * 8192;
constexpr size_t WS_CK_QY = WS_CK_HT + (size_t)CKN * 16384;
constexpr size_t WS_CK_AY = WS_CK_QY + (size_t)CKN * 4096;
constexpr size_t WS_CK_S = WS_CK_AY + (size_t)CKN * 2048;
constexpr size_t WS_END4 = al(WS_CK_S + (size_t)CKN * 8192);
constexpr int CKL_N = 0, CKL_R1 = 4096, CKL_MKA = 8192, CKL_ZT = 10240, CKL_STRIDE = 17920, CKL_HKT = 0;

DI bf16x8 ldg8(const bf16* p) { return *(const bf16x8*)p; }
#if MK_DIAG
#define CKA_STAMP(k) do { if (cg == 0 && F.lane == 0) __hip_atomic_store((unsigned long long*)((unsigned*)(P.ws + WS_CTL) + 65536) + 1 + (k), __builtin_amdgcn_s_memrealtime(), __ATOMIC_RELAXED, __HIP_MEMORY_SCOPE_AGENT); } while (0)
#else
#define CKA_STAMP(k) do {} while (0)
#endif
DI void rwkv_chunk_a(const Params& P, const Frame& F, int cg) {
    unsigned char* ws = P.ws; int lane_ = F.lane; asm volatile("" : "+v"(lane_)); const int lane = lane_, r32 = lane & 31, hi = lane >> 5;
    const int bh = cg >> 7, c = cg & 127, b = bh >> 3, h = bh & 7; const size_t row0 = (size_t)b * SEQ + c * 32;
    const float* LW = (const float*)(ws + WS_W); const bf16* KK = (const bf16*)(ws + WS_KK); const bf16* KKA = (const bf16*)(ws + WS_KKA);
    const bf16* KP = (const bf16*)(ws + WS_KP); const bf16* RR = (const bf16*)(ws + WS_R); const bf16* VV = (const bf16*)(ws + WS_V);
    const int slot = (int)blockIdx.x * 8 + F.wave;
    bf16* AT = (bf16*)(ws + WS_CK_AT) + (size_t)slot * 2048; bf16* BT = (bf16*)(ws + WS_CK_BT) + (size_t)slot * 2048; bf16* KT = (bf16*)(ws + WS_CK_KT) + (size_t)slot * 2048; bf16* RT = (bf16*)(ws + WS_CK_RT) + (size_t)slot * 2048;
    bf16* ATT = (bf16*)(ws + WS_CK_ATT) + (size_t)slot * 2048; bf16* VT = (bf16*)(ws + WS_CK_VT) + (size_t)cg * 2048; float* KH = (float*)(ws + WS_CK_KH) + (size_t)slot * 2048;
    LAS unsigned char* wl = F.lds + F.wave * CKL_STRIDE;
    LAS float* Nl = (LAS float*)(wl + CKL_N); LAS float* R1 = (LAS float*)(wl + CKL_R1); LAS bf16* MKA = (LAS bf16*)(wl + CKL_MKA); LAS bf16* ZT = (LAS bf16*)(wl + CKL_ZT); LAS bf16* HKT = (LAS bf16*)(wl + CKL_HKT);
    float bh_[32];
    { unsigned atp[16], vtp[16]; float aprev = 0.f, vprev = 0.f, kt_[32]; float cum = 0.f;
      LAS unsigned char* stg = wl; const size_t gro = row0 * 512 + h * 64;
#pragma unroll
      for (int hf = 0; hf < 2; ++hf) {
          wave_fence();
          { v4u xb[5][2]; f32x4 xl[4];
#pragma unroll
            for (int q = 0; q < 4; ++q) { const int p = lane + 64 * q, tk = p >> 4, pc4 = p & 15; xl[q] = *(const f32x4*)(LW + gro + (size_t)(16 * hf + tk) * 512 + 4 * pc4); }
#pragma unroll
            for (int a = 0; a < 5; ++a)
#pragma unroll
                for (int q = 0; q < 2; ++q) { const int p = lane + 64 * q, tk = p >> 3, pc8 = p & 7; const bf16* sp = a == 0 ? KK : a == 1 ? KKA : a == 2 ? KP : a == 3 ? RR : VV; xb[a][q] = *(const v4u*)(sp + gro + (size_t)(16 * hf + tk) * 512 + 8 * pc8); }
#pragma unroll
            for (int q = 0; q < 4; ++q) *(LAS f32x4*)(stg + (lane + 64 * q) * 16) = xl[q];
#pragma unroll
            for (int a = 0; a < 5; ++a)
#pragma unroll
                for (int q = 0; q < 2; ++q) *(LAS v4u*)(stg + 4096 + a * 2048 + (lane + 64 * q) * 16) = xb[a][q]; }
          wave_fence();
#pragma unroll
          for (int tt = 0; tt < 16; ++tt) { const int t = 16 * hf + tt;
              const float lw = *(const LAS float*)(stg + (tt * 64 + lane) * 4);
              const float kk = bf2f(*(const LAS bf16*)(stg + 4096 + (tt * 64 + lane) * 2)), ka = bf2f(*(const LAS bf16*)(stg + 6144 + (tt * 64 + lane) * 2)), kp = bf2f(*(const LAS bf16*)(stg + 8192 + (tt * 64 + lane) * 2));
              const float r = bf2f(*(const LAS bf16*)(stg + 10240 + (tt * 64 + lane) * 2)), v = bf2f(*(const LAS bf16*)(stg + 12288 + (tt * 64 + lane) * 2));
              const float ep = __expf(cum); cum += lw; const float en = __expf(-cum), er = __expf(cum);
              const float at = -kk * ep;
              AT[t * 64 + lane] = (bf16)(pk2(at, 0.f) & 0xffffu); BT[t * 64 + lane] = (bf16)(pk2(ka * en, 0.f) & 0xffffu); KT[t * 64 + lane] = (bf16)(pk2(kp * en, 0.f) & 0xffffu); RT[t * 64 + lane] = (bf16)(pk2(r * er, 0.f) & 0xffffu);
              kt_[t] = kp * en; bh_[t] = ka * en;
              if (t & 1) { atp[t >> 1] = pk2(aprev, at); vtp[t >> 1] = pk2(vprev, v); } else { aprev = at; vprev = v; } } }
#pragma unroll
      for (int q = 0; q < 4; ++q) { *(v4u*)(ATT + lane * 32 + 8 * q) = (v4u){atp[4 * q], atp[4 * q + 1], atp[4 * q + 2], atp[4 * q + 3]}; *(v4u*)(VT + lane * 32 + 8 * q) = (v4u){vtp[4 * q], vtp[4 * q + 1], vtp[4 * q + 2], vtp[4 * q + 3]}; }
      const float pcv = __expf(cum);
#pragma unroll
      for (int t = 0; t < 32; ++t) { KH[t * 64 + lane] = kt_[t] * pcv; bh_[t] *= pcv; }
      ((float*)(ws + WS_CK_PC))[(size_t)slot * 64 + lane] = pcv; }
    wave_fence();
    CKA_STAMP(50);
    VM_WAIT();
    f32x16 mkrT;
    { f32x16 n_, mka_, mbr_;
#pragma unroll
      for (int i = 0; i < 16; ++i) { n_[i] = 0.f; mka_[i] = 0.f; mbr_[i] = 0.f; mkrT[i] = 0.f; }
#pragma unroll
      for (int ks = 0; ks < 4; ++ks) { const int fo = r32 * 64 + 16 * ks + 8 * hi; const bf16x8 fa = ldg8(AT + fo), fb = ldg8(BT + fo), fk = ldg8(KT + fo), fr = ldg8(RT + fo);
          n_ = MFMA32(fb, fa, n_); mka_ = MFMA32(fk, fa, mka_); mbr_ = MFMA32(fb, fr, mbr_); mkrT = MFMA32(fr, fk, mkrT); }
#pragma unroll
      for (int i = 0; i < 16; ++i) { const int rw = crow(i, hi);
          Nl[rw * 32 + r32] = (rw < r32) ? n_[i] : 0.f; R1[rw * 32 + r32] = (rw <= r32) ? mbr_[i] : 0.f;
          MKA[rw * 32 + r32] = (bf16)(pk2((rw < r32) ? mka_[i] : 0.f, 0.f) & 0xffffu); mkrT[i] = (r32 <= rw) ? mkrT[i] : 0.f; } }
    wave_fence();
    CKA_STAMP(51);
#define CK_SOLVE2(ZA, ZB) do { _Pragma("unroll") for (int s_ = 30; s_ >= 0; --s_) { const LAS float* np_ = Nl + s_ * 32; asm volatile("" : "+v"(np_), "+v"(ZA[s_ + 1]), "+v"(ZB[s_ + 1]));     \
            float acca_ = ZA[s_], accb_ = ZB[s_]; \
            _Pragma("unroll") for (int u4 = (s_ + 1) & ~3; u4 < 32; u4 += 4) { const f32x4 nv = *(const LAS f32x4*)(np_ + u4);     \
                acca_ += nv[0] * ZA[u4] + nv[1] * ZA[u4 + 1] + nv[2] * ZA[u4 + 2] + nv[3] * ZA[u4 + 3]; accb_ += nv[0] * ZB[u4] + nv[1] * ZB[u4 + 1] + nv[2] * ZB[u4 + 2] + nv[3] * ZB[u4 + 3]; } \
            ZA[s_] = acca_; ZB[s_] = accb_; } } while (0)
#define CK_ZSTORE(ZZ, zr) do { _Pragma("unroll") for (int q = 0; q < 4; ++q) *(LAS v4u*)((zr) + 8 * q) = (v4u){pk2(ZZ[8 * q], ZZ[8 * q + 1]), pk2(ZZ[8 * q + 2], ZZ[8 * q + 3]), pk2(ZZ[8 * q + 4], ZZ[8 * q + 5]), pk2(ZZ[8 * q + 6], ZZ[8 * q + 7])}; } while (0)
    { float z[32];
#pragma unroll
      for (int s = 0; s < 32; ++s) z[s] = R1[s * 32 + r32];
      CK_SOLVE2(bh_, z);
      CK_ZSTORE(bh_, ZT + (32 + lane) * 40);
      if (lane < 32) CK_ZSTORE(z, ZT + r32 * 40); }
#undef CK_SOLVE2
#undef CK_ZSTORE
    wave_fence();
    CKA_STAMP(52);
    bf16x8 za[3][2];
#pragma unroll
    for (int rb = 0; rb < 3; ++rb)
#pragma unroll
        for (int ks = 0; ks < 2; ++ks) za[rb][ks] = *(const LAS bf16x8*)(ZT + (32 * rb + r32) * 40 + 16 * ks + 8 * hi);
    {
      bf16x8 mb[2];
#pragma unroll
      for (int ks = 0; ks < 2; ++ks) mb[ks] = *(const LAS bf16x8*)(MKA + r32 * 32 + 16 * ks + 8 * hi);
      f32x16 ay = mkrT; ay = MFMA32(za[0][0], mb[0], ay); ay = MFMA32(za[0][1], mb[1], ay);
      bf16* AY = (bf16*)(ws + WS_CK_AY) + (size_t)cg * 1024;
#pragma unroll
      for (int i = 0; i < 16; ++i) AY[4 * hi * 32 + r32 + ((i & 3) + 8 * (i >> 2)) * 32] = (bf16)(pk2(ay[i], 0.f) & 0xffffu);
      wave_fence();
#pragma unroll
      for (int jb = 0; jb < 2; ++jb) { int ro = r32; asm volatile("" : "+v"(ro) :: "memory"); f32x16 hk;
#pragma unroll
          for (int gi = 0; gi < 4; ++gi) { const f32x4 kh = *(const f32x4*)(KH + ro * 64 + 32 * jb + 8 * gi + 4 * hi); hk[4 * gi] = kh.x; hk[4 * gi + 1] = kh.y; hk[4 * gi + 2] = kh.z; hk[4 * gi + 3] = kh.w; }
          hk = MFMA32(za[1 + jb][0], mb[0], hk); hk = MFMA32(za[1 + jb][1], mb[1], hk);
#pragma unroll
          for (int i = 0; i < 16; ++i) HKT[(32 * jb + crow(i, hi)) * 40 + ro] = (bf16)(pk2(hk[i], 0.f) & 0xffffu); } }
    {
      bf16* QY = (bf16*)(ws + WS_CK_QY) + (size_t)cg * 2048; bf16* GT = (bf16*)(ws + WS_CK_GT) + (size_t)cg * 4096; const float* PC = (const float*)(ws + WS_CK_PC) + (size_t)slot * 64;
#pragma unroll
      for (int cb = 0; cb < 2; ++cb) { const int j = 32 * cb + r32; bf16x8 ab[2];
#pragma unroll
          for (int ks = 0; ks < 2; ++ks) ab[ks] = ldg8(ATT + j * 32 + 16 * ks + 8 * hi);
          const float pc = PC[j];
#pragma unroll
          for (int rb = 0; rb < 3; ++rb) { int jo = j; asm volatile("" : "+v"(jo) :: "memory"); f32x16 acc;
              const bf16* rtp = RT + 4 * hi * 64 + jo;
              bf16* dst = rb == 0 ? QY + 4 * hi * 64 + jo : GT + (((rb - 1) * 4 + (jo >> 4)) * 64 + 4 * hi + 32 * ((jo >> 2) & 1)) * 8 + (jo & 3) + 4 * ((jo >> 3) & 1);
#pragma unroll
              for (int i = 0; i < 16; ++i) { const int rw = crow(i, hi); acc[i] = rb == 0 ? bf2f(rtp[((i & 3) + 8 * (i >> 2)) * 64]) : ((32 * (rb - 1) + rw == jo) ? pc : 0.f); }
              acc = MFMA32(za[rb][0], ab[0], acc); acc = MFMA32(za[rb][1], ab[1], acc);
#pragma unroll
              for (int i = 0; i < 16; ++i) dst[((i & 3) + 8 * (i >> 2)) * (rb == 0 ? 64 : 8)] = (bf16)(pk2(acc[i], 0.f) & 0xffffu); } } }
    wave_fence();
    {
      bf16* HT = (bf16*)(ws + WS_CK_HT) + (size_t)cg * 4096;
#pragma unroll
      for (int ib = 0; ib < 2; ++ib) { bf16x8 vb[2];
#pragma unroll
          for (int ks = 0; ks < 2; ++ks) vb[ks] = ldg8(VT + (32 * ib + r32) * 32 + 16 * ks + 8 * hi);
#pragma unroll
          for (int jb = 0; jb < 2; ++jb) { int ro = r32; asm volatile("" : "+v"(ro) :: "memory"); f32x16 acc;
#pragma unroll
              for (int i = 0; i < 16; ++i) acc[i] = 0.f;
#pragma unroll
              for (int ks = 0; ks < 2; ++ks) acc = MFMA32(*(const LAS bf16x8*)(HKT + (32 * jb + ro) * 40 + 16 * ks + 8 * hi), vb[ks], acc);
              bf16* dst = HT + ((ib * 64 + ro + 32 * hi) * 32 + 16 * jb);
              *(v4u*)dst = (v4u){pk2(acc[0], acc[1]), pk2(acc[2], acc[3]), pk2(acc[4], acc[5]), pk2(acc[6], acc[7])}; *(v4u*)(dst + 8) = (v4u){pk2(acc[8], acc[9]), pk2(acc[10], acc[11]), pk2(acc[12], acc[13]), pk2(acc[14], acc[15])}; } } }
    wave_fence();
    CKA_STAMP(53);
}
struct CkbSet { bf16x8 g[2][4]; v4u h[4]; };
DI void ckb_load(CkbSet& S, const bf16* GT, const bf16* HT, int c, int ih, int lane) {
    const bf16* g = GT + (size_t)c * 4096 + lane * 8; const bf16* h = HT + (size_t)c * 4096 + (ih * 64 + lane) * 32;
#pragma unroll
    for (int jb = 0; jb < 2; ++jb)
#pragma unroll
        for (int ks = 0; ks < 4; ++ks) S.g[jb][ks] = *(const bf16x8*)(g + (jb * 4 + ks) * 512);
#pragma unroll
    for (int q = 0; q < 4; ++q) S.h[q] = *(const v4u*)(h + 8 * q);
}
DI void ckb_step(const CkbSet& S, f32x16& X0, f32x16& X1, bf16* sdst, int hi) {
#pragma unroll
    for (int gi = 0; gi < 4; ++gi) { *(v2u*)(sdst + 8 * gi + 4 * hi) = (v2u){pk2(X0[4 * gi], X0[4 * gi + 1]), pk2(X0[4 * gi + 2], X0[4 * gi + 3])}; *(v2u*)(sdst + 32 + 8 * gi + 4 * hi) = (v2u){pk2(X1[4 * gi], X1[4 * gi + 1]), pk2(X1[4 * gi + 2], X1[4 * gi + 3])}; }
    const bf16x8 xb0 = pack8(X0, 0), xb1 = pack8(X0, 1), xb2 = pack8(X1, 0), xb3 = pack8(X1, 1);
    f32x16 n0, n1;
#pragma unroll
    for (int q = 0; q < 2; ++q) { const v4u a = S.h[q], b2 = S.h[2 + q];
        n0[8 * q] = bflo(a.x); n0[8 * q + 1] = bfhi(a.x); n0[8 * q + 2] = bflo(a.y); n0[8 * q + 3] = bfhi(a.y); n0[8 * q + 4] = bflo(a.z); n0[8 * q + 5] = bfhi(a.z); n0[8 * q + 6] = bflo(a.w); n0[8 * q + 7] = bfhi(a.w);
        n1[8 * q] = bflo(b2.x); n1[8 * q + 1] = bfhi(b2.x); n1[8 * q + 2] = bflo(b2.y); n1[8 * q + 3] = bfhi(b2.y); n1[8 * q + 4] = bflo(b2.z); n1[8 * q + 5] = bfhi(b2.z); n1[8 * q + 6] = bflo(b2.w); n1[8 * q + 7] = bfhi(b2.w); }
    n0 = MFMA32(S.g[0][0], xb0, n0); n0 = MFMA32(S.g[0][1], xb1, n0); n0 = MFMA32(S.g[0][2], xb2, n0); n0 = MFMA32(S.g[0][3], xb3, n0);
    n1 = MFMA32(S.g[1][0], xb0, n1); n1 = MFMA32(S.g[1][1], xb1, n1); n1 = MFMA32(S.g[1][2], xb2, n1); n1 = MFMA32(S.g[1][3], xb3, n1);
    X0 = n0; X1 = n1;
}
DI void rwkv_chunk_b(const Params& P, int bh, int ih, int lane, volatile LAS int* prog) {
    unsigned char* ws = P.ws; const int r32 = lane & 31, hi = lane >> 5, icol = 32 * ih + r32;
    f32x16 X0, X1;
#pragma unroll
    for (int i = 0; i < 16; ++i) { X0[i] = 0.f; X1[i] = 0.f; }
    const bf16* GT = (const bf16*)(ws + WS_CK_GT) + (size_t)bh * 128 * 4096; const bf16* HT = (const bf16*)(ws + WS_CK_HT) + (size_t)bh * 128 * 4096; bf16* SS = (bf16*)(ws + WS_CK_S) + (size_t)bh * 128 * 4096 + icol * 64;
    CkbSet A, B, C;
    ckb_load(A, GT, HT, 0, ih, lane); ckb_load(B, GT, HT, 1, ih, lane); ckb_load(C, GT, HT, 2, ih, lane);
#define CKB_ROUND(c) do { \
        ckb_step(A, X0, X1, SS + (size_t)(c) * 4096, hi); __builtin_amdgcn_sched_barrier(0); ckb_load(A, GT, HT, (c) + 3 < 127 ? (c) + 3 : 127, ih, lane); __builtin_amdgcn_sched_barrier(0);     \
        ckb_step(B, X0, X1, SS + (size_t)((c) + 1) * 4096, hi); __builtin_amdgcn_sched_barrier(0); ckb_load(B, GT, HT, (c) + 4 < 127 ? (c) + 4 : 127, ih, lane); __builtin_amdgcn_sched_barrier(0); \
        ckb_step(C, X0, X1, SS + (size_t)((c) + 2) * 4096, hi); __builtin_amdgcn_sched_barrier(0); ckb_load(C, GT, HT, (c) + 5 < 127 ? (c) + 5 : 127, ih, lane); __builtin_amdgcn_sched_barrier(0); \
        *prog = (c) + 3;     } while (0)
    CKB_ROUND(0);
    for (int c = 3; c < 126; c += 3) CKB_ROUND(c);
#undef CKB_ROUND
    ckb_step(A, X0, X1, SS + (size_t)126 * 4096, hi); ckb_step(B, X0, X1, SS + (size_t)127 * 4096, hi);
    *prog = 128;
    float* so = P.out + O_WKVP + (size_t)bh * 4096 + icol * 64;
#pragma unroll
    for (int gi = 0; gi < 4; ++gi) { *(f32x4*)(so + 8 * gi + 4 * hi) = (f32x4){X0[4 * gi], X0[4 * gi + 1], X0[4 * gi + 2], X0[4 * gi + 3]}; *(f32x4*)(so + 32 + 8 * gi + 4 * hi) = (f32x4){X1[4 * gi], X1[4 * gi + 1], X1[4 * gi + 2], X1[4 * gi + 3]}; }
}
DI void rwkv_chunk_b_touch(const Params& P, int bh, int ih, int lane, volatile LAS int* prog) {
    const char* base = (const char*)(P.ws + ((lane & 32) ? WS_CK_HT : WS_CK_GT)) + (size_t)bh * 128 * 8192 + ih * 4096 + (lane & 31) * 128;
    int done = 3;
    for (;;) { const int cur = *prog; if (cur >= 128) break;
        const int tgt = cur + 16 < 128 ? cur + 16 : 128;
        for (; done < tgt; ++done) { unsigned d_; const char* p_ = base + (size_t)done * 8192; asm volatile("global_load_dword %0, %1, off" : "=v"(d_) : "v"(p_) : "memory"); }
        asm volatile("s_waitcnt vmcnt(0)" ::: "memory");
        __builtin_amdgcn_s_sleep(32); }
}
DI void rwkv_chunk_c(const Params& P, int cg, int lane, LAS float* ylds) {
    unsigned char* ws = P.ws; const int r32 = lane & 31, hi = lane >> 5; const int bh = cg >> 7, c = cg & 127, b = bh >> 3, h = bh & 7; const size_t row0 = (size_t)b * SEQ + c * 32;
    const bf16* QY = (const bf16*)(ws + WS_CK_QY) + (size_t)cg * 2048; const bf16* AY = (const bf16*)(ws + WS_CK_AY) + (size_t)cg * 1024; const bf16* SS = (const bf16*)(ws + WS_CK_S) + (size_t)cg * 4096; const bf16* VT = (const bf16*)(ws + WS_CK_VT) + (size_t)cg * 2048;
    bf16x8 qa[4], aa[2];
#pragma unroll
    for (int ks = 0; ks < 4; ++ks) qa[ks] = ldg8(QY + r32 * 64 + 16 * ks + 8 * hi);
#pragma unroll
    for (int ks = 0; ks < 2; ++ks) aa[ks] = ldg8(AY + r32 * 32 + 16 * ks + 8 * hi);
#pragma unroll
    for (int ib = 0; ib < 2; ++ib) { const int i = 32 * ib + r32; f32x16 acc;
#pragma unroll
        for (int q = 0; q < 16; ++q) acc[q] = 0.f;
#pragma unroll
        for (int ks = 0; ks < 4; ++ks) acc = MFMA32(qa[ks], ldg8(SS + i * 64 + 16 * ks + 8 * hi), acc);
#pragma unroll
        for (int ks = 0; ks < 2; ++ks) acc = MFMA32(aa[ks], ldg8(VT + i * 32 + 16 * ks + 8 * hi), acc);
#pragma unroll
        for (int q = 0; q < 16; ++q) ylds[crow(q, hi) * 512 + h * 64 + i] = acc[q]; }
}
DI int wq_next(unsigned* ctr, volatile LAS int* slot, int tid) {
    if (tid == 0) *slot = (int)__hip_atomic_fetch_add(ctr, 1u, __ATOMIC_RELAXED, __HIP_MEMORY_SCOPE_AGENT);
    __syncthreads(); const int u = *slot; __syncthreads(); return u;
}
DI void bg_drain_means(const Params& P, const Frame& F, unsigned* ctl, int limit) {
    volatile LAS int* wslot = (volatile LAS int*)(F.lds + LDS_BYTES - 128 + 64);
    for (int n = 0; n < limit; ++n) { const int u = wq_next(ctl + 8384, wslot, F.tid); if (u >= 1024) break; prep_means_unit(P, F, u); }
}
DI void bg_drain_w1(const Params& P, const Frame& F, unsigned* ctl) {
    volatile LAS int* wslot = (volatile LAS int*)(F.lds + LDS_BYTES - 128 + 64); constexpr int NW1 = (WI_L1 + 7) / 8;
    for (;;) { const int u = wq_next(ctl + 8448, wslot, F.tid); if (u >= NW1) break; const int i = u * 8 + F.wave; if (i < WI_L1) weight_item(P, (LAS float*)(F.lds + F.wave * 16384), wi_l1(i), F.lane); }
}
constexpr int N_PHASES = 21;
__global__ void __launch_bounds__(512, 2) mk_fwd(Params P) {
    extern __shared__ __attribute__((aligned(16))) unsigned char lds_raw[];
    Frame F;
    F.lds = (LAS unsigned char*)lds_raw;
    F.tid = threadIdx.x; F.lane = F.tid & 63; F.wave = __builtin_amdgcn_readfirstlane(F.tid >> 6);
    F.G = gridDim.x; F.gw = blockIdx.x * NWAVES + F.wave; F.ngw = F.G * NWAVES;
    volatile LAS unsigned* MISC = (volatile LAS unsigned*)(F.lds + MISC_OFF);
    for (int u = F.tid; u < (LDS_BYTES - RING_BYTES) / 4; u += 512) ((LAS unsigned*)(F.lds + RING_BYTES))[u] = 0u;
    __syncthreads();
    unsigned char* ws = P.ws;
    unsigned* ctl = (unsigned*)(ws + WS_CTL);
    XcdBarrier bar = xcd_barrier_post(ctl + 4096, MISC + 8);
    const int lo = P.ph_lo, hi = P.ph_hi;
#define IN(k) (lo <= (k) && (k) < hi)
#if MK_DIAG
    unsigned long long* tstamp = (unsigned long long*)(ctl + 65536);
    if (blockIdx.x == 0 && F.tid == 0) __hip_atomic_store(tstamp + 0, __builtin_amdgcn_s_memrealtime(), __ATOMIC_RELAXED, __HIP_MEMORY_SCOPE_AGENT);
#define STAMP(k) do { if (blockIdx.x == 0 && F.tid == 0) __hip_atomic_store(tstamp + 1 + (k), __builtin_amdgcn_s_memrealtime(), __ATOMIC_RELAXED, __HIP_MEMORY_SCOPE_AGENT); } while (0)
#define STAMPL(k) do { if (blockIdx.x == gridDim.x - 1 && F.tid == 0) __hip_atomic_store(tstamp + 1 + (k), __builtin_amdgcn_s_memrealtime(), __ATOMIC_RELAXED, __HIP_MEMORY_SCOPE_AGENT); } while (0)
#else
#define STAMP(k) do {} while (0)
#define STAMPL(k) do {} while (0)
#endif
#define SEAM(k) do { if (IN(k) && IN((k) + 1)) xcd_barrier(bar); STAMP(k); } while (0)

    if (IN(0)) {
        p0_rope(P, F);
        { LAS float* scr = (LAS float*)(F.lds + F.wave * 16384); for (int i = F.gw; i < WI_L0; i += F.ngw) weight_item(P, scr, wi_l0(i), F.lane); }
        __syncthreads();
        norm_phase(F, INF(0), INF(1), INF(8), (bf16*)(ws + WS_XN));
        for (int u = (int)blockIdx.x; u < 256; u += F.G) prep_conv_unit(P, F, u);
        p0_cmp_bias(P, F); p0_wincopy(P, F);
        for (int i = blockIdx.x * 512 + F.tid; i < 4 * MT; i += F.G * 512) ((float*)(ws + WS_SS))[i] = 0.f;
    }
    SEAM(0);
    if (IN(1)) {
        EpiIn0 e0{(bf16*)(ws + WS_RW), (bf16*)(ws + WS_Q0), (bf16*)(ws + WS_KV0), (bf16*)(ws + WS_KVS0), (const f32x2*)(ws + WS_ROPE), P.out};
        { pg8::Gemm g{(const bf16*)(ws + WS_XN), (const bf16*)(ws + WS_WIN0), MP, 3072, 1024}; pg8::StaticOrder S; S.init(MP, 3072, F.G, (int)blockIdx.x);
          EpiHead<EpiIn0> E{e0};
          pg8::gemm_phase<EpiHead<EpiIn0>, pg8::StaticOrder, PG8_ALIGN, PG8_SP2>(F.lds, g, S, E); }
        __syncthreads();
        for (int u = F.G - 1 - (int)blockIdx.x; u < 96 + 129; u += F.G) {
            if (u < 96) skinny_unit(F.lds, (const bf16*)(ws + WS_XN), (const bf16*)(ws + WS_WIN0), 1024, MP, 32 * u, e0, F.wave, F.lane);
            else skinny_unit(F.lds, (const bf16*)(ws + WS_XN), (const bf16*)(ws + WS_WG0), 1024, 128 * (u - 96), 0, EpiGates{(float*)(ws + WS_GATES), INF(24)}, F.wave, F.lane);
        }
    }
    SEAM(1);
    if (IN(2)) {
        { pg8::Gemm g{(const bf16*)(ws + WS_ACMPS), (const bf16*)(ws + WS_WCMP), 65536, 256, 1024}; pg8::StaticOrder S; S.init(65536, 256, F.G, (int)blockIdx.x);
          EpiHead<EpiCmp> E{EpiCmp{(float*)(ws + WS_HCS), 32768}};
          pg8::gemm_phase<EpiHead<EpiCmp>, pg8::StaticOrder, PG8_ALIGN, PG8_SP2>(F.lds, g, S, E); }
        __syncthreads();
        { pg8::Gemm g{(const bf16*)(ws + WS_KV0), (const bf16*)(ws + WS_WCMP), 4096, 256, 1024}; pg8::StaticOrder S; S.init(4096, 256, F.G, (int)blockIdx.x);
          EpiHead<EpiCmp> E{EpiCmp{(float*)(ws + WS_HCP), 2048}};
          pg8::gemm_phase<EpiHead<EpiCmp>, pg8::StaticOrder, PG8_ALIGN, PG8_SP2>(F.lds, g, S, E); }
        __syncthreads();
        rwkv_prep(P, F, F.G > 32 ? 16 : 0);
    }
    SEAM(2);
    if (IN(3)) {
        EpiLora el{INF(14), INF(16), INF(20), (const bf16*)(ws + WS_K), (const bf16*)(ws + WS_KK), (float*)(ws + WS_W), (bf16*)(ws + WS_KP), (bf16*)(ws + WS_KKA), (bf16*)(ws + WS_G)};
        { pg8::Gemm g{(const bf16*)(ws + WS_LA), (const bf16*)(ws + WS_WLORA), MP, 1536, 256}; pg8::StaticOrder S; S.init(MP, 1536, F.G, (int)blockIdx.x);
          EpiHead<EpiLora> E{el};
          pg8::gemm_phase<EpiHead<EpiLora>, pg8::StaticOrder, PG8_ALIGN, PG8_SP2>(F.lds, g, S, E); }
        __syncthreads();
        for (int u = F.G - 1 - (int)blockIdx.x; u < 48; u += F.G) skinny_unit(F.lds, (const bf16*)(ws + WS_LA), (const bf16*)(ws + WS_WLORA), 256, MP, 32 * u, el, F.wave, F.lane);
        cmp_stage2(P, F);
        __syncthreads();
        if ((int)blockIdx.x >= 128) bg_drain_means(P, F, ctl, 3);
    }
    SEAM(3);
    if (IN(4)) {
        for (int cg = (int)blockIdx.x * NWAVES + F.wave; cg < CKN; cg += F.G * NWAVES) rwkv_chunk_a(P, F, cg);
        __syncthreads();
    }
    SEAM(4);
    if (IN(5)) {
        unsigned* bdone = ctl + 8576;
        if ((int)blockIdx.x < 32) {
            volatile LAS int* prog = (volatile LAS int*)F.lds;
            { int t_ = F.tid; asm volatile("" : "+v"(t_)); if (t_ < 2) prog[t_] = 0; }
            __syncthreads();
            if (F.wave >= 2 && F.wave < 4) rwkv_chunk_b_touch(P, (int)blockIdx.x, F.wave - 2, F.lane, prog + (F.wave - 2));
            if (F.wave >= 4) { for (int wid = (int)blockIdx.x * 4 + (F.wave - 4); wid < 2048; wid += 128) scan_sample_wave(P, wid, F.lane); }
            if (F.wave < 2) rwkv_chunk_b(P, (int)blockIdx.x, F.wave, F.lane, prog + F.wave);
            __syncthreads();
            if (F.tid < 64) { __builtin_amdgcn_fence(__ATOMIC_RELEASE, "agent"); asm volatile("s_waitcnt vmcnt(0)" ::: "memory"); if (F.tid == 0) __hip_atomic_fetch_add(bdone, 1u, __ATOMIC_RELAXED, __HIP_MEMORY_SCOPE_AGENT); }
            __syncthreads(); STAMP(30); }
        volatile LAS int* wslot = (volatile LAS int*)(F.lds + LDS_BYTES - 128 + 64);
        int u;
        for (;;) { u = wq_next(ctl + 8192, wslot, F.tid); if (u >= 576) break;
            if (u >= 224 && u < 288) { const int v = u - 224; nsa_sample_unit(P, F, v >> 1, v & 1); }
            else { const int v = u < 224 ? u : u - 64; nsa_prompt_unit(P, F, (v & 7) >> 1, v & 1, 63 - (v >> 3)); } }
        const bool has_post = MP + F.gw - F.wave < MP + MS;
        if (u < 576 + 512 || has_post) {
            if (F.tid == 0) { while (__hip_atomic_load(bdone, __ATOMIC_RELAXED, __HIP_MEMORY_SCOPE_AGENT) < 32u) __builtin_amdgcn_s_sleep(8); }
            __syncthreads(); __builtin_amdgcn_fence(__ATOMIC_ACQUIRE, "agent");
            for (; u < 576 + 512; u = wq_next(ctl + 8192, wslot, F.tid)) { const int v = u - 576, b = v >> 7, c = v & 127;
                rwkv_chunk_c(P, (b * 8 + F.wave) * 128 + c, F.lane, (LAS float*)F.lds);
                __syncthreads();
                rwkv_post_rows<2, true>(P, b * SEQ + c * 32 + F.wave, 8, F.lane, (const LAS float*)F.lds, F.wave); rwkv_post_rows<2, true>(P, b * SEQ + c * 32 + 16 + F.wave, 8, F.lane, (const LAS float*)F.lds, 16 + F.wave);
                __syncthreads(); } }
        for (int row = MP + F.gw; row < MP + MS; row += F.ngw) rwkv_post_rows<1, false>(P, row, 0, F.lane, (const LAS float*)F.lds, 0);
    }
    STAMP(5);
    SEAM(6);
#define GEMM_PHASE(EPI_T, epi, Aptr, Bptr, N_, K_, nskinny) do { \
        { pg8::Gemm g{(const bf16*)(Aptr), (const bf16*)(Bptr), MP, (N_), (K_)}; pg8::StaticOrder S; S.init(MP, (N_), F.G, (int)blockIdx.x); EpiHead<EPI_T> E{epi}; \
          pg8::gemm_phase<EpiHead<EPI_T>, pg8::StaticOrder, PG8_ALIGN, PG8_SP2>(F.lds, g, S, E); } \
        __syncthreads(); \
        for (int u = F.G - 1 - (int)blockIdx.x; u < 2 * (nskinny); u += F.G) skinny_unit(F.lds, (const bf16*)(Aptr), (const bf16*)(Bptr), (K_), MP, 32 * u, epi, F.wave, F.lane); } while (0)
    bf16* Hb = (bf16*)(ws + WS_H); float* SSb = (float*)(ws + WS_SS);
#define GEMM_PHASE_SC(EPI_T, epi, ssp, Aptr, Bptr, N_, K_, nskinny) do { \
        { pg8::Gemm g{(const bf16*)(Aptr), (const bf16*)(Bptr), MP, (N_), (K_)}; pg8::StaticOrder S; S.init(MP, (N_), F.G, (int)blockIdx.x); EpiHeadScaled<EPI_T> E{epi, (ssp)}; \
          pg8::gemm_phase<EpiHeadScaled<EPI_T>, pg8::StaticOrder, PG8_ALIGN, PG8_SP2>(F.lds, g, S, E); } \
        __syncthreads(); \
        { RowScaled<EPI_T> es{epi, (ssp)}; for (int u = F.G - 1 - (int)blockIdx.x; u < 2 * (nskinny); u += F.G) skinny_unit(F.lds, (const bf16*)(Aptr), (const bf16*)(Bptr), (K_), MP, 32 * u, es, F.wave, F.lane); } } while (0)
#define RESID_PHASE(F32, baseP, baseS, Aptr, Bptr, K_, ssk) do { \
        { pg8::Gemm g{(const bf16*)(Aptr), (const bf16*)(Bptr), MP, 1024, (K_)}; pg8::StaticOrder S; S.init(MP, 1024, F.G, (int)blockIdx.x); EpiResidN<F32> E{(const void*)(baseP), Hb, SSb + (size_t)(ssk) * MT}; \
          pg8::gemm_phase<EpiResidN<F32>, pg8::StaticOrder, PG8_ALIGN, PG8_SP2>(F.lds, g, S, E); } \
        __syncthreads(); \
        { EpiResidNS<F32> es{(const void*)(baseS), Hb, SSb + (size_t)(ssk) * MT}; \
          for (int u = F.G - 1 - (int)blockIdx.x; u < 32; u += F.G) skinny_unit(F.lds, (const bf16*)(Aptr), (const bf16*)(Bptr), (K_), MP, 32 * u, es, F.wave, F.lane); } } while (0)
    if (IN(8)) { RESID_PHASE(true, INF(0), INF(1), ws + WS_ATT, ws + WS_WOUT0, 1024, 0); }
    SEAM(8);
    if (IN(10)) { EpiSwiglu e{(bf16*)(ws + WS_HFF)}; GEMM_PHASE_SC(EpiSwiglu, e, SSb, Hb, ws + WS_WGU0, 5632, 1024, 88); __syncthreads(); bg_drain_w1(P, F, ctl); }
    SEAM(10);
    if (IN(11)) { RESID_PHASE(false, Hb, Hb + (size_t)MP * D, ws + WS_HFF, ws + WS_WDN0, FF, 1); }
    SEAM(11);
    if (IN(13)) { EpiIn1 e{(bf16*)(ws + WS_Q1), (bf16*)(ws + WS_K1), (bf16*)(ws + WS_K1S), (const f32x2*)(ws + WS_ROPE), P.out};
        GEMM_PHASE_SC(EpiIn1, e, SSb + (size_t)MT, Hb, ws + WS_WIN1, 1536, 1024, 24); __syncthreads(); if ((int)blockIdx.x >= 128) bg_drain_means(P, F, ctl, 4); }
    SEAM(13);
    if (IN(14)) { moba_means(P, F); __syncthreads(); bg_drain_means(P, F, ctl, 1 << 30); }
    SEAM(14);
    if (IN(15)) {
        volatile LAS int* wslot = (volatile LAS int*)(F.lds + LDS_BYTES - 128 + 64);
        for (;;) { const int u = wq_next(ctl + 8256, wslot, F.tid); if (u >= 1152) break;
            const bool samp = u < 512 && (u & 3) == 0; const int v = u < 512 ? (samp ? (u >> 2) : u - ((u + 3) >> 2)) : u - 128;
            if (samp) moba_sample_unit(P, F, v >> 2, v & 3);
            else moba_prompt_unit(P, F, (v & 15) >> 2, v & 3, 63 - (v >> 4)); }
    }
    SEAM(15);
    if (IN(16)) { RESID_PHASE(false, Hb, Hb + (size_t)MP * D, ws + WS_ATT, ws + WS_WOUT1, 1024, 2); }
    SEAM(16);
    if (IN(18)) { EpiSwiglu e{(bf16*)(ws + WS_HFF)}; GEMM_PHASE_SC(EpiSwiglu, e, SSb + (size_t)2 * MT, Hb, ws + WS_WGU1, 5632, 1024, 88); }
    SEAM(18);
    if (IN(19)) { RESID_PHASE(false, Hb, Hb + (size_t)MP * D, ws + WS_HFF, ws + WS_WDN1, FF, 3); }
    SEAM(19);
    if (IN(20)) { final_norm(P, F); }
#if MK_DIAG
    xcd_barrier(bar); STAMP(20);
    if (blockIdx.x == 0) { __syncthreads();
#define DIAG_OUT2(OFF, SLO, SHI) do { unsigned n_ = (unsigned)((__hip_atomic_load(tstamp + (SHI), __ATOMIC_RELAXED, __HIP_MEMORY_SCOPE_AGENT) - __hip_atomic_load(tstamp + (SLO), __ATOMIC_RELAXED, __HIP_MEMORY_SCOPE_AGENT) + ((MK_DIAG == 5 || MK_DIAG == 9) ? 100ull : 500ull)) / ((MK_DIAG == 5 || MK_DIAG == 9) ? 200ull : 1000ull)); \
            if (n_ > 7000u) n_ = 7000u; for (unsigned i_ = F.tid; i_ < n_; i_ += 512) ((unsigned*)P.out)[(OFF) + i_] = 0xAAAAAAAAu; } while (0)
#if MK_DIAG == 1
        DIAG_OUT2(O_YP, 0, 1); DIAG_OUT2(O_NSAP, 1, 2); DIAG_OUT2(O_MOBP, 3, 4);
#elif MK_DIAG == 2
        DIAG_OUT2(O_YP, 4, 5); DIAG_OUT2(O_NSAP, 5, 6); DIAG_OUT2(O_MOBP, 6, 7);
#elif MK_DIAG == 3
        DIAG_OUT2(O_YP, 7, 9); DIAG_OUT2(O_NSAP, 9, 11); DIAG_OUT2(O_MOBP, 11, 12);
#elif MK_DIAG == 4
        DIAG_OUT2(O_YP, 12, 14); DIAG_OUT2(O_NSAP, 14, 15); DIAG_OUT2(O_MOBP, 15, 16);
#elif MK_DIAG == 10
        DIAG_OUT2(O_YP, 2, 3); DIAG_OUT2(O_NSAP, 3, 4); DIAG_OUT2(O_MOBP, 4, 5);
#elif MK_DIAG == 11
        DIAG_OUT2(O_YP, 5, 31); DIAG_OUT2(O_NSAP, 5, 6); DIAG_OUT2(O_MOBP, 6, 7);
#elif MK_DIAG == 9
        DIAG_OUT2(O_YP, 4, 51); DIAG_OUT2(O_NSAP, 51, 53); DIAG_OUT2(O_MOBP, 53, 54);
#else
        DIAG_OUT2(O_YP, 16, 17); DIAG_OUT2(O_NSAP, 17, 19); DIAG_OUT2(O_MOBP, 19, 21);
#endif
#undef DIAG_OUT2
    }
#endif
#undef GEMM_PHASE
#undef GEMM_PHASE_SC
#undef RESID_PHASE
#undef IN
#undef SEAM
}

extern "C" void kernel_launch(void* const* d_in, const int* in_sizes, int n_in, void* d_out, int out_size, void* d_ws, size_t ws_size, hipStream_t stream) {
    static int grid = 0;
    if (grid == 0) {
        if (n_in != 33 || (size_t)out_size != O_END || ws_size < WS_END4) { fprintf(stderr, "kernel_launch: unexpected shapes n_in %d out %d ws %zu (need %zu)\n", n_in, out_size, ws_size, (size_t)WS_END4); grid = -1; return; }
        int dev = 0, cus = 0, per_cu = 0;
        if (hipGetDevice(&dev) != hipSuccess || hipDeviceGetAttribute(&cus, hipDeviceAttributeMultiprocessorCount, dev) != hipSuccess) { grid = -1; return; }
        if (hipFuncSetAttribute((const void*)mk_fwd, hipFuncAttributeMaxDynamicSharedMemorySize, LDS_BYTES) != hipSuccess) { fprintf(stderr, "kernel_launch: hipFuncSetAttribute failed\n"); grid = -1; return; }
        if (hipOccupancyMaxActiveBlocksPerMultiprocessor(&per_cu, (const void*)mk_fwd, 512, LDS_BYTES) != hipSuccess || per_cu < 1) fprintf(stderr, "kernel_launch: occupancy query says %d\n", per_cu);
        (void)hipGetLastError();
        grid = cus;
    }
    if (grid < 0) return;
    if (hipMemsetAsync((char*)d_ws + WS_CTL, 0, CTL_BYTES, stream) != hipSuccess) return;
    Params p{};
    for (int i = 0; i < 33; ++i) p.in[i] = d_in[i];
    p.out = (float*)d_out; p.ws = (unsigned char*)d_ws;
#ifndef MK_LAUNCH_PER_PHASE
#define MK_LAUNCH_PER_PHASE 0
#endif
#if MK_LAUNCH_PER_PHASE
    for (int k = 0; k < N_PHASES; ++k) { p.ph_lo = k; p.ph_hi = k + 1; hipLaunchKernelGGL(mk_fwd, dim3(grid), dim3(512), LDS_BYTES, stream, p); }
#else
    p.ph_lo = 0; p.ph_hi = N_PHASES; hipLaunchKernelGGL(mk_fwd, dim3(grid), dim3(512), LDS_BYTES, stream, p);
#endif
}
```

```cpp
#include <hip/hip_runtime.h>
#include <cstdio>
#include <cstdint>
namespace pg8 {
#define PG8_LAS __attribute__((address_space(3)))
typedef unsigned short bf16_t;
typedef short bf16x8 __attribute__((ext_vector_type(8)));
typedef float f32x4 __attribute__((ext_vector_type(4)));
typedef unsigned u32x4 __attribute__((ext_vector_type(4)));
constexpr int BM = 256, BK = 64, HALF = 128, HTB = HALF * BK * 2  , STAGE_BYTES = 8 * HTB, NXCD = 8, WGM = 8;

__host__ __device__ __forceinline__ int lds_byte(int r, int c) { const int st = (r >> 4) * 2 + (c >> 5), rr = r & 15, cc = c & 31, ob = rr * 64 + cc * 2; return st * 1024 + (ob ^ (((ob >> 9) & 1) << 5)); }
__host__ __device__ __forceinline__ void stage_rc(int b, int& R, int& C) { const int st = b / 1024, sb = b % 1024, swz = sb ^ (((sb >> 9) & 1) << 5); R = (st >> 1) * 16 + swz / 64; C = (st & 1) * 32 + (swz % 64) / 2; }
__host__ __device__ __forceinline__ int perm32(int rho) { const int n = rho >> 4, i = rho & 15; return 8 * (i >> 2) + 4 * n + (i & 3); }

struct Unit { int pm, pn; };
struct Gemm { const bf16_t* A; const bf16_t* Bt; int M, N, K; };

struct StaticOrder {
    int nM, nN, nwg, G, c;
    __host__ __device__ void init(int M, int N, int G_, int c_) { nM = M / BM; nN = N / BM; nwg = nM * nN; G = G_; c = c_; }
    __host__ __device__ bool next(int i, Unit& u) const {
        const long L = (long)i * G + c; if (L >= nwg) return false;
        int wgid = (int)L; { const int q = nwg / NXCD, r = nwg % NXCD, xcd = wgid % NXCD, off = wgid / NXCD; wgid = (xcd < r ? xcd * (q + 1) : r * (q + 1) + (xcd - r) * q) + off; }
        const int nig = WGM * nN, gid = wgid / nig, fm = gid * WGM, gsz = (nM - fm) < WGM ? (nM - fm) : WGM;
        u.pm = fm + ((wgid % nig) % gsz); u.pn = (wgid % nig) / gsz; return true;
    }
    __device__ __forceinline__ void a_ready(const Unit&) const {}
    __device__ __forceinline__ void done(const Unit&) const {}
};

template <class Epi, class Sched, bool ALIGN_EPI = false, bool SP2 = false>
__device__ __forceinline__ void gemm_phase(PG8_LAS unsigned char* lds, const Gemm g, const Sched& S, const Epi& E) {
    const int tid = threadIdx.x, wid = __builtin_amdgcn_readfirstlane(tid >> 6), lane = tid & 63, wr = wid >> 2, wc = wid & 3, fr = lane & 15, fq = lane >> 4;
    const int K = g.K, nt = K / BK;
    unsigned voffA[2], voffB[2];
#pragma unroll
    for (int i = 0; i < 2; ++i) { int R, C; stage_rc(tid * 16 + i * 8192, R, C); const int Rb = Epi::PERM ? ((R & ~31) + perm32(R & 31)) : R;
        voffA[i] = (unsigned)(R * K + C) * 2u; voffB[i] = (unsigned)(Rb * K + C) * 2u; }
    const size_t kstep = (size_t)(BK * 2);
    const size_t hstep = (size_t)HALF * K * 2;
    const size_t tstep = 2 * hstep;
    const unsigned ldsw = (unsigned)wid * 1024u;
    const int aoff = lds_byte(wr * 64 + fr, fq * 8), boff = lds_byte(wc * 32 + fr, fq * 8);
#define PG8_SA(b, h) (((b) * 2 + (h)) * HTB)
#define PG8_SB(b, h) ((4 + (b) * 2 + (h)) * HTB)
#define PG8_STAGE(bufoff, gbase, voff) do { _Pragma("unroll") for (int _i = 0; _i < 2; ++_i) \
        __builtin_amdgcn_global_load_lds((const unsigned*)((const char*)(gbase) + (voff)[_i]), (PG8_LAS unsigned*)(lds + (bufoff) + ldsw + _i * 8192), 16, 0, 0); } while (0)
#define PG8_LDA(dst, b, h) do { _Pragma("unroll") for (int m = 0; m < 4; ++m) _Pragma("unroll") for (int k = 0; k < 2; ++k) dst[m][k] = *(const PG8_LAS bf16x8*)(lds + PG8_SA(b, h) + aoff + m * 2048 + k * 1024); } while (0)
#define PG8_LDB(dst, b, h) do { _Pragma("unroll") for (int n = 0; n < 2; ++n) _Pragma("unroll") for (int k = 0; k < 2; ++k) dst[n][k] = *(const PG8_LAS bf16x8*)(lds + PG8_SB(b, h) + boff + n * 2048 + k * 1024); } while (0)
#define PG8_MMA(ai, bj, At, Bt) do { __builtin_amdgcn_s_setprio(1); _Pragma("unroll") for (int m = 0; m < 4; ++m) _Pragma("unroll") for (int n = 0; n < 2; ++n) _Pragma("unroll") for (int k = 0; k < 2; ++k) \
        acc[ai][bj][m][n] = __builtin_amdgcn_mfma_f32_16x16x32_bf16(Bt[n][k], At[m][k], acc[ai][bj][m][n], 0, 0, 0); __builtin_amdgcn_s_setprio(0); } while (0)
#define PG8_WAIT_V(n) asm volatile("s_waitcnt vmcnt(" #n ")" ::: "memory")
#define PG8_WAIT_L(n) asm volatile("s_waitcnt lgkmcnt(" #n ")" ::: "memory")
#define PG8_BAR __builtin_amdgcn_s_barrier()
#define PG8_SCHED __builtin_amdgcn_sched_barrier(0)
    Unit cur, nxt; int ui = 0;
    if (!S.next(0, cur)) return;
    f32x4 acc[2][2][4][2];
#pragma unroll
    for (int a = 0; a < 2; ++a)
#pragma unroll
        for (int b = 0; b < 2; ++b)
#pragma unroll
            for (int m = 0; m < 4; ++m)
#pragma unroll
                for (int n = 0; n < 2; ++n) acc[a][b][m][n] = (f32x4){0.f, 0.f, 0.f, 0.f};
    bf16x8 At[4][2], B0[2][2], B1[2][2];
    const char* cA = (const char*)g.A + (size_t)cur.pm * tstep; const char* cB = (const char*)g.Bt + (size_t)cur.pn * tstep;
    S.a_ready(cur);
    if constexpr (SP2) {
        PG8_STAGE(PG8_SB(0, 0), cB, voffB); PG8_STAGE(PG8_SB(0, 1), cB + hstep, voffB); PG8_STAGE(PG8_SA(0, 0), cA, voffA); PG8_STAGE(PG8_SA(0, 1), cA + hstep, voffA);
        if (wr == 1) PG8_BAR;
        PG8_WAIT_V(2); PG8_BAR;
        PG8_STAGE(PG8_SB(1, 0), cB + kstep, voffB); PG8_STAGE(PG8_SA(1, 0), cA + kstep, voffA); PG8_STAGE(PG8_SB(1, 1), cB + hstep + kstep, voffB);
        PG8_WAIT_V(6); PG8_BAR;
    } else {
        PG8_STAGE(PG8_SB(0, 0), cB, voffB); PG8_STAGE(PG8_SA(0, 0), cA, voffA); PG8_STAGE(PG8_SB(0, 1), cB + hstep, voffB); PG8_STAGE(PG8_SA(0, 1), cA + hstep, voffA);
        if (wr == 1) PG8_BAR;
        PG8_WAIT_V(4); PG8_BAR;
        PG8_STAGE(PG8_SB(1, 0), cB + kstep, voffB); PG8_STAGE(PG8_SA(1, 0), cA + kstep, voffA); PG8_STAGE(PG8_SB(1, 1), cB + hstep + kstep, voffB);
        PG8_WAIT_V(6); PG8_BAR;
    }
    for (;;) {
        const bool has_next = S.next(ui + 1, nxt);
        const char* nA = has_next ? (const char*)g.A + (size_t)nxt.pm * tstep : cA; const char* nB = has_next ? (const char*)g.Bt + (size_t)nxt.pn * tstep : cB;
        for (int t = 0; t < nt; t += 2) {
            const bool last = (t == nt - 2);
            const char* a1 = cA + (size_t)(t + 1) * kstep;
            const char* a2 = last ? nA : cA + (size_t)(t + 2) * kstep; const char* b2 = last ? nB : cB + (size_t)(t + 2) * kstep;
            const char* a3 = a2 + kstep; const char* b3 = b2 + kstep;
            if (last && has_next) S.a_ready(nxt);
            if constexpr (SP2) {
            PG8_LDB(B0, 0, 0); PG8_LDB(B1, 0, 1); PG8_SCHED; PG8_LDA(At, 0, 0); PG8_STAGE(PG8_SA(1, 1), a1 + hstep, voffA);
            PG8_WAIT_V(8); PG8_WAIT_L(0); PG8_BAR; PG8_MMA(0, 0, At, B0); PG8_MMA(0, 1, At, B1); PG8_BAR; PG8_SCHED;
            PG8_LDA(At, 0, 1); PG8_STAGE(PG8_SB(0, 0), b2, voffB); PG8_STAGE(PG8_SB(0, 1), b2 + hstep, voffB); PG8_STAGE(PG8_SA(0, 0), a2, voffA);
            PG8_WAIT_V(8); PG8_WAIT_L(0); PG8_BAR; PG8_MMA(1, 0, At, B0); PG8_MMA(1, 1, At, B1); PG8_BAR; PG8_SCHED;
            PG8_LDB(B0, 1, 0); PG8_LDB(B1, 1, 1); PG8_SCHED; PG8_LDA(At, 1, 0); PG8_STAGE(PG8_SA(0, 1), a2 + hstep, voffA);
            PG8_WAIT_V(8); PG8_WAIT_L(0); PG8_BAR; PG8_MMA(0, 0, At, B0); PG8_MMA(0, 1, At, B1); PG8_BAR; PG8_SCHED;
            PG8_LDA(At, 1, 1); PG8_STAGE(PG8_SB(1, 0), b3, voffB); PG8_STAGE(PG8_SB(1, 1), b3 + hstep, voffB); PG8_STAGE(PG8_SA(1, 0), a3, voffA);
            PG8_WAIT_V(8); PG8_WAIT_L(0); PG8_BAR; PG8_MMA(1, 0, At, B0); PG8_MMA(1, 1, At, B1); PG8_BAR; PG8_SCHED;
            } else {
            PG8_LDB(B0, 0, 0); PG8_SCHED; PG8_LDA(At, 0, 0); PG8_STAGE(PG8_SA(1, 1), a1 + hstep, voffA);
            PG8_WAIT_L(8); PG8_BAR; PG8_WAIT_L(0); PG8_MMA(0, 0, At, B0); PG8_BAR; PG8_SCHED;
            PG8_LDB(B1, 0, 1); PG8_STAGE(PG8_SB(0, 0), b2, voffB);
            PG8_BAR; PG8_WAIT_L(0); PG8_MMA(0, 1, At, B1); PG8_BAR;
            PG8_LDA(At, 0, 1); PG8_STAGE(PG8_SA(0, 0), a2, voffA);
            PG8_BAR; PG8_WAIT_L(0); PG8_MMA(1, 0, At, B0); PG8_BAR; PG8_SCHED;
            PG8_STAGE(PG8_SB(0, 1), b2 + hstep, voffB);
            PG8_WAIT_V(6); PG8_BAR; PG8_MMA(1, 1, At, B1); PG8_BAR;
            PG8_LDB(B0, 1, 0); PG8_SCHED; PG8_LDA(At, 1, 0); PG8_STAGE(PG8_SA(0, 1), a2 + hstep, voffA);
            PG8_WAIT_L(8); PG8_BAR; PG8_WAIT_L(0); PG8_MMA(0, 0, At, B0); PG8_BAR; PG8_SCHED;
            PG8_LDB(B1, 1, 1); PG8_STAGE(PG8_SB(1, 0), b3, voffB);
            PG8_BAR; PG8_WAIT_L(0); PG8_MMA(0, 1, At, B1); PG8_BAR;
            PG8_LDA(At, 1, 1); PG8_STAGE(PG8_SA(1, 0), a3, voffA);
            PG8_BAR; PG8_WAIT_L(0); PG8_MMA(1, 0, At, B0); PG8_BAR; PG8_SCHED;
            PG8_STAGE(PG8_SB(1, 1), b3 + hstep, voffB);
            PG8_WAIT_V(6); PG8_BAR; PG8_MMA(1, 1, At, B1); PG8_BAR;
            }
        }
        if constexpr (ALIGN_EPI) { if (wr == 0) PG8_BAR; }
        if constexpr (!Epi::AFTER_DRAIN) { E(acc, cur, wr, wc, fr, fq); S.done(cur); }
        if (!has_next) break;
#pragma unroll
        for (int a = 0; a < 2; ++a)
#pragma unroll
            for (int b = 0; b < 2; ++b)
#pragma unroll
                for (int m = 0; m < 4; ++m)
#pragma unroll
                    for (int n = 0; n < 2; ++n) acc[a][b][m][n] = (f32x4){0.f, 0.f, 0.f, 0.f};
        cur = nxt; cA = nA; cB = nB; ++ui;
        if constexpr (ALIGN_EPI) { if (wr == 1) PG8_BAR; }
    }
    PG8_WAIT_V(0);
    if constexpr (!ALIGN_EPI) { if (wr == 0) PG8_BAR; }
    PG8_BAR;
    if constexpr (Epi::AFTER_DRAIN) { E.fused(acc, cur, wr, wc, fr, fq, lds, wid, lane); S.done(cur); }
#undef PG8_SA
#undef PG8_SB
#undef PG8_STAGE
#undef PG8_LDA
#undef PG8_LDB
#undef PG8_MMA
#undef PG8_WAIT_V
#undef PG8_WAIT_L
#undef PG8_BAR
#undef PG8_SCHED
}
}
#define PG8_SP2 true
#define PG8_ALIGN true
#define GAS __attribute__((address_space(1)))
#define LAS __attribute__((address_space(3)))
#define MK_DIAG 0
typedef unsigned short bf16;
typedef unsigned v4u __attribute__((ext_vector_type(4)));
typedef unsigned v2u __attribute__((ext_vector_type(2)));
typedef float f32x4 __attribute__((ext_vector_type(4)));
typedef float f32x2 __attribute__((ext_vector_type(2)));
typedef float f32x16 __attribute__((ext_vector_type(16)));
typedef short bf16x8 __attribute__((ext_vector_type(8)));
typedef short s16x4 __attribute__((ext_vector_type(4)));
typedef __bf16 bf16x2_t __attribute__((ext_vector_type(2)));
#define DI __device__ __forceinline__
#define LDS_WAIT() asm volatile("s_waitcnt lgkmcnt(0)" ::: "memory")
#define VM_WAIT() asm volatile("s_waitcnt vmcnt(0)" ::: "memory")

DI unsigned pk2(float lo, float hi) { f32x2 v = {lo, hi}; bf16x2_t b = __builtin_convertvector(v, bf16x2_t); return __builtin_bit_cast(unsigned, b); }
DI float bflo(unsigned u) { return __uint_as_float(u << 16); }
DI float bfhi(unsigned u) { return __uint_as_float(u & 0xffff0000u); }
DI float bf2f(bf16 u) { return __uint_as_float((unsigned)u << 16); }
DI float wave_sum(float v) {
#pragma unroll
    for (int o = 1; o < 64; o <<= 1) v += __shfl_xor(v, o);
    return v;
}
DI float sigmoidf_(float x) { return 1.0f / (1.0f + __expf(-x)); }
constexpr float ATT_SC = 0.125f * 1.4426950408889634f;

constexpr int D = 1024, MP = 16384, MS = 128, MT = 16640, SEQ = 4096, NB = 4, NSQ = 32, TS = 4;
constexpr int RWC = 1792, FF = 2816, NPG = 64, PAGE = 128, PAST = 8192;
constexpr int NWAVES = 8;
constexpr size_t O_YP = 0, O_YS = O_YP + (size_t)MP * D, O_NSAP = O_YS + (size_t)MS * D, O_NSAS = O_NSAP + (size_t)MP * 512,
                 O_MOBP = O_NSAS + (size_t)MS * 512, O_MOBS = O_MOBP + (size_t)MP * 512, O_WINP = O_MOBS + (size_t)MS * 512,
                 O_WINS = O_WINP + (size_t)NB * 512 * 256, O_WKVP = O_WINS + (size_t)NSQ * 512 * 256, O_WKVS = O_WKVP + (size_t)NB * 8 * 4096,
                 O_SHP = O_WKVS + (size_t)NSQ * 8 * 4096, O_SHS = O_SHP + (size_t)NB * RWC, O_END = O_SHS + (size_t)NSQ * RWC;
constexpr size_t al(size_t x) { return (x + 4095) & ~(size_t)4095; }
constexpr size_t WS_CTL = 0, CTL_BYTES = 1u << 20;
constexpr size_t WS_ROPE  = CTL_BYTES;
constexpr size_t WS_WIN0  = al(WS_ROPE + (size_t)4100 * 32 * 8);
constexpr size_t WS_WG0   = al(WS_WIN0 + (size_t)3072 * 1024 * 2);
constexpr size_t WS_WOUT0 = al(WS_WG0 + (size_t)64 * 1024 * 2);
constexpr size_t WS_WGU0  = al(WS_WOUT0 + (size_t)1024 * 1024 * 2);
constexpr size_t WS_WDN0  = al(WS_WGU0 + (size_t)5632 * 1024 * 2);
constexpr size_t WS_WIN1  = al(WS_WDN0 + (size_t)1024 * 2816 * 2);
constexpr size_t WS_WOUT1 = al(WS_WIN1 + (size_t)1536 * 1024 * 2);
constexpr size_t WS_WGU1  = al(WS_WOUT1 + (size_t)1024 * 1024 * 2);
constexpr size_t WS_WDN1  = al(WS_WGU1 + (size_t)5632 * 1024 * 2);
constexpr size_t WS_WLORA = al(WS_WDN1 + (size_t)1024 * 2816 * 2);
constexpr size_t WS_WCMP  = al(WS_WLORA + (size_t)1536 * 256 * 2);
constexpr size_t WS_XN    = al(WS_WCMP + (size_t)256 * 1024 * 2);
constexpr size_t WS_RW    = al(WS_XN + (size_t)MT * 1024 * 2);
constexpr size_t WS_Q0    = al(WS_RW + (size_t)MT * RWC * 2);
constexpr size_t WS_GATES = al(WS_Q0 + (size_t)MT * 512 * 2);
constexpr size_t WS_KV0   = al(WS_GATES + (size_t)MT * 32 * 4);
constexpr size_t WS_KVS0  = al(WS_KV0 + (size_t)6 * 4 * 2 * 4096 * 64 * 2);
constexpr size_t WS_ACMPS = al(WS_KVS0 + (size_t)6 * 32 * 2 * 4 * 64 * 2);
constexpr size_t WS_HCP   = al(WS_ACMPS + (size_t)2 * 32 * 2 * 8192 * 64 * 2);
constexpr size_t WS_HCS   = al(WS_HCP + (size_t)4096 * 128 * 4);
constexpr size_t WS_MEANS = al(WS_HCS + (size_t)65536 * 128 * 4);
constexpr size_t WS_END0  = al(WS_MEANS + (size_t)32 * 4 * 32 * 64 * 4);
#define XB_TMO      128
#define XB_XCNT(j)  (256  + 64 * (j))
#define XB_XSUB(j)  (1280 + 64 * (j))
#define XB_XGEN(j)  (2304 + 64 * (j))
#define XB_TOP      3328
#define XB_TOPGEN   3392
#define XCD_BAR_WORDS 3456
#define XB_SPIN_CAP (1u << 18)

__device__ __forceinline__ unsigned xb_ld(unsigned* p)              { return __hip_atomic_load(p, __ATOMIC_RELAXED, __HIP_MEMORY_SCOPE_AGENT); }
__device__ __forceinline__ unsigned xb_add(unsigned* p, unsigned v) { return __hip_atomic_fetch_add(p, v, __ATOMIC_RELAXED, __HIP_MEMORY_SCOPE_AGENT); }
__device__ __forceinline__ unsigned xb_xcc_id() { return (unsigned)__builtin_amdgcn_s_getreg((3 << 11) | 20) & 0xFu; }
#define XB_SPIN(cond, bar) do { unsigned _sp = 0; while (cond) { __builtin_amdgcn_s_sleep(1); \
    if ((++_sp & 255u) == 0u) { if (xb_ld(&(bar)[XB_TMO])) break; if (_sp > XB_SPIN_CAP) { atomicAdd(&(bar)[XB_TMO], 1u); break; } } } } while (0)

struct XcdBarrier {
    unsigned* bar; unsigned x;
    volatile LAS unsigned* st;
};

__device__ __forceinline__ XcdBarrier xcd_barrier_post(unsigned* bar, volatile LAS unsigned* st) {
    XcdBarrier b; b.bar = bar; b.x = xb_xcc_id(); b.st = st;
    if (threadIdx.x == 0) (void)xb_add(&bar[XB_XCNT(b.x)], 1u);
    return b;
}
__device__ __forceinline__ void xcd_barrier_complete(unsigned* bar, unsigned x, unsigned& nloc, unsigned& nx) {
    const unsigned G = gridDim.x * gridDim.y * gridDim.z;
    unsigned sum, cnt, mine, sp = 0u;
    for (;;) {
        sum = 0u; cnt = 0u; mine = 0u;
#pragma unroll
        for (unsigned j = 0; j < 16; ++j) { const unsigned c = xb_ld(&bar[XB_XCNT(j)]); sum += c; cnt += (c > 0u) ? 1u : 0u; mine = (j == x) ? c : mine; }
        if (sum == G) break;
        __builtin_amdgcn_s_sleep(1);
        if ((++sp & 255u) == 0u) { if (xb_ld(&bar[XB_TMO])) break; if (sp > XB_SPIN_CAP) { atomicAdd(&bar[XB_TMO], 1u); break; } }
    }
    nloc = mine > 0u ? mine : 1u; nx = cnt > 0u ? cnt : 1u;
}

__device__ __forceinline__ void xcd_barrier(const XcdBarrier& b) {
    asm volatile("s_waitcnt vmcnt(0)" ::: "memory");
    __syncthreads();
    if (threadIdx.x == 0) {
        unsigned* bar = b.bar;
        __builtin_amdgcn_s_waitcnt(0);
        unsigned nloc = b.st[0], nx = b.st[1];
        if (nloc == 0u) { xcd_barrier_complete(bar, b.x, nloc, nx); b.st[0] = nloc; b.st[1] = nx; }
        const unsigned old = xb_add(&bar[XB_XSUB(b.x)], 1u);
        const unsigned gen = old / nloc;
        if (old + 1u == (gen + 1u) * nloc) {
            __builtin_amdgcn_fence(__ATOMIC_RELEASE, "agent");
            asm volatile("s_waitcnt vmcnt(0)" ::: "memory");
            const unsigned og = xb_add(&bar[XB_TOP], 1u);
            const unsigned tg = og / nx;
            if (og + 1u == (tg + 1u) * nx) xb_add(&bar[XB_TOPGEN], 1u);
            else XB_SPIN(xb_ld(&bar[XB_TOPGEN]) == tg, bar);
            __builtin_amdgcn_fence(__ATOMIC_ACQUIRE, "agent");
            xb_add(&bar[XB_XGEN(b.x)], 1u);
            asm volatile("s_waitcnt vmcnt(0)" ::: "memory");
        } else {
            XB_SPIN(xb_ld(&bar[XB_XGEN(b.x)]) == gen, bar);
            __builtin_amdgcn_fence(__ATOMIC_ACQUIRE, "agent");
            asm volatile("s_waitcnt vmcnt(0)" ::: "memory");
        }
    }
    __syncthreads();
}
struct Params { const void* in[33]; float* out; unsigned char* ws; int ph_lo, ph_hi; };
struct Frame { LAS unsigned char* lds; int tid, lane, wave, G, gw, ngw; };
#define INF(i) ((const float*)P.in[i])
constexpr int LDS_BYTES = 147456;
constexpr int RING_BYTES = 131072, MISC_OFF = LDS_BYTES - 128;

DI void dsincos(double r, double& s, double& c) {
    const double r2 = r * r; double ss = 1.0, cc = 1.0;
#pragma unroll
    for (int n = 16; n >= 1; --n) { ss = 1.0 - r2 * (1.0 / (double)((2 * n) * (2 * n + 1))) * ss; cc = 1.0 - r2 * (1.0 / (double)((2 * n - 1) * (2 * n))) * cc; }
    s = r * ss; c = cc;
}
DI void p0_rope(const Params& P, const Frame& F) {
    f32x2* tab = (f32x2*)(P.ws + WS_ROPE);
    for (int idx = blockIdx.x * 512 + F.tid; idx < 4100 * 32; idx += F.G * 512) {
        const int pi = idx >> 5, i = idx & 31; const int pos = pi < 4096 ? pi : 8192 + (pi - 4096);
        const float inv = exp2f(-(float)i * 0.41524101186092029f);
        const float ang = (float)pos * inv;
        const double a = (double)ang; const double k = rint(a * 0.15915494309189535); const double r = fma(-k, 6.283185307179586, a);
        double s, c; dsincos(r, s, c);
        tab[idx] = (f32x2){(float)c, (float)s};
    }
}
struct ColRef { const float* p; int ld, klo, khi; };
DI int perm64(int p) { return 32 * ((p >> 4) & 1) + 16 * (p >> 5) + (p & 15); }
DI int logical_col(int n) { return (n & ~63) + perm64(n & 63); }
template <class Src> DI void tr_item(const Src& S, int K, int nphys, bf16* WT, LAS float* scr, int item, int lane, const float* gain = nullptr) {
    const int nblk = nphys / 32, kb = item / nblk, nb = item % nblk, k0 = 64 * kb, n0 = 32 * nb;
    const int kr = lane >> 3, q = lane & 7;
    const ColRef cr = S.col(n0 + 4 * q);
    f32x4 v[8];
#pragma unroll
    for (int i = 0; i < 8; ++i) { const int k = k0 + 8 * i + kr; v[i] = (f32x4){0.f, 0.f, 0.f, 0.f};
        if (k >= cr.klo && k < cr.khi) v[i] = *(const f32x4*)(cr.p + (size_t)(k - cr.klo) * cr.ld);
        if (gain) v[i] *= gain[k]; }
#pragma unroll
    for (int i = 0; i < 8; ++i) *(LAS f32x4*)(scr + (8 * i + kr) * 36 + 4 * q) = v[i];
    LDS_WAIT(); asm volatile("" ::: "memory");
    const int c = lane & 7;
#pragma unroll
    for (int j = 0; j < 4; ++j) { const int n = (lane >> 3) + 8 * j; const LAS float* s = scr + (8 * c) * 36 + n;
        v4u o; o.x = pk2(s[0 * 36], s[1 * 36]); o.y = pk2(s[2 * 36], s[3 * 36]); o.z = pk2(s[4 * 36], s[5 * 36]); o.w = pk2(s[6 * 36], s[7 * 36]);
        *(v4u*)(WT + (size_t)(n0 + n) * K + k0 + 8 * c) = o; }
    LDS_WAIT(); asm volatile("" ::: "memory");
}
struct SrcPlain { const float* W; int ld, ncols;
    DI ColRef col(int n) const { const int l = logical_col(n); ColRef r; r.p = W + (l < ncols ? l : 0); r.ld = ld; r.klo = 0; r.khi = (l < ncols) ? (1 << 30) : 0; return r; } };
struct SrcGate { const float* W;
    DI ColRef col(int n) const { const int l = logical_col(n); const bool ok = l < 16 || (l >= 32 && l < 40); const int c = l < 16 ? l : l - 16; ColRef r; r.p = W + (ok ? c : 0); r.ld = 3096; r.klo = 0; r.khi = ok ? (1 << 30) : 0; return r; } };
struct SrcGU { const float* Wg; const float* Wu;
    DI ColRef col(int n) const { const int l = logical_col(n), hd = l >> 6, d = l & 63; ColRef r; const uintptr_t a_ = (uintptr_t)Wg, b_ = (uintptr_t)Wu, m_ = (uintptr_t)0 - (uintptr_t)(d >= 32); r.p = (const float*)(a_ ^ ((a_ ^ b_) & m_)) + 32 * hd + (d & 31); r.ld = FF; r.klo = 0; r.khi = 1 << 30; return r; } };
struct SrcLora { const float* wu; const float* au; const float* gu;
    DI ColRef col(int n) const { const int l = logical_col(n), reg = l >> 9, c = l & 511; ColRef r; r.ld = 512;
        if (reg == 0) { r.p = wu + c; r.klo = 0; r.khi = 64; } else if (reg == 1) { r.p = au + c; r.klo = 64; r.khi = 128; } else { r.p = gu + c; r.klo = 128; r.khi = 256; } return r; } };
struct SrcCmp { const float* w1;
    DI ColRef col(int n) const { const int l = logical_col(n), kind = l >> 7, ab = (l >> 6) & 1, e = l & 63; ColRef r; r.p = w1 + (size_t)((kind * 32 + ab * 16) * 64) * 64 + e; r.ld = 64; r.klo = 0; r.khi = 1 << 30; return r; } };

constexpr int WI_IN0 = 16 * 96, WI_G0 = 16 * 1, WI_O = 16 * 32, WI_GU = 16 * 176, WI_DN = 44 * 32, WI_IN1 = 16 * 48, WI_LORA = 4 * 48, WI_CMP = 16 * 8;
constexpr int WI_EARLY = WI_IN0 + WI_G0, WI_ALL = WI_EARLY + 2 * WI_O + 2 * WI_GU + 2 * WI_DN + WI_IN1 + WI_LORA + WI_CMP;
constexpr int WI_L1 = WI_O + WI_GU + WI_DN + WI_IN1, WI_L0 = WI_ALL - WI_L1;
constexpr int WO_O0 = WI_EARLY, WO_O1 = WO_O0 + WI_O, WO_GU0 = WO_O1 + WI_O, WO_GU1 = WO_GU0 + WI_GU, WO_DN0 = WO_GU1 + WI_GU, WO_DN1 = WO_DN0 + WI_DN, WO_IN1 = WO_DN1 + WI_DN, WO_LORA = WO_IN1 + WI_IN1;
DI int wi_l0(int i) { if (i < WI_EARLY + WI_O) return i; i -= WI_EARLY + WI_O; if (i < WI_GU) return WO_GU0 + i; i -= WI_GU; if (i < WI_DN) return WO_DN0 + i; i -= WI_DN; return WO_LORA + i; }
DI int wi_l1(int i) { if (i < WI_O) return WO_O1 + i; i -= WI_O; if (i < WI_GU) return WO_GU1 + i; i -= WI_GU; if (i < WI_DN) return WO_DN1 + i; i -= WI_DN; return WO_IN1 + i; }
DI void weight_item(const Params& P, LAS float* scr, int it, int lane) {
    unsigned char* ws = P.ws; int r = it;
    if (r < WI_IN0) { tr_item(SrcPlain{INF(11), 3096, 3072}, 1024, 3072, (bf16*)(ws + WS_WIN0), scr, r, lane); return; } r -= WI_IN0;
    if (r < WI_G0)  { tr_item(SrcGate{INF(11) + 3072}, 1024, 32, (bf16*)(ws + WS_WG0), scr, r, lane); return; } r -= WI_G0;
    if (r < WI_O)   { tr_item(SrcPlain{INF(12), 1024, 1024}, 1024, 1024, (bf16*)(ws + WS_WOUT0), scr, r, lane); return; } r -= WI_O;
    if (r < WI_O)   { tr_item(SrcPlain{INF(29), 1024, 1024}, 1024, 1024, (bf16*)(ws + WS_WOUT1), scr, r, lane); return; } r -= WI_O;
    if (r < WI_GU)  { tr_item(SrcGU{INF(30), INF(31)}, 1024, 5632, (bf16*)(ws + WS_WGU0), scr, r, lane, INF(9)); return; } r -= WI_GU;
    if (r < WI_GU)  { tr_item(SrcGU{INF(30) + (size_t)1024 * FF, INF(31) + (size_t)1024 * FF}, 1024, 5632, (bf16*)(ws + WS_WGU1), scr, r, lane, INF(9) + D); return; } r -= WI_GU;
    if (r < WI_DN)  { tr_item(SrcPlain{INF(32), 1024, 1024}, FF, 1024, (bf16*)(ws + WS_WDN0), scr, r, lane); return; } r -= WI_DN;
    if (r < WI_DN)  { tr_item(SrcPlain{INF(32) + (size_t)FF * 1024, 1024, 1024}, FF, 1024, (bf16*)(ws + WS_WDN1), scr, r, lane); return; } r -= WI_DN;
    if (r < WI_IN1) { tr_item(SrcPlain{INF(28), 1536, 1536}, 1024, 1536, (bf16*)(ws + WS_WIN1), scr, r, lane, INF(8) + D); return; } r -= WI_IN1;
    if (r < WI_LORA){ tr_item(SrcLora{INF(15), INF(17), INF(18)}, 256, 1536, (bf16*)(ws + WS_WLORA), scr, r, lane); return; } r -= WI_LORA;
    tr_item(SrcCmp{INF(25)}, 1024, 256, (bf16*)(ws + WS_WCMP), scr, r, lane);
}
DI void st_bf16x4(bf16* p, f32x4 v) { *(v2u*)p = (v2u){pk2(v.x, v.y), pk2(v.z, v.w)}; }
DI void norm_rows2_bf16(const float* x0, const float* x1, const float* gain, bf16* o0, bf16* o1, int lane_in) {
    int lane = lane_in; asm volatile("" : "+v"(lane));
    f32x4 v[2][4]; float ss0 = 0.f, ss1 = 0.f;
#pragma unroll
    for (int i = 0; i < 4; ++i) { v[0][i] = *(const f32x4*)(x0 + 256 * i + 4 * lane); v[1][i] = *(const f32x4*)(x1 + 256 * i + 4 * lane); }
#pragma unroll
    for (int i = 0; i < 4; ++i) { ss0 += (v[0][i].x * v[0][i].x + v[0][i].y * v[0][i].y) + (v[0][i].z * v[0][i].z + v[0][i].w * v[0][i].w); ss1 += (v[1][i].x * v[1][i].x + v[1][i].y * v[1][i].y) + (v[1][i].z * v[1][i].z + v[1][i].w * v[1][i].w); }
    const float rs0 = 1.0f / sqrtf(wave_sum(ss0) * (1.0f / 1024.0f) + 1e-6f), rs1 = 1.0f / sqrtf(wave_sum(ss1) * (1.0f / 1024.0f) + 1e-6f);
#pragma unroll
    for (int i = 0; i < 4; ++i) { const f32x4 g = *(const f32x4*)(gain + 256 * i + 4 * lane); st_bf16x4(o0 + 256 * i + 4 * lane, v[0][i] * rs0 * g); st_bf16x4(o1 + 256 * i + 4 * lane, v[1][i] * rs1 * g); }
}
DI void norm_phase(const Frame& F, const float* src0, const float* src1, const float* gain, bf16* XN) {
    for (int m = 2 * F.gw; m < MP + MS; m += 2 * F.ngw) { const float* xr = m < MP ? src0 + (size_t)m * D : src1 + (size_t)(m - MP) * D; norm_rows2_bf16(xr, xr + D, gain, XN + (size_t)m * D, XN + (size_t)(m + 1) * D, F.lane); }
}
DI void prep_conv_unit(const Params& P, const Frame& F, int u) {
    const int* ptab = (const int*)P.in[7]; const float* cache = INF(2); bf16* A = (bf16*)(P.ws + WS_ACMPS);
    const int kind = F.lane >> 5, g = (F.lane >> 4) & 1, d = (F.lane & 15) * 4;
    for (int i8 = 0; i8 < 8; ++i8) { const int it0 = u * 1024 + F.wave * 128 + i8 * 16; f32x4 v[16];
#pragma unroll
        for (int j = 0; j < 16; ++j) { const int it = it0 + j, bs = it >> 13, t = it & 8191; const int page = ptab[bs * NPG + (t >> 7)];
            v[j] = *(const f32x4*)(cache + ((size_t)page * PAGE + (t & 127)) * 512 + 4 * F.lane); }
#pragma unroll
        for (int j = 0; j < 16; ++j) { const int it = it0 + j, bs = it >> 13, t = it & 8191;
            *(v2u*)(A + ((((size_t)kind * NSQ + bs) * 2 + g) * PAST + t) * 64 + d) = (v2u){pk2(v[j].x, v[j].y), pk2(v[j].z, v[j].w)}; } }
}
DI void prep_means_unit(const Params& P, const Frame& F, int it) {
    const int* ptab = (const int*)P.in[7]; const float* cache = INF(3); float* MEANS = (float*)(P.ws + WS_MEANS); LAS f32x4* red = (LAS f32x4*)F.lds;
    const int bs = it >> 5, nb = it & 31;
    const int page = ptab[bs * NPG + 2 * nb + (F.wave >> 2)], tok0 = (F.wave & 3) * 32;
    const float* src = cache + ((size_t)page * PAGE + tok0) * 512 + 4 * F.lane;
    f32x4 acc = {0.f, 0.f, 0.f, 0.f};
#pragma unroll
    for (int i = 0; i < 32; ++i) acc += *(const f32x4*)(src + (size_t)i * 512);
    red[F.wave * 64 + F.lane] = acc;
    __syncthreads();
    if (F.wave == 0) { f32x4 s = red[F.lane];
#pragma unroll
        for (int w = 1; w < 8; ++w) s += red[w * 64 + F.lane];
        s *= (1.0f / 256.0f);
        *(f32x4*)(MEANS + (((size_t)bs * 4 + (F.lane >> 4)) * 32 + nb) * 64 + (F.lane & 15) * 4) = s; }
    __syncthreads();
}
DI void p0_wincopy(const Params& P, const Frame& F) {
    const f32x4* src = (const f32x4*)INF(4); f32x4* dst = (f32x4*)(P.out + O_WINS);
    for (int i = blockIdx.x * 512 + F.tid; i < NSQ * 508 * 64; i += F.G * 512) { const int bs = i / (508 * 64), r = i % (508 * 64); dst[(size_t)bs * 512 * 64 + r] = src[(size_t)bs * 512 * 64 + 4 * 64 + r]; }
}

template <class Fn> struct EpiHead {
    static constexpr bool PERM = false, AFTER_DRAIN = false;
    Fn f;
    DI void operator()(const f32x4 (&acc)[2][2][4][2], const pg8::Unit& u, int wr, int wc, int fr, int fq) const {
#pragma unroll
        for (int ai = 0; ai < 2; ++ai)
#pragma unroll
            for (int m = 0; m < 4; ++m) { const int row = u.pm * 256 + ai * 128 + wr * 64 + m * 16 + fr;
#pragma unroll
                for (int bj = 0; bj < 2; ++bj) f(row, u.pn * 4 + bj * 2 + (wc >> 1), 16 * (wc & 1) + 4 * fq, acc[ai][bj][m][0], acc[ai][bj][m][1]); }
    }
};
template <class Fn> DI void skinny_unit(LAS unsigned char* lds, const bf16* A, const bf16* Bt, int K, int row0, int col0, const Fn& f, int wave, int lane_in) {
    int lane = lane_in; asm volatile("" : "+v"(lane));
    const int fr = lane & 15, fq = lane >> 4, kw = K >> 3, nk = kw >> 5;
    const bf16* ap = A + (size_t)(row0 + fr) * K + wave * kw + 8 * fq;
    const bf16* bp = Bt + (size_t)(col0 + fr) * K + wave * kw + 8 * fq;
    f32x4 acc[8][2];
#pragma unroll
    for (int rb = 0; rb < 8; ++rb) { acc[rb][0] = (f32x4){0.f, 0.f, 0.f, 0.f}; acc[rb][1] = (f32x4){0.f, 0.f, 0.f, 0.f}; }
    bf16x8 a0[8], b0[2], a1[8], b1[2], a2[8], b2[2];
#define SK_LOAD(AA, BB, ks) do { _Pragma("unroll") for (int rb = 0; rb < 8; ++rb) AA[rb] = *(const bf16x8*)(ap + (size_t)rb * 16 * K + 32 * (ks)); BB[0] = *(const bf16x8*)(bp + 32 * (ks)); BB[1] = *(const bf16x8*)(bp + (size_t)16 * K + 32 * (ks)); } while (0)
#define SK_MMA(AA, BB) do { _Pragma("unroll") for (int rb = 0; rb < 8; ++rb) { acc[rb][0] = __builtin_amdgcn_mfma_f32_16x16x32_bf16(BB[0], AA[rb], acc[rb][0], 0, 0, 0); acc[rb][1] = __builtin_amdgcn_mfma_f32_16x16x32_bf16(BB[1], AA[rb], acc[rb][1], 0, 0, 0); } } while (0)
    SK_LOAD(a0, b0, 0); if (nk > 1) SK_LOAD(a1, b1, 1);
    for (int ks = 0; ks < nk; ks += 3) {
        if (ks + 2 < nk) SK_LOAD(a2, b2, ks + 2);
        SK_MMA(a0, b0);
        if (ks + 1 < nk) { if (ks + 3 < nk) SK_LOAD(a0, b0, ks + 3); SK_MMA(a1, b1); }
        if (ks + 2 < nk) { if (ks + 4 < nk) SK_LOAD(a1, b1, ks + 4); SK_MMA(a2, b2); }
    }
#undef SK_LOAD
#undef SK_MMA
    LAS float* red = (LAS float*)lds;
#pragma unroll
    for (int rb = 0; rb < 8; ++rb) { *(LAS f32x4*)(red + (wave * 128 + 16 * rb + fr) * 32 + 4 * fq) = acc[rb][0]; *(LAS f32x4*)(red + (wave * 128 + 16 * rb + fr) * 32 + 16 + 4 * fq) = acc[rb][1]; }
    __syncthreads();
    f32x4 lo = {0.f, 0.f, 0.f, 0.f}, hi = {0.f, 0.f, 0.f, 0.f};
#pragma unroll
    for (int w = 0; w < 8; ++w) { lo += *(const LAS f32x4*)(red + (w * 128 + 16 * wave + fr) * 32 + 4 * fq); hi += *(const LAS f32x4*)(red + (w * 128 + 16 * wave + fr) * 32 + 16 + 4 * fq); }
    f(row0 + 16 * wave + fr, col0 >> 6, 16 * ((col0 >> 5) & 1) + 4 * fq, lo, hi);
    __syncthreads();
}

struct EpiIn0 {
    bf16* RW; bf16* Q0; bf16* KV0; bf16* KVS0; const f32x2* rope; float* out;
    DI void operator()(int row, int head, int d4, f32x4 lo, f32x4 hi) const {
        if (row >= MP + MS) return;
        const bool samp = row >= MP; const int sr = row - MP;
        const int b = samp ? (sr >> 2) : (row >> 12), t = samp ? (sr & 3) : (row & 4095), ridx = samp ? 4096 + t : t;
        if (head < 28) {
            bf16* p = RW + (size_t)row * RWC + head * 64 + d4; st_bf16x4(p, lo); st_bf16x4(p + 32, hi);
            const bool last = samp ? (t == 3) : (t == SEQ - 1);
            if (last) { float* o = out + (samp ? O_SHS : O_SHP) + (size_t)b * RWC + head * 64 + d4; *(f32x4*)o = lo; *(f32x4*)(o + 32) = hi; }
            return;
        }
        const bool isq = head < 36; const int idx = head - 36; const int which = idx >> 2, kvsel = (idx >> 1) & 1, g = idx & 1;
        if (isq || kvsel == 0) {
            const f32x2* cs = rope + (size_t)ridx * 32 + d4; const f32x4 a = *(const f32x4*)cs, c2 = *(const f32x4*)(cs + 2);
            const f32x4 co = {a.x, a.z, c2.x, c2.z}, si = {a.y, a.w, c2.y, c2.w};
            const f32x4 x1 = lo, x2 = hi; lo = x1 * co - x2 * si; hi = x2 * co + x1 * si;
        }
        if (isq) { bf16* p = Q0 + (size_t)row * 512 + (head - 28) * 64 + d4; st_bf16x4(p, lo * ATT_SC); st_bf16x4(p + 32, hi * ATT_SC); return; }
        const int k6 = which * 2 + kvsel;
        bf16* p = samp ? KVS0 + ((((size_t)k6 * NSQ + b) * 2 + g) * 4 + t) * 64 + d4 : KV0 + ((((size_t)k6 * NB + b) * 2 + g) * SEQ + t) * 64 + d4;
        st_bf16x4(p, lo); st_bf16x4(p + 32, hi);
        if (which < 2) { float* o = out + (samp ? O_NSAS + (((size_t)sr * 4 + k6) * 2 + g) * 64 : O_NSAP + (((size_t)row * 4 + k6) * 2 + g) * 64) + d4; *(f32x4*)o = lo; *(f32x4*)(o + 32) = hi; }
        else if (samp) { float* o = out + O_WINS + ((((size_t)b * 512 + 508 + t) * 2 + kvsel) * 2 + g) * 64 + d4; *(f32x4*)o = lo; *(f32x4*)(o + 32) = hi; }
        else if (t >= SEQ - 512) { float* o = out + O_WINP + ((((size_t)b * 512 + (t - (SEQ - 512))) * 2 + kvsel) * 2 + g) * 64 + d4; *(f32x4*)o = lo; *(f32x4*)(o + 32) = hi; }
    }
};
struct EpiGates { float* G; const float* bias;
    DI void operator()(int row, int head, int d4, f32x4 lo, f32x4 hi) const {
        { const f32x4 bv = *(const f32x4*)(bias + d4); f32x4 o;
          o.x = sigmoidf_(lo.x + bv.x); o.y = sigmoidf_(lo.y + bv.y); o.z = sigmoidf_(lo.z + bv.z); o.w = sigmoidf_(lo.w + bv.w);
          *(f32x4*)(G + (size_t)row * 32 + d4) = o; }
        if (d4 < 8) { const f32x4 bv = *(const f32x4*)(bias + 16 + d4); f32x4 o;
          o.x = sigmoidf_(hi.x + bv.x); o.y = sigmoidf_(hi.y + bv.y); o.z = sigmoidf_(hi.z + bv.z); o.w = sigmoidf_(hi.w + bv.w);
          *(f32x4*)(G + (size_t)row * 32 + 16 + d4) = o; } } };
struct EpiCmp { float* HC; int half_rows;
    DI void operator()(int row, int head, int d4, f32x4 lo, f32x4 hi) const {
        const int kind = row >= half_rows ? 1 : 0; if ((head >> 1) != kind) return;
        float* o = HC + (size_t)row * 128 + (head & 1) * 64 + d4; *(f32x4*)o = lo; *(f32x4*)(o + 32) = hi; } };
constexpr size_t RWKV_ARR = (size_t)MT * 512 * 4;
constexpr size_t WS_R = WS_END0, WS_K = WS_R + RWKV_ARR, WS_V = WS_K + RWKV_ARR, WS_KK = WS_V + RWKV_ARR, WS_W = WS_KK + RWKV_ARR, WS_KP = WS_W + RWKV_ARR,
                 WS_KKA = WS_KP + RWKV_ARR, WS_G = WS_KKA + RWKV_ARR, WS_Y = WS_G + RWKV_ARR;
constexpr size_t WS_LA = al(WS_Y + RWKV_ARR);
constexpr size_t WS_ATT = al(WS_LA + (size_t)MT * 256 * 2);
constexpr size_t WS_H = al(WS_ATT + (size_t)MT * 1024 * 2);
constexpr size_t WS_HFF = al(WS_H + (size_t)MT * 1024 * 4);
constexpr size_t WS_END1 = al(WS_HFF + (size_t)MT * FF * 2);

DI float red8(float v) {
    v += __builtin_bit_cast(float, __builtin_amdgcn_update_dpp(0, __builtin_bit_cast(int, v), 0xB1, 0xf, 0xf, false));
    v += __builtin_bit_cast(float, __builtin_amdgcn_update_dpp(0, __builtin_bit_cast(int, v), 0x4E, 0xf, 0xf, false));
    v += __builtin_bit_cast(float, __builtin_amdgcn_update_dpp(0, __builtin_bit_cast(int, v), 0x141, 0xf, 0xf, false));
    return v;
}
DI void ld_bf8(const bf16* p, float (&o)[8]) { const v4u u = *(const v4u*)p; o[0] = bflo(u.x); o[1] = bfhi(u.x); o[2] = bflo(u.y); o[3] = bfhi(u.y); o[4] = bflo(u.z); o[5] = bfhi(u.z); o[6] = bflo(u.w); o[7] = bfhi(u.w); }
DI void ld_f8(const float* p, float (&o)[8]) { const f32x4 a = *(const f32x4*)p, b = *(const f32x4*)(p + 4); o[0] = a.x; o[1] = a.y; o[2] = a.z; o[3] = a.w; o[4] = b.x; o[5] = b.y; o[6] = b.z; o[7] = b.w; }
DI f32x4 ld_bf4(const bf16* p) { const v2u u = *(const v2u*)p; return (f32x4){bflo(u.x), bfhi(u.x), bflo(u.y), bfhi(u.y)}; }
DI void st_bf8(bf16* p, const float (&o)[8]) { *(v4u*)p = (v4u){pk2(o[0], o[1]), pk2(o[2], o[3]), pk2(o[4], o[5]), pk2(o[6], o[7])}; }
DI void st_f8(float* p, const float (&o)[8]) { *(f32x4*)p = (f32x4){o[0], o[1], o[2], o[3]}; *(f32x4*)(p + 4) = (f32x4){o[4], o[5], o[6], o[7]}; }

DI void rwkv_prep(const Params& P, const Frame& F, int skip_blocks) {
    unsigned char* ws = P.ws; const bf16* RW = (const bf16*)(ws + WS_RW);
    const float* mu = INF(13); const float* k_k = INF(19); const float* sshift = INF(6);
    bf16* R_ = (bf16*)(ws + WS_R); bf16* K_ = (bf16*)(ws + WS_K); bf16* V_ = (bf16*)(ws + WS_V); bf16* KK_ = (bf16*)(ws + WS_KK); bf16* LA = (bf16*)(ws + WS_LA);
    const int lane = F.lane;
    if ((int)blockIdx.x < skip_blocks) return;
    for (int row = F.gw - skip_blocks * NWAVES; row < MP + MS; row += F.ngw - skip_blocks * NWAVES) {
        const bool samp = row >= MP; const int t = samp ? ((row - MP) & 3) : (row & 4095); const int bs = (row - MP) >> 2;
        const bf16* cur = RW + (size_t)row * RWC; const bf16* prv = cur - RWC;
#pragma unroll
        for (int part = 0; part < 3; ++part) {
            const int c = part * 512 + 8 * lane; float x[8], p[8], m[8];
            ld_bf8(cur + c, x); ld_f8(mu + c, m);
            if (t > 0) ld_bf8(prv + c, p); else if (samp) ld_f8(sshift + (size_t)bs * RWC + c, p); else {
#pragma unroll
                for (int e = 0; e < 8; ++e) p[e] = 0.f; }
#pragma unroll
            for (int e = 0; e < 8; ++e) x[e] = x[e] + (p[e] - x[e]) * m[e];
            bf16* dst = (part == 0 ? R_ : part == 1 ? K_ : V_) + (size_t)row * 512 + 8 * lane;
            st_bf8(dst, x);
            if (part == 1) { float kc[8], q[8]; ld_f8(k_k + 8 * lane, kc); float ss = 0.f;
#pragma unroll
                for (int e = 0; e < 8; ++e) { q[e] = x[e] * kc[e]; ss += q[e] * q[e]; }
                ss = red8(ss); const float inv = 1.0f / fmaxf(sqrtf(ss), 1e-12f);
#pragma unroll
                for (int e = 0; e < 8; ++e) q[e] *= inv;
                st_bf8(KK_ + (size_t)row * 512 + 8 * lane, q); }
        }
        { const int c = 1536 + 4 * lane; const v2u uc = *(const v2u*)(cur + c); float x[4] = {bflo(uc.x), bfhi(uc.x), bflo(uc.y), bfhi(uc.y)}, p[4];
          const f32x4 m = *(const f32x4*)(mu + c);
          if (t > 0) { const v2u up = *(const v2u*)(prv + c); p[0] = bflo(up.x); p[1] = bfhi(up.x); p[2] = bflo(up.y); p[3] = bfhi(up.y); }
          else if (samp) { const f32x4 s4 = *(const f32x4*)(sshift + (size_t)bs * RWC + c); p[0] = s4.x; p[1] = s4.y; p[2] = s4.z; p[3] = s4.w; }
          else { p[0] = p[1] = p[2] = p[3] = 0.f; }
          x[0] += (p[0] - x[0]) * m.x; x[1] += (p[1] - x[1]) * m.y; x[2] += (p[2] - x[2]) * m.z; x[3] += (p[3] - x[3]) * m.w;
          const int reg = lane >> 4;
#pragma unroll
          for (int e = 0; e < 4; ++e) { if (reg == 0) x[e] = 1.0f - 2.0f / (__expf(2.0f * x[e]) + 1.0f); else if (reg >= 2) x[e] = sigmoidf_(x[e]); }
          *(v2u*)(LA + (size_t)row * 256 + 4 * lane) = (v2u){pk2(x[0], x[1]), pk2(x[2], x[3])}; }
    }
}
struct EpiLora {
    const float* w0; const float* a0; const float* k_a; const bf16* K_; const bf16* KK_; float* W_; bf16* KP_; bf16* KKA_; bf16* G_;
    DI void operator()(int row, int head, int d4, f32x4 lo, f32x4 hi) const {
        if (row >= MP + MS) return;
        const int reg = head >> 3, c0 = (head & 7) * 64 + d4;
#pragma unroll
        for (int hh = 0; hh < 2; ++hh) { const int c = c0 + 32 * hh; const f32x4 x = hh ? hi : lo; const size_t o = (size_t)row * 512 + c;
            if (reg == 0) { const f32x4 b = *(const f32x4*)(w0 + c); f32x4 r;
                r.x = -0.6065306597126334f * sigmoidf_(b.x + x.x); r.y = -0.6065306597126334f * sigmoidf_(b.y + x.y);
                r.z = -0.6065306597126334f * sigmoidf_(b.z + x.z); r.w = -0.6065306597126334f * sigmoidf_(b.w + x.w); *(f32x4*)(W_ + o) = r; }
            else if (reg == 1) { const f32x4 b = *(const f32x4*)(a0 + c), ka = *(const f32x4*)(k_a + c); const v2u ku = *(const v2u*)(K_ + o), kku = *(const v2u*)(KK_ + o);
                const f32x4 k = {bflo(ku.x), bfhi(ku.x), bflo(ku.y), bfhi(ku.y)}, kk = {bflo(kku.x), bfhi(kku.x), bflo(kku.y), bfhi(kku.y)}; f32x4 a;
                a.x = sigmoidf_(b.x + x.x); a.y = sigmoidf_(b.y + x.y); a.z = sigmoidf_(b.z + x.z); a.w = sigmoidf_(b.w + x.w);
                st_bf16x4(KP_ + o, k * (1.0f + (a - 1.0f) * ka)); st_bf16x4(KKA_ + o, kk * a); }
            else { st_bf16x4(G_ + o, x); } }
    }
};
constexpr int SC_CH = 32, SC_STEP = 384;
DI void scan_chain(const Params& P, const Frame& F, int row0, int h, int ihalf, int nsteps, const float* S0, float* Sout) {
    unsigned char* ws = P.ws;
    const float* a0p = (const float*)(ws + WS_W); const bf16* a1p = (const bf16*)(ws + WS_KK); const bf16* a2p = (const bf16*)(ws + WS_KKA);
    const bf16* a3p = (const bf16*)(ws + WS_KP); const bf16* a4p = (const bf16*)(ws + WS_R); const bf16* a5p = (const bf16*)(ws + WS_V);
    float* Y_ = (float*)(ws + WS_Y);
    LAS float* buf = (LAS float*)F.lds;
    LAS float* ybuf = (LAS float*)(F.lds + 2 * SC_CH * SC_STEP * 4);
    const int lane = F.lane, il = 8 * (F.wave & 3) + (lane >> 3), i = 32 * ihalf + il, j0 = 8 * (lane & 7); const bool comp = F.wave < 4;
    f32x2 S[4];
    if (S0) { const f32x4 a = *(const f32x4*)(S0 + i * 64 + j0), b = *(const f32x4*)(S0 + i * 64 + j0 + 4); S[0] = (f32x2){a.x, a.y}; S[1] = (f32x2){a.z, a.w}; S[2] = (f32x2){b.x, b.y}; S[3] = (f32x2){b.z, b.w}; }
    else { S[0] = S[1] = S[2] = S[3] = (f32x2){0.f, 0.f}; }
    f32x4 st0, st1, st2, st3, st4, st5;
    const int lstep = F.tid >> 4, lc4 = (F.tid & 15) * 4;
    const size_t goff = (size_t)(row0 + lstep) * 512 + h * 64 + lc4;
#define SC_GLOAD(step0) do { const bool ok_ = (step0) + lstep < nsteps; const size_t o_ = goff + (size_t)(step0) * 512; const f32x4 z_ = {0.f, 0.f, 0.f, 0.f}; \
        st0 = ok_ ? *(const f32x4*)(a0p + o_) : z_; st0.x = __expf(st0.x); st0.y = __expf(st0.y); st0.z = __expf(st0.z); st0.w = __expf(st0.w); \
        st1 = ok_ ? ld_bf4(a1p + o_) : z_; st2 = ok_ ? ld_bf4(a2p + o_) : z_; st3 = ok_ ? ld_bf4(a3p + o_) : z_; st4 = ok_ ? ld_bf4(a4p + o_) : z_; st5 = ok_ ? ld_bf4(a5p + o_) : z_; } while (0)
#define SC_LSTORE(bi) do { LAS float* d_ = buf + (bi) * SC_CH * SC_STEP + lstep * SC_STEP + lc4; \
        *(LAS f32x4*)(d_) = st0; *(LAS f32x4*)(d_ + 64) = st1; *(LAS f32x4*)(d_ + 128) = st2; *(LAS f32x4*)(d_ + 192) = st3; *(LAS f32x4*)(d_ + 256) = st4; *(LAS f32x4*)(d_ + 320) = st5; } while (0)
    SC_GLOAD(0); SC_LSTORE(0); __syncthreads();
    const int nch = (nsteps + SC_CH - 1) / SC_CH;
    for (int ch = 0; ch < nch; ++ch) {
        const int bi = ch & 1; if (ch + 1 < nch) SC_GLOAD((ch + 1) * SC_CH);
        const LAS float* cb = buf + bi * SC_CH * SC_STEP;
        const int rem = nsteps - ch * SC_CH, ns = rem < SC_CH ? rem : SC_CH;
        if (comp) {
            f32x4 w0, w1, k0, k1, a0, a1, p0, p1, r0, r1; float vi;
#define SC_LD(s_) do { const LAS float* sb_ = cb + (s_) * SC_STEP; w0 = *(const LAS f32x4*)(sb_ + j0); w1 = *(const LAS f32x4*)(sb_ + j0 + 4); k0 = *(const LAS f32x4*)(sb_ + 64 + j0); k1 = *(const LAS f32x4*)(sb_ + 64 + j0 + 4); \
                a0 = *(const LAS f32x4*)(sb_ + 128 + j0); a1 = *(const LAS f32x4*)(sb_ + 128 + j0 + 4); p0 = *(const LAS f32x4*)(sb_ + 192 + j0); p1 = *(const LAS f32x4*)(sb_ + 192 + j0 + 4); \
                r0 = *(const LAS f32x4*)(sb_ + 256 + j0); r1 = *(const LAS f32x4*)(sb_ + 256 + j0 + 4); vi = sb_[320 + i]; } while (0)
            SC_LD(0);
            for (int s = 0; s < ns; ++s) {
                const f32x4 cw0 = w0, cw1 = w1, ck0 = k0, ck1 = k1, ca0 = a0, ca1 = a1, cp0 = p0, cp1 = p1, cr0 = r0, cr1 = r1; const float cvi = vi;
                SC_LD(s + 1 < SC_CH ? s + 1 : s);
                f32x2 d2 = S[0] * (f32x2){ck0.x, ck0.y}; d2 = __builtin_elementwise_fma(S[1], (f32x2){ck0.z, ck0.w}, d2); f32x2 e2 = S[2] * (f32x2){ck1.x, ck1.y}; e2 = __builtin_elementwise_fma(S[3], (f32x2){ck1.z, ck1.w}, e2);
                d2 += e2; float sk = red8(d2.x + d2.y);
                const f32x2 vv = {cvi, cvi}, nsk = {-sk, -sk};
                S[0] = __builtin_elementwise_fma(nsk, (f32x2){ca0.x, ca0.y}, __builtin_elementwise_fma(vv, (f32x2){cp0.x, cp0.y}, S[0] * (f32x2){cw0.x, cw0.y}));
                S[1] = __builtin_elementwise_fma(nsk, (f32x2){ca0.z, ca0.w}, __builtin_elementwise_fma(vv, (f32x2){cp0.z, cp0.w}, S[1] * (f32x2){cw0.z, cw0.w}));
                S[2] = __builtin_elementwise_fma(nsk, (f32x2){ca1.x, ca1.y}, __builtin_elementwise_fma(vv, (f32x2){cp1.x, cp1.y}, S[2] * (f32x2){cw1.x, cw1.y}));
                S[3] = __builtin_elementwise_fma(nsk, (f32x2){ca1.z, ca1.w}, __builtin_elementwise_fma(vv, (f32x2){cp1.z, cp1.w}, S[3] * (f32x2){cw1.z, cw1.w}));
                f32x2 y2 = S[0] * (f32x2){cr0.x, cr0.y}; y2 = __builtin_elementwise_fma(S[1], (f32x2){cr0.z, cr0.w}, y2); f32x2 z2 = S[2] * (f32x2){cr1.x, cr1.y}; z2 = __builtin_elementwise_fma(S[3], (f32x2){cr1.z, cr1.w}, z2);
                y2 += z2; const float y = red8(y2.x + y2.y);
                if ((lane & 7) == 0) ybuf[s * 32 + il] = y;
            }
#undef SC_LD
        }
        __syncthreads();
#pragma unroll
        for (int m = 0; m < 2; ++m) { const int q = F.tid + 512 * m, step = q >> 5, c = q & 31; if (step < ns) Y_[(size_t)(row0 + ch * SC_CH + step) * 512 + h * 64 + 32 * ihalf + c] = ybuf[q]; }
        if (ch + 1 < nch) SC_LSTORE(bi ^ 1);
        __syncthreads();
    }
#undef SC_GLOAD
#undef SC_LSTORE
    if (comp) { *(f32x4*)(Sout + i * 64 + j0) = (f32x4){S[0].x, S[0].y, S[1].x, S[1].y}; *(f32x4*)(Sout + i * 64 + j0 + 4) = (f32x4){S[2].x, S[2].y, S[3].x, S[3].y}; }
}
DI void scan_sample_wave(const Params& P, int wid, int lane_in) {
    int lane = lane_in; asm volatile("" : "+v"(lane));
    unsigned char* ws = P.ws; const int c = wid >> 3, rg = wid & 7, h = c & 7, row0 = MP + (c >> 3) * 4, i = 8 * rg + (lane >> 3), j0 = 8 * (lane & 7);
    const float* LW = (const float*)(ws + WS_W); const bf16* KK = (const bf16*)(ws + WS_KK); const bf16* KKA = (const bf16*)(ws + WS_KKA); const bf16* KP = (const bf16*)(ws + WS_KP);
    const bf16* RR = (const bf16*)(ws + WS_R); const bf16* VV = (const bf16*)(ws + WS_V); float* Y_ = (float*)(ws + WS_Y);
    float S[8]; ld_f8(INF(5) + (size_t)c * 4096 + i * 64 + j0, S);
    float w[4][8], kk[4][8], ka[4][8], kp[4][8], r[4][8], vi[4];
#pragma unroll
    for (int st = 0; st < 4; ++st) { const size_t o = (size_t)(row0 + st) * 512 + h * 64; ld_f8(LW + o + j0, w[st]); ld_bf8(KK + o + j0, kk[st]); ld_bf8(KKA + o + j0, ka[st]); ld_bf8(KP + o + j0, kp[st]); ld_bf8(RR + o + j0, r[st]); vi[st] = bf2f(VV[o + i]); }
#pragma unroll
    for (int st = 0; st < 4; ++st) { float sk = 0.f;
#pragma unroll
        for (int e = 0; e < 8; ++e) sk += S[e] * kk[st][e];
        sk = red8(sk); float y = 0.f;
#pragma unroll
        for (int e = 0; e < 8; ++e) { S[e] = S[e] * __expf(w[st][e]) + vi[st] * kp[st][e] - sk * ka[st][e]; y += S[e] * r[st][e]; }
        y = red8(y);
        if ((lane & 7) == 0) Y_[(size_t)(row0 + st) * 512 + h * 64 + i] = y; }
    st_f8(P.out + O_WKVS + (size_t)c * 4096 + i * 64 + j0, S);
}
template <int NR, bool YLDS> DI void rwkv_post_rows(const Params& P, int row0, int rstride, int lane_in, const LAS float* ylds, int yrow0) {
    int lane = lane_in; asm volatile("" : "+v"(lane));
    unsigned char* ws = P.ws; const float* r_k = INF(21); const float* ln_g = INF(22); const float* ln_b = INF(23);
    const bf16* R_ = (const bf16*)(ws + WS_R); const bf16* KP_ = (const bf16*)(ws + WS_KP); const bf16* V_ = (const bf16*)(ws + WS_V); const bf16* G_ = (const bf16*)(ws + WS_G); const float* Y_ = (const float*)(ws + WS_Y);
    bf16* ATT = (bf16*)(ws + WS_ATT); const int c = 8 * lane;
    float rk[8], lg[8], lb[8]; ld_f8(r_k + c, rk); ld_f8(ln_g + c, lg); ld_f8(ln_b + c, lb);
    float y[NR][8]; v4u ru[NR], ku[NR], vu[NR], gu[NR];
#pragma unroll
    for (int q = 0; q < NR; ++q) { const size_t o = (size_t)(row0 + q * rstride) * 512 + c;
        if (YLDS) { const f32x4 a = *(const LAS f32x4*)(ylds + (yrow0 + q * rstride) * 512 + c), b2 = *(const LAS f32x4*)(ylds + (yrow0 + q * rstride) * 512 + c + 4); y[q][0] = a.x; y[q][1] = a.y; y[q][2] = a.z; y[q][3] = a.w; y[q][4] = b2.x; y[q][5] = b2.y; y[q][6] = b2.z; y[q][7] = b2.w; }
        else ld_f8(Y_ + o, y[q]); ru[q] = *(const v4u*)(R_ + o); ku[q] = *(const v4u*)(KP_ + o); vu[q] = *(const v4u*)(V_ + o); gu[q] = *(const v4u*)(G_ + o); }
#pragma unroll
    for (int q = 0; q < NR; ++q) {
        float r[8] = {bflo(ru[q].x), bfhi(ru[q].x), bflo(ru[q].y), bfhi(ru[q].y), bflo(ru[q].z), bfhi(ru[q].z), bflo(ru[q].w), bfhi(ru[q].w)};
        float k[8] = {bflo(ku[q].x), bfhi(ku[q].x), bflo(ku[q].y), bfhi(ku[q].y), bflo(ku[q].z), bfhi(ku[q].z), bflo(ku[q].w), bfhi(ku[q].w)};
        float v[8] = {bflo(vu[q].x), bfhi(vu[q].x), bflo(vu[q].y), bfhi(vu[q].y), bflo(vu[q].z), bfhi(vu[q].z), bflo(vu[q].w), bfhi(vu[q].w)};
        float g[8] = {bflo(gu[q].x), bfhi(gu[q].x), bflo(gu[q].y), bfhi(gu[q].y), bflo(gu[q].z), bfhi(gu[q].z), bflo(gu[q].w), bfhi(gu[q].w)};
        float s = 0.f, bs = 0.f;
#pragma unroll
        for (int e = 0; e < 8; ++e) { s += y[q][e]; bs += r[e] * k[e] * rk[e]; }
        s = red8(s); bs = red8(bs); const float mean = s * (1.0f / 64.0f); float qq = 0.f;
#pragma unroll
        for (int e = 0; e < 8; ++e) { y[q][e] -= mean; qq += y[q][e] * y[q][e]; }
        qq = red8(qq); const float rstd = 1.0f / sqrtf(qq * (1.0f / 64.0f) + 64e-5f);
        float o8[8];
#pragma unroll
        for (int e = 0; e < 8; ++e) o8[e] = (y[q][e] * rstd * lg[e] + lb[e] + bs * v[e]) * g[e];
        *(v4u*)(ATT + (size_t)(row0 + q * rstride) * 1024 + c) = (v4u){pk2(o8[0], o8[1]), pk2(o8[2], o8[3]), pk2(o8[4], o8[5]), pk2(o8[6], o8[7])}; }
}
DI void rwkv_post(const Params& P, const Frame& F) {
    unsigned char* ws = P.ws; const float* r_k = INF(21); const float* ln_g = INF(22); const float* ln_b = INF(23);
    const bf16* R_ = (const bf16*)(ws + WS_R); const bf16* KP_ = (const bf16*)(ws + WS_KP); const bf16* V_ = (const bf16*)(ws + WS_V); const bf16* G_ = (const bf16*)(ws + WS_G); const float* Y_ = (const float*)(ws + WS_Y);
    bf16* ATT = (bf16*)(ws + WS_ATT); const int lane = F.lane, c = 8 * lane;
    float rk[8], lg[8], lb[8]; ld_f8(r_k + c, rk); ld_f8(ln_g + c, lg); ld_f8(ln_b + c, lb);
    for (int row = F.gw; row < MP + MS; row += F.ngw) { const size_t o = (size_t)row * 512 + c;
        float y[8], r[8], k[8], v[8], g[8]; ld_f8(Y_ + o, y); ld_bf8(R_ + o, r); ld_bf8(KP_ + o, k); ld_bf8(V_ + o, v); ld_bf8(G_ + o, g);
        float s = 0.f, bs = 0.f;
#pragma unroll
        for (int e = 0; e < 8; ++e) { s += y[e]; bs += r[e] * k[e] * rk[e]; }
        s = red8(s); bs = red8(bs); const float mean = s * (1.0f / 64.0f); float q = 0.f;
#pragma unroll
        for (int e = 0; e < 8; ++e) { y[e] -= mean; q += y[e] * y[e]; }
        q = red8(q); const float rstd = 1.0f / sqrtf(q * (1.0f / 64.0f) + 64e-5f);
        float o8[8];
#pragma unroll
        for (int e = 0; e < 8; ++e) o8[e] = (y[e] * rstd * lg[e] + lb[e] + bs * v[e]) * g[e];
        *(v4u*)(ATT + (size_t)row * 1024 + c) = (v4u){pk2(o8[0], o8[1]), pk2(o8[2], o8[3]), pk2(o8[4], o8[5]), pk2(o8[6], o8[7])};
    }
}
typedef short v4i16_t __attribute__((ext_vector_type(4)));
DI int crow(int r, int hi) { return (r & 3) + 8 * (r >> 2) + 4 * hi; }
DI float half_max(float v) { auto rr = __builtin_amdgcn_permlane32_swap(__float_as_uint(v), __float_as_uint(v), false, false); return fmaxf(__uint_as_float(rr[0]), __uint_as_float(rr[1])); }
DI float half_sum(float v) { auto rr = __builtin_amdgcn_permlane32_swap(__float_as_uint(v), __float_as_uint(v), false, false); return __uint_as_float(rr[0]) + __uint_as_float(rr[1]); }
DI s16x4 vtr(const LAS unsigned char* p) { return __builtin_bit_cast(s16x4, __builtin_amdgcn_ds_read_tr16_b64_v4i16((LAS v4i16_t*)p)); }
#define MFMA32(a, b, c) __builtin_amdgcn_mfma_f32_32x32x16_bf16((a), (b), (c), 0, 0, 0)
struct AttnAcc { f32x16 o0, o1; float m, l; };
DI void acc_init(AttnAcc& A) {
#pragma unroll
    for (int i = 0; i < 16; ++i) { A.o0[i] = 0.f; A.o1[i] = 0.f; }
    A.m = 0.f; A.l = 0.f; }
DI void ld_q(const bf16* qrow, bf16x8 (&qr)[4], int hi) {
#pragma unroll
    for (int d0 = 0; d0 < 4; ++d0) qr[d0] = *(const bf16x8*)(qrow + 16 * d0 + 8 * hi); }
DI void qk_tile(const LAS unsigned char* Kt, const bf16x8 (&qr)[4], f32x16& p0, f32x16& p1, int lane, float init = 0.f) {
    const LAS unsigned char* kb = Kt + (lane >> 5) * 1024 + (lane & 31) * 16;
#pragma unroll
    for (int i = 0; i < 16; ++i) { p0[i] = init; p1[i] = init; }
#pragma unroll
    for (int d0 = 0; d0 < 4; ++d0) { const bf16x8 b0 = *(const LAS bf16x8*)(kb + d0 * 2048), b1 = *(const LAS bf16x8*)(kb + d0 * 2048 + 512);
        p0 = MFMA32(b0, qr[d0], p0); p1 = MFMA32(b1, qr[d0], p1); }
}
DI float max3f(float a, float b, float c) { float r; asm("v_max3_f32 %0, %1, %2, %3" : "=v"(r) : "v"(a), "v"(b), "v"(c)); return r; }
DI bf16x8 pack8(const f32x16& p, int s) { v4u u; u.x = pk2(p[8 * s], p[8 * s + 1]); u.y = pk2(p[8 * s + 2], p[8 * s + 3]); u.z = pk2(p[8 * s + 4], p[8 * s + 5]); u.w = pk2(p[8 * s + 6], p[8 * s + 7]); return __builtin_bit_cast(bf16x8, u); }
DI void pv_tile(const LAS unsigned char* Vt, const f32x16& p0, const f32x16& p1, f32x16& o0, f32x16& o1, int lane) {
    const int hi = lane >> 5;
    const LAS unsigned char* vp = Vt + ((lane >> 4) & 1) * 32 + (lane & 3) * 8 + (4 * hi + ((lane & 15) >> 2)) * 64;
#pragma unroll
    for (int cc = 0; cc < 2; ++cc)
#pragma unroll
        for (int s = 0; s < 2; ++s) { const int ks = 2 * cc + s; const bf16x8 pb = pack8(cc ? p1 : p0, s);
#pragma unroll
            for (int d0 = 0; d0 < 2; ++d0) { const s16x4 lo = vtr(vp + d0 * 4096 + ks * 1024), h4 = vtr(vp + d0 * 4096 + ks * 1024 + 512);
                const bf16x8 a = {lo[0], lo[1], lo[2], lo[3], h4[0], h4[1], h4[2], h4[3]};
                if (d0 == 0) o0 = MFMA32(a, pb, o0); else o1 = MFMA32(a, pb, o1); } }
}
template <int MODE> DI void mask_scale(f32x16& p0, f32x16& p1, bool rowok, int a, int hi) {
#pragma unroll
    for (int i = 0; i < 16; ++i) { const int k0 = crow(i, hi), k1 = k0 + 32;
        bool v0 = rowok, v1 = rowok;
        if (MODE == 1) { v0 = v0 && (k0 <= a); v1 = v1 && (k1 <= a); }
        if (MODE == 2) { v0 = v0 && (k0 > a); v1 = v1 && (k1 > a); }
        p0[i] = v0 ? p0[i] : -INFINITY; p1[i] = v1 ? p1[i] : -INFINITY; }
}
template <int MODE> DI void attn_tile(const LAS unsigned char* Kt, const LAS unsigned char* Vt, const bf16x8 (&qr)[4], AttnAcc& A, bool rowok, int a, int lane) {
    f32x16 p0, p1; qk_tile(Kt, qr, p0, p1, lane, rowok ? -A.m : -INFINITY);
    const int hi = lane >> 5;
    if (MODE != 0) {
#pragma unroll
        for (int i = 0; i < 16; ++i) { const int k0 = crow(i, hi), k1 = k0 + 32; const bool v0 = MODE == 1 ? (k0 <= a) : (k0 > a), v1 = MODE == 1 ? (k1 <= a) : (k1 > a);
            p0[i] = v0 ? p0[i] : -INFINITY; p1[i] = v1 ? p1[i] : -INFINITY; } }
    float mx = max3f(p0[0], p0[1], p1[0]); mx = max3f(mx, p1[1], p0[2]);
#pragma unroll
    for (int i = 2; i < 16; i += 2) mx = max3f(mx, max3f(p0[i], p0[i + 1], p1[i]), p1[i + 1]);
    mx = half_max(mx);
    if (__any(mx > 8.0f)) {
        const float dl = mx > 8.0f ? mx : 0.f, alpha = __builtin_amdgcn_exp2f(-dl);
        A.m += dl; A.l *= alpha;
#pragma unroll
        for (int i = 0; i < 16; ++i) { A.o0[i] *= alpha; A.o1[i] *= alpha; p0[i] -= dl; p1[i] -= dl; } }
    float ls = 0.f;
#pragma unroll
    for (int i = 0; i < 16; ++i) { p0[i] = __builtin_amdgcn_exp2f(p0[i]); p1[i] = __builtin_amdgcn_exp2f(p1[i]); ls += p0[i] + p1[i]; }
    A.l += ls;
    pv_tile(Vt, p0, p1, A.o0, A.o1, lane);
}
DI void mask_rt(f32x16& p0, f32x16& p1, int mode, int a, int hi) {
    if (mode != 0) {
#pragma unroll
        for (int i = 0; i < 16; ++i) { const int k0 = crow(i, hi), k1 = k0 + 32; const bool v0 = mode == 1 ? (k0 <= a) : (k0 > a), v1 = mode == 1 ? (k1 <= a) : (k1 > a);
            p0[i] = v0 ? p0[i] : -INFINITY; p1[i] = v1 ? p1[i] : -INFINITY; } }
}
DI void attn_tile2(const LAS unsigned char* Ka, const LAS unsigned char* Va, const LAS unsigned char* Kb, const LAS unsigned char* Vb, const bf16x8 (&qr)[4], AttnAcc& A,
                   bool ok_a, int mode_a, int a_a, bool ok_b, int mode_b, int a_b, int lane) {
    f32x16 p0, p1, p2, p3; qk_tile(Ka, qr, p0, p1, lane, ok_a ? -A.m : -INFINITY); qk_tile(Kb, qr, p2, p3, lane, ok_b ? -A.m : -INFINITY);
    const int hi = lane >> 5;
    mask_rt(p0, p1, mode_a, a_a, hi); mask_rt(p2, p3, mode_b, a_b, hi);
    float mx = max3f(p0[0], p1[0], p2[0]); mx = fmaxf(mx, p3[0]);
#pragma unroll
    for (int i = 1; i < 16; ++i) mx = max3f(mx, max3f(p0[i], p1[i], p2[i]), p3[i]);
    mx = half_max(mx);
    if (__any(mx > 8.0f)) {
        const float dl = mx > 8.0f ? mx : 0.f, alpha = __builtin_amdgcn_exp2f(-dl);
        A.m += dl; A.l *= alpha;
#pragma unroll
        for (int i = 0; i < 16; ++i) { A.o0[i] *= alpha; A.o1[i] *= alpha; p0[i] -= dl; p1[i] -= dl; p2[i] -= dl; p3[i] -= dl; } }
    float ls = 0.f;
#pragma unroll
    for (int i = 0; i < 16; ++i) { p0[i] = __builtin_amdgcn_exp2f(p0[i]); p1[i] = __builtin_amdgcn_exp2f(p1[i]); p2[i] = __builtin_amdgcn_exp2f(p2[i]); p3[i] = __builtin_amdgcn_exp2f(p3[i]); ls += (p0[i] + p1[i]) + (p2[i] + p3[i]); }
    A.l += ls;
    pv_tile(Va, p0, p1, A.o0, A.o1, lane); pv_tile(Vb, p2, p3, A.o0, A.o1, lane);
}
struct TileRegs { v4u k, v; };
DI void tile_gload(TileRegs& R, const bf16* Kt, const bf16* Vt, int wave, int lane) {
    R.k = *(const v4u*)(Kt + (size_t)lane * 64 + wave * 8);
    R.v = *(const v4u*)(Vt + (size_t)(16 * (wave & 3) + (lane >> 2)) * 64 + 32 * (wave >> 2) + 8 * (lane & 3));
}
DI void tile_lstore(const TileRegs& R, LAS unsigned char* kb, LAS unsigned char* vb, int wave, int lane) {
    *(LAS v4u*)(kb + wave * 1024 + lane * 16) = R.k; *(LAS v4u*)(vb + wave * 1024 + lane * 16) = R.v; }
DI void branch_out(f32x16& out0, f32x16& out1, const AttnAcc& A, float gate) {
    const float lt = half_sum(A.l); const float sc = gate / fmaxf(lt, 1e-30f);
#pragma unroll
    for (int i = 0; i < 16; ++i) { out0[i] += A.o0[i] * sc; out1[i] += A.o1[i] * sc; }
}
template <bool FIRST> DI void branch_out_lds(LAS float* ob, const AttnAcc& A, float gate) {
    const float lt = half_sum(A.l); const float sc = gate / fmaxf(lt, 1e-30f);
#pragma unroll
    for (int i = 0; i < 16; ++i) { if (FIRST) { ob[i] = A.o0[i] * sc; ob[16 + i] = A.o1[i] * sc; } else { ob[i] += A.o0[i] * sc; ob[16 + i] += A.o1[i] * sc; } }
}
DI void store_ot(bf16* dst, const f32x16& o0, const f32x16& o1, int hi) {
#pragma unroll
    for (int gi = 0; gi < 4; ++gi) { *(v2u*)(dst + 8 * gi + 4 * hi) = (v2u){pk2(o0[4 * gi], o0[4 * gi + 1]), pk2(o0[4 * gi + 2], o0[4 * gi + 3])};
        *(v2u*)(dst + 32 + 8 * gi + 4 * hi) = (v2u){pk2(o1[4 * gi], o1[4 * gi + 1]), pk2(o1[4 * gi + 2], o1[4 * gi + 3])}; }
}
constexpr size_t WS_BIASC = WS_END1;
constexpr size_t WS_KCP = al(WS_BIASC + 2 * 64 * 4);
constexpr size_t WS_KCS = al(WS_KCP + (size_t)2 * 8 * 256 * 64 * 2);
constexpr size_t WS_END2 = al(WS_KCS + (size_t)2 * 64 * 512 * 64 * 2);

DI void p0_cmp_bias(const Params& P, const Frame& F) {
    const float* pe = INF(26); const float* w1 = INF(25); float* B = (float*)(P.ws + WS_BIASC);
    for (int it = F.gw; it < 128; it += F.ngw) { const int kind = it >> 6, e = it & 63; float s = 0.f;
        for (int i = 0; i < 32; ++i) { const int idx = F.lane + 64 * i; s += pe[kind * 2048 + idx] * w1[((size_t)kind * 2048 + idx) * 64 + e]; }
        s = wave_sum(s); if (F.lane == 0) B[it] = s; }
}
DI float gelu_tanh(float x) { const float u = 0.7978845608028654f * (x + 0.044715f * x * x * x); const float t = 1.0f - 2.0f / (__expf(2.0f * u) + 1.0f); return 0.5f * x * (1.0f + t); }
DI void cmp_stage2(const Params& P, const Frame& F) {
    unsigned char* ws = P.ws; LAS bf16* w2t = (LAS bf16*)F.lds;
    for (int i = F.tid; i < 2 * 64 * 64; i += 512) { const int kind = i >> 12, e = (i >> 6) & 63, f = i & 63; w2t[(kind * 64 + f) * 64 + e] = (bf16)(pk2(INF(27)[i], 0.f) & 0xffffu); }
    __syncthreads();
    const float* bias = (const float*)(ws + WS_BIASC); const float* HCP = (const float*)(ws + WS_HCP); const float* HCS = (const float*)(ws + WS_HCS);
    bf16* KCP = (bf16*)(ws + WS_KCP); bf16* KCS = (bf16*)(ws + WS_KCS); int lane_ = F.lane; asm volatile("" : "+v"(lane_)); const int lane = lane_, r32 = lane & 31, hi = lane >> 5;
    for (int tile = F.gw; tile < (4096 + 65536) / 32; tile += F.ngw) {
        const bool samp = tile >= 128; const int r0 = (samp ? tile - 128 : tile) * 32; const int half = samp ? 32768 : 2048, nn = samp ? 512 : 256;
        const int kind = r0 >= half ? 1 : 0, r = r0 + r32, n = r & (nn - 1); const float* HC = samp ? HCS : HCP; bf16* dst = (samp ? KCS : KCP) + (size_t)r0 * 64;
        const bool zrow = (n == nn - 1); const float* pa = HC + (size_t)r * 128 + 8 * hi; const float* pb = HC + (size_t)(zrow ? r : r + 1) * 128 + 64 + 8 * hi; const float* bp = bias + kind * 64 + 8 * hi;
        bf16x8 af[4];
#pragma unroll
        for (int ks = 0; ks < 4; ++ks) { if (ks == 2) asm volatile("" ::: "memory"); float x[8], y[8], z[8]; ld_f8(pa + 16 * ks, x); ld_f8(pb + 16 * ks, y); ld_f8(bp + 16 * ks, z);
#pragma unroll
            for (int j = 0; j < 8; ++j) x[j] = gelu_tanh(x[j] + y[j] + z[j]);
            af[ks] = __builtin_bit_cast(bf16x8, (v4u){pk2(x[0], x[1]), pk2(x[2], x[3]), pk2(x[4], x[5]), pk2(x[6], x[7])}); }
#pragma unroll
        for (int cb = 0; cb < 2; ++cb) { f32x16 acc;
#pragma unroll
            for (int i = 0; i < 16; ++i) acc[i] = 0.f;
#pragma unroll
            for (int ks = 0; ks < 4; ++ks) acc = MFMA32(af[ks], *(const LAS bf16x8*)(w2t + (kind * 64 + 32 * cb + r32) * 64 + 16 * ks + 8 * hi), acc);
#pragma unroll
            for (int i = 0; i < 16; ++i) { const int rw = crow(i, hi); const bool zr = ((r0 + rw) & (nn - 1)) == nn - 1; dst[(size_t)rw * 64 + 32 * cb + r32] = zr ? (bf16)0 : (bf16)(pk2(acc[i], 0.f) & 0xffffu); } }
    }
}
struct TileRegs2 { TileRegs a, b; };
DI void kv_prefetch(TileRegs2& R, int jb, int je, const bf16* KB, const bf16* VB, int wave, int lane) {
    tile_gload(R.a, KB + (size_t)jb * 4096, VB + (size_t)jb * 4096, wave, lane);
    if (jb + 1 <= je) tile_gload(R.b, KB + (size_t)(jb + 1) * 4096, VB + (size_t)(jb + 1) * 4096, wave, lane);
}
template <class Body> DI void kv_loop(TileRegs2& R, int& cur, LAS unsigned char* kvb, int jb, int je, const bf16* KB, const bf16* VB, int wave, int lane, Body&& body, bool pre = false) {
    if (!pre) kv_prefetch(R, jb, je, KB, VB, wave, lane);
    tile_lstore(R.a, kvb + (2 * cur) * 16384, kvb + (2 * cur) * 16384 + 8192, wave, lane);
    if (jb + 1 <= je) tile_lstore(R.b, kvb + (2 * cur + 1) * 16384, kvb + (2 * cur + 1) * 16384 + 8192, wave, lane);
    __syncthreads();
    for (int j = jb; j <= je; j += 2) {
        const bool n0 = j + 2 <= je, n1 = j + 3 <= je;
        if (n0) tile_gload(R.a, KB + (size_t)(j + 2) * 4096, VB + (size_t)(j + 2) * 4096, wave, lane);
        if (n1) tile_gload(R.b, KB + (size_t)(j + 3) * 4096, VB + (size_t)(j + 3) * 4096, wave, lane);
        { const LAS unsigned char* Kt_ = kvb + (2 * cur) * 16384; body(j, Kt_, Kt_ + 8192); }
        if (j + 1 <= je) { const LAS unsigned char* Kt_ = kvb + (2 * cur + 1) * 16384; body(j + 1, Kt_, Kt_ + 8192); }
        if (n0) tile_lstore(R.a, kvb + (2 * (cur ^ 1)) * 16384, kvb + (2 * (cur ^ 1)) * 16384 + 8192, wave, lane);
        if (n1) tile_lstore(R.b, kvb + (2 * (cur ^ 1) + 1) * 16384, kvb + (2 * (cur ^ 1) + 1) * 16384 + 8192, wave, lane);
        __syncthreads(); cur ^= 1; }
}
template <class Body2> DI void kv_loop2(TileRegs2& R, int& cur, LAS unsigned char* kvb, int jb, int je, const bf16* KB, const bf16* VB, int wave, int lane, Body2&& body2, bool pre = false) {
    if (!pre) kv_prefetch(R, jb, je, KB, VB, wave, lane);
    tile_lstore(R.a, kvb + (2 * cur) * 16384, kvb + (2 * cur) * 16384 + 8192, wave, lane);
    if (jb + 1 <= je) tile_lstore(R.b, kvb + (2 * cur + 1) * 16384, kvb + (2 * cur + 1) * 16384 + 8192, wave, lane);
    __syncthreads();
    for (int j = jb; j <= je; j += 2) {
        const bool n0 = j + 2 <= je, n1 = j + 3 <= je;
        if (n0) tile_gload(R.a, KB + (size_t)(j + 2) * 4096, VB + (size_t)(j + 2) * 4096, wave, lane);
        if (n1) tile_gload(R.b, KB + (size_t)(j + 3) * 4096, VB + (size_t)(j + 3) * 4096, wave, lane);
        { const LAS unsigned char* Ka_ = kvb + (2 * cur) * 16384; body2(j, Ka_, Ka_ + 8192, Ka_ + 16384, Ka_ + 16384 + 8192, j + 1 <= je); }
        if (n0) tile_lstore(R.a, kvb + (2 * (cur ^ 1)) * 16384, kvb + (2 * (cur ^ 1)) * 16384 + 8192, wave, lane);
        if (n1) tile_lstore(R.b, kvb + (2 * (cur ^ 1) + 1) * 16384, kvb + (2 * (cur ^ 1) + 1) * 16384 + 8192, wave, lane);
        __syncthreads(); cur ^= 1; }
}
constexpr int NSA_KV_OFF = 0, NSA_SEL_OFF = 65536, NSA_OUT_OFF = NSA_SEL_OFF + 512, NSA_IMP_OFF = NSA_OUT_OFF;
DI void nsa_prompt_unit(const Params& P, const Frame& F, int b, int g, int qb) {
    unsigned char* ws = P.ws; int lane_ = F.lane; asm volatile("" : "+v"(lane_));
    const int lane = lane_, wave = F.wave, r32 = lane & 31, hi = lane >> 5;
    const int tl = 8 * wave + (r32 >> 2), hh = r32 & 3, t0 = 64 * qb, tok = t0 + tl, row = b * SEQ + tok, head = g * 4 + hh;
    LAS unsigned char* kvb = F.lds + NSA_KV_OFF;
    LAS float* impM = (LAS float*)(F.lds + NSA_IMP_OFF); LAS float* impS = impM + 64 * 65;
    LAS unsigned long long* selm = (LAS unsigned long long*)(F.lds + NSA_SEL_OFF);
    bf16x8 qr[4]; ld_q((const bf16*)(ws + WS_Q0) + (size_t)row * 512 + head * 64, qr, hi);
    const float* gt = (const float*)(ws + WS_GATES) + (size_t)row * 32 + head * 3; const float g0 = gt[0], g1 = gt[1], g2 = gt[2];
    const bf16* KV0 = (const bf16*)(ws + WS_KV0);
    LAS float* outb = (LAS float*)(F.lds + NSA_OUT_OFF) + (wave * 64 + lane) * 33;
    TileRegs2 R; int cur = 0;
    const int ncv = tok >= 31 ? ((tok - 15) >> 4) : 0, ntc = (4 * qb + 66) >> 6;
    const bf16* KC = (const bf16*)(ws + WS_KCP) + (size_t)((0 * 4 + b) * 2 + g) * 256 * 64; const bf16* VC = (const bf16*)(ws + WS_KCP) + (size_t)((1 * 4 + b) * 2 + g) * 256 * 64;
    AttnAcc A; acc_init(A);
    kv_loop(R, cur, kvb, 0, ntc - 1, KC, VC, wave, lane, [&](int j, const LAS unsigned char* Kt_, const LAS unsigned char* Vt_) { attn_tile<1>(Kt_, Vt_, qr, A, true, ncv - 1 - 64 * j, lane); });
    {
      const float lt = half_sum(A.l), rl = 1.0f / fmaxf(lt, 1e-30f), mfin = (A.m == -INFINITY) ? 0.f : A.m;
      for (int i = lane; i < 8 * 65; i += 64) { impM[wave * 8 * 65 + i] = 0.f; impS[wave * 8 * 65 + i] = 0.f; }
      kv_loop(R, cur, kvb, 0, ntc - 1, KC, VC, wave, lane, [&](int j, const LAS unsigned char* Kt_, const LAS unsigned char* Vt_) {
          f32x16 p0, p1; qk_tile(Kt_, qr, p0, p1, lane); mask_scale<1>(p0, p1, true, ncv - 1 - 64 * j, hi);
#pragma unroll
          for (int cc = 0; cc < 2; ++cc)
#pragma unroll
              for (int gi = 0; gi < 4; ++gi) { const f32x16& p = cc ? p1 : p0;
                  const float e0 = __builtin_amdgcn_exp2f(p[4 * gi] - mfin) * rl, e1 = __builtin_amdgcn_exp2f(p[4 * gi + 1] - mfin) * rl, e2 = __builtin_amdgcn_exp2f(p[4 * gi + 2] - mfin) * rl, e3 = __builtin_amdgcn_exp2f(p[4 * gi + 3] - mfin) * rl;
                  float mn = e0 + e1 + e2 + 0.5f * e3, sp = 0.5f * e3;
                  mn += __builtin_bit_cast(float, __builtin_amdgcn_update_dpp(0, __builtin_bit_cast(int, mn), 0xB1, 0xf, 0xf, false)); mn += __builtin_bit_cast(float, __builtin_amdgcn_update_dpp(0, __builtin_bit_cast(int, mn), 0x4E, 0xf, 0xf, false));
                  sp += __builtin_bit_cast(float, __builtin_amdgcn_update_dpp(0, __builtin_bit_cast(int, sp), 0xB1, 0xf, 0xf, false)); sp += __builtin_bit_cast(float, __builtin_amdgcn_update_dpp(0, __builtin_bit_cast(int, sp), 0x4E, 0xf, 0xf, false));
                  const int jj = 16 * j + 8 * cc + 2 * gi + hi;
                  if (hh == 0) { impM[tl * 65 + jj] = mn; impS[tl * 65 + jj + 1] = sp; } } });
    }
    const bf16* KS = KV0 + (size_t)((2 * 4 + b) * 2 + g) * SEQ * 64; const bf16* VS = KV0 + (size_t)((3 * 4 + b) * 2 + g) * SEQ * 64;
    kv_prefetch(R, 0, qb, KS, VS, wave, lane);
    {
#pragma unroll 1
      for (int tt = 0; tt < 8; ++tt) { const int tq = 8 * wave + tt;
          float sc = -INFINITY;
          if (lane <= qb) { sc = impM[tq * 65 + lane] + impS[tq * 65 + lane]; if (lane == qb || lane == qb - 1 || lane == 0) sc += 100.0f; }
          int cnt = 0; int ln = lane; asm volatile("" : "+v"(ln));
#pragma unroll
          for (int jp = 0; jp < 64; ++jp) { const float o = __builtin_bit_cast(float, __builtin_amdgcn_readlane(__builtin_bit_cast(int, sc), jp)); cnt += (o > sc || (o == sc && jp < ln)) ? 1 : 0; }
          const unsigned long long m = __ballot(lane <= qb && cnt < 16);
          if (lane == 0) selm[tq] = m; }
    }
    __syncthreads();
    branch_out_lds<true>(outb, A, g0);
    const unsigned long long mysel = selm[tl];
    { acc_init(A);
      kv_loop2(R, cur, kvb, 0, qb, KS, VS, wave, lane, [&](int j, const LAS unsigned char* Ka_, const LAS unsigned char* Va_, const LAS unsigned char* Kb_, const LAS unsigned char* Vb_, bool has_b) {
          const bool oka = (mysel >> j) & 1ull, okb = (mysel >> (j + 1)) & 1ull;
          if (has_b) attn_tile2(Ka_, Va_, Kb_, Vb_, qr, A, oka, 0, 0, okb, (j + 1 == qb) ? 1 : 0, tl, lane);
          else attn_tile<1>(Ka_, Va_, qr, A, oka, tl, lane); }, true);
      branch_out_lds<false>(outb, A, g1); }
    { const bf16* KW = KV0 + (size_t)((4 * 4 + b) * 2 + g) * SEQ * 64; const bf16* VW = KV0 + (size_t)((5 * 4 + b) * 2 + g) * SEQ * 64;
      acc_init(A); const int jlo = qb >= 8 ? qb - 8 : 0;
      kv_loop2(R, cur, kvb, jlo, qb, KW, VW, wave, lane, [&](int j, const LAS unsigned char* Ka_, const LAS unsigned char* Va_, const LAS unsigned char* Kb_, const LAS unsigned char* Vb_, bool has_b) {
          const int ma = (j == qb) ? 1 : (j == qb - 8) ? 2 : 0, mb = (j + 1 == qb) ? 1 : (j + 1 == qb - 8) ? 2 : 0;
          if (has_b) attn_tile2(Ka_, Va_, Kb_, Vb_, qr, A, true, ma, tl, true, mb, tl, lane);
          else if (ma == 1) attn_tile<1>(Ka_, Va_, qr, A, true, tl, lane); else if (ma == 2) attn_tile<2>(Ka_, Va_, qr, A, true, tl, lane); else attn_tile<0>(Ka_, Va_, qr, A, true, 0, lane); });
      branch_out_lds<false>(outb, A, g2); }
    { f32x16 out0, out1;
#pragma unroll
      for (int i = 0; i < 16; ++i) { out0[i] = outb[i]; out1[i] = outb[16 + i]; }
      store_ot((bf16*)(ws + WS_ATT) + (size_t)row * 1024 + 512 + head * 64, out0, out1, hi); }
}
constexpr size_t WS_Q1 = WS_END2;
constexpr size_t WS_K1 = al(WS_Q1 + (size_t)MT * 1024 * 2);
constexpr size_t WS_V1 = al(WS_K1 + (size_t)16 * SEQ * 64 * 2);
constexpr size_t WS_K1S = al(WS_V1 + (size_t)16 * SEQ * 64 * 2);
constexpr size_t WS_V1S = al(WS_K1S + (size_t)NSQ * 4 * 4 * 64 * 2);
constexpr size_t WS_MEANH = al(WS_V1S + (size_t)NSQ * 4 * 4 * 64 * 2);
constexpr size_t WS_MEANL = al(WS_MEANH + (size_t)16 * 64 * 64 * 2);
constexpr size_t WS_SS = al(WS_MEANL + (size_t)16 * 64 * 64 * 2);
constexpr size_t WS_END3 = al(WS_SS + (size_t)4 * MT * 4);

template <bool BASE_F32> struct EpiResidN {
    static constexpr bool PERM = false, AFTER_DRAIN = false;
    const void* base; bf16* Hb; float* ss;
    DI void operator()(const f32x4 (&acc)[2][2][4][2], const pg8::Unit& u, int wr, int wc, int fr, int fq) const {
#pragma unroll
        for (int ai = 0; ai < 2; ++ai)
#pragma unroll
            for (int m = 0; m < 4; ++m) { const int row = u.pm * 256 + ai * 128 + wr * 64 + m * 16 + fr; float sq = 0.f;
#pragma unroll
                for (int bj = 0; bj < 2; ++bj) { const int c = (u.pn * 4 + bj * 2 + (wc >> 1)) * 64 + 16 * (wc & 1) + 4 * fq; const size_t o = (size_t)row * D + c;
                    f32x4 b0, b1;
                    if (BASE_F32) { b0 = *(const f32x4*)((const float*)base + o); b1 = *(const f32x4*)((const float*)base + o + 32); }
                    else { b0 = ld_bf4((const bf16*)base + o); b1 = ld_bf4((const bf16*)base + o + 32); }
                    const f32x4 h0 = b0 + acc[ai][bj][m][0], h1 = b1 + acc[ai][bj][m][1];
                    st_bf16x4(Hb + o, h0); st_bf16x4(Hb + o + 32, h1);
                    sq += (h0.x * h0.x + h0.y * h0.y) + (h0.z * h0.z + h0.w * h0.w) + (h1.x * h1.x + h1.y * h1.y) + (h1.z * h1.z + h1.w * h1.w); }
                sq += __shfl_xor(sq, 16); sq += __shfl_xor(sq, 32);
                if (fq == 0) atomicAdd(ss + row, sq); }
    }
};
template <bool BASE_F32> struct EpiResidNS { const void* base1; bf16* Hb; float* ss;
    DI void operator()(int row, int head, int d4, f32x4 lo, f32x4 hi) const {
        const int c = head * 64 + d4; const size_t o = (size_t)row * D + c, ob = (size_t)(row - MP) * D + c; f32x4 b0, b1;
        if (BASE_F32) { b0 = *(const f32x4*)((const float*)base1 + ob); b1 = *(const f32x4*)((const float*)base1 + ob + 32); }
        else { b0 = ld_bf4((const bf16*)base1 + ob); b1 = ld_bf4((const bf16*)base1 + ob + 32); }
        const f32x4 h0 = b0 + lo, h1 = b1 + hi; st_bf16x4(Hb + o, h0); st_bf16x4(Hb + o + 32, h1);
        atomicAdd(ss + row, (h0.x * h0.x + h0.y * h0.y) + (h0.z * h0.z + h0.w * h0.w) + (h1.x * h1.x + h1.y * h1.y) + (h1.z * h1.z + h1.w * h1.w)); } };
template <class Fn> struct RowScaled { Fn f; const float* ss;
    DI void operator()(int row, int head, int d4, f32x4 lo, f32x4 hi) const { const float rs = __builtin_amdgcn_rsqf(ss[row] * (1.0f / 1024.0f) + 1e-6f); f(row, head, d4, lo * rs, hi * rs); } };
template <class Fn> struct EpiHeadScaled {
    static constexpr bool PERM = false, AFTER_DRAIN = false;
    Fn f; const float* ss;
    DI void operator()(const f32x4 (&acc)[2][2][4][2], const pg8::Unit& u, int wr, int wc, int fr, int fq) const {
        float rs[2][4];
#pragma unroll
        for (int ai = 0; ai < 2; ++ai)
#pragma unroll
            for (int m = 0; m < 4; ++m) rs[ai][m] = ss[u.pm * 256 + ai * 128 + wr * 64 + m * 16 + fr];
#pragma unroll
        for (int ai = 0; ai < 2; ++ai)
#pragma unroll
            for (int m = 0; m < 4; ++m) { const int row = u.pm * 256 + ai * 128 + wr * 64 + m * 16 + fr; const float r = __builtin_amdgcn_rsqf(rs[ai][m] * (1.0f / 1024.0f) + 1e-6f);
#pragma unroll
                for (int bj = 0; bj < 2; ++bj) f(row, u.pn * 4 + bj * 2 + (wc >> 1), 16 * (wc & 1) + 4 * fq, acc[ai][bj][m][0] * r, acc[ai][bj][m][1] * r); }
    }
};
struct EpiResid { const float* base0; const float* base1; float* H;
    DI void operator()(int row, int head, int d4, f32x4 lo, f32x4 hi) const {
        if (row >= MP + MS) return;
        const float* b = (row < MP ? base0 + (size_t)row * D : base1 + (size_t)(row - MP) * D) + head * 64 + d4; float* o = H + (size_t)row * D + head * 64 + d4;
        const f32x4 b0 = *(const f32x4*)b, b1 = *(const f32x4*)(b + 32); *(f32x4*)o = b0 + lo; *(f32x4*)(o + 32) = b1 + hi; } };
struct EpiSwiglu { bf16* HFF;
    DI void operator()(int row, int head, int d4, f32x4 lo, f32x4 hi) const {
        if (row >= MP + MS) return;
        f32x4 r; r.x = lo.x * sigmoidf_(lo.x) * hi.x; r.y = lo.y * sigmoidf_(lo.y) * hi.y; r.z = lo.z * sigmoidf_(lo.z) * hi.z; r.w = lo.w * sigmoidf_(lo.w) * hi.w;
        st_bf16x4(HFF + (size_t)row * FF + 32 * head + d4, r); } };
struct EpiIn1 { bf16* Q1; bf16* K1; bf16* K1S; const f32x2* rope; float* out;
    DI void operator()(int row, int head, int d4, f32x4 lo, f32x4 hi) const {
        if (row >= MP + MS) return;
        const bool samp = row >= MP; const int sr = row - MP; const int b = samp ? (sr >> 2) : (row >> 12), t = samp ? (sr & 3) : (row & 4095), ridx = samp ? 4096 + t : t;
        if (head < 20) { const f32x2* cs = rope + (size_t)ridx * 32 + d4; const f32x4 a = *(const f32x4*)cs, c2 = *(const f32x4*)(cs + 2);
            const f32x4 co = {a.x, a.z, c2.x, c2.z}, si = {a.y, a.w, c2.y, c2.w}; const f32x4 x1 = lo, x2 = hi; lo = x1 * co - x2 * si; hi = x2 * co + x1 * si; }
        if (head < 16) { bf16* p = Q1 + (size_t)row * 1024 + head * 64 + d4; st_bf16x4(p, lo * ATT_SC); st_bf16x4(p + 32, hi * ATT_SC); return; }
        const int kv = head >= 20 ? 1 : 0, kvh = (head - 16) & 3;
        bf16* p = samp ? K1S + (size_t)kv * ((WS_V1S - WS_K1S) / 2) + (((size_t)b * 4 + kvh) * 4 + t) * 64 + d4 : K1 + (size_t)kv * ((WS_V1 - WS_K1) / 2) + (((size_t)b * 4 + kvh) * SEQ + t) * 64 + d4;
        st_bf16x4(p, lo); st_bf16x4(p + 32, hi);
        float* o = out + (samp ? O_MOBS + (((size_t)sr * 2 + kv) * 4 + kvh) * 64 : O_MOBP + (((size_t)row * 2 + kv) * 4 + kvh) * 64) + d4; *(f32x4*)o = lo; *(f32x4*)(o + 32) = hi; } };
DI void final_norm(const Params& P, const Frame& F) {
    const bf16* H = (const bf16*)(P.ws + WS_H); const float* gain = INF(10); const float* ss = (const float*)(P.ws + WS_SS) + (size_t)3 * MT;
    for (int m = F.gw; m < MP + MS; m += F.ngw) { const bf16* xr = H + (size_t)m * D; float* o = P.out + (m < MP ? O_YP + (size_t)m * D : O_YS + (size_t)(m - MP) * D);
        const float rs = 1.0f / sqrtf(ss[m] * (1.0f / 1024.0f) + 1e-6f);
#pragma unroll
        for (int i = 0; i < 4; ++i) { const f32x4 v = ld_bf4(xr + 256 * i + 4 * F.lane), g = *(const f32x4*)(gain + 256 * i + 4 * F.lane); *(f32x4*)(o + 256 * i + 4 * F.lane) = v * rs * g; } }
}
DI void moba_means(const Params& P, const Frame& F) {
    unsigned char* ws = P.ws; const bf16* K1 = (const bf16*)(ws + WS_K1); bf16* MH = (bf16*)(ws + WS_MEANH); bf16* ML = (bf16*)(ws + WS_MEANL); const int lane = F.lane;
    for (int it = F.gw; it < 256; it += F.ngw) { const int bk = it >> 4, blk = it & 15; const bf16* src = K1 + ((size_t)bk * SEQ + blk * 256) * 64;
        float acc[8];
#pragma unroll
        for (int e = 0; e < 8; ++e) acc[e] = 0.f;
        for (int i = 0; i < 32; ++i) { float x[8]; ld_bf8(src + (size_t)(8 * i + (lane >> 3)) * 64 + (lane & 7) * 8, x);
#pragma unroll
            for (int e = 0; e < 8; ++e) acc[e] += x[e]; }
#pragma unroll
        for (int e = 0; e < 8; ++e) { acc[e] += __shfl_xor(acc[e], 8); acc[e] += __shfl_xor(acc[e], 16); acc[e] += __shfl_xor(acc[e], 32); acc[e] *= (1.0f / 256.0f); }
        if (lane < 8) { unsigned h[4], l[4];
#pragma unroll
            for (int e = 0; e < 4; ++e) { h[e] = pk2(acc[2 * e], acc[2 * e + 1]); l[e] = pk2(acc[2 * e] - bflo(h[e]), acc[2 * e + 1] - bfhi(h[e])); }
            *(v4u*)(MH + ((size_t)bk * 64 + blk) * 64 + lane * 8) = (v4u){h[0], h[1], h[2], h[3]}; *(v4u*)(ML + ((size_t)bk * 64 + blk) * 64 + lane * 8) = (v4u){l[0], l[1], l[2], l[3]}; }
    }
    for (int i = blockIdx.x * 512 + F.tid; i < 16 * 48 * 8; i += F.G * 512) { const int bk = i / (48 * 8), r = i % (48 * 8); const size_t o = ((size_t)bk * 64 + 16) * 64 + (size_t)r * 8;
        *(v4u*)(MH + o) = (v4u){0u, 0u, 0u, 0u}; *(v4u*)(ML + o) = (v4u){0u, 0u, 0u, 0u}; }
}
DI void moba_prompt_unit(const Params& P, const Frame& F, int b, int kvh, int qb) {
    unsigned char* ws = P.ws; int lane_ = F.lane; asm volatile("" : "+v"(lane_));
    const int lane = lane_, wave = F.wave, r32 = lane & 31, hi = lane >> 5;
    const int tl = 8 * wave + (r32 >> 2), hh = r32 & 3, row = b * SEQ + 64 * qb + tl, head = kvh * 4 + hh, cur = qb >> 2;
    LAS unsigned char* kvb = F.lds;
    bf16x8 qr[4]; ld_q((const bf16*)(ws + WS_Q1) + (size_t)row * 1024 + head * 64, qr, hi);
    TileRegs2 R; int cb = 0; unsigned rowmask = 1u << cur;
    const bf16* KB = (const bf16*)(ws + WS_K1) + (size_t)(b * 4 + kvh) * SEQ * 64; const bf16* VB = (const bf16*)(ws + WS_V1) + (size_t)(b * 4 + kvh) * SEQ * 64;
    kv_prefetch(R, 0, qb, KB, VB, wave, lane);
    if (cur > 0) {
        const bf16* MH = (const bf16*)(ws + WS_MEANH) + (size_t)(b * 4 + kvh) * 4096; const bf16* ML = (const bf16*)(ws + WS_MEANL) + (size_t)(b * 4 + kvh) * 4096;
        { const v4u k1 = *(const v4u*)(MH + (size_t)lane * 64 + wave * 8), k2 = *(const v4u*)(ML + (size_t)lane * 64 + wave * 8); *(LAS v4u*)(kvb + wave * 1024 + lane * 16) = k1; *(LAS v4u*)(kvb + 16384 + wave * 1024 + lane * 16) = k2; }
        __syncthreads();
        f32x16 p0, p1, q0, q1; qk_tile(kvb, qr, p0, p1, lane); qk_tile(kvb + 16384, qr, q0, q1, lane);
        float gs[16];
#pragma unroll
        for (int i = 0; i < 8; ++i) { const float v = p0[i] + q0[i]; auto rr = __builtin_amdgcn_permlane32_swap(__float_as_uint(v), __float_as_uint(v), false, false);
            gs[8 * (i >> 2) + (i & 3)] = __uint_as_float(rr[0]); gs[8 * (i >> 2) + 4 + (i & 3)] = __uint_as_float(rr[1]); }
        unsigned taken = 0;
#pragma unroll
        for (int pass = 0; pass < 3; ++pass) { float best = -INFINITY; int bi = -1;
#pragma unroll
            for (int n = 0; n < 16; ++n) { const bool c = (n < cur) && !((taken >> n) & 1u) && (gs[n] > best); best = c ? gs[n] : best; bi = c ? n : bi; }
            if (bi >= 0) taken |= 1u << bi; }
        rowmask |= taken;
        __syncthreads();
    }
    AttnAcc A; acc_init(A);
    kv_loop2(R, cb, kvb, 0, qb, KB, VB, wave, lane, [&](int j, const LAS unsigned char* Ka_, const LAS unsigned char* Va_, const LAS unsigned char* Kb_, const LAS unsigned char* Vb_, bool has_b) {
        const bool ok = (rowmask >> (j >> 2)) & 1u;
        if (has_b) attn_tile2(Ka_, Va_, Kb_, Vb_, qr, A, ok, 0, 0, ok, (j + 1 == qb) ? 1 : 0, tl, lane);
        else attn_tile<1>(Ka_, Va_, qr, A, ok, tl, lane); }, true);
    const float lt = half_sum(A.l), sc = 1.0f / fmaxf(lt, 1e-30f);
#pragma unroll
    for (int i = 0; i < 16; ++i) { A.o0[i] *= sc; A.o1[i] *= sc; }
    store_ot((bf16*)(ws + WS_ATT) + (size_t)row * 1024 + head * 64, A.o0, A.o1, hi);
}
constexpr int SM_MO = 0, SM_MM = 69632, SM_ML = 70656, SM_TAB = RING_BYTES + 1024;
DI void wave_fence() { asm volatile("s_waitcnt lgkmcnt(0)" ::: "memory"); __builtin_amdgcn_wave_barrier(); asm volatile("" ::: "memory"); }
DI void stage_row_f32(LAS unsigned char* kb, LAS unsigned char* vb, const float* kp, const float* vp, int lane) {
    { f32x4 x[16];
#pragma unroll
      for (int c = 0; c < 16; ++c) x[c] = kp ? *(const f32x4*)(kp + 4 * c) : (f32x4){0.f, 0.f, 0.f, 0.f};
#pragma unroll
      for (int c = 0; c < 8; ++c) *(LAS v4u*)(kb + c * 1024 + lane * 16) = (v4u){pk2(x[2 * c].x, x[2 * c].y), pk2(x[2 * c].z, x[2 * c].w), pk2(x[2 * c + 1].x, x[2 * c + 1].y), pk2(x[2 * c + 1].z, x[2 * c + 1].w)}; }
    asm volatile("" ::: "memory");
    { f32x4 x[16];
#pragma unroll
      for (int c = 0; c < 16; ++c) x[c] = vp ? *(const f32x4*)(vp + 4 * c) : (f32x4){0.f, 0.f, 0.f, 0.f};
#pragma unroll
      for (int c = 0; c < 8; ++c) *(LAS v4u*)(vb + (c >> 2) * 4096 + lane * 64 + (c & 3) * 16) = (v4u){pk2(x[2 * c].x, x[2 * c].y), pk2(x[2 * c].z, x[2 * c].w), pk2(x[2 * c + 1].x, x[2 * c + 1].y), pk2(x[2 * c + 1].z, x[2 * c + 1].w)}; }
}
DI void stage_row_bf16(LAS unsigned char* kb, LAS unsigned char* vb, const bf16* kp, const bf16* vp, int lane) {
#pragma unroll
    for (int c = 0; c < 8; ++c) { v4u ku = {0u, 0u, 0u, 0u}, vu = {0u, 0u, 0u, 0u};
        if (kp) ku = *(const v4u*)(kp + 8 * c);
        if (vp) vu = *(const v4u*)(vp + 8 * c);
        *(LAS v4u*)(kb + c * 1024 + lane * 16) = ku; *(LAS v4u*)(vb + (c >> 2) * 4096 + lane * 64 + (c & 3) * 16) = vu; }
}
DI void stage_tile_f32(LAS unsigned char* kb, LAS unsigned char* vb, const float* kp0, const float* vp0, size_t stride, int lane) {
    const int rsub = lane >> 4, piece = lane & 15;
#pragma unroll
    for (int hf = 0; hf < 2; ++hf) { f32x4 x[8]; asm volatile("" ::: "memory");
#pragma unroll
      for (int it = 0; it < 8; ++it) x[it] = *(const f32x4*)(kp0 + (size_t)(4 * (8 * hf + it) + rsub) * stride + 4 * piece);
#pragma unroll
      for (int it = 0; it < 8; ++it) *(LAS v2u*)(kb + (piece >> 1) * 1024 + (4 * (8 * hf + it) + rsub) * 16 + (piece & 1) * 8) = (v2u){pk2(x[it].x, x[it].y), pk2(x[it].z, x[it].w)}; }
#pragma unroll
    for (int hf = 0; hf < 2; ++hf) { f32x4 x[8]; asm volatile("" ::: "memory");
#pragma unroll
      for (int it = 0; it < 8; ++it) x[it] = *(const f32x4*)(vp0 + (size_t)(4 * (8 * hf + it) + rsub) * stride + 4 * piece);
#pragma unroll
      for (int it = 0; it < 8; ++it) *(LAS v2u*)(vb + (piece >> 3) * 4096 + (4 * (8 * hf + it) + rsub) * 64 + (piece & 7) * 8) = (v2u){pk2(x[it].x, x[it].y), pk2(x[it].z, x[it].w)}; }
}
DI void merge_waves(const Frame& F, AttnAcc& A, int lane, int wave) {
    LAS float* mo = (LAS float*)(F.lds + SM_MO); LAS float* mm = (LAS float*)(F.lds + SM_MM); LAS float* ml = (LAS float*)(F.lds + SM_ML);
    const float lt = half_sum(A.l);
    __syncthreads();
#pragma unroll
    for (int i = 0; i < 16; ++i) { mo[(wave * 64 + lane) * 33 + i] = A.o0[i]; mo[(wave * 64 + lane) * 33 + 16 + i] = A.o1[i]; }
    if (lane < 32) { mm[wave * 32 + lane] = A.m; ml[wave * 32 + lane] = lt; }
    __syncthreads();
    const int r32 = lane & 31; float M = -INFINITY;
#pragma unroll
    for (int w = 0; w < 8; ++w) M = fmaxf(M, mm[w * 32 + r32]);
    const float Mu = (M == -INFINITY) ? 0.f : M; float L = 0.f;
#pragma unroll
    for (int i = 0; i < 16; ++i) { A.o0[i] = 0.f; A.o1[i] = 0.f; }
#pragma unroll 1
    for (int w = 0; w < 8; ++w) { const float sc = __builtin_amdgcn_exp2f(mm[w * 32 + r32] - Mu); L += ml[w * 32 + r32] * sc;
#pragma unroll
        for (int i = 0; i < 16; ++i) { A.o0[i] += mo[(w * 64 + lane) * 33 + i] * sc; A.o1[i] += mo[(w * 64 + lane) * 33 + 16 + i] * sc; } }
    A.m = M; A.l = 0.5f * L;
    __syncthreads();
}
DI void nsa_sample_unit(const Params& P, const Frame& F, int bs, int g) {
    unsigned char* ws = P.ws; int lane_ = F.lane; asm volatile("" : "+v"(lane_));
    const int lane = lane_, wave = F.wave, r32 = lane & 31, hi = lane >> 5, ts = r32 >> 2, hh = r32 & 3, head = g * 4 + hh; const bool rowv = ts < 4;
    const int row = MP + bs * 4 + (ts & 3);
    LAS unsigned char* kb = F.lds + wave * 16384; LAS unsigned char* vb = kb + 8192;
    LAS float* impM = (LAS float*)(F.lds + SM_TAB); LAS float* impS = impM + 4 * 132; LAS unsigned long long* selS = (LAS unsigned long long*)(F.lds + SM_TAB + 2 * 4 * 132 * 4);
    const int* ptab = (const int*)P.in[7] + bs * NPG;
    bf16x8 qr[4]; ld_q((const bf16*)(ws + WS_Q0) + (size_t)row * 512 + head * 64, qr, hi);
    const float* gt = (const float*)(ws + WS_GATES) + (size_t)row * 32 + head * 3; const float g0 = gt[0], g1 = gt[1], g2 = gt[2];
    const bf16* KVS0 = (const bf16*)(ws + WS_KVS0);
    LAS float* outb = (LAS float*)(F.lds + SM_TAB + 4608) + lane * 33;
    const bf16* KC = (const bf16*)(ws + WS_KCS) + ((size_t)((0 * NSQ + bs) * 2 + g) * 512 + 64 * wave + lane) * 64;
    const bf16* VC = (const bf16*)(ws + WS_KCS) + ((size_t)((1 * NSQ + bs) * 2 + g) * 512 + 64 * wave + lane) * 64;
    { int tid_ = F.tid; asm volatile("" : "+v"(tid_)); for (int i = tid_; i < 2 * 4 * 132; i += 512) impM[i] = 0.f; }
    AttnAcc A; acc_init(A);
    stage_row_bf16(kb, vb, KC, VC, lane); wave_fence();
    attn_tile<1>(kb, vb, qr, A, rowv, 510 - 64 * wave, lane);
    merge_waves(F, A, lane, wave);
    if (wave == 0) branch_out_lds<true>(outb, A, g0);
    { const float lt = half_sum(A.l), rl = 1.0f / fmaxf(lt, 1e-30f), mfin = (A.m == -INFINITY) ? 0.f : A.m;
      stage_row_bf16(kb, vb, KC, nullptr, lane); wave_fence();
      f32x16 p0, p1; qk_tile(kb, qr, p0, p1, lane); mask_scale<1>(p0, p1, rowv, 510 - 64 * wave, hi);
#pragma unroll
      for (int cc = 0; cc < 2; ++cc)
#pragma unroll
          for (int gi = 0; gi < 4; ++gi) { const f32x16& p = cc ? p1 : p0;
              const float e0 = __builtin_amdgcn_exp2f(p[4 * gi] - mfin) * rl, e1 = __builtin_amdgcn_exp2f(p[4 * gi + 1] - mfin) * rl, e2 = __builtin_amdgcn_exp2f(p[4 * gi + 2] - mfin) * rl, e3 = __builtin_amdgcn_exp2f(p[4 * gi + 3] - mfin) * rl;
              float mn = e0 + e1 + e2 + 0.5f * e3, sp = 0.5f * e3;
              mn += __builtin_bit_cast(float, __builtin_amdgcn_update_dpp(0, __builtin_bit_cast(int, mn), 0xB1, 0xf, 0xf, false)); mn += __builtin_bit_cast(float, __builtin_amdgcn_update_dpp(0, __builtin_bit_cast(int, mn), 0x4E, 0xf, 0xf, false));
              sp += __builtin_bit_cast(float, __builtin_amdgcn_update_dpp(0, __builtin_bit_cast(int, sp), 0xB1, 0xf, 0xf, false)); sp += __builtin_bit_cast(float, __builtin_amdgcn_update_dpp(0, __builtin_bit_cast(int, sp), 0x4E, 0xf, 0xf, false));
              const int jj = 16 * wave + 8 * cc + 2 * gi + hi;
              if (hh == 0 && rowv) { impM[ts * 132 + jj] = mn; impS[ts * 132 + jj + 1] = sp; } } }
    __syncthreads();
    if (wave < 4) { const int tq = wave;
        float s0 = impM[tq * 132 + lane] + impS[tq * 132 + lane], s1 = impM[tq * 132 + 64 + lane] + impS[tq * 132 + 64 + lane];
        float s2 = (lane == 0) ? impM[tq * 132 + 128] + impS[tq * 132 + 128] + 100.0f : -INFINITY;
        if (lane == 0) s0 += 100.0f; if (lane == 63) s1 += 100.0f;
        int c0 = 0, c1 = 0, c2 = 0; int ln = lane; asm volatile("" : "+v"(ln));
#pragma unroll 8
        for (int jp = 0; jp < 64; ++jp) { const float o = __shfl(s0, jp); c0 += (o > s0 || (o == s0 && jp < ln)) ? 1 : 0; c1 += (o >= s1) ? 1 : 0; c2 += (o >= s2) ? 1 : 0; }
#pragma unroll 8
        for (int jp = 0; jp < 64; ++jp) { const float o = __shfl(s1, jp); c0 += (o > s0) ? 1 : 0; c1 += (o > s1 || (o == s1 && jp < ln)) ? 1 : 0; c2 += (o >= s2) ? 1 : 0; }
        { const float o = __shfl(s2, 0); c0 += (o > s0) ? 1 : 0; c1 += (o > s1) ? 1 : 0; }
        const unsigned long long m0 = __ballot(c0 < 16), m1 = __ballot(c1 < 16), m2 = __ballot(lane == 0 && c2 < 16);
        if (lane == 0) { selS[tq * 4 + 0] = m0; selS[tq * 4 + 1] = m1; selS[tq * 4 + 2] = m2; } }
    __syncthreads();
    const unsigned long long my0 = selS[(ts & 3) * 4 + 0], my1 = selS[(ts & 3) * 4 + 1], my2 = selS[(ts & 3) * 4 + 2];
    const unsigned long long u0v = selS[0] | selS[4] | selS[8] | selS[12], u1v = selS[1] | selS[5] | selS[9] | selS[13];
    const unsigned long long u0 = ((unsigned long long)(unsigned)__builtin_amdgcn_readfirstlane((int)(u0v >> 32)) << 32) | (unsigned)__builtin_amdgcn_readfirstlane((int)u0v);
    const unsigned long long u1 = ((unsigned long long)(unsigned)__builtin_amdgcn_readfirstlane((int)(u1v >> 32)) << 32) | (unsigned)__builtin_amdgcn_readfirstlane((int)u1v);
    { acc_init(A); const float* cache = INF(2); int k = 0;
      for (int j = 0; j < 129; ++j) { const bool inu = j < 64 ? ((u0 >> j) & 1ull) : j < 128 ? ((u1 >> (j - 64)) & 1ull) : true; if (!inu) continue;
          if ((k++ & 7) != wave) continue;
          const bool ok = rowv && (j < 64 ? ((my0 >> j) & 1ull) : j < 128 ? ((my1 >> (j - 64)) & 1ull) : (my2 & 1ull));
          if (j < 128) { const int page = ptab[j >> 1]; const float* base = cache + ((size_t)page * PAGE + (j & 1) * 64) * 512 + g * 64;
              stage_tile_f32(kb, vb, base + 256, base + 384, 512, lane); wave_fence(); attn_tile<0>(kb, vb, qr, A, ok, 0, lane); }
          else { const bf16* kn = lane < 4 ? KVS0 + ((((size_t)2 * NSQ + bs) * 2 + g) * 4 + lane) * 64 : nullptr; const bf16* vn = lane < 4 ? KVS0 + ((((size_t)3 * NSQ + bs) * 2 + g) * 4 + lane) * 64 : nullptr;
              stage_row_bf16(kb, vb, kn, vn, lane); wave_fence(); attn_tile<1>(kb, vb, qr, A, ok, ts, lane); }
          wave_fence(); }
      merge_waves(F, A, lane, wave); if (wave == 0) branch_out_lds<false>(outb, A, g1); }
    { acc_init(A); const float* wbuf = INF(4) + (size_t)bs * 512 * 256;
      for (int tile = wave; tile < 9; tile += 8) { const int idx = 64 * tile + lane;
          if (tile < 8) { const float* base = wbuf + (size_t)(64 * tile) * 256 + g * 64; stage_tile_f32(kb, vb, base, base + 128, 256, lane); }
          else { const bf16* kn = lane < 4 ? KVS0 + ((((size_t)4 * NSQ + bs) * 2 + g) * 4 + lane) * 64 : nullptr; const bf16* vn = lane < 4 ? KVS0 + ((((size_t)5 * NSQ + bs) * 2 + g) * 4 + lane) * 64 : nullptr;
              stage_row_bf16(kb, vb, kn, vn, lane); }
          wave_fence();
          if (tile == 0) attn_tile<2>(kb, vb, qr, A, rowv, ts, lane); else if (tile == 8) attn_tile<1>(kb, vb, qr, A, rowv, ts, lane); else attn_tile<0>(kb, vb, qr, A, rowv, 0, lane);
          wave_fence(); }
      merge_waves(F, A, lane, wave); if (wave == 0) branch_out_lds<false>(outb, A, g2); }
    if (wave == 0) { f32x16 out0, out1;
#pragma unroll
        for (int i = 0; i < 16; ++i) { out0[i] = outb[i]; out1[i] = outb[16 + i]; }
        if (rowv) store_ot((bf16*)(ws + WS_ATT) + (size_t)row * 1024 + 512 + head * 64, out0, out1, hi); }
}
DI void moba_sample_unit(const Params& P, const Frame& F, int bs, int kvh) {
    unsigned char* ws = P.ws; int lane_ = F.lane; asm volatile("" : "+v"(lane_));
    const int lane = lane_, wave = F.wave, r32 = lane & 31, hi = lane >> 5, ts = r32 >> 2, hh = r32 & 3, head = kvh * 4 + hh; const bool rowv = ts < 4;
    const int row = MP + bs * 4 + (ts & 3);
    LAS unsigned char* kb = F.lds + wave * 16384; LAS unsigned char* vb = kb + 8192;
    const int* ptab = (const int*)P.in[7] + bs * NPG;
    bf16x8 qr[4]; ld_q((const bf16*)(ws + WS_Q1) + (size_t)row * 1024 + head * 64, qr, hi);
    unsigned long long rowmask = 1ull << 32;
    { const float* mp = (const float*)(ws + WS_MEANS) + (((size_t)bs * 4 + kvh) * 32 + (lane & 31)) * 64;
#pragma unroll
      for (int c = 0; c < 8; ++c) { v4u hu = {0u, 0u, 0u, 0u}, lu = {0u, 0u, 0u, 0u};
          if (lane < 32) { const f32x4 a = *(const f32x4*)(mp + 8 * c), b2 = *(const f32x4*)(mp + 8 * c + 4);
              hu = (v4u){pk2(a.x, a.y), pk2(a.z, a.w), pk2(b2.x, b2.y), pk2(b2.z, b2.w)};
              lu = (v4u){pk2(a.x - bflo(hu.x), a.y - bfhi(hu.x)), pk2(a.z - bflo(hu.y), a.w - bfhi(hu.y)), pk2(b2.x - bflo(hu.z), b2.y - bfhi(hu.z)), pk2(b2.z - bflo(hu.w), b2.w - bfhi(hu.w))}; }
          *(LAS v4u*)(kb + c * 1024 + lane * 16) = hu; *(LAS v4u*)(vb + c * 1024 + lane * 16) = lu; }
      wave_fence();
      f32x16 p0, p1, q0, q1; qk_tile(kb, qr, p0, p1, lane); qk_tile(vb, qr, q0, q1, lane);
      float gs[32];
#pragma unroll
      for (int i = 0; i < 16; ++i) { const float v = p0[i] + q0[i]; auto rr = __builtin_amdgcn_permlane32_swap(__float_as_uint(v), __float_as_uint(v), false, false);
          gs[8 * (i >> 2) + (i & 3)] = __uint_as_float(rr[0]); gs[8 * (i >> 2) + 4 + (i & 3)] = __uint_as_float(rr[1]); }
      unsigned taken = 0;
#pragma unroll
      for (int pass = 0; pass < 3; ++pass) { float best = -INFINITY; int bi = -1;
#pragma unroll
          for (int n = 0; n < 32; ++n) { const bool c = !((taken >> n) & 1u) && (gs[n] > best); best = c ? gs[n] : best; bi = c ? n : bi; }
          if (bi >= 0) taken |= 1u << bi; }
      rowmask |= (unsigned long long)taken;
      wave_fence(); }
    unsigned umask = 0;
#pragma unroll
    for (int n = 0; n < 32; ++n) if (__ballot(rowv && ((rowmask >> n) & 1ull)) != 0ull) umask |= 1u << n;
    AttnAcc A; acc_init(A); const float* cache = INF(3); int k = 0;
    for (int blk = 0; blk < 32; ++blk) { if (!((umask >> blk) & 1u)) continue;
        const bool ok = rowv && ((rowmask >> blk) & 1ull);
        for (int q4 = 0; q4 < 4; ++q4) { if ((k++ & 7) != wave) continue;
            const int page = ptab[2 * blk + (q4 >> 1)]; const float* base = cache + ((size_t)page * PAGE + (q4 & 1) * 64) * 512 + kvh * 64;
            stage_tile_f32(kb, vb, base, base + 256, 512, lane); wave_fence(); attn_tile<0>(kb, vb, qr, A, ok, 0, lane); wave_fence(); } }
    if ((k & 7) == wave) { const bf16* kn = lane < 4 ? (const bf16*)(ws + WS_K1S) + (((size_t)bs * 4 + kvh) * 4 + lane) * 64 : nullptr; const bf16* vn = lane < 4 ? (const bf16*)(ws + WS_V1S) + (((size_t)bs * 4 + kvh) * 4 + lane) * 64 : nullptr;
        stage_row_bf16(kb, vb, kn, vn, lane); wave_fence(); attn_tile<1>(kb, vb, qr, A, rowv, ts, lane); wave_fence(); }
    merge_waves(F, A, lane, wave);
    const float lt = half_sum(A.l), sc = 1.0f / fmaxf(lt, 1e-30f);
#pragma unroll
    for (int i = 0; i < 16; ++i) { A.o0[i] *= sc; A.o1[i] *= sc; }
    if (wave == 0 && rowv) store_ot((bf16*)(ws + WS_ATT) + (size_t)row * 1024 + head * 64, A.o0, A.o1, hi);
}
constexpr int CKN = 4096;
constexpr size_t WS_CK_AT = WS_END3;
constexpr size_t WS_CK_BT = WS_CK_AT + (size_t)CKN * 4096, WS_CK_KT = WS_CK_BT + (size_t)CKN * 4096, WS_CK_RT = WS_CK_KT + (size_t)CKN * 4096;
constexpr size_t WS_CK_ATT = WS_CK_RT + (size_t)CKN * 4096;
constexpr size_t WS_CK_VT = WS_CK_ATT + (size_t)CKN * 4096;
constexpr size_t WS_CK_KH = WS_CK_VT + (size_t)CKN * 4096;
constexpr size_t WS_CK_PC = WS_CK_KH + (size_t)CKN * 8192;
constexpr size_t WS_CK_GT = WS_CK_PC + (size_t)CKN * 256;
constexpr size_t WS_CK_HT = WS_CK_GT + (size_t)CKN * 8192;
constexpr size_t WS_CK_QY = WS_CK_HT + (size_t)CKN * 16384;
constexpr size_t WS_CK_AY = WS_CK_QY + (size_t)CKN * 4096;
constexpr size_t WS_CK_S = WS_CK_AY + (size_t)CKN * 2048;
constexpr size_t WS_END4 = al(WS_CK_S + (size_t)CKN * 8192);
constexpr int CKL_N = 0, CKL_R1 = 4096, CKL_MKA = 8192, CKL_ZT = 10240, CKL_STRIDE = 17920, CKL_HKT = 0;

DI bf16x8 ldg8(const bf16* p) { return *(const bf16x8*)p; }
#if MK_DIAG
#define CKA_STAMP(k) do { if (cg == 0 && F.lane == 0) __hip_atomic_store((unsigned long long*)((unsigned*)(P.ws + WS_CTL) + 65536) + 1 + (k), __builtin_amdgcn_s_memrealtime(), __ATOMIC_RELAXED, __HIP_MEMORY_SCOPE_AGENT); } while (0)
#else
#define CKA_STAMP(k) do {} while (0)
#endif
DI void rwkv_chunk_a(const Params& P, const Frame& F, int cg) {
    unsigned char* ws = P.ws; int lane_ = F.lane; asm volatile("" : "+v"(lane_)); const int lane = lane_, r32 = lane & 31, hi = lane >> 5;
    const int bh = cg >> 7, c = cg & 127, b = bh >> 3, h = bh & 7; const size_t row0 = (size_t)b * SEQ + c * 32;
    const float* LW = (const float*)(ws + WS_W); const bf16* KK = (const bf16*)(ws + WS_KK); const bf16* KKA = (const bf16*)(ws + WS_KKA);
    const bf16* KP = (const bf16*)(ws + WS_KP); const bf16* RR = (const bf16*)(ws + WS_R); const bf16* VV = (const bf16*)(ws + WS_V);
    const int slot = (int)blockIdx.x * 8 + F.wave;
    bf16* AT = (bf16*)(ws + WS_CK_AT) + (size_t)slot * 2048; bf16* BT = (bf16*)(ws + WS_CK_BT) + (size_t)slot * 2048; bf16* KT = (bf16*)(ws + WS_CK_KT) + (size_t)slot * 2048; bf16* RT = (bf16*)(ws + WS_CK_RT) + (size_t)slot * 2048;
    bf16* ATT = (bf16*)(ws + WS_CK_ATT) + (size_t)slot * 2048; bf16* VT = (bf16*)(ws + WS_CK_VT) + (size_t)cg * 2048; float* KH = (float*)(ws + WS_CK_KH) + (size_t)slot * 2048;
    LAS unsigned char* wl = F.lds + F.wave * CKL_STRIDE;
    LAS float* Nl = (LAS float*)(wl + CKL_N); LAS float* R1 = (LAS float*)(wl + CKL_R1); LAS bf16* MKA = (LAS bf16*)(wl + CKL_MKA); LAS bf16* ZT = (LAS bf16*)(wl + CKL_ZT); LAS bf16* HKT = (LAS bf16*)(wl + CKL_HKT);
    float bh_[32];
    { unsigned atp[16], vtp[16]; float aprev = 0.f, vprev = 0.f, kt_[32]; float cum = 0.f;
      LAS unsigned char* stg = wl; const size_t gro = row0 * 512 + h * 64;
#pragma unroll
      for (int hf = 0; hf < 2; ++hf) {
          wave_fence();
          { v4u xb[5][2]; f32x4 xl[4];
#pragma unroll
            for (int q = 0; q < 4; ++q) { const int p = lane + 64 * q, tk = p >> 4, pc4 = p & 15; xl[q] = *(const f32x4*)(LW + gro + (size_t)(16 * hf + tk) * 512 + 4 * pc4); }
#pragma unroll
            for (int a = 0; a < 5; ++a)
#pragma unroll
                for (int q = 0; q < 2; ++q) { const int p = lane + 64 * q, tk = p >> 3, pc8 = p & 7; const bf16* sp = a == 0 ? KK : a == 1 ? KKA : a == 2 ? KP : a == 3 ? RR : VV; xb[a][q] = *(const v4u*)(sp + gro + (size_t)(16 * hf + tk) * 512 + 8 * pc8); }
#pragma unroll
            for (int q = 0; q < 4; ++q) *(LAS f32x4*)(stg + (lane + 64 * q) * 16) = xl[q];
#pragma unroll
            for (int a = 0; a < 5; ++a)
#pragma unroll
                for (int q = 0; q < 2; ++q) *(LAS v4u*)(stg + 4096 + a * 2048 + (lane + 64 * q) * 16) = xb[a][q]; }
          wave_fence();
#pragma unroll
          for (int tt = 0; tt < 16; ++tt) { const int t = 16 * hf + tt;
              const float lw = *(const LAS float*)(stg + (tt * 64 + lane) * 4);
              const float kk = bf2f(*(const LAS bf16*)(stg + 4096 + (tt * 64 + lane) * 2)), ka = bf2f(*(const LAS bf16*)(stg + 6144 + (tt * 64 + lane) * 2)), kp = bf2f(*(const LAS bf16*)(stg + 8192 + (tt * 64 + lane) * 2));
              const float r = bf2f(*(const LAS bf16*)(stg + 10240 + (tt * 64 + lane) * 2)), v = bf2f(*(const LAS bf16*)(stg + 12288 + (tt * 64 + lane) * 2));
              const float ep = __expf(cum); cum += lw; const float en = __expf(-cum), er = __expf(cum);
              const float at = -kk * ep;
              AT[t * 64 + lane] = (bf16)(pk2(at, 0.f) & 0xffffu); BT[t * 64 + lane] = (bf16)(pk2(ka * en, 0.f) & 0xffffu); KT[t * 64 + lane] = (bf16)(pk2(kp * en, 0.f) & 0xffffu); RT[t * 64 + lane] = (bf16)(pk2(r * er, 0.f) & 0xffffu);
              kt_[t] = kp * en; bh_[t] = ka * en;
              if (t & 1) { atp[t >> 1] = pk2(aprev, at); vtp[t >> 1] = pk2(vprev, v); } else { aprev = at; vprev = v; } } }
#pragma unroll
      for (int q = 0; q < 4; ++q) { *(v4u*)(ATT + lane * 32 + 8 * q) = (v4u){atp[4 * q], atp[4 * q + 1], atp[4 * q + 2], atp[4 * q + 3]}; *(v4u*)(VT + lane * 32 + 8 * q) = (v4u){vtp[4 * q], vtp[4 * q + 1], vtp[4 * q + 2], vtp[4 * q + 3]}; }
      const float pcv = __expf(cum);
#pragma unroll
      for (int t = 0; t < 32; ++t) { KH[t * 64 + lane] = kt_[t] * pcv; bh_[t] *= pcv; }
      ((float*)(ws + WS_CK_PC))[(size_t)slot * 64 + lane] = pcv; }
    wave_fence();
    CKA_STAMP(50);
    VM_WAIT();
    f32x16 mkrT;
    { f32x16 n_, mka_, mbr_;
#pragma unroll
      for (int i = 0; i < 16; ++i) { n_[i] = 0.f; mka_[i] = 0.f; mbr_[i] = 0.f; mkrT[i] = 0.f; }
#pragma unroll
      for (int ks = 0; ks < 4; ++ks) { const int fo = r32 * 64 + 16 * ks + 8 * hi; const bf16x8 fa = ldg8(AT + fo), fb = ldg8(BT + fo), fk = ldg8(KT + fo), fr = ldg8(RT + fo);
          n_ = MFMA32(fb, fa, n_); mka_ = MFMA32(fk, fa, mka_); mbr_ = MFMA32(fb, fr, mbr_); mkrT = MFMA32(fr, fk, mkrT); }
#pragma unroll
      for (int i = 0; i < 16; ++i) { const int rw = crow(i, hi);
          Nl[rw * 32 + r32] = (rw < r32) ? n_[i] : 0.f; R1[rw * 32 + r32] = (rw <= r32) ? mbr_[i] : 0.f;
          MKA[rw * 32 + r32] = (bf16)(pk2((rw < r32) ? mka_[i] : 0.f, 0.f) & 0xffffu); mkrT[i] = (r32 <= rw) ? mkrT[i] : 0.f; } }
    wave_fence();
    CKA_STAMP(51);
#define CK_SOLVE2(ZA, ZB) do { _Pragma("unroll") for (int s_ = 30; s_ >= 0; --s_) { const LAS float* np_ = Nl + s_ * 32; asm volatile("" : "+v"(np_), "+v"(ZA[s_ + 1]), "+v"(ZB[s_ + 1]));     \
            float acca_ = ZA[s_], accb_ = ZB[s_]; \
            _Pragma("unroll") for (int u4 = (s_ + 1) & ~3; u4 < 32; u4 += 4) { const f32x4 nv = *(const LAS f32x4*)(np_ + u4);     \
                acca_ += nv[0] * ZA[u4] + nv[1] * ZA[u4 + 1] + nv[2] * ZA[u4 + 2] + nv[3] * ZA[u4 + 3]; accb_ += nv[0] * ZB[u4] + nv[1] * ZB[u4 + 1] + nv[2] * ZB[u4 + 2] + nv[3] * ZB[u4 + 3]; } \
            ZA[s_] = acca_; ZB[s_] = accb_; } } while (0)
#define CK_ZSTORE(ZZ, zr) do { _Pragma("unroll") for (int q = 0; q < 4; ++q) *(LAS v4u*)((zr) + 8 * q) = (v4u){pk2(ZZ[8 * q], ZZ[8 * q + 1]), pk2(ZZ[8 * q + 2], ZZ[8 * q + 3]), pk2(ZZ[8 * q + 4], ZZ[8 * q + 5]), pk2(ZZ[8 * q + 6], ZZ[8 * q + 7])}; } while (0)
    { float z[32];
#pragma unroll
      for (int s = 0; s < 32; ++s) z[s] = R1[s * 32 + r32];
      CK_SOLVE2(bh_, z);
      CK_ZSTORE(bh_, ZT + (32 + lane) * 40);
      if (lane < 32) CK_ZSTORE(z, ZT + r32 * 40); }
#undef CK_SOLVE2
#undef CK_ZSTORE
    wave_fence();
    CKA_STAMP(52);
    bf16x8 za[3][2];
#pragma unroll
    for (int rb = 0; rb < 3; ++rb)
#pragma unroll
        for (int ks = 0; ks < 2; ++ks) za[rb][ks] = *(const LAS bf16x8*)(ZT + (32 * rb + r32) * 40 + 16 * ks + 8 * hi);
    {
      bf16x8 mb[2];
#pragma unroll
      for (int ks = 0; ks < 2; ++ks) mb[ks] = *(const LAS bf16x8*)(MKA + r32 * 32 + 16 * ks + 8 * hi);
      f32x16 ay = mkrT; ay = MFMA32(za[0][0], mb[0], ay); ay = MFMA32(za[0][1], mb[1], ay);
      bf16* AY = (bf16*)(ws + WS_CK_AY) + (size_t)cg * 1024;
#pragma unroll
      for (int i = 0; i < 16; ++i) AY[4 * hi * 32 + r32 + ((i & 3) + 8 * (i >> 2)) * 32] = (bf16)(pk2(ay[i], 0.f) & 0xffffu);
      wave_fence();
#pragma unroll
      for (int jb = 0; jb < 2; ++jb) { int ro = r32; asm volatile("" : "+v"(ro) :: "memory"); f32x16 hk;
#pragma unroll
          for (int gi = 0; gi < 4; ++gi) { const f32x4 kh = *(const f32x4*)(KH + ro * 64 + 32 * jb + 8 * gi + 4 * hi); hk[4 * gi] = kh.x; hk[4 * gi + 1] = kh.y; hk[4 * gi + 2] = kh.z; hk[4 * gi + 3] = kh.w; }
          hk = MFMA32(za[1 + jb][0], mb[0], hk); hk = MFMA32(za[1 + jb][1], mb[1], hk);
#pragma unroll
          for (int i = 0; i < 16; ++i) HKT[(32 * jb + crow(i, hi)) * 40 + ro] = (bf16)(pk2(hk[i], 0.f) & 0xffffu); } }
    {
      bf16* QY = (bf16*)(ws + WS_CK_QY) + (size_t)cg * 2048; bf16* GT = (bf16*)(ws + WS_CK_GT) + (size_t)cg * 4096; const float* PC = (const float*)(ws + WS_CK_PC) + (size_t)slot * 64;
#pragma unroll
      for (int cb = 0; cb < 2; ++cb) { const int j = 32 * cb + r32; bf16x8 ab[2];
#pragma unroll
          for (int ks = 0; ks < 2; ++ks) ab[ks] = ldg8(ATT + j * 32 + 16 * ks + 8 * hi);
          const float pc = PC[j];
#pragma unroll
          for (int rb = 0; rb < 3; ++rb) { int jo = j; asm volatile("" : "+v"(jo) :: "memory"); f32x16 acc;
              const bf16* rtp = RT + 4 * hi * 64 + jo;
              bf16* dst = rb == 0 ? QY + 4 * hi * 64 + jo : GT + (((rb - 1) * 4 + (jo >> 4)) * 64 + 4 * hi + 32 * ((jo >> 2) & 1)) * 8 + (jo & 3) + 4 * ((jo >> 3) & 1);
#pragma unroll
              for (int i = 0; i < 16; ++i) { const int rw = crow(i, hi); acc[i] = rb == 0 ? bf2f(rtp[((i & 3) + 8 * (i >> 2)) * 64]) : ((32 * (rb - 1) + rw == jo) ? pc : 0.f); }
              acc = MFMA32(za[rb][0], ab[0], acc); acc = MFMA32(za[rb][1], ab[1], acc);
#pragma unroll
              for (int i = 0; i < 16; ++i) dst[((i & 3) + 8 * (i >> 2)) * (rb == 0 ? 64 : 8)] = (bf16)(pk2(acc[i], 0.f) & 0xffffu); } } }
    wave_fence();
    {
      bf16* HT = (bf16*)(ws + WS_CK_HT) + (size_t)cg * 4096;
#pragma unroll
      for (int ib = 0; ib < 2; ++ib) { bf16x8 vb[2];
#pragma unroll
          for (int ks = 0; ks < 2; ++ks) vb[ks] = ldg8(VT + (32 * ib + r32) * 32 + 16 * ks + 8 * hi);
#pragma unroll
          for (int jb = 0; jb < 2; ++jb) { int ro = r32; asm volatile("" : "+v"(ro) :: "memory"); f32x16 acc;
#pragma unroll
              for (int i = 0; i < 16; ++i) acc[i] = 0.f;
#pragma unroll
              for (int ks = 0; ks < 2; ++ks) acc = MFMA32(*(const LAS bf16x8*)(HKT + (32 * jb + ro) * 40 + 16 * ks + 8 * hi), vb[ks], acc);
              bf16* dst = HT + ((ib * 64 + ro + 32 * hi) * 32 + 16 * jb);
              *(v4u*)dst = (v4u){pk2(acc[0], acc[1]), pk2(acc[2], acc[3]), pk2(acc[4], acc[5]), pk2(acc[6], acc[7])}; *(v4u*)(dst + 8) = (v4u){pk2(acc[8], acc[9]), pk2(acc[10], acc[11]), pk2(acc[12], acc[13]), pk2(acc[14], acc[15])}; } } }
    wave_fence();
    CKA_STAMP(53);
}
struct CkbSet { bf16x8 g[2][4]; v4u h[4]; };
DI void ckb_load(CkbSet& S, const bf16* GT, const bf16* HT, int c, int ih, int lane) {
    const bf16* g = GT + (size_t)c * 4096 + lane * 8; const bf16* h = HT + (size_t)c * 4096 + (ih * 64 + lane) * 32;
#pragma unroll
    for (int jb = 0; jb < 2; ++jb)
#pragma unroll
        for (int ks = 0; ks < 4; ++ks) S.g[jb][ks] = *(const bf16x8*)(g + (jb * 4 + ks) * 512);
#pragma unroll
    for (int q = 0; q < 4; ++q) S.h[q] = *(const v4u*)(h + 8 * q);
}
DI void ckb_step(const CkbSet& S, f32x16& X0, f32x16& X1, bf16* sdst, int hi) {
#pragma unroll
    for (int gi = 0; gi < 4; ++gi) { *(v2u*)(sdst + 8 * gi + 4 * hi) = (v2u){pk2(X0[4 * gi], X0[4 * gi + 1]), pk2(X0[4 * gi + 2], X0[4 * gi + 3])}; *(v2u*)(sdst + 32 + 8 * gi + 4 * hi) = (v2u){pk2(X1[4 * gi], X1[4 * gi + 1]), pk2(X1[4 * gi + 2], X1[4 * gi + 3])}; }
    const bf16x8 xb0 = pack8(X0, 0), xb1 = pack8(X0, 1), xb2 = pack8(X1, 0), xb3 = pack8(X1, 1);
    f32x16 n0, n1;
#pragma unroll
    for (int q = 0; q < 2; ++q) { const v4u a = S.h[q], b2 = S.h[2 + q];
        n0[8 * q] = bflo(a.x); n0[8 * q + 1] = bfhi(a.x); n0[8 * q + 2] = bflo(a.y); n0[8 * q + 3] = bfhi(a.y); n0[8 * q + 4] = bflo(a.z); n0[8 * q + 5] = bfhi(a.z); n0[8 * q + 6] = bflo(a.w); n0[8 * q + 7] = bfhi(a.w);
        n1[8 * q] = bflo(b2.x); n1[8 * q + 1] = bfhi(b2.x); n1[8 * q + 2] = bflo(b2.y); n1[8 * q + 3] = bfhi(b2.y); n1[8 * q + 4] = bflo(b2.z); n1[8 * q + 5] = bfhi(b2.z); n1[8 * q + 6] = bflo(b2.w); n1[8 * q + 7] = bfhi(b2.w); }
    n0 = MFMA32(S.g[0][0], xb0, n0); n0 = MFMA32(S.g[0][1], xb1, n0); n0 = MFMA32(S.g[0][2], xb2, n0); n0 = MFMA32(S.g[0][3], xb3, n0);
    n1 = MFMA32(S.g[1][0], xb0, n1); n1 = MFMA32(S.g[1][1], xb1, n1); n1 = MFMA32(S.g[1][2], xb2, n1); n1 = MFMA32(S.g[1][3], xb3, n1);
    X0 = n0; X1 = n1;
}
DI void rwkv_chunk_b(const Params& P, int bh, int ih, int lane, volatile LAS int* prog) {
    unsigned char* ws = P.ws; const int r32 = lane & 31, hi = lane >> 5, icol = 32 * ih + r32;
    f32x16 X0, X1;
#pragma unroll
    for (int i = 0; i < 16; ++i) { X0[i] = 0.f; X1[i] = 0.f; }
    const bf16* GT = (const bf16*)(ws + WS_CK_GT) + (size_t)bh * 128 * 4096; const bf16* HT = (const bf16*)(ws + WS_CK_HT) + (size_t)bh * 128 * 4096; bf16* SS = (bf16*)(ws + WS_CK_S) + (size_t)bh * 128 * 4096 + icol * 64;
    CkbSet A, B, C;
    ckb_load(A, GT, HT, 0, ih, lane); ckb_load(B, GT, HT, 1, ih, lane); ckb_load(C, GT, HT, 2, ih, lane);
#define CKB_ROUND(c) do { \
        ckb_step(A, X0, X1, SS + (size_t)(c) * 4096, hi); __builtin_amdgcn_sched_barrier(0); ckb_load(A, GT, HT, (c) + 3 < 127 ? (c) + 3 : 127, ih, lane); __builtin_amdgcn_sched_barrier(0);     \
        ckb_step(B, X0, X1, SS + (size_t)((c) + 1) * 4096, hi); __builtin_amdgcn_sched_barrier(0); ckb_load(B, GT, HT, (c) + 4 < 127 ? (c) + 4 : 127, ih, lane); __builtin_amdgcn_sched_barrier(0); \
        ckb_step(C, X0, X1, SS + (size_t)((c) + 2) * 4096, hi); __builtin_amdgcn_sched_barrier(0); ckb_load(C, GT, HT, (c) + 5 < 127 ? (c) + 5 : 127, ih, lane); __builtin_amdgcn_sched_barrier(0); \
        *prog = (c) + 3;     } while (0)
    CKB_ROUND(0);
    for (int c = 3; c < 126; c += 3) CKB_ROUND(c);
#undef CKB_ROUND
    ckb_step(A, X0, X1, SS + (size_t)126 * 4096, hi); ckb_step(B, X0, X1, SS + (size_t)127 * 4096, hi);
    *prog = 128;
    float* so = P.out + O_WKVP + (size_t)bh * 4096 + icol * 64;
#pragma unroll
    for (int gi = 0; gi < 4; ++gi) { *(f32x4*)(so + 8 * gi + 4 * hi) = (f32x4){X0[4 * gi], X0[4 * gi + 1], X0[4 * gi + 2], X0[4 * gi + 3]}; *(f32x4*)(so + 32 + 8 * gi + 4 * hi) = (f32x4){X1[4 * gi], X1[4 * gi + 1], X1[4 * gi + 2], X1[4 * gi + 3]}; }
}
DI void rwkv_chunk_b_touch(const Params& P, int bh, int ih, int lane, volatile LAS int* prog) {
    const char* base = (const char*)(P.ws + ((lane & 32) ? WS_CK_HT : WS_CK_GT)) + (size_t)bh * 128 * 8192 + ih * 4096 + (lane & 31) * 128;
    int done = 3;
    for (;;) { const int cur = *prog; if (cur >= 128) break;
        const int tgt = cur + 16 < 128 ? cur + 16 : 128;
        for (; done < tgt; ++done) { unsigned d_; const char* p_ = base + (size_t)done * 8192; asm volatile("global_load_dword %0, %1, off" : "=v"(d_) : "v"(p_) : "memory"); }
        asm volatile("s_waitcnt vmcnt(0)" ::: "memory");
        __builtin_amdgcn_s_sleep(32); }
}
DI void rwkv_chunk_c(const Params& P, int cg, int lane, LAS float* ylds) {
    unsigned char* ws = P.ws; const int r32 = lane & 31, hi = lane >> 5; const int bh = cg >> 7, c = cg & 127, b = bh >> 3, h = bh & 7; const size_t row0 = (size_t)b * SEQ + c * 32;
    const bf16* QY = (const bf16*)(ws + WS_CK_QY) + (size_t)cg * 2048; const bf16* AY = (const bf16*)(ws + WS_CK_AY) + (size_t)cg * 1024; const bf16* SS = (const bf16*)(ws + WS_CK_S) + (size_t)cg * 4096; const bf16* VT = (const bf16*)(ws + WS_CK_VT) + (size_t)cg * 2048;
    bf16x8 qa[4], aa[2];
#pragma unroll
    for (int ks = 0; ks < 4; ++ks) qa[ks] = ldg8(QY + r32 * 64 + 16 * ks + 8 * hi);
#pragma unroll
    for (int ks = 0; ks < 2; ++ks) aa[ks] = ldg8(AY + r32 * 32 + 16 * ks + 8 * hi);
#pragma unroll
    for (int ib = 0; ib < 2; ++ib) { const int i = 32 * ib + r32; f32x16 acc;
#pragma unroll
        for (int q = 0; q < 16; ++q) acc[q] = 0.f;
#pragma unroll
        for (int ks = 0; ks < 4; ++ks) acc = MFMA32(qa[ks], ldg8(SS + i * 64 + 16 * ks + 8 * hi), acc);
#pragma unroll
        for (int ks = 0; ks < 2; ++ks) acc = MFMA32(aa[ks], ldg8(VT + i * 32 + 16 * ks + 8 * hi), acc);
#pragma unroll
        for (int q = 0; q < 16; ++q) ylds[crow(q, hi) * 512 + h * 64 + i] = acc[q]; }
}
DI int wq_next(unsigned* ctr, volatile LAS int* slot, int tid) {
    if (tid == 0) *slot = (int)__hip_atomic_fetch_add(ctr, 1u, __ATOMIC_RELAXED, __HIP_MEMORY_SCOPE_AGENT);
    __syncthreads(); const int u = *slot; __syncthreads(); return u;
}
DI void bg_drain_means(const Params& P, const Frame& F, unsigned* ctl, int limit) {
    volatile LAS int* wslot = (volatile LAS int*)(F.lds + LDS_BYTES - 128 + 64);
    for (int n = 0; n < limit; ++n) { const int u = wq_next(ctl + 8384, wslot, F.tid); if (u >= 1024) break; prep_means_unit(P, F, u); }
}
DI void bg_drain_w1(const Params& P, const Frame& F, unsigned* ctl) {
    volatile LAS int* wslot = (volatile LAS int*)(F.lds + LDS_BYTES - 128 + 64); constexpr int NW1 = (WI_L1 + 7) / 8;
    for (;;) { const int u = wq_next(ctl + 8448, wslot, F.tid); if (u >= NW1) break; const int i = u * 8 + F.wave; if (i < WI_L1) weight_item(P, (LAS float*)(F.lds + F.wave * 16384), wi_l1(i), F.lane); }
}
constexpr int N_PHASES = 21;
__global__ void __launch_bounds__(512, 2) mk_fwd(Params P) {
    extern __shared__ __attribute__((aligned(16))) unsigned char lds_raw[];
    Frame F;
    F.lds = (LAS unsigned char*)lds_raw;
    F.tid = threadIdx.x; F.lane = F.tid & 63; F.wave = __builtin_amdgcn_readfirstlane(F.tid >> 6);
    F.G = gridDim.x; F.gw = blockIdx.x * NWAVES + F.wave; F.ngw = F.G * NWAVES;
    volatile LAS unsigned* MISC = (volatile LAS unsigned*)(F.lds + MISC_OFF);
    for (int u = F.tid; u < (LDS_BYTES - RING_BYTES) / 4; u += 512) ((LAS unsigned*)(F.lds + RING_BYTES))[u] = 0u;
    __syncthreads();
    unsigned char* ws = P.ws;
    unsigned* ctl = (unsigned*)(ws + WS_CTL);
    XcdBarrier bar = xcd_barrier_post(ctl + 4096, MISC + 8);
    const int lo = P.ph_lo, hi = P.ph_hi;
#define IN(k) (lo <= (k) && (k) < hi)
#if MK_DIAG
    unsigned long long* tstamp = (unsigned long long*)(ctl + 65536);
    if (blockIdx.x == 0 && F.tid == 0) __hip_atomic_store(tstamp + 0, __builtin_amdgcn_s_memrealtime(), __ATOMIC_RELAXED, __HIP_MEMORY_SCOPE_AGENT);
#define STAMP(k) do { if (blockIdx.x == 0 && F.tid == 0) __hip_atomic_store(tstamp + 1 + (k), __builtin_amdgcn_s_memrealtime(), __ATOMIC_RELAXED, __HIP_MEMORY_SCOPE_AGENT); } while (0)
#define STAMPL(k) do { if (blockIdx.x == gridDim.x - 1 && F.tid == 0) __hip_atomic_store(tstamp + 1 + (k), __builtin_amdgcn_s_memrealtime(), __ATOMIC_RELAXED, __HIP_MEMORY_SCOPE_AGENT); } while (0)
#else
#define STAMP(k) do {} while (0)
#define STAMPL(k) do {} while (0)
#endif
#define SEAM(k) do { if (IN(k) && IN((k) + 1)) xcd_barrier(bar); STAMP(k); } while (0)

    if (IN(0)) {
        p0_rope(P, F);
        { LAS float* scr = (LAS float*)(F.lds + F.wave * 16384); for (int i = F.gw; i < WI_L0; i += F.ngw) weight_item(P, scr, wi_l0(i), F.lane); }
        __syncthreads();
        norm_phase(F, INF(0), INF(1), INF(8), (bf16*)(ws + WS_XN));
        for (int u = (int)blockIdx.x; u < 256; u += F.G) prep_conv_unit(P, F, u);
        p0_cmp_bias(P, F); p0_wincopy(P, F);
        for (int i = blockIdx.x * 512 + F.tid; i < 4 * MT; i += F.G * 512) ((float*)(ws + WS_SS))[i] = 0.f;
    }
    SEAM(0);
    if (IN(1)) {
        EpiIn0 e0{(bf16*)(ws + WS_RW), (bf16*)(ws + WS_Q0), (bf16*)(ws + WS_KV0), (bf16*)(ws + WS_KVS0), (const f32x2*)(ws + WS_ROPE), P.out};
        { pg8::Gemm g{(const bf16*)(ws + WS_XN), (const bf16*)(ws + WS_WIN0), MP, 3072, 1024}; pg8::StaticOrder S; S.init(MP, 3072, F.G, (int)blockIdx.x);
          EpiHead<EpiIn0> E{e0};
          pg8::gemm_phase<EpiHead<EpiIn0>, pg8::StaticOrder, PG8_ALIGN, PG8_SP2>(F.lds, g, S, E); }
        __syncthreads();
        for (int u = F.G - 1 - (int)blockIdx.x; u < 96 + 129; u += F.G) {
            if (u < 96) skinny_unit(F.lds, (const bf16*)(ws + WS_XN), (const bf16*)(ws + WS_WIN0), 1024, MP, 32 * u, e0, F.wave, F.lane);
            else skinny_unit(F.lds, (const bf16*)(ws + WS_XN), (const bf16*)(ws + WS_WG0), 1024, 128 * (u - 96), 0, EpiGates{(float*)(ws + WS_GATES), INF(24)}, F.wave, F.lane);
        }
    }
    SEAM(1);
    if (IN(2)) {
        { pg8::Gemm g{(const bf16*)(ws + WS_ACMPS), (const bf16*)(ws + WS_WCMP), 65536, 256, 1024}; pg8::StaticOrder S; S.init(65536, 256, F.G, (int)blockIdx.x);
          EpiHead<EpiCmp> E{EpiCmp{(float*)(ws + WS_HCS), 32768}};
          pg8::gemm_phase<EpiHead<EpiCmp>, pg8::StaticOrder, PG8_ALIGN, PG8_SP2>(F.lds, g, S, E); }
        __syncthreads();
        { pg8::Gemm g{(const bf16*)(ws + WS_KV0), (const bf16*)(ws + WS_WCMP), 4096, 256, 1024}; pg8::StaticOrder S; S.init(4096, 256, F.G, (int)blockIdx.x);
          EpiHead<EpiCmp> E{EpiCmp{(float*)(ws + WS_HCP), 2048}};
          pg8::gemm_phase<EpiHead<EpiCmp>, pg8::StaticOrder, PG8_ALIGN, PG8_SP2>(F.lds, g, S, E); }
        __syncthreads();
        rwkv_prep(P, F, F.G > 32 ? 16 : 0);
    }
    SEAM(2);
    if (IN(3)) {
        EpiLora el{INF(14), INF(16), INF(20), (const bf16*)(ws + WS_K), (const bf16*)(ws + WS_KK), (float*)(ws + WS_W), (bf16*)(ws + WS_KP), (bf16*)(ws + WS_KKA), (bf16*)(ws + WS_G)};
        { pg8::Gemm g{(const bf16*)(ws + WS_LA), (const bf16*)(ws + WS_WLORA), MP, 1536, 256}; pg8::StaticOrder S; S.init(MP, 1536, F.G, (int)blockIdx.x);
          EpiHead<EpiLora> E{el};
          pg8::gemm_phase<EpiHead<EpiLora>, pg8::StaticOrder, PG8_ALIGN, PG8_SP2>(F.lds, g, S, E); }
        __syncthreads();
        for (int u = F.G - 1 - (int)blockIdx.x; u < 48; u += F.G) skinny_unit(F.lds, (const bf16*)(ws + WS_LA), (const bf16*)(ws + WS_WLORA), 256, MP, 32 * u, el, F.wave, F.lane);
        cmp_stage2(P, F);
        __syncthreads();
        if ((int)blockIdx.x >= 128) bg_drain_means(P, F, ctl, 3);
    }
    SEAM(3);
    if (IN(4)) {
        for (int cg = (int)blockIdx.x * NWAVES + F.wave; cg < CKN; cg += F.G * NWAVES) rwkv_chunk_a(P, F, cg);
        __syncthreads();
        for (int wid = F.gw; wid < 2048; wid += F.ngw) scan_sample_wave(P, wid, F.lane);
    }
    SEAM(4);
    if (IN(5)) {
        unsigned* bdone = ctl + 8576;
        if ((int)blockIdx.x < 32) {
            volatile LAS int* prog = (volatile LAS int*)F.lds;
            { int t_ = F.tid; asm volatile("" : "+v"(t_)); if (t_ < 2) prog[t_] = 0; }
            __syncthreads();
            if (F.wave >= 2 && F.wave < 4) rwkv_chunk_b_touch(P, (int)blockIdx.x, F.wave - 2, F.lane, prog + (F.wave - 2));
            if (F.wave < 2) { rwkv_chunk_b(P, (int)blockIdx.x, F.wave, F.lane, prog + F.wave); __builtin_amdgcn_fence(__ATOMIC_RELEASE, "agent");
                              if (F.lane == 0) __hip_atomic_fetch_add(bdone, 1u, __ATOMIC_RELAXED, __HIP_MEMORY_SCOPE_AGENT); }
            __syncthreads(); STAMP(30); }
        volatile LAS int* wslot = (volatile LAS int*)(F.lds + LDS_BYTES - 128 + 64);
        int u;
        for (;;) { u = wq_next(ctl + 8192, wslot, F.tid); if (u >= 576) break;
            if (u >= 224 && u < 288) { const int v = u - 224; nsa_sample_unit(P, F, v >> 1, v & 1); }
            else { const int v = u < 224 ? u : u - 64; nsa_prompt_unit(P, F, (v & 7) >> 1, v & 1, 63 - (v >> 3)); } }
        if (u < 576 + 512) {
            if (F.tid == 0) { while (__hip_atomic_load(bdone, __ATOMIC_RELAXED, __HIP_MEMORY_SCOPE_AGENT) < 64u) __builtin_amdgcn_s_sleep(8); }
            __syncthreads(); __builtin_amdgcn_fence(__ATOMIC_ACQUIRE, "agent");
            for (; u < 576 + 512; u = wq_next(ctl + 8192, wslot, F.tid)) { const int v = u - 576, b = v >> 7, c = v & 127;
                rwkv_chunk_c(P, (b * 8 + F.wave) * 128 + c, F.lane, (LAS float*)F.lds);
                __syncthreads();
                rwkv_post_rows<2, true>(P, b * SEQ + c * 32 + F.wave, 8, F.lane, (const LAS float*)F.lds, F.wave); rwkv_post_rows<2, true>(P, b * SEQ + c * 32 + 16 + F.wave, 8, F.lane, (const LAS float*)F.lds, 16 + F.wave);
                __syncthreads(); } }
        for (int row = MP + F.gw; row < MP + MS; row += F.ngw) rwkv_post_rows<1, false>(P, row, 0, F.lane, (const LAS float*)F.lds, 0);
    }
    STAMP(5);
    SEAM(6);
#define GEMM_PHASE(EPI_T, epi, Aptr, Bptr, N_, K_, nskinny) do { \
        { pg8::Gemm g{(const bf16*)(Aptr), (const bf16*)(Bptr), MP, (N_), (K_)}; pg8::StaticOrder S; S.init(MP, (N_), F.G, (int)blockIdx.x); EpiHead<EPI_T> E{epi}; \
          pg8::gemm_phase<EpiHead<EPI_T>, pg8::StaticOrder, PG8_ALIGN, PG8_SP2>(F.lds, g, S, E); } \
        __syncthreads(); \
        for (int u = F.G - 1 - (int)blockIdx.x; u < 2 * (nskinny); u += F.G) skinny_unit(F.lds, (const bf16*)(Aptr), (const bf16*)(Bptr), (K_), MP, 32 * u, epi, F.wave, F.lane); } while (0)
    bf16* Hb = (bf16*)(ws + WS_H); float* SSb = (float*)(ws + WS_SS);
#define GEMM_PHASE_SC(EPI_T, epi, ssp, Aptr, Bptr, N_, K_, nskinny) do { \
        { pg8::Gemm g{(const bf16*)(Aptr), (const bf16*)(Bptr), MP, (N_), (K_)}; pg8::StaticOrder S; S.init(MP, (N_), F.G, (int)blockIdx.x); EpiHeadScaled<EPI_T> E{epi, (ssp)}; \
          pg8::gemm_phase<EpiHeadScaled<EPI_T>, pg8::StaticOrder, PG8_ALIGN, PG8_SP2>(F.lds, g, S, E); } \
        __syncthreads(); \
        { RowScaled<EPI_T> es{epi, (ssp)}; for (int u = F.G - 1 - (int)blockIdx.x; u < 2 * (nskinny); u += F.G) skinny_unit(F.lds, (const bf16*)(Aptr), (const bf16*)(Bptr), (K_), MP, 32 * u, es, F.wave, F.lane); } } while (0)
#define RESID_PHASE(F32, baseP, baseS, Aptr, Bptr, K_, ssk) do { \
        { pg8::Gemm g{(const bf16*)(Aptr), (const bf16*)(Bptr), MP, 1024, (K_)}; pg8::StaticOrder S; S.init(MP, 1024, F.G, (int)blockIdx.x); EpiResidN<F32> E{(const void*)(baseP), Hb, SSb + (size_t)(ssk) * MT}; \
          pg8::gemm_phase<EpiResidN<F32>, pg8::StaticOrder, PG8_ALIGN, PG8_SP2>(F.lds, g, S, E); } \
        __syncthreads(); \
        { EpiResidNS<F32> es{(const void*)(baseS), Hb, SSb + (size_t)(ssk) * MT}; \
          for (int u = F.G - 1 - (int)blockIdx.x; u < 32; u += F.G) skinny_unit(F.lds, (const bf16*)(Aptr), (const bf16*)(Bptr), (K_), MP, 32 * u, es, F.wave, F.lane); } } while (0)
    if (IN(8)) { RESID_PHASE(true, INF(0), INF(1), ws + WS_ATT, ws + WS_WOUT0, 1024, 0); }
    SEAM(8);
    if (IN(10)) { EpiSwiglu e{(bf16*)(ws + WS_HFF)}; GEMM_PHASE_SC(EpiSwiglu, e, SSb, Hb, ws + WS_WGU0, 5632, 1024, 88); __syncthreads(); bg_drain_w1(P, F, ctl); }
    SEAM(10);
    if (IN(11)) { RESID_PHASE(false, Hb, Hb + (size_t)MP * D, ws + WS_HFF, ws + WS_WDN0, FF, 1); }
    SEAM(11);
    if (IN(13)) { EpiIn1 e{(bf16*)(ws + WS_Q1), (bf16*)(ws + WS_K1), (bf16*)(ws + WS_K1S), (const f32x2*)(ws + WS_ROPE), P.out};
        GEMM_PHASE_SC(EpiIn1, e, SSb + (size_t)MT, Hb, ws + WS_WIN1, 1536, 1024, 24); __syncthreads(); if ((int)blockIdx.x >= 128) bg_drain_means(P, F, ctl, 4); }
    SEAM(13);
    if (IN(14)) { moba_means(P, F); __syncthreads(); bg_drain_means(P, F, ctl, 1 << 30); }
    SEAM(14);
    if (IN(15)) {
        volatile LAS int* wslot = (volatile LAS int*)(F.lds + LDS_BYTES - 128 + 64);
        for (;;) { const int u = wq_next(ctl + 8256, wslot, F.tid); if (u >= 1152) break;
            const bool samp = u < 512 && (u & 3) == 0; const int v = u < 512 ? (samp ? (u >> 2) : u - ((u + 3) >> 2)) : u - 128;
            if (samp) moba_sample_unit(P, F, v >> 2, v & 3);
            else moba_prompt_unit(P, F, (v & 15) >> 2, v & 3, 63 - (v >> 4)); }
    }
    SEAM(15);
    if (IN(16)) { RESID_PHASE(false, Hb, Hb + (size_t)MP * D, ws + WS_ATT, ws + WS_WOUT1, 1024, 2); }
    SEAM(16);
    if (IN(18)) { EpiSwiglu e{(bf16*)(ws + WS_HFF)}; GEMM_PHASE_SC(EpiSwiglu, e, SSb + (size_t)2 * MT, Hb, ws + WS_WGU1, 5632, 1024, 88); }
    SEAM(18);
    if (IN(19)) { RESID_PHASE(false, Hb, Hb + (size_t)MP * D, ws + WS_HFF, ws + WS_WDN1, FF, 3); }
    SEAM(19);
    if (IN(20)) { final_norm(P, F); }
#if MK_DIAG
    xcd_barrier(bar); STAMP(20);
    if (blockIdx.x == 0) { __syncthreads();
#define DIAG_OUT2(OFF, SLO, SHI) do { unsigned n_ = (unsigned)((__hip_atomic_load(tstamp + (SHI), __ATOMIC_RELAXED, __HIP_MEMORY_SCOPE_AGENT) - __hip_atomic_load(tstamp + (SLO), __ATOMIC_RELAXED, __HIP_MEMORY_SCOPE_AGENT) + ((MK_DIAG == 5 || MK_DIAG == 9) ? 100ull : 500ull)) / ((MK_DIAG == 5 || MK_DIAG == 9) ? 200ull : 1000ull)); \
            if (n_ > 7000u) n_ = 7000u; for (unsigned i_ = F.tid; i_ < n_; i_ += 512) ((unsigned*)P.out)[(OFF) + i_] = 0xAAAAAAAAu; } while (0)
#if MK_DIAG == 1
        DIAG_OUT2(O_YP, 0, 1); DIAG_OUT2(O_NSAP, 1, 2); DIAG_OUT2(O_MOBP, 3, 4);
#elif MK_DIAG == 2
        DIAG_OUT2(O_YP, 4, 5); DIAG_OUT2(O_NSAP, 5, 6); DIAG_OUT2(O_MOBP, 6, 7);
#elif MK_DIAG == 3
        DIAG_OUT2(O_YP, 7, 9); DIAG_OUT2(O_NSAP, 9, 11); DIAG_OUT2(O_MOBP, 11, 12);
#elif MK_DIAG == 4
        DIAG_OUT2(O_YP, 12, 14); DIAG_OUT2(O_NSAP, 14, 15); DIAG_OUT2(O_MOBP, 15, 16);
#elif MK_DIAG == 10
        DIAG_OUT2(O_YP, 2, 3); DIAG_OUT2(O_NSAP, 3, 4); DIAG_OUT2(O_MOBP, 4, 5);
#elif MK_DIAG == 11
        DIAG_OUT2(O_YP, 5, 31); DIAG_OUT2(O_NSAP, 5, 6); DIAG_OUT2(O_MOBP, 6, 7);
#elif MK_DIAG == 9
        DIAG_OUT2(O_YP, 4, 51); DIAG_OUT2(O_NSAP, 51, 53); DIAG_OUT2(O_MOBP, 53, 54);
#else
        DIAG_OUT2(O_YP, 16, 17); DIAG_OUT2(O_NSAP, 17, 19); DIAG_OUT2(O_MOBP, 19, 21);
#endif
#undef DIAG_OUT2
    }
#endif
#undef GEMM_PHASE
#undef GEMM_PHASE_SC
#undef RESID_PHASE
#undef IN
#undef SEAM
}

extern "C" void kernel_launch(void* const* d_in, const int* in_sizes, int n_in, void* d_out, int out_size, void* d_ws, size_t ws_size, hipStream_t stream) {
    static int grid = 0;
    if (grid == 0) {
        if (n_in != 33 || (size_t)out_size != O_END || ws_size < WS_END4) { fprintf(stderr, "kernel_launch: unexpected shapes n_in %d out %d ws %zu (need %zu)\n", n_in, out_size, ws_size, (size_t)WS_END4); grid = -1; return; }
        int dev = 0, cus = 0, per_cu = 0;
        if (hipGetDevice(&dev) != hipSuccess || hipDeviceGetAttribute(&cus, hipDeviceAttributeMultiprocessorCount, dev) != hipSuccess) { grid = -1; return; }
        if (hipFuncSetAttribute((const void*)mk_fwd, hipFuncAttributeMaxDynamicSharedMemorySize, LDS_BYTES) != hipSuccess) { fprintf(stderr, "kernel_launch: hipFuncSetAttribute failed\n"); grid = -1; return; }
        if (hipOccupancyMaxActiveBlocksPerMultiprocessor(&per_cu, (const void*)mk_fwd, 512, LDS_BYTES) != hipSuccess || per_cu < 1) fprintf(stderr, "kernel_launch: occupancy query says %d\n", per_cu);
        (void)hipGetLastError();
        grid = cus;
    }
    if (grid < 0) return;
    if (hipMemsetAsync((char*)d_ws + WS_CTL, 0, CTL_BYTES, stream) != hipSuccess) return;
    Params p{};
    for (int i = 0; i < 33; ++i) p.in[i] = d_in[i];
    p.out = (float*)d_out; p.ws = (unsigned char*)d_ws;
#ifndef MK_LAUNCH_PER_PHASE
#define MK_LAUNCH_PER_PHASE 0
#endif
#if MK_LAUNCH_PER_PHASE
    for (int k = 0; k < N_PHASES; ++k) { p.ph_lo = k; p.ph_hi = k + 1; hipLaunchKernelGGL(mk_fwd, dim3(grid), dim3(512), LDS_BYTES, stream, p); }
#else
    p.ph_lo = 0; p.ph_hi = N_PHASES; hipLaunchKernelGGL(mk_fwd, dim3(grid), dim3(512), LDS_BYTES, stream, p);
#endif
}
```

```cpp
#include <hip/hip_runtime.h>
#include <cstdio>
#include <cstdint>
namespace pg8 {
#define PG8_LAS __attribute__((address_space(3)))
typedef unsigned short bf16_t;
typedef short bf16x8 __attribute__((ext_vector_type(8)));
typedef float f32x4 __attribute__((ext_vector_type(4)));
typedef unsigned u32x4 __attribute__((ext_vector_type(4)));
constexpr int BM = 256, BK = 64, HALF = 128, HTB = HALF * BK * 2  , STAGE_BYTES = 8 * HTB, NXCD = 8, WGM = 8;

__host__ __device__ __forceinline__ int lds_byte(int r, int c) { const int st = (r >> 4) * 2 + (c >> 5), rr = r & 15, cc = c & 31, ob = rr * 64 + cc * 2; return st * 1024 + (ob ^ (((ob >> 9) & 1) << 5)); }
__host__ __device__ __forceinline__ void stage_rc(int b, int& R, int& C) { const int st = b / 1024, sb = b % 1024, swz = sb ^ (((sb >> 9) & 1) << 5); R = (st >> 1) * 16 + swz / 64; C = (st & 1) * 32 + (swz % 64) / 2; }
__host__ __device__ __forceinline__ int perm32(int rho) { const int n = rho >> 4, i = rho & 15; return 8 * (i >> 2) + 4 * n + (i & 3); }

struct Unit { int pm, pn; };
struct Gemm { const bf16_t* A; const bf16_t* Bt; int M, N, K; };

struct StaticOrder {
    int nM, nN, nwg, G, c;
    __host__ __device__ void init(int M, int N, int G_, int c_) { nM = M / BM; nN = N / BM; nwg = nM * nN; G = G_; c = c_; }
    __host__ __device__ bool next(int i, Unit& u) const {
        const long L = (long)i * G + c; if (L >= nwg) return false;
        int wgid = (int)L; { const int q = nwg / NXCD, r = nwg % NXCD, xcd = wgid % NXCD, off = wgid / NXCD; wgid = (xcd < r ? xcd * (q + 1) : r * (q + 1) + (xcd - r) * q) + off; }
        const int nig = WGM * nN, gid = wgid / nig, fm = gid * WGM, gsz = (nM - fm) < WGM ? (nM - fm) : WGM;
        u.pm = fm + ((wgid % nig) % gsz); u.pn = (wgid % nig) / gsz; return true;
    }
    __device__ __forceinline__ void a_ready(const Unit&) const {}
    __device__ __forceinline__ void done(const Unit&) const {}
};

template <class Epi, class Sched, bool ALIGN_EPI = false, bool SP2 = false>
__device__ __forceinline__ void gemm_phase(PG8_LAS unsigned char* lds, const Gemm g, const Sched& S, const Epi& E) {
    const int tid = threadIdx.x, wid = __builtin_amdgcn_readfirstlane(tid >> 6), lane = tid & 63, wr = wid >> 2, wc = wid & 3, fr = lane & 15, fq = lane >> 4;
    const int K = g.K, nt = K / BK;
    unsigned voffA[2], voffB[2];
#pragma unroll
    for (int i = 0; i < 2; ++i) { int R, C; stage_rc(tid * 16 + i * 8192, R, C); const int Rb = Epi::PERM ? ((R & ~31) + perm32(R & 31)) : R;
        voffA[i] = (unsigned)(R * K + C) * 2u; voffB[i] = (unsigned)(Rb * K + C) * 2u; }
    const size_t kstep = (size_t)(BK * 2);
    const size_t hstep = (size_t)HALF * K * 2;
    const size_t tstep = 2 * hstep;
    const unsigned ldsw = (unsigned)wid * 1024u;
    const int aoff = lds_byte(wr * 64 + fr, fq * 8), boff = lds_byte(wc * 32 + fr, fq * 8);
#define PG8_SA(b, h) (((b) * 2 + (h)) * HTB)
#define PG8_SB(b, h) ((4 + (b) * 2 + (h)) * HTB)
#define PG8_STAGE(bufoff, gbase, voff) do { _Pragma("unroll") for (int _i = 0; _i < 2; ++_i) \
        __builtin_amdgcn_global_load_lds((const unsigned*)((const char*)(gbase) + (voff)[_i]), (PG8_LAS unsigned*)(lds + (bufoff) + ldsw + _i * 8192), 16, 0, 0); } while (0)
#define PG8_LDA(dst, b, h) do { _Pragma("unroll") for (int m = 0; m < 4; ++m) _Pragma("unroll") for (int k = 0; k < 2; ++k) dst[m][k] = *(const PG8_LAS bf16x8*)(lds + PG8_SA(b, h) + aoff + m * 2048 + k * 1024); } while (0)
#define PG8_LDB(dst, b, h) do { _Pragma("unroll") for (int n = 0; n < 2; ++n) _Pragma("unroll") for (int k = 0; k < 2; ++k) dst[n][k] = *(const PG8_LAS bf16x8*)(lds + PG8_SB(b, h) + boff + n * 2048 + k * 1024); } while (0)
#define PG8_MMA(ai, bj, At, Bt) do { __builtin_amdgcn_s_setprio(1); _Pragma("unroll") for (int m = 0; m < 4; ++m) _Pragma("unroll") for (int n = 0; n < 2; ++n) _Pragma("unroll") for (int k = 0; k < 2; ++k) \
        acc[ai][bj][m][n] = __builtin_amdgcn_mfma_f32_16x16x32_bf16(Bt[n][k], At[m][k], acc[ai][bj][m][n], 0, 0, 0); __builtin_amdgcn_s_setprio(0); } while (0)
#define PG8_WAIT_V(n) asm volatile("s_waitcnt vmcnt(" #n ")" ::: "memory")
#define PG8_WAIT_L(n) asm volatile("s_waitcnt lgkmcnt(" #n ")" ::: "memory")
#define PG8_BAR __builtin_amdgcn_s_barrier()
#define PG8_SCHED __builtin_amdgcn_sched_barrier(0)
    Unit cur, nxt; int ui = 0;
    if (!S.next(0, cur)) return;
    f32x4 acc[2][2][4][2];
#pragma unroll
    for (int a = 0; a < 2; ++a)
#pragma unroll
        for (int b = 0; b < 2; ++b)
#pragma unroll
            for (int m = 0; m < 4; ++m)
#pragma unroll
                for (int n = 0; n < 2; ++n) acc[a][b][m][n] = (f32x4){0.f, 0.f, 0.f, 0.f};
    bf16x8 At[4][2], B0[2][2], B1[2][2];
    const char* cA = (const char*)g.A + (size_t)cur.pm * tstep; const char* cB = (const char*)g.Bt + (size_t)cur.pn * tstep;
    S.a_ready(cur);
    if constexpr (SP2) {
        PG8_STAGE(PG8_SB(0, 0), cB, voffB); PG8_STAGE(PG8_SB(0, 1), cB + hstep, voffB); PG8_STAGE(PG8_SA(0, 0), cA, voffA); PG8_STAGE(PG8_SA(0, 1), cA + hstep, voffA);
        if (wr == 1) PG8_BAR;
        PG8_WAIT_V(2); PG8_BAR;
        PG8_STAGE(PG8_SB(1, 0), cB + kstep, voffB); PG8_STAGE(PG8_SA(1, 0), cA + kstep, voffA); PG8_STAGE(PG8_SB(1, 1), cB + hstep + kstep, voffB);
        PG8_WAIT_V(6); PG8_BAR;
    } else {
        PG8_STAGE(PG8_SB(0, 0), cB, voffB); PG8_STAGE(PG8_SA(0, 0), cA, voffA); PG8_STAGE(PG8_SB(0, 1), cB + hstep, voffB); PG8_STAGE(PG8_SA(0, 1), cA + hstep, voffA);
        if (wr == 1) PG8_BAR;
        PG8_WAIT_V(4); PG8_BAR;
        PG8_STAGE(PG8_SB(1, 0), cB + kstep, voffB); PG8_STAGE(PG8_SA(1, 0), cA + kstep, voffA); PG8_STAGE(PG8_SB(1, 1), cB + hstep + kstep, voffB);
        PG8_WAIT_V(6); PG8_BAR;
    }
    for (;;) {
        const bool has_next = S.next(ui + 1, nxt);
        const char* nA = has_next ? (const char*)g.A + (size_t)nxt.pm * tstep : cA; const char* nB = has_next ? (const char*)g.Bt + (size_t)nxt.pn * tstep : cB;
        for (int t = 0; t < nt; t += 2) {
            const bool last = (t == nt - 2);
            const char* a1 = cA + (size_t)(t + 1) * kstep;
            const char* a2 = last ? nA : cA + (size_t)(t + 2) * kstep; const char* b2 = last ? nB : cB + (size_t)(t + 2) * kstep;
            const char* a3 = a2 + kstep; const char* b3 = b2 + kstep;
            if (last && has_next) S.a_ready(nxt);
            if constexpr (SP2) {
            PG8_LDB(B0, 0, 0); PG8_LDB(B1, 0, 1); PG8_SCHED; PG8_LDA(At, 0, 0); PG8_STAGE(PG8_SA(1, 1), a1 + hstep, voffA);
            PG8_WAIT_V(8); PG8_WAIT_L(0); PG8_BAR; PG8_MMA(0, 0, At, B0); PG8_MMA(0, 1, At, B1); PG8_BAR; PG8_SCHED;
            PG8_LDA(At, 0, 1); PG8_STAGE(PG8_SB(0, 0), b2, voffB); PG8_STAGE(PG8_SB(0, 1), b2 + hstep, voffB); PG8_STAGE(PG8_SA(0, 0), a2, voffA);
            PG8_WAIT_V(8); PG8_WAIT_L(0); PG8_BAR; PG8_MMA(1, 0, At, B0); PG8_MMA(1, 1, At, B1); PG8_BAR; PG8_SCHED;
            PG8_LDB(B0, 1, 0); PG8_LDB(B1, 1, 1); PG8_SCHED; PG8_LDA(At, 1, 0); PG8_STAGE(PG8_SA(0, 1), a2 + hstep, voffA);
            PG8_WAIT_V(8); PG8_WAIT_L(0); PG8_BAR; PG8_MMA(0, 0, At, B0); PG8_MMA(0, 1, At, B1); PG8_BAR; PG8_SCHED;
            PG8_LDA(At, 1, 1); PG8_STAGE(PG8_SB(1, 0), b3, voffB); PG8_STAGE(PG8_SB(1, 1), b3 + hstep, voffB); PG8_STAGE(PG8_SA(1, 0), a3, voffA);
            PG8_WAIT_V(8); PG8_WAIT_L(0); PG8_BAR; PG8_MMA(1, 0, At, B0); PG8_MMA(1, 1, At, B1); PG8_BAR; PG8_SCHED;
            } else {
            PG8_LDB(B0, 0, 0); PG8_SCHED; PG8_LDA(At, 0, 0); PG8_STAGE(PG8_SA(1, 1), a1 + hstep, voffA);
            PG8_WAIT_L(8); PG8_BAR; PG8_WAIT_L(0); PG8_MMA(0, 0, At, B0); PG8_BAR; PG8_SCHED;
            PG8_LDB(B1, 0, 1); PG8_STAGE(PG8_SB(0, 0), b2, voffB);
            PG8_BAR; PG8_WAIT_L(0); PG8_MMA(0, 1, At, B1); PG8_BAR;
            PG8_LDA(At, 0, 1); PG8_STAGE(PG8_SA(0, 0), a2, voffA);
            PG8_BAR; PG8_WAIT_L(0); PG8_MMA(1, 0, At, B0); PG8_BAR; PG8_SCHED;
            PG8_STAGE(PG8_SB(0, 1), b2 + hstep, voffB);
            PG8_WAIT_V(6); PG8_BAR; PG8_MMA(1, 1, At, B1); PG8_BAR;
            PG8_LDB(B0, 1, 0); PG8_SCHED; PG8_LDA(At, 1, 0); PG8_STAGE(PG8_SA(0, 1), a2 + hstep, voffA);
            PG8_WAIT_L(8); PG8_BAR; PG8_WAIT_L(0); PG8_MMA(0, 0, At, B0); PG8_BAR; PG8_SCHED;
            PG8_LDB(B1, 1, 1); PG8_STAGE(PG8_SB(1, 0), b3, voffB);
            PG8_BAR; PG8_WAIT_L(0); PG8_MMA(0, 1, At, B1); PG8_BAR;
            PG8_LDA(At, 1, 1); PG8_STAGE(PG8_SA(1, 0), a3, voffA);
            PG8_BAR; PG8_WAIT_L(0); PG8_MMA(1, 0, At, B0); PG8_BAR; PG8_SCHED;
            PG8_STAGE(PG8_SB(1, 1), b3 + hstep, voffB);
            PG8_WAIT_V(6); PG8_BAR; PG8_MMA(1, 1, At, B1); PG8_BAR;
            }
        }
        if constexpr (ALIGN_EPI) { if (wr == 0) PG8_BAR; }
        if constexpr (!Epi::AFTER_DRAIN) { E(acc, cur, wr, wc, fr, fq); S.done(cur); }
        if (!has_next) break;
#pragma unroll
        for (int a = 0; a < 2; ++a)
#pragma unroll
            for (int b = 0; b < 2; ++b)
#pragma unroll
                for (int m = 0; m < 4; ++m)
#pragma unroll
                    for (int n = 0; n < 2; ++n) acc[a][b][m][n] = (f32x4){0.f, 0.f, 0.f, 0.f};
        cur = nxt; cA = nA; cB = nB; ++ui;
        if constexpr (ALIGN_EPI) { if (wr == 1) PG8_BAR; }
    }
    PG8_WAIT_V(0);
    if constexpr (!ALIGN_EPI) { if (wr == 0) PG8_BAR; }
    PG8_BAR;
    if constexpr (Epi::AFTER_DRAIN) { E.fused(acc, cur, wr, wc, fr, fq, lds, wid, lane); S.done(cur); }
#undef PG8_SA
#undef PG8_SB
#undef PG8_STAGE
#undef PG8_LDA
#undef PG8_LDB
#undef PG8_MMA
#undef PG8_WAIT_V
#undef PG8_WAIT_L
#undef PG8_BAR
#undef PG8_SCHED
}
}
#define PG8_SP2 true
#define PG8_ALIGN true
#define GAS __attribute__((address_space(1)))
#define LAS __attribute__((address_space(3)))
#define MK_DIAG 0
typedef unsigned short bf16;
typedef unsigned v4u __attribute__((ext_vector_type(4)));
typedef unsigned v2u __attribute__((ext_vector_type(2)));
typedef float f32x4 __attribute__((ext_vector_type(4)));
typedef float f32x2 __attribute__((ext_vector_type(2)));
typedef float f32x16 __attribute__((ext_vector_type(16)));
typedef short bf16x8 __attribute__((ext_vector_type(8)));
typedef short s16x4 __attribute__((ext_vector_type(4)));
typedef __bf16 bf16x2_t __attribute__((ext_vector_type(2)));
#define DI __device__ __forceinline__
#define LDS_WAIT() asm volatile("s_waitcnt lgkmcnt(0)" ::: "memory")
#define VM_WAIT() asm volatile("s_waitcnt vmcnt(0)" ::: "memory")

DI unsigned pk2(float lo, float hi) { f32x2 v = {lo, hi}; bf16x2_t b = __builtin_convertvector(v, bf16x2_t); return __builtin_bit_cast(unsigned, b); }
DI float bflo(unsigned u) { return __uint_as_float(u << 16); }
DI float bfhi(unsigned u) { return __uint_as_float(u & 0xffff0000u); }
DI float bf2f(bf16 u) { return __uint_as_float((unsigned)u << 16); }
DI float wave_sum(float v) {
#pragma unroll
    for (int o = 1; o < 64; o <<= 1) v += __shfl_xor(v, o);
    return v;
}
DI float sigmoidf_(float x) { return 1.0f / (1.0f + __expf(-x)); }
constexpr float ATT_SC = 0.125f * 1.4426950408889634f;

constexpr int D = 1024, MP = 16384, MS = 128, MT = 16640, SEQ = 4096, NB = 4, NSQ = 32, TS = 4;
constexpr int RWC = 1792, FF = 2816, NPG = 64, PAGE = 128, PAST = 8192;
constexpr int NWAVES = 8;
constexpr size_t O_YP = 0, O_YS = O_YP + (size_t)MP * D, O_NSAP = O_YS + (size_t)MS * D, O_NSAS = O_NSAP + (size_t)MP * 512,
                 O_MOBP = O_NSAS + (size_t)MS * 512, O_MOBS = O_MOBP + (size_t)MP * 512, O_WINP = O_MOBS + (size_t)MS * 512,
                 O_WINS = O_WINP + (size_t)NB * 512 * 256, O_WKVP = O_WINS + (size_t)NSQ * 512 * 256, O_WKVS = O_WKVP + (size_t)NB * 8 * 4096,
                 O_SHP = O_WKVS + (size_t)NSQ * 8 * 4096, O_SHS = O_SHP + (size_t)NB * RWC, O_END = O_SHS + (size_t)NSQ * RWC;
constexpr size_t al(size_t x) { return (x + 4095) & ~(size_t)4095; }
constexpr size_t WS_CTL = 0, CTL_BYTES = 1u << 20;
constexpr size_t WS_ROPE  = CTL_BYTES;
constexpr size_t WS_WIN0  = al(WS_ROPE + (size_t)4100 * 32 * 8);
constexpr size_t WS_WG0   = al(WS_WIN0 + (size_t)3072 * 1024 * 2);
constexpr size_t WS_WOUT0 = al(WS_WG0 + (size_t)64 * 1024 * 2);
constexpr size_t WS_WGU0  = al(WS_WOUT0 + (size_t)1024 * 1024 * 2);
constexpr size_t WS_WDN0  = al(WS_WGU0 + (size_t)5632 * 1024 * 2);
constexpr size_t WS_WIN1  = al(WS_WDN0 + (size_t)1024 * 2816 * 2);
constexpr size_t WS_WOUT1 = al(WS_WIN1 + (size_t)1536 * 1024 * 2);
constexpr size_t WS_WGU1  = al(WS_WOUT1 + (size_t)1024 * 1024 * 2);
constexpr size_t WS_WDN1  = al(WS_WGU1 + (size_t)5632 * 1024 * 2);
constexpr size_t WS_WLORA = al(WS_WDN1 + (size_t)1024 * 2816 * 2);
constexpr size_t WS_WCMP  = al(WS_WLORA + (size_t)1536 * 256 * 2);
constexpr size_t WS_XN    = al(WS_WCMP + (size_t)256 * 1024 * 2);
constexpr size_t WS_RW    = al(WS_XN + (size_t)MT * 1024 * 2);
constexpr size_t WS_Q0    = al(WS_RW + (size_t)MT * RWC * 2);
constexpr size_t WS_GATES = al(WS_Q0 + (size_t)MT * 512 * 2);
constexpr size_t WS_KV0   = al(WS_GATES + (size_t)MT * 32 * 4);
constexpr size_t WS_KVS0  = al(WS_KV0 + (size_t)6 * 4 * 2 * 4096 * 64 * 2);
constexpr size_t WS_ACMPS = al(WS_KVS0 + (size_t)6 * 32 * 2 * 4 * 64 * 2);
constexpr size_t WS_HCP   = al(WS_ACMPS + (size_t)2 * 32 * 2 * 8192 * 64 * 2);
constexpr size_t WS_HCS   = al(WS_HCP + (size_t)4096 * 128 * 4);
constexpr size_t WS_MEANS = al(WS_HCS + (size_t)65536 * 128 * 4);
constexpr size_t WS_END0  = al(WS_MEANS + (size_t)32 * 4 * 32 * 64 * 4);
#define XB_TMO      128
#define XB_XCNT(j)  (256  + 64 * (j))
#define XB_XSUB(j)  (1280 + 64 * (j))
#define XB_XGEN(j)  (2304 + 64 * (j))
#define XB_TOP      3328
#define XB_TOPGEN   3392
#define XCD_BAR_WORDS 3456
#define XB_SPIN_CAP (1u << 18)

__device__ __forceinline__ unsigned xb_ld(unsigned* p)              { return __hip_atomic_load(p, __ATOMIC_RELAXED, __HIP_MEMORY_SCOPE_AGENT); }
__device__ __forceinline__ unsigned xb_add(unsigned* p, unsigned v) { return __hip_atomic_fetch_add(p, v, __ATOMIC_RELAXED, __HIP_MEMORY_SCOPE_AGENT); }
__device__ __forceinline__ unsigned xb_xcc_id() { return (unsigned)__builtin_amdgcn_s_getreg((3 << 11) | 20) & 0xFu; }
#define XB_SPIN(cond, bar) do { unsigned _sp = 0; while (cond) { __builtin_amdgcn_s_sleep(1); \
    if ((++_sp & 255u) == 0u) { if (xb_ld(&(bar)[XB_TMO])) break; if (_sp > XB_SPIN_CAP) { atomicAdd(&(bar)[XB_TMO], 1u); break; } } } } while (0)

struct XcdBarrier {
    unsigned* bar; unsigned x;
    volatile LAS unsigned* st;
};

__device__ __forceinline__ XcdBarrier xcd_barrier_post(unsigned* bar, volatile LAS unsigned* st) {
    XcdBarrier b; b.bar = bar; b.x = xb_xcc_id(); b.st = st;
    if (threadIdx.x == 0) (void)xb_add(&bar[XB_XCNT(b.x)], 1u);
    return b;
}
__device__ __forceinline__ void xcd_barrier_complete(unsigned* bar, unsigned x, unsigned& nloc, unsigned& nx) {
    const unsigned G = gridDim.x * gridDim.y * gridDim.z;
    unsigned sum, cnt, mine, sp = 0u;
    for (;;) {
        sum = 0u; cnt = 0u; mine = 0u;
#pragma unroll
        for (unsigned j = 0; j < 16; ++j) { const unsigned c = xb_ld(&bar[XB_XCNT(j)]); sum += c; cnt += (c > 0u) ? 1u : 0u; mine = (j == x) ? c : mine; }
        if (sum == G) break;
        __builtin_amdgcn_s_sleep(1);
        if ((++sp & 255u) == 0u) { if (xb_ld(&bar[XB_TMO])) break; if (sp > XB_SPIN_CAP) { atomicAdd(&bar[XB_TMO], 1u); break; } }
    }
    nloc = mine > 0u ? mine : 1u; nx = cnt > 0u ? cnt : 1u;
}

__device__ __forceinline__ void xcd_barrier(const XcdBarrier& b) {
    asm volatile("s_waitcnt vmcnt(0)" ::: "memory");
    __syncthreads();
    if (threadIdx.x == 0) {
        unsigned* bar = b.bar;
        __builtin_amdgcn_s_waitcnt(0);
        unsigned nloc = b.st[0], nx = b.st[1];
        if (nloc == 0u) { xcd_barrier_complete(bar, b.x, nloc, nx); b.st[0] = nloc; b.st[1] = nx; }
        const unsigned old = xb_add(&bar[XB_XSUB(b.x)], 1u);
        const unsigned gen = old / nloc;
        if (old + 1u == (gen + 1u) * nloc) {
            __builtin_amdgcn_fence(__ATOMIC_RELEASE, "agent");
            asm volatile("s_waitcnt vmcnt(0)" ::: "memory");
            const unsigned og = xb_add(&bar[XB_TOP], 1u);
            const unsigned tg = og / nx;
            if (og + 1u == (tg + 1u) * nx) xb_add(&bar[XB_TOPGEN], 1u);
            else XB_SPIN(xb_ld(&bar[XB_TOPGEN]) == tg, bar);
            __builtin_amdgcn_fence(__ATOMIC_ACQUIRE, "agent");
            xb_add(&bar[XB_XGEN(b.x)], 1u);
            asm volatile("s_waitcnt vmcnt(0)" ::: "memory");
        } else {
            XB_SPIN(xb_ld(&bar[XB_XGEN(b.x)]) == gen, bar);
            __builtin_amdgcn_fence(__ATOMIC_ACQUIRE, "agent");
            asm volatile("s_waitcnt vmcnt(0)" ::: "memory");
        }
    }
    __syncthreads();
}
struct Params { const void* in[33]; float* out; unsigned char* ws; int ph_lo, ph_hi; };
struct Frame { LAS unsigned char* lds; int tid, lane, wave, G, gw, ngw; };
#define INF(i) ((const float*)P.in[i])
constexpr int LDS_BYTES = 147456;
constexpr int RING_BYTES = 131072, MISC_OFF = LDS_BYTES - 128;

DI void dsincos(double r, double& s, double& c) {
    const double r2 = r * r; double ss = 1.0, cc = 1.0;
#pragma unroll
    for (int n = 16; n >= 1; --n) { ss = 1.0 - r2 * (1.0 / (double)((2 * n) * (2 * n + 1))) * ss; cc = 1.0 - r2 * (1.0 / (double)((2 * n - 1) * (2 * n))) * cc; }
    s = r * ss; c = cc;
}
DI void p0_rope(const Params& P, const Frame& F) {
    f32x2* tab = (f32x2*)(P.ws + WS_ROPE);
    for (int idx = blockIdx.x * 512 + F.tid; idx < 4100 * 32; idx += F.G * 512) {
        const int pi = idx >> 5, i = idx & 31; const int pos = pi < 4096 ? pi : 8192 + (pi - 4096);
        const float inv = exp2f(-(float)i * 0.41524101186092029f);
        const float ang = (float)pos * inv;
        const double a = (double)ang; const double k = rint(a * 0.15915494309189535); const double r = fma(-k, 6.283185307179586, a);
        double s, c; dsincos(r, s, c);
        tab[idx] = (f32x2){(float)c, (float)s};
    }
}
struct ColRef { const float* p; int ld, klo, khi; };
DI int perm64(int p) { return 32 * ((p >> 4) & 1) + 16 * (p >> 5) + (p & 15); }
DI int logical_col(int n) { return (n & ~63) + perm64(n & 63); }
template <class Src> DI void tr_item(const Src& S, int K, int nphys, bf16* WT, LAS float* scr, int item, int lane, const float* gain = nullptr) {
    const int nblk = nphys / 32, kb = item / nblk, nb = item % nblk, k0 = 64 * kb, n0 = 32 * nb;
    const int kr = lane >> 3, q = lane & 7;
    const ColRef cr = S.col(n0 + 4 * q);
    f32x4 v[8];
#pragma unroll
    for (int i = 0; i < 8; ++i) { const int k = k0 + 8 * i + kr; v[i] = (f32x4){0.f, 0.f, 0.f, 0.f};
        if (k >= cr.klo && k < cr.khi) v[i] = *(const f32x4*)(cr.p + (size_t)(k - cr.klo) * cr.ld);
        if (gain) v[i] *= gain[k]; }
#pragma unroll
    for (int i = 0; i < 8; ++i) *(LAS f32x4*)(scr + (8 * i + kr) * 36 + 4 * q) = v[i];
    LDS_WAIT(); asm volatile("" ::: "memory");
    const int c = lane & 7;
#pragma unroll
    for (int j = 0; j < 4; ++j) { const int n = (lane >> 3) + 8 * j; const LAS float* s = scr + (8 * c) * 36 + n;
        v4u o; o.x = pk2(s[0 * 36], s[1 * 36]); o.y = pk2(s[2 * 36], s[3 * 36]); o.z = pk2(s[4 * 36], s[5 * 36]); o.w = pk2(s[6 * 36], s[7 * 36]);
        *(v4u*)(WT + (size_t)(n0 + n) * K + k0 + 8 * c) = o; }
    LDS_WAIT(); asm volatile("" ::: "memory");
}
struct SrcPlain { const float* W; int ld, ncols;
    DI ColRef col(int n) const { const int l = logical_col(n); ColRef r; r.p = W + (l < ncols ? l : 0); r.ld = ld; r.klo = 0; r.khi = (l < ncols) ? (1 << 30) : 0; return r; } };
struct SrcGate { const float* W;
    DI ColRef col(int n) const { const int l = logical_col(n); const bool ok = l < 16 || (l >= 32 && l < 40); const int c = l < 16 ? l : l - 16; ColRef r; r.p = W + (ok ? c : 0); r.ld = 3096; r.klo = 0; r.khi = ok ? (1 << 30) : 0; return r; } };
struct SrcGU { const float* Wg; const float* Wu;
    DI ColRef col(int n) const { const int l = logical_col(n), hd = l >> 6, d = l & 63; ColRef r; const uintptr_t a_ = (uintptr_t)Wg, b_ = (uintptr_t)Wu, m_ = (uintptr_t)0 - (uintptr_t)(d >= 32); r.p = (const float*)(a_ ^ ((a_ ^ b_) & m_)) + 32 * hd + (d & 31); r.ld = FF; r.klo = 0; r.khi = 1 << 30; return r; } };
struct SrcLora { const float* wu; const float* au; const float* gu;
    DI ColRef col(int n) const { const int l = logical_col(n), reg = l >> 9, c = l & 511; ColRef r; r.ld = 512;
        if (reg == 0) { r.p = wu + c; r.klo = 0; r.khi = 64; } else if (reg == 1) { r.p = au + c; r.klo = 64; r.khi = 128; } else { r.p = gu + c; r.klo = 128; r.khi = 256; } return r; } };
struct SrcCmp { const float* w1;
    DI ColRef col(int n) const { const int l = logical_col(n), kind = l >> 7, ab = (l >> 6) & 1, e = l & 63; ColRef r; r.p = w1 + (size_t)((kind * 32 + ab * 16) * 64) * 64 + e; r.ld = 64; r.klo = 0; r.khi = 1 << 30; return r; } };

constexpr int WI_IN0 = 16 * 96, WI_G0 = 16 * 1, WI_O = 16 * 32, WI_GU = 16 * 176, WI_DN = 44 * 32, WI_IN1 = 16 * 48, WI_LORA = 4 * 48, WI_CMP = 16 * 8;
constexpr int WI_EARLY = WI_IN0 + WI_G0, WI_ALL = WI_EARLY + 2 * WI_O + 2 * WI_GU + 2 * WI_DN + WI_IN1 + WI_LORA + WI_CMP;
constexpr int WI_L1 = WI_O + WI_GU + WI_DN + WI_IN1, WI_L0 = WI_ALL - WI_L1;
constexpr int WO_O0 = WI_EARLY, WO_O1 = WO_O0 + WI_O, WO_GU0 = WO_O1 + WI_O, WO_GU1 = WO_GU0 + WI_GU, WO_DN0 = WO_GU1 + WI_GU, WO_DN1 = WO_DN0 + WI_DN, WO_IN1 = WO_DN1 + WI_DN, WO_LORA = WO_IN1 + WI_IN1;
DI int wi_l0(int i) { if (i < WI_EARLY + WI_O) return i; i -= WI_EARLY + WI_O; if (i < WI_GU) return WO_GU0 + i; i -= WI_GU; if (i < WI_DN) return WO_DN0 + i; i -= WI_DN; return WO_LORA + i; }
DI int wi_l1(int i) { if (i < WI_O) return WO_O1 + i; i -= WI_O; if (i < WI_GU) return WO_GU1 + i; i -= WI_GU; if (i < WI_DN) return WO_DN1 + i; i -= WI_DN; return WO_IN1 + i; }
DI void weight_item(const Params& P, LAS float* scr, int it, int lane) {
    unsigned char* ws = P.ws; int r = it;
    if (r < WI_IN0) { tr_item(SrcPlain{INF(11), 3096, 3072}, 1024, 3072, (bf16*)(ws + WS_WIN0), scr, r, lane); return; } r -= WI_IN0;
    if (r < WI_G0)  { tr_item(SrcGate{INF(11) + 3072}, 1024, 32, (bf16*)(ws + WS_WG0), scr, r, lane); return; } r -= WI_G0;
    if (r < WI_O)   { tr_item(SrcPlain{INF(12), 1024, 1024}, 1024, 1024, (bf16*)(ws + WS_WOUT0), scr, r, lane); return; } r -= WI_O;
    if (r < WI_O)   { tr_item(SrcPlain{INF(29), 1024, 1024}, 1024, 1024, (bf16*)(ws + WS_WOUT1), scr, r, lane); return; } r -= WI_O;
    if (r < WI_GU)  { tr_item(SrcGU{INF(30), INF(31)}, 1024, 5632, (bf16*)(ws + WS_WGU0), scr, r, lane, INF(9)); return; } r -= WI_GU;
    if (r < WI_GU)  { tr_item(SrcGU{INF(30) + (size_t)1024 * FF, INF(31) + (size_t)1024 * FF}, 1024, 5632, (bf16*)(ws + WS_WGU1), scr, r, lane, INF(9) + D); return; } r -= WI_GU;
    if (r < WI_DN)  { tr_item(SrcPlain{INF(32), 1024, 1024}, FF, 1024, (bf16*)(ws + WS_WDN0), scr, r, lane); return; } r -= WI_DN;
    if (r < WI_DN)  { tr_item(SrcPlain{INF(32) + (size_t)FF * 1024, 1024, 1024}, FF, 1024, (bf16*)(ws + WS_WDN1), scr, r, lane); return; } r -= WI_DN;
    if (r < WI_IN1) { tr_item(SrcPlain{INF(28), 1536, 1536}, 1024, 1536, (bf16*)(ws + WS_WIN1), scr, r, lane, INF(8) + D); return; } r -= WI_IN1;
    if (r < WI_LORA){ tr_item(SrcLora{INF(15), INF(17), INF(18)}, 256, 1536, (bf16*)(ws + WS_WLORA), scr, r, lane); return; } r -= WI_LORA;
    tr_item(SrcCmp{INF(25)}, 1024, 256, (bf16*)(ws + WS_WCMP), scr, r, lane);
}
DI void st_bf16x4(bf16* p, f32x4 v) { *(v2u*)p = (v2u){pk2(v.x, v.y), pk2(v.z, v.w)}; }
DI void norm_rows2_bf16(const float* x0, const float* x1, const float* gain, bf16* o0, bf16* o1, int lane_in) {
    int lane = lane_in; asm volatile("" : "+v"(lane));
    f32x4 v[2][4]; float ss0 = 0.f, ss1 = 0.f;
#pragma unroll
    for (int i = 0; i < 4; ++i) { v[0][i] = *(const f32x4*)(x0 + 256 * i + 4 * lane); v[1][i] = *(const f32x4*)(x1 + 256 * i + 4 * lane); }
#pragma unroll
    for (int i = 0; i < 4; ++i) { ss0 += (v[0][i].x * v[0][i].x + v[0][i].y * v[0][i].y) + (v[0][i].z * v[0][i].z + v[0][i].w * v[0][i].w); ss1 += (v[1][i].x * v[1][i].x + v[1][i].y * v[1][i].y) + (v[1][i].z * v[1][i].z + v[1][i].w * v[1][i].w); }
    const float rs0 = 1.0f / sqrtf(wave_sum(ss0) * (1.0f / 1024.0f) + 1e-6f), rs1 = 1.0f / sqrtf(wave_sum(ss1) * (1.0f / 1024.0f) + 1e-6f);
#pragma unroll
    for (int i = 0; i < 4; ++i) { const f32x4 g = *(const f32x4*)(gain + 256 * i + 4 * lane); st_bf16x4(o0 + 256 * i + 4 * lane, v[0][i] * rs0 * g); st_bf16x4(o1 + 256 * i + 4 * lane, v[1][i] * rs1 * g); }
}
DI void norm_phase(const Frame& F, const float* src0, const float* src1, const float* gain, bf16* XN) {
    for (int m = 2 * F.gw; m < MP + MS; m += 2 * F.ngw) { const float* xr = m < MP ? src0 + (size_t)m * D : src1 + (size_t)(m - MP) * D; norm_rows2_bf16(xr, xr + D, gain, XN + (size_t)m * D, XN + (size_t)(m + 1) * D, F.lane); }
}
DI void prep_conv_unit(const Params& P, const Frame& F, int u) {
    const int* ptab = (const int*)P.in[7]; const float* cache = INF(2); bf16* A = (bf16*)(P.ws + WS_ACMPS);
    const int kind = F.lane >> 5, g = (F.lane >> 4) & 1, d = (F.lane & 15) * 4;
    for (int i8 = 0; i8 < 8; ++i8) { const int it0 = u * 1024 + F.wave * 128 + i8 * 16; f32x4 v[16];
#pragma unroll
        for (int j = 0; j < 16; ++j) { const int it = it0 + j, bs = it >> 13, t = it & 8191; const int page = ptab[bs * NPG + (t >> 7)];
            v[j] = *(const f32x4*)(cache + ((size_t)page * PAGE + (t & 127)) * 512 + 4 * F.lane); }
#pragma unroll
        for (int j = 0; j < 16; ++j) { const int it = it0 + j, bs = it >> 13, t = it & 8191;
            *(v2u*)(A + ((((size_t)kind * NSQ + bs) * 2 + g) * PAST + t) * 64 + d) = (v2u){pk2(v[j].x, v[j].y), pk2(v[j].z, v[j].w)}; } }
}
DI void prep_means_unit(const Params& P, const Frame& F, int it) {
    const int* ptab = (const int*)P.in[7]; const float* cache = INF(3); float* MEANS = (float*)(P.ws + WS_MEANS); LAS f32x4* red = (LAS f32x4*)F.lds;
    const int bs = it >> 5, nb = it & 31;
    const int page = ptab[bs * NPG + 2 * nb + (F.wave >> 2)], tok0 = (F.wave & 3) * 32;
    const float* src = cache + ((size_t)page * PAGE + tok0) * 512 + 4 * F.lane;
    f32x4 acc = {0.f, 0.f, 0.f, 0.f};
#pragma unroll
    for (int i = 0; i < 32; ++i) acc += *(const f32x4*)(src + (size_t)i * 512);
    red[F.wave * 64 + F.lane] = acc;
    __syncthreads();
    if (F.wave == 0) { f32x4 s = red[F.lane];
#pragma unroll
        for (int w = 1; w < 8; ++w) s += red[w * 64 + F.lane];
        s *= (1.0f / 256.0f);
        *(f32x4*)(MEANS + (((size_t)bs * 4 + (F.lane >> 4)) * 32 + nb) * 64 + (F.lane & 15) * 4) = s; }
    __syncthreads();
}
DI void p0_wincopy(const Params& P, const Frame& F) {
    const f32x4* src = (const f32x4*)INF(4); f32x4* dst = (f32x4*)(P.out + O_WINS);
    for (int i = blockIdx.x * 512 + F.tid; i < NSQ * 508 * 64; i += F.G * 512) { const int bs = i / (508 * 64), r = i % (508 * 64); dst[(size_t)bs * 512 * 64 + r] = src[(size_t)bs * 512 * 64 + 4 * 64 + r]; }
}

template <class Fn> struct EpiHead {
    static constexpr bool PERM = false, AFTER_DRAIN = false;
    Fn f;
    DI void operator()(const f32x4 (&acc)[2][2][4][2], const pg8::Unit& u, int wr, int wc, int fr, int fq) const {
#pragma unroll
        for (int ai = 0; ai < 2; ++ai)
#pragma unroll
            for (int m = 0; m < 4; ++m) { const int row = u.pm * 256 + ai * 128 + wr * 64 + m * 16 + fr;
#pragma unroll
                for (int bj = 0; bj < 2; ++bj) f(row, u.pn * 4 + bj * 2 + (wc >> 1), 16 * (wc & 1) + 4 * fq, acc[ai][bj][m][0], acc[ai][bj][m][1]); }
    }
};
template <class Fn> DI void skinny_unit(LAS unsigned char* lds, const bf16* A, const bf16* Bt, int K, int row0, int col0, const Fn& f, int wave, int lane_in) {
    int lane = lane_in; asm volatile("" : "+v"(lane));
    const int fr = lane & 15, fq = lane >> 4, kw = K >> 3, nk = kw >> 5;
    const bf16* ap = A + (size_t)(row0 + fr) * K + wave * kw + 8 * fq;
    const bf16* bp = Bt + (size_t)(col0 + fr) * K + wave * kw + 8 * fq;
    f32x4 acc[8][2];
#pragma unroll
    for (int rb = 0; rb < 8; ++rb) { acc[rb][0] = (f32x4){0.f, 0.f, 0.f, 0.f}; acc[rb][1] = (f32x4){0.f, 0.f, 0.f, 0.f}; }
    bf16x8 a0[8], b0[2], a1[8], b1[2], a2[8], b2[2];
#define SK_LOAD(AA, BB, ks) do { _Pragma("unroll") for (int rb = 0; rb < 8; ++rb) AA[rb] = *(const bf16x8*)(ap + (size_t)rb * 16 * K + 32 * (ks)); BB[0] = *(const bf16x8*)(bp + 32 * (ks)); BB[1] = *(const bf16x8*)(bp + (size_t)16 * K + 32 * (ks)); } while (0)
#define SK_MMA(AA, BB) do { _Pragma("unroll") for (int rb = 0; rb < 8; ++rb) { acc[rb][0] = __builtin_amdgcn_mfma_f32_16x16x32_bf16(BB[0], AA[rb], acc[rb][0], 0, 0, 0); acc[rb][1] = __builtin_amdgcn_mfma_f32_16x16x32_bf16(BB[1], AA[rb], acc[rb][1], 0, 0, 0); } } while (0)
    SK_LOAD(a0, b0, 0); if (nk > 1) SK_LOAD(a1, b1, 1);
    for (int ks = 0; ks < nk; ks += 3) {
        if (ks + 2 < nk) SK_LOAD(a2, b2, ks + 2);
        SK_MMA(a0, b0);
        if (ks + 1 < nk) { if (ks + 3 < nk) SK_LOAD(a0, b0, ks + 3); SK_MMA(a1, b1); }
        if (ks + 2 < nk) { if (ks + 4 < nk) SK_LOAD(a1, b1, ks + 4); SK_MMA(a2, b2); }
    }
#undef SK_LOAD
#undef SK_MMA
    LAS float* red = (LAS float*)lds;
#pragma unroll
    for (int rb = 0; rb < 8; ++rb) { *(LAS f32x4*)(red + (wave * 128 + 16 * rb + fr) * 32 + 4 * fq) = acc[rb][0]; *(LAS f32x4*)(red + (wave * 128 + 16 * rb + fr) * 32 + 16 + 4 * fq) = acc[rb][1]; }
    __syncthreads();
    f32x4 lo = {0.f, 0.f, 0.f, 0.f}, hi = {0.f, 0.f, 0.f, 0.f};
#pragma unroll
    for (int w = 0; w < 8; ++w) { lo += *(const LAS f32x4*)(red + (w * 128 + 16 * wave + fr) * 32 + 4 * fq); hi += *(const LAS f32x4*)(red + (w * 128 + 16 * wave + fr) * 32 + 16 + 4 * fq); }
    f(row0 + 16 * wave + fr, col0 >> 6, 16 * ((col0 >> 5) & 1) + 4 * fq, lo, hi);
    __syncthreads();
}

struct EpiIn0 {
    bf16* RW; bf16* Q0; bf16* KV0; bf16* KVS0; const f32x2* rope; float* out;
    DI void operator()(int row, int head, int d4, f32x4 lo, f32x4 hi) const {
        if (row >= MP + MS) return;
        const bool samp = row >= MP; const int sr = row - MP;
        const int b = samp ? (sr >> 2) : (row >> 12), t = samp ? (sr & 3) : (row & 4095), ridx = samp ? 4096 + t : t;
        if (head < 28) {
            bf16* p = RW + (size_t)row * RWC + head * 64 + d4; st_bf16x4(p, lo); st_bf16x4(p + 32, hi);
            const bool last = samp ? (t == 3) : (t == SEQ - 1);
            if (last) { float* o = out + (samp ? O_SHS : O_SHP) + (size_t)b * RWC + head * 64 + d4; *(f32x4*)o = lo; *(f32x4*)(o + 32) = hi; }
            return;
        }
        const bool isq = head < 36; const int idx = head - 36; const int which = idx >> 2, kvsel = (idx >> 1) & 1, g = idx & 1;
        if (isq || kvsel == 0) {
            const f32x2* cs = rope + (size_t)ridx * 32 + d4; const f32x4 a = *(const f32x4*)cs, c2 = *(const f32x4*)(cs + 2);
            const f32x4 co = {a.x, a.z, c2.x, c2.z}, si = {a.y, a.w, c2.y, c2.w};
            const f32x4 x1 = lo, x2 = hi; lo = x1 * co - x2 * si; hi = x2 * co + x1 * si;
        }
        if (isq) { bf16* p = Q0 + (size_t)row * 512 + (head - 28) * 64 + d4; st_bf16x4(p, lo * ATT_SC); st_bf16x4(p + 32, hi * ATT_SC); return; }
        const int k6 = which * 2 + kvsel;
        bf16* p = samp ? KVS0 + ((((size_t)k6 * NSQ + b) * 2 + g) * 4 + t) * 64 + d4 : KV0 + ((((size_t)k6 * NB + b) * 2 + g) * SEQ + t) * 64 + d4;
        st_bf16x4(p, lo); st_bf16x4(p + 32, hi);
        if (which < 2) { float* o = out + (samp ? O_NSAS + (((size_t)sr * 4 + k6) * 2 + g) * 64 : O_NSAP + (((size_t)row * 4 + k6) * 2 + g) * 64) + d4; *(f32x4*)o = lo; *(f32x4*)(o + 32) = hi; }
        else if (samp) { float* o = out + O_WINS + ((((size_t)b * 512 + 508 + t) * 2 + kvsel) * 2 + g) * 64 + d4; *(f32x4*)o = lo; *(f32x4*)(o + 32) = hi; }
        else if (t >= SEQ - 512) { float* o = out + O_WINP + ((((size_t)b * 512 + (t - (SEQ - 512))) * 2 + kvsel) * 2 + g) * 64 + d4; *(f32x4*)o = lo; *(f32x4*)(o + 32) = hi; }
    }
};
struct EpiGates { float* G; const float* bias;
    DI void operator()(int row, int head, int d4, f32x4 lo, f32x4 hi) const {
        { const f32x4 bv = *(const f32x4*)(bias + d4); f32x4 o;
          o.x = sigmoidf_(lo.x + bv.x); o.y = sigmoidf_(lo.y + bv.y); o.z = sigmoidf_(lo.z + bv.z); o.w = sigmoidf_(lo.w + bv.w);
          *(f32x4*)(G + (size_t)row * 32 + d4) = o; }
        if (d4 < 8) { const f32x4 bv = *(const f32x4*)(bias + 16 + d4); f32x4 o;
          o.x = sigmoidf_(hi.x + bv.x); o.y = sigmoidf_(hi.y + bv.y); o.z = sigmoidf_(hi.z + bv.z); o.w = sigmoidf_(hi.w + bv.w);
          *(f32x4*)(G + (size_t)row * 32 + 16 + d4) = o; } } };
struct EpiCmp { float* HC; int half_rows;
    DI void operator()(int row, int head, int d4, f32x4 lo, f32x4 hi) const {
        const int kind = row >= half_rows ? 1 : 0; if ((head >> 1) != kind) return;
        float* o = HC + (size_t)row * 128 + (head & 1) * 64 + d4; *(f32x4*)o = lo; *(f32x4*)(o + 32) = hi; } };
constexpr size_t RWKV_ARR = (size_t)MT * 512 * 4;
constexpr size_t WS_R = WS_END0, WS_K = WS_R + RWKV_ARR, WS_V = WS_K + RWKV_ARR, WS_KK = WS_V + RWKV_ARR, WS_W = WS_KK + RWKV_ARR, WS_KP = WS_W + RWKV_ARR,
                 WS_KKA = WS_KP + RWKV_ARR, WS_G = WS_KKA + RWKV_ARR, WS_Y = WS_G + RWKV_ARR;
constexpr size_t WS_LA = al(WS_Y + RWKV_ARR);
constexpr size_t WS_ATT = al(WS_LA + (size_t)MT * 256 * 2);
constexpr size_t WS_H = al(WS_ATT + (size_t)MT * 1024 * 2);
constexpr size_t WS_HFF = al(WS_H + (size_t)MT * 1024 * 4);
constexpr size_t WS_END1 = al(WS_HFF + (size_t)MT * FF * 2);

DI float red8(float v) {
    v += __builtin_bit_cast(float, __builtin_amdgcn_update_dpp(0, __builtin_bit_cast(int, v), 0xB1, 0xf, 0xf, false));
    v += __builtin_bit_cast(float, __builtin_amdgcn_update_dpp(0, __builtin_bit_cast(int, v), 0x4E, 0xf, 0xf, false));
    v += __builtin_bit_cast(float, __builtin_amdgcn_update_dpp(0, __builtin_bit_cast(int, v), 0x141, 0xf, 0xf, false));
    return v;
}
DI void ld_bf8(const bf16* p, float (&o)[8]) { const v4u u = *(const v4u*)p; o[0] = bflo(u.x); o[1] = bfhi(u.x); o[2] = bflo(u.y); o[3] = bfhi(u.y); o[4] = bflo(u.z); o[5] = bfhi(u.z); o[6] = bflo(u.w); o[7] = bfhi(u.w); }
DI void ld_f8(const float* p, float (&o)[8]) { const f32x4 a = *(const f32x4*)p, b = *(const f32x4*)(p + 4); o[0] = a.x; o[1] = a.y; o[2] = a.z; o[3] = a.w; o[4] = b.x; o[5] = b.y; o[6] = b.z; o[7] = b.w; }
DI f32x4 ld_bf4(const bf16* p) { const v2u u = *(const v2u*)p; return (f32x4){bflo(u.x), bfhi(u.x), bflo(u.y), bfhi(u.y)}; }
DI void st_bf8(bf16* p, const float (&o)[8]) { *(v4u*)p = (v4u){pk2(o[0], o[1]), pk2(o[2], o[3]), pk2(o[4], o[5]), pk2(o[6], o[7])}; }
DI void st_f8(float* p, const float (&o)[8]) { *(f32x4*)p = (f32x4){o[0], o[1], o[2], o[3]}; *(f32x4*)(p + 4) = (f32x4){o[4], o[5], o[6], o[7]}; }

DI void rwkv_prep(const Params& P, const Frame& F, int skip_blocks) {
    unsigned char* ws = P.ws; const bf16* RW = (const bf16*)(ws + WS_RW);
    const float* mu = INF(13); const float* k_k = INF(19); const float* sshift = INF(6);
    bf16* R_ = (bf16*)(ws + WS_R); bf16* K_ = (bf16*)(ws + WS_K); bf16* V_ = (bf16*)(ws + WS_V); bf16* KK_ = (bf16*)(ws + WS_KK); bf16* LA = (bf16*)(ws + WS_LA);
    const int lane = F.lane;
    if ((int)blockIdx.x < skip_blocks) return;
    for (int row = F.gw - skip_blocks * NWAVES; row < MP + MS; row += F.ngw - skip_blocks * NWAVES) {
        const bool samp = row >= MP; const int t = samp ? ((row - MP) & 3) : (row & 4095); const int bs = (row - MP) >> 2;
        const bf16* cur = RW + (size_t)row * RWC; const bf16* prv = cur - RWC;
#pragma unroll
        for (int part = 0; part < 3; ++part) {
            const int c = part * 512 + 8 * lane; float x[8], p[8], m[8];
            ld_bf8(cur + c, x); ld_f8(mu + c, m);
            if (t > 0) ld_bf8(prv + c, p); else if (samp) ld_f8(sshift + (size_t)bs * RWC + c, p); else {
#pragma unroll
                for (int e = 0; e < 8; ++e) p[e] = 0.f; }
#pragma unroll
            for (int e = 0; e < 8; ++e) x[e] = x[e] + (p[e] - x[e]) * m[e];
            bf16* dst = (part == 0 ? R_ : part == 1 ? K_ : V_) + (size_t)row * 512 + 8 * lane;
            st_bf8(dst, x);
            if (part == 1) { float kc[8], q[8]; ld_f8(k_k + 8 * lane, kc); float ss = 0.f;
#pragma unroll
                for (int e = 0; e < 8; ++e) { q[e] = x[e] * kc[e]; ss += q[e] * q[e]; }
                ss = red8(ss); const float inv = 1.0f / fmaxf(sqrtf(ss), 1e-12f);
#pragma unroll
                for (int e = 0; e < 8; ++e) q[e] *= inv;
                st_bf8(KK_ + (size_t)row * 512 + 8 * lane, q); }
        }
        { const int c = 1536 + 4 * lane; const v2u uc = *(const v2u*)(cur + c); float x[4] = {bflo(uc.x), bfhi(uc.x), bflo(uc.y), bfhi(uc.y)}, p[4];
          const f32x4 m = *(const f32x4*)(mu + c);
          if (t > 0) { const v2u up = *(const v2u*)(prv + c); p[0] = bflo(up.x); p[1] = bfhi(up.x); p[2] = bflo(up.y); p[3] = bfhi(up.y); }
          else if (samp) { const f32x4 s4 = *(const f32x4*)(sshift + (size_t)bs * RWC + c); p[0] = s4.x; p[1] = s4.y; p[2] = s4.z; p[3] = s4.w; }
          else { p[0] = p[1] = p[2] = p[3] = 0.f; }
          x[0] += (p[0] - x[0]) * m.x; x[1] += (p[1] - x[1]) * m.y; x[2] += (p[2] - x[2]) * m.z; x[3] += (p[3] - x[3]) * m.w;
          const int reg = lane >> 4;
#pragma unroll
          for (int e = 0; e < 4; ++e) { if (reg == 0) x[e] = 1.0f - 2.0f / (__expf(2.0f * x[e]) + 1.0f); else if (reg >= 2) x[e] = sigmoidf_(x[e]); }
          *(v2u*)(LA + (size_t)row * 256 + 4 * lane) = (v2u){pk2(x[0], x[1]), pk2(x[2], x[3])}; }
    }
}
struct EpiLora {
    const float* w0; const float* a0; const float* k_a; const bf16* K_; const bf16* KK_; float* W_; bf16* KP_; bf16* KKA_; bf16* G_;
    DI void operator()(int row, int head, int d4, f32x4 lo, f32x4 hi) const {
        if (row >= MP + MS) return;
        const int reg = head >> 3, c0 = (head & 7) * 64 + d4;
#pragma unroll
        for (int hh = 0; hh < 2; ++hh) { const int c = c0 + 32 * hh; const f32x4 x = hh ? hi : lo; const size_t o = (size_t)row * 512 + c;
            if (reg == 0) { const f32x4 b = *(const f32x4*)(w0 + c); f32x4 r;
                r.x = -0.6065306597126334f * sigmoidf_(b.x + x.x); r.y = -0.6065306597126334f * sigmoidf_(b.y + x.y);
                r.z = -0.6065306597126334f * sigmoidf_(b.z + x.z); r.w = -0.6065306597126334f * sigmoidf_(b.w + x.w); *(f32x4*)(W_ + o) = r; }
            else if (reg == 1) { const f32x4 b = *(const f32x4*)(a0 + c), ka = *(const f32x4*)(k_a + c); const v2u ku = *(const v2u*)(K_ + o), kku = *(const v2u*)(KK_ + o);
                const f32x4 k = {bflo(ku.x), bfhi(ku.x), bflo(ku.y), bfhi(ku.y)}, kk = {bflo(kku.x), bfhi(kku.x), bflo(kku.y), bfhi(kku.y)}; f32x4 a;
                a.x = sigmoidf_(b.x + x.x); a.y = sigmoidf_(b.y + x.y); a.z = sigmoidf_(b.z + x.z); a.w = sigmoidf_(b.w + x.w);
                st_bf16x4(KP_ + o, k * (1.0f + (a - 1.0f) * ka)); st_bf16x4(KKA_ + o, kk * a); }
            else { st_bf16x4(G_ + o, x); } }
    }
};
constexpr int SC_CH = 32, SC_STEP = 384;
DI void scan_chain(const Params& P, const Frame& F, int row0, int h, int ihalf, int nsteps, const float* S0, float* Sout) {
    unsigned char* ws = P.ws;
    const float* a0p = (const float*)(ws + WS_W); const bf16* a1p = (const bf16*)(ws + WS_KK); const bf16* a2p = (const bf16*)(ws + WS_KKA);
    const bf16* a3p = (const bf16*)(ws + WS_KP); const bf16* a4p = (const bf16*)(ws + WS_R); const bf16* a5p = (const bf16*)(ws + WS_V);
    float* Y_ = (float*)(ws + WS_Y);
    LAS float* buf = (LAS float*)F.lds;
    LAS float* ybuf = (LAS float*)(F.lds + 2 * SC_CH * SC_STEP * 4);
    const int lane = F.lane, il = 8 * (F.wave & 3) + (lane >> 3), i = 32 * ihalf + il, j0 = 8 * (lane & 7); const bool comp = F.wave < 4;
    f32x2 S[4];
    if (S0) { const f32x4 a = *(const f32x4*)(S0 + i * 64 + j0), b = *(const f32x4*)(S0 + i * 64 + j0 + 4); S[0] = (f32x2){a.x, a.y}; S[1] = (f32x2){a.z, a.w}; S[2] = (f32x2){b.x, b.y}; S[3] = (f32x2){b.z, b.w}; }
    else { S[0] = S[1] = S[2] = S[3] = (f32x2){0.f, 0.f}; }
    f32x4 st0, st1, st2, st3, st4, st5;
    const int lstep = F.tid >> 4, lc4 = (F.tid & 15) * 4;
    const size_t goff = (size_t)(row0 + lstep) * 512 + h * 64 + lc4;
#define SC_GLOAD(step0) do { const bool ok_ = (step0) + lstep < nsteps; const size_t o_ = goff + (size_t)(step0) * 512; const f32x4 z_ = {0.f, 0.f, 0.f, 0.f}; \
        st0 = ok_ ? *(const f32x4*)(a0p + o_) : z_; st0.x = __expf(st0.x); st0.y = __expf(st0.y); st0.z = __expf(st0.z); st0.w = __expf(st0.w); \
        st1 = ok_ ? ld_bf4(a1p + o_) : z_; st2 = ok_ ? ld_bf4(a2p + o_) : z_; st3 = ok_ ? ld_bf4(a3p + o_) : z_; st4 = ok_ ? ld_bf4(a4p + o_) : z_; st5 = ok_ ? ld_bf4(a5p + o_) : z_; } while (0)
#define SC_LSTORE(bi) do { LAS float* d_ = buf + (bi) * SC_CH * SC_STEP + lstep * SC_STEP + lc4; \
        *(LAS f32x4*)(d_) = st0; *(LAS f32x4*)(d_ + 64) = st1; *(LAS f32x4*)(d_ + 128) = st2; *(LAS f32x4*)(d_ + 192) = st3; *(LAS f32x4*)(d_ + 256) = st4; *(LAS f32x4*)(d_ + 320) = st5; } while (0)
    SC_GLOAD(0); SC_LSTORE(0); __syncthreads();
    const int nch = (nsteps + SC_CH - 1) / SC_CH;
    for (int ch = 0; ch < nch; ++ch) {
        const int bi = ch & 1; if (ch + 1 < nch) SC_GLOAD((ch + 1) * SC_CH);
        const LAS float* cb = buf + bi * SC_CH * SC_STEP;
        const int rem = nsteps - ch * SC_CH, ns = rem < SC_CH ? rem : SC_CH;
        if (comp) {
            f32x4 w0, w1, k0, k1, a0, a1, p0, p1, r0, r1; float vi;
#define SC_LD(s_) do { const LAS float* sb_ = cb + (s_) * SC_STEP; w0 = *(const LAS f32x4*)(sb_ + j0); w1 = *(const LAS f32x4*)(sb_ + j0 + 4); k0 = *(const LAS f32x4*)(sb_ + 64 + j0); k1 = *(const LAS f32x4*)(sb_ + 64 + j0 + 4); \
                a0 = *(const LAS f32x4*)(sb_ + 128 + j0); a1 = *(const LAS f32x4*)(sb_ + 128 + j0 + 4); p0 = *(const LAS f32x4*)(sb_ + 192 + j0); p1 = *(const LAS f32x4*)(sb_ + 192 + j0 + 4); \
                r0 = *(const LAS f32x4*)(sb_ + 256 + j0); r1 = *(const LAS f32x4*)(sb_ + 256 + j0 + 4); vi = sb_[320 + i]; } while (0)
            SC_LD(0);
            for (int s = 0; s < ns; ++s) {
                const f32x4 cw0 = w0, cw1 = w1, ck0 = k0, ck1 = k1, ca0 = a0, ca1 = a1, cp0 = p0, cp1 = p1, cr0 = r0, cr1 = r1; const float cvi = vi;
                SC_LD(s + 1 < SC_CH ? s + 1 : s);
                f32x2 d2 = S[0] * (f32x2){ck0.x, ck0.y}; d2 = __builtin_elementwise_fma(S[1], (f32x2){ck0.z, ck0.w}, d2); f32x2 e2 = S[2] * (f32x2){ck1.x, ck1.y}; e2 = __builtin_elementwise_fma(S[3], (f32x2){ck1.z, ck1.w}, e2);
                d2 += e2; float sk = red8(d2.x + d2.y);
                const f32x2 vv = {cvi, cvi}, nsk = {-sk, -sk};
                S[0] = __builtin_elementwise_fma(nsk, (f32x2){ca0.x, ca0.y}, __builtin_elementwise_fma(vv, (f32x2){cp0.x, cp0.y}, S[0] * (f32x2){cw0.x, cw0.y}));
                S[1] = __builtin_elementwise_fma(nsk, (f32x2){ca0.z, ca0.w}, __builtin_elementwise_fma(vv, (f32x2){cp0.z, cp0.w}, S[1] * (f32x2){cw0.z, cw0.w}));
                S[2] = __builtin_elementwise_fma(nsk, (f32x2){ca1.x, ca1.y}, __builtin_elementwise_fma(vv, (f32x2){cp1.x, cp1.y}, S[2] * (f32x2){cw1.x, cw1.y}));
                S[3] = __builtin_elementwise_fma(nsk, (f32x2){ca1.z, ca1.w}, __builtin_elementwise_fma(vv, (f32x2){cp1.z, cp1.w}, S[3] * (f32x2){cw1.z, cw1.w}));
                f32x2 y2 = S[0] * (f32x2){cr0.x, cr0.y}; y2 = __builtin_elementwise_fma(S[1], (f32x2){cr0.z, cr0.w}, y2); f32x2 z2 = S[2] * (f32x2){cr1.x, cr1.y}; z2 = __builtin_elementwise_fma(S[3], (f32x2){cr1.z, cr1.w}, z2);
                y2 += z2; const float y = red8(y2.x + y2.y);
                if ((lane & 7) == 0) ybuf[s * 32 + il] = y;
            }
#undef SC_LD
        }
        __syncthreads();
#pragma unroll
        for (int m = 0; m < 2; ++m) { const int q = F.tid + 512 * m, step = q >> 5, c = q & 31; if (step < ns) Y_[(size_t)(row0 + ch * SC_CH + step) * 512 + h * 64 + 32 * ihalf + c] = ybuf[q]; }
        if (ch + 1 < nch) SC_LSTORE(bi ^ 1);
        __syncthreads();
    }
#undef SC_GLOAD
#undef SC_LSTORE
    if (comp) { *(f32x4*)(Sout + i * 64 + j0) = (f32x4){S[0].x, S[0].y, S[1].x, S[1].y}; *(f32x4*)(Sout + i * 64 + j0 + 4) = (f32x4){S[2].x, S[2].y, S[3].x, S[3].y}; }
}
DI void scan_sample_wave(const Params& P, int wid, int lane_in) {
    int lane = lane_in; asm volatile("" : "+v"(lane));
    unsigned char* ws = P.ws; const int c = wid >> 3, rg = wid & 7, h = c & 7, row0 = MP + (c >> 3) * 4, i = 8 * rg + (lane >> 3), j0 = 8 * (lane & 7);
    const float* LW = (const float*)(ws + WS_W); const bf16* KK = (const bf16*)(ws + WS_KK); const bf16* KKA = (const bf16*)(ws + WS_KKA); const bf16* KP = (const bf16*)(ws + WS_KP);
    const bf16* RR = (const bf16*)(ws + WS_R); const bf16* VV = (const bf16*)(ws + WS_V); float* Y_ = (float*)(ws + WS_Y);
    float S[8]; ld_f8(INF(5) + (size_t)c * 4096 + i * 64 + j0, S);
    float w[4][8], kk[4][8], ka[4][8], kp[4][8], r[4][8], vi[4];
#pragma unroll
    for (int st = 0; st < 4; ++st) { const size_t o = (size_t)(row0 + st) * 512 + h * 64; ld_f8(LW + o + j0, w[st]); ld_bf8(KK + o + j0, kk[st]); ld_bf8(KKA + o + j0, ka[st]); ld_bf8(KP + o + j0, kp[st]); ld_bf8(RR + o + j0, r[st]); vi[st] = bf2f(VV[o + i]); }
#pragma unroll
    for (int st = 0; st < 4; ++st) { float sk = 0.f;
#pragma unroll
        for (int e = 0; e < 8; ++e) sk += S[e] * kk[st][e];
        sk = red8(sk); float y = 0.f;
#pragma unroll
        for (int e = 0; e < 8; ++e) { S[e] = S[e] * __expf(w[st][e]) + vi[st] * kp[st][e] - sk * ka[st][e]; y += S[e] * r[st][e]; }
        y = red8(y);
        if ((lane & 7) == 0) Y_[(size_t)(row0 + st) * 512 + h * 64 + i] = y; }
    st_f8(P.out + O_WKVS + (size_t)c * 4096 + i * 64 + j0, S);
}
template <int NR, bool YLDS> DI void rwkv_post_rows(const Params& P, int row0, int rstride, int lane_in, const LAS float* ylds, int yrow0) {
    int lane = lane_in; asm volatile("" : "+v"(lane));
    unsigned char* ws = P.ws; const float* r_k = INF(21); const float* ln_g = INF(22); const float* ln_b = INF(23);
    const bf16* R_ = (const bf16*)(ws + WS_R); const bf16* KP_ = (const bf16*)(ws + WS_KP); const bf16* V_ = (const bf16*)(ws + WS_V); const bf16* G_ = (const bf16*)(ws + WS_G); const float* Y_ = (const float*)(ws + WS_Y);
    bf16* ATT = (bf16*)(ws + WS_ATT); const int c = 8 * lane;
    float rk[8], lg[8], lb[8]; ld_f8(r_k + c, rk); ld_f8(ln_g + c, lg); ld_f8(ln_b + c, lb);
    float y[NR][8]; v4u ru[NR], ku[NR], vu[NR], gu[NR];
#pragma unroll
    for (int q = 0; q < NR; ++q) { const size_t o = (size_t)(row0 + q * rstride) * 512 + c;
        if (YLDS) { const f32x4 a = *(const LAS f32x4*)(ylds + (yrow0 + q * rstride) * 512 + c), b2 = *(const LAS f32x4*)(ylds + (yrow0 + q * rstride) * 512 + c + 4); y[q][0] = a.x; y[q][1] = a.y; y[q][2] = a.z; y[q][3] = a.w; y[q][4] = b2.x; y[q][5] = b2.y; y[q][6] = b2.z; y[q][7] = b2.w; }
        else ld_f8(Y_ + o, y[q]); ru[q] = *(const v4u*)(R_ + o); ku[q] = *(const v4u*)(KP_ + o); vu[q] = *(const v4u*)(V_ + o); gu[q] = *(const v4u*)(G_ + o); }
#pragma unroll
    for (int q = 0; q < NR; ++q) {
        float r[8] = {bflo(ru[q].x), bfhi(ru[q].x), bflo(ru[q].y), bfhi(ru[q].y), bflo(ru[q].z), bfhi(ru[q].z), bflo(ru[q].w), bfhi(ru[q].w)};
        float k[8] = {bflo(ku[q].x), bfhi(ku[q].x), bflo(ku[q].y), bfhi(ku[q].y), bflo(ku[q].z), bfhi(ku[q].z), bflo(ku[q].w), bfhi(ku[q].w)};
        float v[8] = {bflo(vu[q].x), bfhi(vu[q].x), bflo(vu[q].y), bfhi(vu[q].y), bflo(vu[q].z), bfhi(vu[q].z), bflo(vu[q].w), bfhi(vu[q].w)};
        float g[8] = {bflo(gu[q].x), bfhi(gu[q].x), bflo(gu[q].y), bfhi(gu[q].y), bflo(gu[q].z), bfhi(gu[q].z), bflo(gu[q].w), bfhi(gu[q].w)};
        float s = 0.f, bs = 0.f;
#pragma unroll
        for (int e = 0; e < 8; ++e) { s += y[q][e]; bs += r[e] * k[e] * rk[e]; }
        s = red8(s); bs = red8(bs); const float mean = s * (1.0f / 64.0f); float qq = 0.f;
#pragma unroll
        for (int e = 0; e < 8; ++e) { y[q][e] -= mean; qq += y[q][e] * y[q][e]; }
        qq = red8(qq); const float rstd = 1.0f / sqrtf(qq * (1.0f / 64.0f) + 64e-5f);
        float o8[8];
#pragma unroll
        for (int e = 0; e < 8; ++e) o8[e] = (y[q][e] * rstd * lg[e] + lb[e] + bs * v[e]) * g[e];
        *(v4u*)(ATT + (size_t)(row0 + q * rstride) * 1024 + c) = (v4u){pk2(o8[0], o8[1]), pk2(o8[2], o8[3]), pk2(o8[4], o8[5]), pk2(o8[6], o8[7])}; }
}
DI void rwkv_post(const Params& P, const Frame& F) {
    unsigned char* ws = P.ws; const float* r_k = INF(21); const float* ln_g = INF(22); const float* ln_b = INF(23);
    const bf16* R_ = (const bf16*)(ws + WS_R); const bf16* KP_ = (const bf16*)(ws + WS_KP); const bf16* V_ = (const bf16*)(ws + WS_V); const bf16* G_ = (const bf16*)(ws + WS_G); const float* Y_ = (const float*)(ws + WS_Y);
    bf16* ATT = (bf16*)(ws + WS_ATT); const int lane = F.lane, c = 8 * lane;
    float rk[8], lg[8], lb[8]; ld_f8(r_k + c, rk); ld_f8(ln_g + c, lg); ld_f8(ln_b + c, lb);
    for (int row = F.gw; row < MP + MS; row += F.ngw) { const size_t o = (size_t)row * 512 + c;
        float y[8], r[8], k[8], v[8], g[8]; ld_f8(Y_ + o, y); ld_bf8(R_ + o, r); ld_bf8(KP_ + o, k); ld_bf8(V_ + o, v); ld_bf8(G_ + o, g);
        float s = 0.f, bs = 0.f;
#pragma unroll
        for (int e = 0; e < 8; ++e) { s += y[e]; bs += r[e] * k[e] * rk[e]; }
        s = red8(s); bs = red8(bs); const float mean = s * (1.0f / 64.0f); float q = 0.f;
#pragma unroll
        for (int e = 0; e < 8; ++e) { y[e] -= mean; q += y[e] * y[e]; }
        q = red8(q); const float rstd = 1.0f / sqrtf(q * (1.0f / 64.0f) + 64e-5f);
        float o8[8];
#pragma unroll
        for (int e = 0; e < 8; ++e) o8[e] = (y[e] * rstd * lg[e] + lb[e] + bs * v[e]) * g[e];
        *(v4u*)(ATT + (size_t)row * 1024 + c) = (v4u){pk2(o8[0], o8[1]), pk2(o8[2], o8[3]), pk2(o8[4], o8[5]), pk2(o8[6], o8[7])};
    }
}
typedef short v4i16_t __attribute__((ext_vector_type(4)));
DI int crow(int r, int hi) { return (r & 3) + 8 * (r >> 2) + 4 * hi; }
DI float half_max(float v) { auto rr = __builtin_amdgcn_permlane32_swap(__float_as_uint(v), __float_as_uint(v), false, false); return fmaxf(__uint_as_float(rr[0]), __uint_as_float(rr[1])); }
DI float half_sum(float v) { auto rr = __builtin_amdgcn_permlane32_swap(__float_as_uint(v), __float_as_uint(v), false, false); return __uint_as_float(rr[0]) + __uint_as_float(rr[1]); }
DI s16x4 vtr(const LAS unsigned char* p) { return __builtin_bit_cast(s16x4, __builtin_amdgcn_ds_read_tr16_b64_v4i16((LAS v4i16_t*)p)); }
#define MFMA32(a, b, c) __builtin_amdgcn_mfma_f32_32x32x16_bf16((a), (b), (c), 0, 0, 0)
struct AttnAcc { f32x16 o0, o1; float m, l; };
DI void acc_init(AttnAcc& A) {
#pragma unroll
    for (int i = 0; i < 16; ++i) { A.o0[i] = 0.f; A.o1[i] = 0.f; }
    A.m = 0.f; A.l = 0.f; }
DI void ld_q(const bf16* qrow, bf16x8 (&qr)[4], int hi) {
#pragma unroll
    for (int d0 = 0; d0 < 4; ++d0) qr[d0] = *(const bf16x8*)(qrow + 16 * d0 + 8 * hi); }
DI void qk_tile(const LAS unsigned char* Kt, const bf16x8 (&qr)[4], f32x16& p0, f32x16& p1, int lane, float init = 0.f) {
    const LAS unsigned char* kb = Kt + (lane >> 5) * 1024 + (lane & 31) * 16;
#pragma unroll
    for (int i = 0; i < 16; ++i) { p0[i] = init; p1[i] = init; }
#pragma unroll
    for (int d0 = 0; d0 < 4; ++d0) { const bf16x8 b0 = *(const LAS bf16x8*)(kb + d0 * 2048), b1 = *(const LAS bf16x8*)(kb + d0 * 2048 + 512);
        p0 = MFMA32(b0, qr[d0], p0); p1 = MFMA32(b1, qr[d0], p1); }
}
DI float max3f(float a, float b, float c) { float r; asm("v_max3_f32 %0, %1, %2, %3" : "=v"(r) : "v"(a), "v"(b), "v"(c)); return r; }
DI bf16x8 pack8(const f32x16& p, int s) { v4u u; u.x = pk2(p[8 * s], p[8 * s + 1]); u.y = pk2(p[8 * s + 2], p[8 * s + 3]); u.z = pk2(p[8 * s + 4], p[8 * s + 5]); u.w = pk2(p[8 * s + 6], p[8 * s + 7]); return __builtin_bit_cast(bf16x8, u); }
DI void pv_tile(const LAS unsigned char* Vt, const f32x16& p0, const f32x16& p1, f32x16& o0, f32x16& o1, int lane) {
    const int hi = lane >> 5;
    const LAS unsigned char* vp = Vt + ((lane >> 4) & 1) * 32 + (lane & 3) * 8 + (4 * hi + ((lane & 15) >> 2)) * 64;
#pragma unroll
    for (int cc = 0; cc < 2; ++cc)
#pragma unroll
        for (int s = 0; s < 2; ++s) { const int ks = 2 * cc + s; const bf16x8 pb = pack8(cc ? p1 : p0, s);
#pragma unroll
            for (int d0 = 0; d0 < 2; ++d0) { const s16x4 lo = vtr(vp + d0 * 4096 + ks * 1024), h4 = vtr(vp + d0 * 4096 + ks * 1024 + 512);
                const bf16x8 a = {lo[0], lo[1], lo[2], lo[3], h4[0], h4[1], h4[2], h4[3]};
                if (d0 == 0) o0 = MFMA32(a, pb, o0); else o1 = MFMA32(a, pb, o1); } }
}
template <int MODE> DI void mask_scale(f32x16& p0, f32x16& p1, bool rowok, int a, int hi) {
#pragma unroll
    for (int i = 0; i < 16; ++i) { const int k0 = crow(i, hi), k1 = k0 + 32;
        bool v0 = rowok, v1 = rowok;
        if (MODE == 1) { v0 = v0 && (k0 <= a); v1 = v1 && (k1 <= a); }
        if (MODE == 2) { v0 = v0 && (k0 > a); v1 = v1 && (k1 > a); }
        p0[i] = v0 ? p0[i] : -INFINITY; p1[i] = v1 ? p1[i] : -INFINITY; }
}
template <int MODE> DI void attn_tile(const LAS unsigned char* Kt, const LAS unsigned char* Vt, const bf16x8 (&qr)[4], AttnAcc& A, bool rowok, int a, int lane) {
    f32x16 p0, p1; qk_tile(Kt, qr, p0, p1, lane, rowok ? -A.m : -INFINITY);
    const int hi = lane >> 5;
    if (MODE != 0) {
#pragma unroll
        for (int i = 0; i < 16; ++i) { const int k0 = crow(i, hi), k1 = k0 + 32; const bool v0 = MODE == 1 ? (k0 <= a) : (k0 > a), v1 = MODE == 1 ? (k1 <= a) : (k1 > a);
            p0[i] = v0 ? p0[i] : -INFINITY; p1[i] = v1 ? p1[i] : -INFINITY; } }
    float mx = max3f(p0[0], p0[1], p1[0]); mx = max3f(mx, p1[1], p0[2]);
#pragma unroll
    for (int i = 2; i < 16; i += 2) mx = max3f(mx, max3f(p0[i], p0[i + 1], p1[i]), p1[i + 1]);
    mx = half_max(mx);
    if (__any(mx > 8.0f)) {
        const float dl = mx > 8.0f ? mx : 0.f, alpha = __builtin_amdgcn_exp2f(-dl);
        A.m += dl; A.l *= alpha;
#pragma unroll
        for (int i = 0; i < 16; ++i) { A.o0[i] *= alpha; A.o1[i] *= alpha; p0[i] -= dl; p1[i] -= dl; } }
    float ls = 0.f;
#pragma unroll
    for (int i = 0; i < 16; ++i) { p0[i] = __builtin_amdgcn_exp2f(p0[i]); p1[i] = __builtin_amdgcn_exp2f(p1[i]); ls += p0[i] + p1[i]; }
    A.l += ls;
    pv_tile(Vt, p0, p1, A.o0, A.o1, lane);
}
DI void mask_rt(f32x16& p0, f32x16& p1, int mode, int a, int hi) {
    if (mode != 0) {
#pragma unroll
        for (int i = 0; i < 16; ++i) { const int k0 = crow(i, hi), k1 = k0 + 32; const bool v0 = mode == 1 ? (k0 <= a) : (k0 > a), v1 = mode == 1 ? (k1 <= a) : (k1 > a);
            p0[i] = v0 ? p0[i] : -INFINITY; p1[i] = v1 ? p1[i] : -INFINITY; } }
}
DI void attn_tile2(const LAS unsigned char* Ka, const LAS unsigned char* Va, const LAS unsigned char* Kb, const LAS unsigned char* Vb, const bf16x8 (&qr)[4], AttnAcc& A,
                   bool ok_a, int mode_a, int a_a, bool ok_b, int mode_b, int a_b, int lane) {
    f32x16 p0, p1, p2, p3; qk_tile(Ka, qr, p0, p1, lane, ok_a ? -A.m : -INFINITY); qk_tile(Kb, qr, p2, p3, lane, ok_b ? -A.m : -INFINITY);
    const int hi = lane >> 5;
    mask_rt(p0, p1, mode_a, a_a, hi); mask_rt(p2, p3, mode_b, a_b, hi);
    float mx = max3f(p0[0], p1[0], p2[0]); mx = fmaxf(mx, p3[0]);
#pragma unroll
    for (int i = 1; i < 16; ++i) mx = max3f(mx, max3f(p0[i], p1[i], p2[i]), p3[i]);
    mx = half_max(mx);
    if (__any(mx > 8.0f)) {
        const float dl = mx > 8.0f ? mx : 0.f, alpha = __builtin_amdgcn_exp2f(-dl);
        A.m += dl; A.l *= alpha;
#pragma unroll
        for (int i = 0; i < 16; ++i) { A.o0[i] *= alpha; A.o1[i] *= alpha; p0[i] -= dl; p1[i] -= dl; p2[i] -= dl; p3[i] -= dl; } }
    float ls = 0.f;
#pragma unroll
    for (int i = 0; i < 16; ++i) { p0[i] = __builtin_amdgcn_exp2f(p0[i]); p1[i] = __builtin_amdgcn_exp2f(p1[i]); p2[i] = __builtin_amdgcn_exp2f(p2[i]); p3[i] = __builtin_amdgcn_exp2f(p3[i]); ls += (p0[i] + p1[i]) + (p2[i] + p3[i]); }
    A.l += ls;
    pv_tile(Va, p0, p1, A.o0, A.o1, lane); pv_tile(Vb, p2, p3, A.o0, A.o1, lane);
}
struct TileRegs { v4u k, v; };
DI void tile_gload(TileRegs& R, const bf16* Kt, const bf16* Vt, int wave, int lane) {
    R.k = *(const v4u*)(Kt + (size_t)lane * 64 + wave * 8);
    R.v = *(const v4u*)(Vt + (size_t)(16 * (wave & 3) + (lane >> 2)) * 64 + 32 * (wave >> 2) + 8 * (lane & 3));
}
DI void tile_lstore(const TileRegs& R, LAS unsigned char* kb, LAS unsigned char* vb, int wave, int lane) {
    *(LAS v4u*)(kb + wave * 1024 + lane * 16) = R.k; *(LAS v4u*)(vb + wave * 1024 + lane * 16) = R.v; }
DI void branch_out(f32x16& out0, f32x16& out1, const AttnAcc& A, float gate) {
    const float lt = half_sum(A.l); const float sc = gate / fmaxf(lt, 1e-30f);
#pragma unroll
    for (int i = 0; i < 16; ++i) { out0[i] += A.o0[i] * sc; out1[i] += A.o1[i] * sc; }
}
template <bool FIRST> DI void branch_out_lds(LAS float* ob, const AttnAcc& A, float gate) {
    const float lt = half_sum(A.l); const float sc = gate / fmaxf(lt, 1e-30f);
#pragma unroll
    for (int i = 0; i < 16; ++i) { if (FIRST) { ob[i] = A.o0[i] * sc; ob[16 + i] = A.o1[i] * sc; } else { ob[i] += A.o0[i] * sc; ob[16 + i] += A.o1[i] * sc; } }
}
DI void store_ot(bf16* dst, const f32x16& o0, const f32x16& o1, int hi) {
#pragma unroll
    for (int gi = 0; gi < 4; ++gi) { *(v2u*)(dst + 8 * gi + 4 * hi) = (v2u){pk2(o0[4 * gi], o0[4 * gi + 1]), pk2(o0[4 * gi + 2], o0[4 * gi + 3])};
        *(v2u*)(dst + 32 + 8 * gi + 4 * hi) = (v2u){pk2(o1[4 * gi], o1[4 * gi + 1]), pk2(o1[4 * gi + 2], o1[4 * gi + 3])}; }
}
constexpr size_t WS_BIASC = WS_END1;
constexpr size_t WS_KCP = al(WS_BIASC + 2 * 64 * 4);
constexpr size_t WS_KCS = al(WS_KCP + (size_t)2 * 8 * 256 * 64 * 2);
constexpr size_t WS_END2 = al(WS_KCS + (size_t)2 * 64 * 512 * 64 * 2);

DI void p0_cmp_bias(const Params& P, const Frame& F) {
    const float* pe = INF(26); const float* w1 = INF(25); float* B = (float*)(P.ws + WS_BIASC);
    for (int it = F.gw; it < 128; it += F.ngw) { const int kind = it >> 6, e = it & 63; float s = 0.f;
        for (int i = 0; i < 32; ++i) { const int idx = F.lane + 64 * i; s += pe[kind * 2048 + idx] * w1[((size_t)kind * 2048 + idx) * 64 + e]; }
        s = wave_sum(s); if (F.lane == 0) B[it] = s; }
}
DI float gelu_tanh(float x) { const float u = 0.7978845608028654f * (x + 0.044715f * x * x * x); const float t = 1.0f - 2.0f / (__expf(2.0f * u) + 1.0f); return 0.5f * x * (1.0f + t); }
DI void cmp_stage2(const Params& P, const Frame& F) {
    unsigned char* ws = P.ws; LAS bf16* w2t = (LAS bf16*)F.lds;
    for (int i = F.tid; i < 2 * 64 * 64; i += 512) { const int kind = i >> 12, e = (i >> 6) & 63, f = i & 63; w2t[(kind * 64 + f) * 64 + e] = (bf16)(pk2(INF(27)[i], 0.f) & 0xffffu); }
    __syncthreads();
    const float* bias = (const float*)(ws + WS_BIASC); const float* HCP = (const float*)(ws + WS_HCP); const float* HCS = (const float*)(ws + WS_HCS);
    bf16* KCP = (bf16*)(ws + WS_KCP); bf16* KCS = (bf16*)(ws + WS_KCS); int lane_ = F.lane; asm volatile("" : "+v"(lane_)); const int lane = lane_, r32 = lane & 31, hi = lane >> 5;
    for (int tile = F.gw; tile < (4096 + 65536) / 32; tile += F.ngw) {
        const bool samp = tile >= 128; const int r0 = (samp ? tile - 128 : tile) * 32; const int half = samp ? 32768 : 2048, nn = samp ? 512 : 256;
        const int kind = r0 >= half ? 1 : 0, r = r0 + r32, n = r & (nn - 1); const float* HC = samp ? HCS : HCP; bf16* dst = (samp ? KCS : KCP) + (size_t)r0 * 64;
        const bool zrow = (n == nn - 1); const float* pa = HC + (size_t)r * 128 + 8 * hi; const float* pb = HC + (size_t)(zrow ? r : r + 1) * 128 + 64 + 8 * hi; const float* bp = bias + kind * 64 + 8 * hi;
        bf16x8 af[4];
#pragma unroll
        for (int ks = 0; ks < 4; ++ks) { if (ks == 2) asm volatile("" ::: "memory"); float x[8], y[8], z[8]; ld_f8(pa + 16 * ks, x); ld_f8(pb + 16 * ks, y); ld_f8(bp + 16 * ks, z);
#pragma unroll
            for (int j = 0; j < 8; ++j) x[j] = gelu_tanh(x[j] + y[j] + z[j]);
            af[ks] = __builtin_bit_cast(bf16x8, (v4u){pk2(x[0], x[1]), pk2(x[2], x[3]), pk2(x[4], x[5]), pk2(x[6], x[7])}); }
#pragma unroll
        for (int cb = 0; cb < 2; ++cb) { f32x16 acc;
#pragma unroll
            for (int i = 0; i < 16; ++i) acc[i] = 0.f;
#pragma unroll
            for (int ks = 0; ks < 4; ++ks) acc = MFMA32(af[ks], *(const LAS bf16x8*)(w2t + (kind * 64 + 32 * cb + r32) * 64 + 16 * ks + 8 * hi), acc);
#pragma unroll
            for (int i = 0; i < 16; ++i) { const int rw = crow(i, hi); const bool zr = ((r0 + rw) & (nn - 1)) == nn - 1; dst[(size_t)rw * 64 + 32 * cb + r32] = zr ? (bf16)0 : (bf16)(pk2(acc[i], 0.f) & 0xffffu); } }
    }
}
struct TileRegs2 { TileRegs a, b; };
DI void kv_prefetch(TileRegs2& R, int jb, int je, const bf16* KB, const bf16* VB, int wave, int lane) {
    tile_gload(R.a, KB + (size_t)jb * 4096, VB + (size_t)jb * 4096, wave, lane);
    if (jb + 1 <= je) tile_gload(R.b, KB + (size_t)(jb + 1) * 4096, VB + (size_t)(jb + 1) * 4096, wave, lane);
}
template <class Body> DI void kv_loop(TileRegs2& R, int& cur, LAS unsigned char* kvb, int jb, int je, const bf16* KB, const bf16* VB, int wave, int lane, Body&& body, bool pre = false) {
    if (!pre) kv_prefetch(R, jb, je, KB, VB, wave, lane);
    tile_lstore(R.a, kvb + (2 * cur) * 16384, kvb + (2 * cur) * 16384 + 8192, wave, lane);
    if (jb + 1 <= je) tile_lstore(R.b, kvb + (2 * cur + 1) * 16384, kvb + (2 * cur + 1) * 16384 + 8192, wave, lane);
    __syncthreads();
    for (int j = jb; j <= je; j += 2) {
        const bool n0 = j + 2 <= je, n1 = j + 3 <= je;
        if (n0) tile_gload(R.a, KB + (size_t)(j + 2) * 4096, VB + (size_t)(j + 2) * 4096, wave, lane);
        if (n1) tile_gload(R.b, KB + (size_t)(j + 3) * 4096, VB + (size_t)(j + 3) * 4096, wave, lane);
        { const LAS unsigned char* Kt_ = kvb + (2 * cur) * 16384; body(j, Kt_, Kt_ + 8192); }
        if (j + 1 <= je) { const LAS unsigned char* Kt_ = kvb + (2 * cur + 1) * 16384; body(j + 1, Kt_, Kt_ + 8192); }
        if (n0) tile_lstore(R.a, kvb + (2 * (cur ^ 1)) * 16384, kvb + (2 * (cur ^ 1)) * 16384 + 8192, wave, lane);
        if (n1) tile_lstore(R.b, kvb + (2 * (cur ^ 1) + 1) * 16384, kvb + (2 * (cur ^ 1) + 1) * 16384 + 8192, wave, lane);
        __syncthreads(); cur ^= 1; }
}
template <class Body2> DI void kv_loop2(TileRegs2& R, int& cur, LAS unsigned char* kvb, int jb, int je, const bf16* KB, const bf16* VB, int wave, int lane, Body2&& body2, bool pre = false) {
    if (!pre) kv_prefetch(R, jb, je, KB, VB, wave, lane);
    tile_lstore(R.a, kvb + (2 * cur) * 16384, kvb + (2 * cur) * 16384 + 8192, wave, lane);
    if (jb + 1 <= je) tile_lstore(R.b, kvb + (2 * cur + 1) * 16384, kvb + (2 * cur + 1) * 16384 + 8192, wave, lane);
    __syncthreads();
    for (int j = jb; j <= je; j += 2) {
        const bool n0 = j + 2 <= je, n1 = j + 3 <= je;
        if (n0) tile_gload(R.a, KB + (size_t)(j + 2) * 4096, VB + (size_t)(j + 2) * 4096, wave, lane);
        if (n1) tile_gload(R.b, KB + (size_t)(j + 3) * 4096, VB + (size_t)(j + 3) * 4096, wave, lane);
        { const LAS unsigned char* Ka_ = kvb + (2 * cur) * 16384; body2(j, Ka_, Ka_ + 8192, Ka_ + 16384, Ka_ + 16384 + 8192, j + 1 <= je); }
        if (n0) tile_lstore(R.a, kvb + (2 * (cur ^ 1)) * 16384, kvb + (2 * (cur ^ 1)) * 16384 + 8192, wave, lane);
        if (n1) tile_lstore(R.b, kvb + (2 * (cur ^ 1) + 1) * 16384, kvb + (2 * (cur ^ 1) + 1) * 16384 + 8192, wave, lane);
        __syncthreads(); cur ^= 1; }
}
constexpr int NSA_KV_OFF = 0, NSA_SEL_OFF = 65536, NSA_OUT_OFF = NSA_SEL_OFF + 512, NSA_IMP_OFF = NSA_OUT_OFF;
DI void nsa_prompt_unit(const Params& P, const Frame& F, int b, int g, int qb) {
    unsigned char* ws = P.ws; int lane_ = F.lane; asm volatile("" : "+v"(lane_));
    const int lane = lane_, wave = F.wave, r32 = lane & 31, hi = lane >> 5;
    const int tl = 8 * wave + (r32 >> 2), hh = r32 & 3, t0 = 64 * qb, tok = t0 + tl, row = b * SEQ + tok, head = g * 4 + hh;
    LAS unsigned char* kvb = F.lds + NSA_KV_OFF;
    LAS float* impM = (LAS float*)(F.lds + NSA_IMP_OFF); LAS float* impS = impM + 64 * 65;
    LAS unsigned long long* selm = (LAS unsigned long long*)(F.lds + NSA_SEL_OFF);
    bf16x8 qr[4]; ld_q((const bf16*)(ws + WS_Q0) + (size_t)row * 512 + head * 64, qr, hi);
    const float* gt = (const float*)(ws + WS_GATES) + (size_t)row * 32 + head * 3; const float g0 = gt[0], g1 = gt[1], g2 = gt[2];
    const bf16* KV0 = (const bf16*)(ws + WS_KV0);
    LAS float* outb = (LAS float*)(F.lds + NSA_OUT_OFF) + (wave * 64 + lane) * 33;
    TileRegs2 R; int cur = 0;
    const int ncv = tok >= 31 ? ((tok - 15) >> 4) : 0, ntc = (4 * qb + 66) >> 6;
    const bf16* KC = (const bf16*)(ws + WS_KCP) + (size_t)((0 * 4 + b) * 2 + g) * 256 * 64; const bf16* VC = (const bf16*)(ws + WS_KCP) + (size_t)((1 * 4 + b) * 2 + g) * 256 * 64;
    AttnAcc A; acc_init(A);
    kv_loop(R, cur, kvb, 0, ntc - 1, KC, VC, wave, lane, [&](int j, const LAS unsigned char* Kt_, const LAS unsigned char* Vt_) { attn_tile<1>(Kt_, Vt_, qr, A, true, ncv - 1 - 64 * j, lane); });
    {
      const float lt = half_sum(A.l), rl = 1.0f / fmaxf(lt, 1e-30f), mfin = (A.m == -INFINITY) ? 0.f : A.m;
      for (int i = lane; i < 8 * 65; i += 64) { impM[wave * 8 * 65 + i] = 0.f; impS[wave * 8 * 65 + i] = 0.f; }
      for (int j = 0; j < ntc; ++j) { const LAS unsigned char* Kt_ = kvb + j * 16384;
          f32x16 p0, p1; qk_tile(Kt_, qr, p0, p1, lane); mask_scale<1>(p0, p1, true, ncv - 1 - 64 * j, hi);
#pragma unroll
          for (int cc = 0; cc < 2; ++cc)
#pragma unroll
              for (int gi = 0; gi < 4; ++gi) { const f32x16& p = cc ? p1 : p0;
                  const float e0 = __builtin_amdgcn_exp2f(p[4 * gi] - mfin) * rl, e1 = __builtin_amdgcn_exp2f(p[4 * gi + 1] - mfin) * rl, e2 = __builtin_amdgcn_exp2f(p[4 * gi + 2] - mfin) * rl, e3 = __builtin_amdgcn_exp2f(p[4 * gi + 3] - mfin) * rl;
                  float mn = e0 + e1 + e2 + 0.5f * e3, sp = 0.5f * e3;
                  mn += __builtin_bit_cast(float, __builtin_amdgcn_update_dpp(0, __builtin_bit_cast(int, mn), 0xB1, 0xf, 0xf, false)); mn += __builtin_bit_cast(float, __builtin_amdgcn_update_dpp(0, __builtin_bit_cast(int, mn), 0x4E, 0xf, 0xf, false));
                  sp += __builtin_bit_cast(float, __builtin_amdgcn_update_dpp(0, __builtin_bit_cast(int, sp), 0xB1, 0xf, 0xf, false)); sp += __builtin_bit_cast(float, __builtin_amdgcn_update_dpp(0, __builtin_bit_cast(int, sp), 0x4E, 0xf, 0xf, false));
                  const int jj = 16 * j + 8 * cc + 2 * gi + hi;
                  if (hh == 0) { impM[tl * 65 + jj] = mn; impS[tl * 65 + jj + 1] = sp; } } }
    }
    const bf16* KS = KV0 + (size_t)((2 * 4 + b) * 2 + g) * SEQ * 64; const bf16* VS = KV0 + (size_t)((3 * 4 + b) * 2 + g) * SEQ * 64;
    kv_prefetch(R, 0, qb, KS, VS, wave, lane);
    {
#pragma unroll 1
      for (int tt = 0; tt < 8; ++tt) { const int tq = 8 * wave + tt;
          float sc = -INFINITY;
          if (lane <= qb) { sc = impM[tq * 65 + lane] + impS[tq * 65 + lane]; if (lane == qb || lane == qb - 1 || lane == 0) sc += 100.0f; }
          int cnt = 0; int ln = lane; asm volatile("" : "+v"(ln));
          if (qb >= 16) {
              for (int jp0 = 0; jp0 <= qb; jp0 += 4) {
#pragma unroll
                  for (int k = 0; k < 4; ++k) { const int jp = jp0 + k; const float o = __builtin_bit_cast(float, __builtin_amdgcn_readlane(__builtin_bit_cast(int, sc), jp)); cnt += (o > sc || (o == sc && jp < ln)) ? 1 : 0; } } }
          const unsigned long long m = __ballot(lane <= qb && cnt < 16);
          if (lane == 0) selm[tq] = m; }
    }
    __syncthreads();
    branch_out_lds<true>(outb, A, g0);
    const unsigned long long mysel = selm[tl];
    { acc_init(A);
      kv_loop2(R, cur, kvb, 0, qb, KS, VS, wave, lane, [&](int j, const LAS unsigned char* Ka_, const LAS unsigned char* Va_, const LAS unsigned char* Kb_, const LAS unsigned char* Vb_, bool has_b) {
          const bool oka = (mysel >> j) & 1ull, okb = (mysel >> (j + 1)) & 1ull;
          if (has_b) attn_tile2(Ka_, Va_, Kb_, Vb_, qr, A, oka, 0, 0, okb, (j + 1 == qb) ? 1 : 0, tl, lane);
          else attn_tile<1>(Ka_, Va_, qr, A, oka, tl, lane); }, true);
      branch_out_lds<false>(outb, A, g1); }
    { const bf16* KW = KV0 + (size_t)((4 * 4 + b) * 2 + g) * SEQ * 64; const bf16* VW = KV0 + (size_t)((5 * 4 + b) * 2 + g) * SEQ * 64;
      acc_init(A); const int jlo = qb >= 8 ? qb - 8 : 0;
      kv_loop2(R, cur, kvb, jlo, qb, KW, VW, wave, lane, [&](int j, const LAS unsigned char* Ka_, const LAS unsigned char* Va_, const LAS unsigned char* Kb_, const LAS unsigned char* Vb_, bool has_b) {
          const int ma = (j == qb) ? 1 : (j == qb - 8) ? 2 : 0, mb = (j + 1 == qb) ? 1 : (j + 1 == qb - 8) ? 2 : 0;
          if (has_b) attn_tile2(Ka_, Va_, Kb_, Vb_, qr, A, true, ma, tl, true, mb, tl, lane);
          else if (ma == 1) attn_tile<1>(Ka_, Va_, qr, A, true, tl, lane); else if (ma == 2) attn_tile<2>(Ka_, Va_, qr, A, true, tl, lane); else attn_tile<0>(Ka_, Va_, qr, A, true, 0, lane); });
      branch_out_lds<false>(outb, A, g2); }
    { f32x16 out0, out1;
#pragma unroll
      for (int i = 0; i < 16; ++i) { out0[i] = outb[i]; out1[i] = outb[16 + i]; }
      store_ot((bf16*)(ws + WS_ATT) + (size_t)row * 1024 + 512 + head * 64, out0, out1, hi); }
}
constexpr size_t WS_Q1 = WS_END2;
constexpr size_t WS_K1 = al(WS_Q1 + (size_t)MT * 1024 * 2);
constexpr size_t WS_V1 = al(WS_K1 + (size_t)16 * SEQ * 64 * 2);
constexpr size_t WS_K1S = al(WS_V1 + (size_t)16 * SEQ * 64 * 2);
constexpr size_t WS_V1S = al(WS_K1S + (size_t)NSQ * 4 * 4 * 64 * 2);
constexpr size_t WS_MEANH = al(WS_V1S + (size_t)NSQ * 4 * 4 * 64 * 2);
constexpr size_t WS_MEANL = al(WS_MEANH + (size_t)16 * 64 * 64 * 2);
constexpr size_t WS_SS = al(WS_MEANL + (size_t)16 * 64 * 64 * 2);
constexpr size_t WS_END3 = al(WS_SS + (size_t)4 * MT * 4);

template <bool BASE_F32> struct EpiResidN {
    static constexpr bool PERM = false, AFTER_DRAIN = false;
    const void* base; bf16* Hb; float* ss;
    DI void operator()(const f32x4 (&acc)[2][2][4][2], const pg8::Unit& u, int wr, int wc, int fr, int fq) const {
#pragma unroll
        for (int ai = 0; ai < 2; ++ai)
#pragma unroll
            for (int m = 0; m < 4; ++m) { const int row = u.pm * 256 + ai * 128 + wr * 64 + m * 16 + fr; float sq = 0.f;
#pragma unroll
                for (int bj = 0; bj < 2; ++bj) { const int c = (u.pn * 4 + bj * 2 + (wc >> 1)) * 64 + 16 * (wc & 1) + 4 * fq; const size_t o = (size_t)row * D + c;
                    f32x4 b0, b1;
                    if (BASE_F32) { b0 = *(const f32x4*)((const float*)base + o); b1 = *(const f32x4*)((const float*)base + o + 32); }
                    else { b0 = ld_bf4((const bf16*)base + o); b1 = ld_bf4((const bf16*)base + o + 32); }
                    const f32x4 h0 = b0 + acc[ai][bj][m][0], h1 = b1 + acc[ai][bj][m][1];
                    st_bf16x4(Hb + o, h0); st_bf16x4(Hb + o + 32, h1);
                    sq += (h0.x * h0.x + h0.y * h0.y) + (h0.z * h0.z + h0.w * h0.w) + (h1.x * h1.x + h1.y * h1.y) + (h1.z * h1.z + h1.w * h1.w); }
                sq += __shfl_xor(sq, 16); sq += __shfl_xor(sq, 32);
                if (fq == 0) atomicAdd(ss + row, sq); }
    }
};
template <bool BASE_F32> struct EpiResidNS { const void* base1; bf16* Hb; float* ss;
    DI void operator()(int row, int head, int d4, f32x4 lo, f32x4 hi) const {
        const int c = head * 64 + d4; const size_t o = (size_t)row * D + c, ob = (size_t)(row - MP) * D + c; f32x4 b0, b1;
        if (BASE_F32) { b0 = *(const f32x4*)((const float*)base1 + ob); b1 = *(const f32x4*)((const float*)base1 + ob + 32); }
        else { b0 = ld_bf4((const bf16*)base1 + ob); b1 = ld_bf4((const bf16*)base1 + ob + 32); }
        const f32x4 h0 = b0 + lo, h1 = b1 + hi; st_bf16x4(Hb + o, h0); st_bf16x4(Hb + o + 32, h1);
        atomicAdd(ss + row, (h0.x * h0.x + h0.y * h0.y) + (h0.z * h0.z + h0.w * h0.w) + (h1.x * h1.x + h1.y * h1.y) + (h1.z * h1.z + h1.w * h1.w)); } };
template <class Fn> struct RowScaled { Fn f; const float* ss;
    DI void operator()(int row, int head, int d4, f32x4 lo, f32x4 hi) const { const float rs = __builtin_amdgcn_rsqf(ss[row] * (1.0f / 1024.0f) + 1e-6f); f(row, head, d4, lo * rs, hi * rs); } };
template <class Fn> struct EpiHeadScaled {
    static constexpr bool PERM = false, AFTER_DRAIN = false;
    Fn f; const float* ss;
    DI void operator()(const f32x4 (&acc)[2][2][4][2], const pg8::Unit& u, int wr, int wc, int fr, int fq) const {
        float rs[2][4];
#pragma unroll
        for (int ai = 0; ai < 2; ++ai)
#pragma unroll
            for (int m = 0; m < 4; ++m) rs[ai][m] = ss[u.pm * 256 + ai * 128 + wr * 64 + m * 16 + fr];
#pragma unroll
        for (int ai = 0; ai < 2; ++ai)
#pragma unroll
            for (int m = 0; m < 4; ++m) { const int row = u.pm * 256 + ai * 128 + wr * 64 + m * 16 + fr; const float r = __builtin_amdgcn_rsqf(rs[ai][m] * (1.0f / 1024.0f) + 1e-6f);
#pragma unroll
                for (int bj = 0; bj < 2; ++bj) f(row, u.pn * 4 + bj * 2 + (wc >> 1), 16 * (wc & 1) + 4 * fq, acc[ai][bj][m][0] * r, acc[ai][bj][m][1] * r); }
    }
};
struct EpiResid { const float* base0; const float* base1; float* H;
    DI void operator()(int row, int head, int d4, f32x4 lo, f32x4 hi) const {
        if (row >= MP + MS) return;
        const float* b = (row < MP ? base0 + (size_t)row * D : base1 + (size_t)(row - MP) * D) + head * 64 + d4; float* o = H + (size_t)row * D + head * 64 + d4;
        const f32x4 b0 = *(const f32x4*)b, b1 = *(const f32x4*)(b + 32); *(f32x4*)o = b0 + lo; *(f32x4*)(o + 32) = b1 + hi; } };
struct EpiSwiglu { bf16* HFF;
    DI void operator()(int row, int head, int d4, f32x4 lo, f32x4 hi) const {
        if (row >= MP + MS) return;
        f32x4 r; r.x = lo.x * sigmoidf_(lo.x) * hi.x; r.y = lo.y * sigmoidf_(lo.y) * hi.y; r.z = lo.z * sigmoidf_(lo.z) * hi.z; r.w = lo.w * sigmoidf_(lo.w) * hi.w;
        st_bf16x4(HFF + (size_t)row * FF + 32 * head + d4, r); } };
struct EpiIn1 { bf16* Q1; bf16* K1; bf16* K1S; const f32x2* rope; float* out;
    DI void operator()(int row, int head, int d4, f32x4 lo, f32x4 hi) const {
        if (row >= MP + MS) return;
        const bool samp = row >= MP; const int sr = row - MP; const int b = samp ? (sr >> 2) : (row >> 12), t = samp ? (sr & 3) : (row & 4095), ridx = samp ? 4096 + t : t;
        if (head < 20) { const f32x2* cs = rope + (size_t)ridx * 32 + d4; const f32x4 a = *(const f32x4*)cs, c2 = *(const f32x4*)(cs + 2);
            const f32x4 co = {a.x, a.z, c2.x, c2.z}, si = {a.y, a.w, c2.y, c2.w}; const f32x4 x1 = lo, x2 = hi; lo = x1 * co - x2 * si; hi = x2 * co + x1 * si; }
        if (head < 16) { bf16* p = Q1 + (size_t)row * 1024 + head * 64 + d4; st_bf16x4(p, lo * ATT_SC); st_bf16x4(p + 32, hi * ATT_SC); return; }
        const int kv = head >= 20 ? 1 : 0, kvh = (head - 16) & 3;
        bf16* p = samp ? K1S + (size_t)kv * ((WS_V1S - WS_K1S) / 2) + (((size_t)b * 4 + kvh) * 4 + t) * 64 + d4 : K1 + (size_t)kv * ((WS_V1 - WS_K1) / 2) + (((size_t)b * 4 + kvh) * SEQ + t) * 64 + d4;
        st_bf16x4(p, lo); st_bf16x4(p + 32, hi);
        float* o = out + (samp ? O_MOBS + (((size_t)sr * 2 + kv) * 4 + kvh) * 64 : O_MOBP + (((size_t)row * 2 + kv) * 4 + kvh) * 64) + d4; *(f32x4*)o = lo; *(f32x4*)(o + 32) = hi; } };
DI void final_norm(const Params& P, const Frame& F) {
    const bf16* H = (const bf16*)(P.ws + WS_H); const float* gain = INF(10); const float* ss = (const float*)(P.ws + WS_SS) + (size_t)3 * MT;
    for (int m = F.gw; m < MP + MS; m += F.ngw) { const bf16* xr = H + (size_t)m * D; float* o = P.out + (m < MP ? O_YP + (size_t)m * D : O_YS + (size_t)(m - MP) * D);
        const float rs = 1.0f / sqrtf(ss[m] * (1.0f / 1024.0f) + 1e-6f);
#pragma unroll
        for (int i = 0; i < 4; ++i) { const f32x4 v = ld_bf4(xr + 256 * i + 4 * F.lane), g = *(const f32x4*)(gain + 256 * i + 4 * F.lane); *(f32x4*)(o + 256 * i + 4 * F.lane) = v * rs * g; } }
}
DI void moba_means(const Params& P, const Frame& F) {
    unsigned char* ws = P.ws; const bf16* K1 = (const bf16*)(ws + WS_K1); bf16* MH = (bf16*)(ws + WS_MEANH); bf16* ML = (bf16*)(ws + WS_MEANL); const int lane = F.lane;
    for (int it = F.gw; it < 256; it += F.ngw) { const int bk = it >> 4, blk = it & 15; const bf16* src = K1 + ((size_t)bk * SEQ + blk * 256) * 64;
        float acc[8];
#pragma unroll
        for (int e = 0; e < 8; ++e) acc[e] = 0.f;
        for (int i = 0; i < 32; ++i) { float x[8]; ld_bf8(src + (size_t)(8 * i + (lane >> 3)) * 64 + (lane & 7) * 8, x);
#pragma unroll
            for (int e = 0; e < 8; ++e) acc[e] += x[e]; }
#pragma unroll
        for (int e = 0; e < 8; ++e) { acc[e] += __shfl_xor(acc[e], 8); acc[e] += __shfl_xor(acc[e], 16); acc[e] += __shfl_xor(acc[e], 32); acc[e] *= (1.0f / 256.0f); }
        if (lane < 8) { unsigned h[4], l[4];
#pragma unroll
            for (int e = 0; e < 4; ++e) { h[e] = pk2(acc[2 * e], acc[2 * e + 1]); l[e] = pk2(acc[2 * e] - bflo(h[e]), acc[2 * e + 1] - bfhi(h[e])); }
            *(v4u*)(MH + ((size_t)bk * 64 + blk) * 64 + lane * 8) = (v4u){h[0], h[1], h[2], h[3]}; *(v4u*)(ML + ((size_t)bk * 64 + blk) * 64 + lane * 8) = (v4u){l[0], l[1], l[2], l[3]}; }
    }
    for (int i = blockIdx.x * 512 + F.tid; i < 16 * 48 * 8; i += F.G * 512) { const int bk = i / (48 * 8), r = i % (48 * 8); const size_t o = ((size_t)bk * 64 + 16) * 64 + (size_t)r * 8;
        *(v4u*)(MH + o) = (v4u){0u, 0u, 0u, 0u}; *(v4u*)(ML + o) = (v4u){0u, 0u, 0u, 0u}; }
}
DI void moba_prompt_unit(const Params& P, const Frame& F, int b, int kvh, int qb) {
    unsigned char* ws = P.ws; int lane_ = F.lane; asm volatile("" : "+v"(lane_));
    const int lane = lane_, wave = F.wave, r32 = lane & 31, hi = lane >> 5;
    const int tl = 8 * wave + (r32 >> 2), hh = r32 & 3, row = b * SEQ + 64 * qb + tl, head = kvh * 4 + hh, cur = qb >> 2;
    LAS unsigned char* kvb = F.lds;
    bf16x8 qr[4]; ld_q((const bf16*)(ws + WS_Q1) + (size_t)row * 1024 + head * 64, qr, hi);
    TileRegs2 R; int cb = 0; unsigned rowmask = 1u << cur;
    const bf16* KB = (const bf16*)(ws + WS_K1) + (size_t)(b * 4 + kvh) * SEQ * 64; const bf16* VB = (const bf16*)(ws + WS_V1) + (size_t)(b * 4 + kvh) * SEQ * 64;
    kv_prefetch(R, 0, qb, KB, VB, wave, lane);
    if (cur > 0) {
        const bf16* MH = (const bf16*)(ws + WS_MEANH) + (size_t)(b * 4 + kvh) * 4096; const bf16* ML = (const bf16*)(ws + WS_MEANL) + (size_t)(b * 4 + kvh) * 4096;
        { const v4u k1 = *(const v4u*)(MH + (size_t)lane * 64 + wave * 8), k2 = *(const v4u*)(ML + (size_t)lane * 64 + wave * 8); *(LAS v4u*)(kvb + wave * 1024 + lane * 16) = k1; *(LAS v4u*)(kvb + 16384 + wave * 1024 + lane * 16) = k2; }
        __syncthreads();
        f32x16 p0, p1, q0, q1; qk_tile(kvb, qr, p0, p1, lane); qk_tile(kvb + 16384, qr, q0, q1, lane);
        float gs[16];
#pragma unroll
        for (int i = 0; i < 8; ++i) { const float v = p0[i] + q0[i]; auto rr = __builtin_amdgcn_permlane32_swap(__float_as_uint(v), __float_as_uint(v), false, false);
            gs[8 * (i >> 2) + (i & 3)] = __uint_as_float(rr[0]); gs[8 * (i >> 2) + 4 + (i & 3)] = __uint_as_float(rr[1]); }
        unsigned taken = 0;
#pragma unroll
        for (int pass = 0; pass < 3; ++pass) { float best = -INFINITY; int bi = -1;
#pragma unroll
            for (int n = 0; n < 16; ++n) { const bool c = (n < cur) && !((taken >> n) & 1u) && (gs[n] > best); best = c ? gs[n] : best; bi = c ? n : bi; }
            if (bi >= 0) taken |= 1u << bi; }
        rowmask |= taken;
        __syncthreads();
    }
    AttnAcc A; acc_init(A);
    kv_loop2(R, cb, kvb, 0, qb, KB, VB, wave, lane, [&](int j, const LAS unsigned char* Ka_, const LAS unsigned char* Va_, const LAS unsigned char* Kb_, const LAS unsigned char* Vb_, bool has_b) {
        const bool ok = (rowmask >> (j >> 2)) & 1u;
        if (has_b) attn_tile2(Ka_, Va_, Kb_, Vb_, qr, A, ok, 0, 0, ok, (j + 1 == qb) ? 1 : 0, tl, lane);
        else attn_tile<1>(Ka_, Va_, qr, A, ok, tl, lane); }, true);
    const float lt = half_sum(A.l), sc = 1.0f / fmaxf(lt, 1e-30f);
#pragma unroll
    for (int i = 0; i < 16; ++i) { A.o0[i] *= sc; A.o1[i] *= sc; }
    store_ot((bf16*)(ws + WS_ATT) + (size_t)row * 1024 + head * 64, A.o0, A.o1, hi);
}
constexpr int SM_MO = 0, SM_MM = 69632, SM_ML = 70656, SM_TAB = RING_BYTES + 1024;
DI void wave_fence() { asm volatile("s_waitcnt lgkmcnt(0)" ::: "memory"); __builtin_amdgcn_wave_barrier(); asm volatile("" ::: "memory"); }
DI void stage_row_f32(LAS unsigned char* kb, LAS unsigned char* vb, const float* kp, const float* vp, int lane) {
    { f32x4 x[16];
#pragma unroll
      for (int c = 0; c < 16; ++c) x[c] = kp ? *(const f32x4*)(kp + 4 * c) : (f32x4){0.f, 0.f, 0.f, 0.f};
#pragma unroll
      for (int c = 0; c < 8; ++c) *(LAS v4u*)(kb + c * 1024 + lane * 16) = (v4u){pk2(x[2 * c].x, x[2 * c].y), pk2(x[2 * c].z, x[2 * c].w), pk2(x[2 * c + 1].x, x[2 * c + 1].y), pk2(x[2 * c + 1].z, x[2 * c + 1].w)}; }
    asm volatile("" ::: "memory");
    { f32x4 x[16];
#pragma unroll
      for (int c = 0; c < 16; ++c) x[c] = vp ? *(const f32x4*)(vp + 4 * c) : (f32x4){0.f, 0.f, 0.f, 0.f};
#pragma unroll
      for (int c = 0; c < 8; ++c) *(LAS v4u*)(vb + (c >> 2) * 4096 + lane * 64 + (c & 3) * 16) = (v4u){pk2(x[2 * c].x, x[2 * c].y), pk2(x[2 * c].z, x[2 * c].w), pk2(x[2 * c + 1].x, x[2 * c + 1].y), pk2(x[2 * c + 1].z, x[2 * c + 1].w)}; }
}
DI void stage_row_bf16(LAS unsigned char* kb, LAS unsigned char* vb, const bf16* kp, const bf16* vp, int lane) {
#pragma unroll
    for (int c = 0; c < 8; ++c) { v4u ku = {0u, 0u, 0u, 0u}, vu = {0u, 0u, 0u, 0u};
        if (kp) ku = *(const v4u*)(kp + 8 * c);
        if (vp) vu = *(const v4u*)(vp + 8 * c);
        *(LAS v4u*)(kb + c * 1024 + lane * 16) = ku; *(LAS v4u*)(vb + (c >> 2) * 4096 + lane * 64 + (c & 3) * 16) = vu; }
}
DI void stage_tile_f32(LAS unsigned char* kb, LAS unsigned char* vb, const float* kp0, const float* vp0, size_t stride, int lane) {
    const int rsub = lane >> 4, piece = lane & 15;
#pragma unroll
    for (int hf = 0; hf < 2; ++hf) { f32x4 x[8]; asm volatile("" ::: "memory");
#pragma unroll
      for (int it = 0; it < 8; ++it) x[it] = *(const f32x4*)(kp0 + (size_t)(4 * (8 * hf + it) + rsub) * stride + 4 * piece);
#pragma unroll
      for (int it = 0; it < 8; ++it) *(LAS v2u*)(kb + (piece >> 1) * 1024 + (4 * (8 * hf + it) + rsub) * 16 + (piece & 1) * 8) = (v2u){pk2(x[it].x, x[it].y), pk2(x[it].z, x[it].w)}; }
#pragma unroll
    for (int hf = 0; hf < 2; ++hf) { f32x4 x[8]; asm volatile("" ::: "memory");
#pragma unroll
      for (int it = 0; it < 8; ++it) x[it] = *(const f32x4*)(vp0 + (size_t)(4 * (8 * hf + it) + rsub) * stride + 4 * piece);
#pragma unroll
      for (int it = 0; it < 8; ++it) *(LAS v2u*)(vb + (piece >> 3) * 4096 + (4 * (8 * hf + it) + rsub) * 64 + (piece & 7) * 8) = (v2u){pk2(x[it].x, x[it].y), pk2(x[it].z, x[it].w)}; }
}
DI void merge_waves(const Frame& F, AttnAcc& A, int lane, int wave) {
    LAS float* mo = (LAS float*)(F.lds + SM_MO); LAS float* mm = (LAS float*)(F.lds + SM_MM); LAS float* ml = (LAS float*)(F.lds + SM_ML);
    const float lt = half_sum(A.l);
    __syncthreads();
#pragma unroll
    for (int i = 0; i < 16; ++i) { mo[(wave * 64 + lane) * 33 + i] = A.o0[i]; mo[(wave * 64 + lane) * 33 + 16 + i] = A.o1[i]; }
    if (lane < 32) { mm[wave * 32 + lane] = A.m; ml[wave * 32 + lane] = lt; }
    __syncthreads();
    const int r32 = lane & 31; float M = -INFINITY;
#pragma unroll
    for (int w = 0; w < 8; ++w) M = fmaxf(M, mm[w * 32 + r32]);
    const float Mu = (M == -INFINITY) ? 0.f : M; float L = 0.f;
#pragma unroll
    for (int i = 0; i < 16; ++i) { A.o0[i] = 0.f; A.o1[i] = 0.f; }
#pragma unroll 1
    for (int w = 0; w < 8; ++w) { const float sc = __builtin_amdgcn_exp2f(mm[w * 32 + r32] - Mu); L += ml[w * 32 + r32] * sc;
#pragma unroll
        for (int i = 0; i < 16; ++i) { A.o0[i] += mo[(w * 64 + lane) * 33 + i] * sc; A.o1[i] += mo[(w * 64 + lane) * 33 + 16 + i] * sc; } }
    A.m = M; A.l = 0.5f * L;
    __syncthreads();
}
DI void nsa_sample_unit(const Params& P, const Frame& F, int bs, int g) {
    unsigned char* ws = P.ws; int lane_ = F.lane; asm volatile("" : "+v"(lane_));
    const int lane = lane_, wave = F.wave, r32 = lane & 31, hi = lane >> 5, ts = r32 >> 2, hh = r32 & 3, head = g * 4 + hh; const bool rowv = ts < 4;
    const int row = MP + bs * 4 + (ts & 3);
    LAS unsigned char* kb = F.lds + wave * 16384; LAS unsigned char* vb = kb + 8192;
    LAS float* impM = (LAS float*)(F.lds + SM_TAB); LAS float* impS = impM + 4 * 132; LAS unsigned long long* selS = (LAS unsigned long long*)(F.lds + SM_TAB + 2 * 4 * 132 * 4);
    const int* ptab = (const int*)P.in[7] + bs * NPG;
    bf16x8 qr[4]; ld_q((const bf16*)(ws + WS_Q0) + (size_t)row * 512 + head * 64, qr, hi);
    const float* gt = (const float*)(ws + WS_GATES) + (size_t)row * 32 + head * 3; const float g0 = gt[0], g1 = gt[1], g2 = gt[2];
    const bf16* KVS0 = (const bf16*)(ws + WS_KVS0);
    LAS float* outb = (LAS float*)(F.lds + SM_TAB + 4608) + lane * 33;
    const bf16* KC = (const bf16*)(ws + WS_KCS) + ((size_t)((0 * NSQ + bs) * 2 + g) * 512 + 64 * wave + lane) * 64;
    const bf16* VC = (const bf16*)(ws + WS_KCS) + ((size_t)((1 * NSQ + bs) * 2 + g) * 512 + 64 * wave + lane) * 64;
    { int tid_ = F.tid; asm volatile("" : "+v"(tid_)); for (int i = tid_; i < 2 * 4 * 132; i += 512) impM[i] = 0.f; }
    AttnAcc A; acc_init(A);
    stage_row_bf16(kb, vb, KC, VC, lane); wave_fence();
    attn_tile<1>(kb, vb, qr, A, rowv, 510 - 64 * wave, lane);
    merge_waves(F, A, lane, wave);
    if (wave == 0) branch_out_lds<true>(outb, A, g0);
    { const float lt = half_sum(A.l), rl = 1.0f / fmaxf(lt, 1e-30f), mfin = (A.m == -INFINITY) ? 0.f : A.m;
      stage_row_bf16(kb, vb, KC, nullptr, lane); wave_fence();
      f32x16 p0, p1; qk_tile(kb, qr, p0, p1, lane); mask_scale<1>(p0, p1, rowv, 510 - 64 * wave, hi);
#pragma unroll
      for (int cc = 0; cc < 2; ++cc)
#pragma unroll
          for (int gi = 0; gi < 4; ++gi) { const f32x16& p = cc ? p1 : p0;
              const float e0 = __builtin_amdgcn_exp2f(p[4 * gi] - mfin) * rl, e1 = __builtin_amdgcn_exp2f(p[4 * gi + 1] - mfin) * rl, e2 = __builtin_amdgcn_exp2f(p[4 * gi + 2] - mfin) * rl, e3 = __builtin_amdgcn_exp2f(p[4 * gi + 3] - mfin) * rl;
              float mn = e0 + e1 + e2 + 0.5f * e3, sp = 0.5f * e3;
              mn += __builtin_bit_cast(float, __builtin_amdgcn_update_dpp(0, __builtin_bit_cast(int, mn), 0xB1, 0xf, 0xf, false)); mn += __builtin_bit_cast(float, __builtin_amdgcn_update_dpp(0, __builtin_bit_cast(int, mn), 0x4E, 0xf, 0xf, false));
              sp += __builtin_bit_cast(float, __builtin_amdgcn_update_dpp(0, __builtin_bit_cast(int, sp), 0xB1, 0xf, 0xf, false)); sp += __builtin_bit_cast(float, __builtin_amdgcn_update_dpp(0, __builtin_bit_cast(int, sp), 0x4E, 0xf, 0xf, false));
              const int jj = 16 * wave + 8 * cc + 2 * gi + hi;
              if (hh == 0 && rowv) { impM[ts * 132 + jj] = mn; impS[ts * 132 + jj + 1] = sp; } } }
    __syncthreads();
    if (wave < 4) { const int tq = wave;
        float s0 = impM[tq * 132 + lane] + impS[tq * 132 + lane], s1 = impM[tq * 132 + 64 + lane] + impS[tq * 132 + 64 + lane];
        float s2 = (lane == 0) ? impM[tq * 132 + 128] + impS[tq * 132 + 128] + 100.0f : -INFINITY;
        if (lane == 0) s0 += 100.0f; if (lane == 63) s1 += 100.0f;
        int c0 = 0, c1 = 0, c2 = 0; int ln = lane; asm volatile("" : "+v"(ln));
#pragma unroll 8
        for (int jp = 0; jp < 64; ++jp) { const float o = __shfl(s0, jp); c0 += (o > s0 || (o == s0 && jp < ln)) ? 1 : 0; c1 += (o >= s1) ? 1 : 0; c2 += (o >= s2) ? 1 : 0; }
#pragma unroll 8
        for (int jp = 0; jp < 64; ++jp) { const float o = __shfl(s1, jp); c0 += (o > s0) ? 1 : 0; c1 += (o > s1 || (o == s1 && jp < ln)) ? 1 : 0; c2 += (o >= s2) ? 1 : 0; }
        { const float o = __shfl(s2, 0); c0 += (o > s0) ? 1 : 0; c1 += (o > s1) ? 1 : 0; }
        const unsigned long long m0 = __ballot(c0 < 16), m1 = __ballot(c1 < 16), m2 = __ballot(lane == 0 && c2 < 16);
        if (lane == 0) { selS[tq * 4 + 0] = m0; selS[tq * 4 + 1] = m1; selS[tq * 4 + 2] = m2; } }
    __syncthreads();
    const unsigned long long my0 = selS[(ts & 3) * 4 + 0], my1 = selS[(ts & 3) * 4 + 1], my2 = selS[(ts & 3) * 4 + 2];
    const unsigned long long u0v = selS[0] | selS[4] | selS[8] | selS[12], u1v = selS[1] | selS[5] | selS[9] | selS[13];
    const unsigned long long u0 = ((unsigned long long)(unsigned)__builtin_amdgcn_readfirstlane((int)(u0v >> 32)) << 32) | (unsigned)__builtin_amdgcn_readfirstlane((int)u0v);
    const unsigned long long u1 = ((unsigned long long)(unsigned)__builtin_amdgcn_readfirstlane((int)(u1v >> 32)) << 32) | (unsigned)__builtin_amdgcn_readfirstlane((int)u1v);
    { acc_init(A); const float* cache = INF(2); int k = 0;
      for (int j = 0; j < 129; ++j) { const bool inu = j < 64 ? ((u0 >> j) & 1ull) : j < 128 ? ((u1 >> (j - 64)) & 1ull) : true; if (!inu) continue;
          if ((k++ & 7) != wave) continue;
          const bool ok = rowv && (j < 64 ? ((my0 >> j) & 1ull) : j < 128 ? ((my1 >> (j - 64)) & 1ull) : (my2 & 1ull));
          if (j < 128) { const int page = ptab[j >> 1]; const float* base = cache + ((size_t)page * PAGE + (j & 1) * 64) * 512 + g * 64;
              stage_tile_f32(kb, vb, base + 256, base + 384, 512, lane); wave_fence(); attn_tile<0>(kb, vb, qr, A, ok, 0, lane); }
          else { const bf16* kn = lane < 4 ? KVS0 + ((((size_t)2 * NSQ + bs) * 2 + g) * 4 + lane) * 64 : nullptr; const bf16* vn = lane < 4 ? KVS0 + ((((size_t)3 * NSQ + bs) * 2 + g) * 4 + lane) * 64 : nullptr;
              stage_row_bf16(kb, vb, kn, vn, lane); wave_fence(); attn_tile<1>(kb, vb, qr, A, ok, ts, lane); }
          wave_fence(); }
      merge_waves(F, A, lane, wave); if (wave == 0) branch_out_lds<false>(outb, A, g1); }
    { acc_init(A); const float* wbuf = INF(4) + (size_t)bs * 512 * 256;
      for (int tile = wave; tile < 9; tile += 8) { const int idx = 64 * tile + lane;
          if (tile < 8) { const float* base = wbuf + (size_t)(64 * tile) * 256 + g * 64; stage_tile_f32(kb, vb, base, base + 128, 256, lane); }
          else { const bf16* kn = lane < 4 ? KVS0 + ((((size_t)4 * NSQ + bs) * 2 + g) * 4 + lane) * 64 : nullptr; const bf16* vn = lane < 4 ? KVS0 + ((((size_t)5 * NSQ + bs) * 2 + g) * 4 + lane) * 64 : nullptr;
              stage_row_bf16(kb, vb, kn, vn, lane); }
          wave_fence();
          if (tile == 0) attn_tile<2>(kb, vb, qr, A, rowv, ts, lane); else if (tile == 8) attn_tile<1>(kb, vb, qr, A, rowv, ts, lane); else attn_tile<0>(kb, vb, qr, A, rowv, 0, lane);
          wave_fence(); }
      merge_waves(F, A, lane, wave); if (wave == 0) branch_out_lds<false>(outb, A, g2); }
    if (wave == 0) { f32x16 out0, out1;
#pragma unroll
        for (int i = 0; i < 16; ++i) { out0[i] = outb[i]; out1[i] = outb[16 + i]; }
        if (rowv) store_ot((bf16*)(ws + WS_ATT) + (size_t)row * 1024 + 512 + head * 64, out0, out1, hi); }
}
DI void moba_sample_unit(const Params& P, const Frame& F, int bs, int kvh) {
    unsigned char* ws = P.ws; int lane_ = F.lane; asm volatile("" : "+v"(lane_));
    const int lane = lane_, wave = F.wave, r32 = lane & 31, hi = lane >> 5, ts = r32 >> 2, hh = r32 & 3, head = kvh * 4 + hh; const bool rowv = ts < 4;
    const int row = MP + bs * 4 + (ts & 3);
    LAS unsigned char* kb = F.lds + wave * 16384; LAS unsigned char* vb = kb + 8192;
    const int* ptab = (const int*)P.in[7] + bs * NPG;
    bf16x8 qr[4]; ld_q((const bf16*)(ws + WS_Q1) + (size_t)row * 1024 + head * 64, qr, hi);
    unsigned long long rowmask = 1ull << 32;
    { const float* mp = (const float*)(ws + WS_MEANS) + (((size_t)bs * 4 + kvh) * 32 + (lane & 31)) * 64;
#pragma unroll
      for (int c = 0; c < 8; ++c) { v4u hu = {0u, 0u, 0u, 0u}, lu = {0u, 0u, 0u, 0u};
          if (lane < 32) { const f32x4 a = *(const f32x4*)(mp + 8 * c), b2 = *(const f32x4*)(mp + 8 * c + 4);
              hu = (v4u){pk2(a.x, a.y), pk2(a.z, a.w), pk2(b2.x, b2.y), pk2(b2.z, b2.w)};
              lu = (v4u){pk2(a.x - bflo(hu.x), a.y - bfhi(hu.x)), pk2(a.z - bflo(hu.y), a.w - bfhi(hu.y)), pk2(b2.x - bflo(hu.z), b2.y - bfhi(hu.z)), pk2(b2.z - bflo(hu.w), b2.w - bfhi(hu.w))}; }
          *(LAS v4u*)(kb + c * 1024 + lane * 16) = hu; *(LAS v4u*)(vb + c * 1024 + lane * 16) = lu; }
      wave_fence();
      f32x16 p0, p1, q0, q1; qk_tile(kb, qr, p0, p1, lane); qk_tile(vb, qr, q0, q1, lane);
      float gs[32];
#pragma unroll
      for (int i = 0; i < 16; ++i) { const float v = p0[i] + q0[i]; auto rr = __builtin_amdgcn_permlane32_swap(__float_as_uint(v), __float_as_uint(v), false, false);
          gs[8 * (i >> 2) + (i & 3)] = __uint_as_float(rr[0]); gs[8 * (i >> 2) + 4 + (i & 3)] = __uint_as_float(rr[1]); }
      unsigned taken = 0;
#pragma unroll
      for (int pass = 0; pass < 3; ++pass) { float best = -INFINITY; int bi = -1;
#pragma unroll
          for (int n = 0; n < 32; ++n) { const bool c = !((taken >> n) & 1u) && (gs[n] > best); best = c ? gs[n] : best; bi = c ? n : bi; }
          if (bi >= 0) taken |= 1u << bi; }
      rowmask |= (unsigned long long)taken;
      wave_fence(); }
    unsigned umask = 0;
#pragma unroll
    for (int n = 0; n < 32; ++n) if (__ballot(rowv && ((rowmask >> n) & 1ull)) != 0ull) umask |= 1u << n;
    AttnAcc A; acc_init(A); const float* cache = INF(3); int k = 0;
    for (int blk = 0; blk < 32; ++blk) { if (!((umask >> blk) & 1u)) continue;
        const bool ok = rowv && ((rowmask >> blk) & 1ull);
        for (int q4 = 0; q4 < 4; ++q4) { if ((k++ & 7) != wave) continue;
            const int page = ptab[2 * blk + (q4 >> 1)]; const float* base = cache + ((size_t)page * PAGE + (q4 & 1) * 64) * 512 + kvh * 64;
            stage_tile_f32(kb, vb, base, base + 256, 512, lane); wave_fence(); attn_tile<0>(kb, vb, qr, A, ok, 0, lane); wave_fence(); } }
    if ((k & 7) == wave) { const bf16* kn = lane < 4 ? (const bf16*)(ws + WS_K1S) + (((size_t)bs * 4 + kvh) * 4 + lane) * 64 : nullptr; const bf16* vn = lane < 4 ? (const bf16*)(ws + WS_V1S) + (((size_t)bs * 4 + kvh) * 4 + lane) * 64 : nullptr;
        stage_row_bf16(kb, vb, kn, vn, lane); wave_fence(); attn_tile<1>(kb, vb, qr, A, rowv, ts, lane); wave_fence(); }
    merge_waves(F, A, lane, wave);
    const float lt = half_sum(A.l), sc = 1.0f / fmaxf(lt, 1e-30f);
#pragma unroll
    for (int i = 0; i < 16; ++i) { A.o0[i] *= sc; A.o1[i] *= sc; }
    if (wave == 0 && rowv) store_ot((bf16*)(ws + WS_ATT) + (size_t)row * 1024 + head * 64, A.o0, A.o1, hi);
}
constexpr int CKN = 4096;
constexpr size_t WS_CK_AT = WS_END3;
constexpr size_t WS_CK_BT = WS_CK_AT + (size_t)CKN * 4096, WS_CK_KT = WS_CK_BT + (size_t)CKN * 4096, WS_CK_RT = WS_CK_KT + (size_t)CKN * 4096;
constexpr size_t WS_CK_ATT = WS_CK_RT + (size_t)CKN * 4096;
constexpr size_t WS_CK_VT = WS_CK_ATT + (size_t)CKN * 4096;
constexpr size_t WS_CK_KH = WS_CK_VT + (size_t)CKN * 4096;
constexpr size_t WS_CK_PC = WS_CK_KH + (size_t)CKN * 8192;
constexpr size_t WS_CK_GT = WS_CK_PC + (size_t)CKN * 256;
constexpr size_t WS_CK_HT = WS_CK_GT + (size_t)CKN * 8192;
constexpr size_t WS_CK_QY = WS_CK_HT + (size_t)CKN * 16384;
constexpr size_t WS_CK_AY = WS_CK_QY + (size_t)CKN * 4096;
constexpr size_t WS_CK_S = WS_CK_AY + (size_t)CKN * 2048;
constexpr size_t WS_END4 = al(WS_CK_S + (size_t)CKN * 8192);
constexpr int CKL_N = 0, CKL_R1 = 4096, CKL_MKA = 8192, CKL_ZT = 10240, CKL_STRIDE = 17920, CKL_HKT = 0;

DI bf16x8 ldg8(const bf16* p) { return *(const bf16x8*)p; }
#if MK_DIAG
#define CKA_STAMP(k) do { if (cg == 0 && F.lane == 0) __hip_atomic_store((unsigned long long*)((unsigned*)(P.ws + WS_CTL) + 65536) + 1 + (k), __builtin_amdgcn_s_memrealtime(), __ATOMIC_RELAXED, __HIP_MEMORY_SCOPE_AGENT); } while (0)
#else
#define CKA_STAMP(k) do {} while (0)
#endif
DI void rwkv_chunk_a(const Params& P, const Frame& F, int cg) {
    unsigned char* ws = P.ws; int lane_ = F.lane; asm volatile("" : "+v"(lane_)); const int lane = lane_, r32 = lane & 31, hi = lane >> 5;
    const int bh = cg >> 7, c = cg & 127, b = bh >> 3, h = bh & 7; const size_t row0 = (size_t)b * SEQ + c * 32;
    const float* LW = (const float*)(ws + WS_W); const bf16* KK = (const bf16*)(ws + WS_KK); const bf16* KKA = (const bf16*)(ws + WS_KKA);
    const bf16* KP = (const bf16*)(ws + WS_KP); const bf16* RR = (const bf16*)(ws + WS_R); const bf16* VV = (const bf16*)(ws + WS_V);
    const int slot = (int)blockIdx.x * 8 + F.wave;
    bf16* AT = (bf16*)(ws + WS_CK_AT) + (size_t)slot * 2048; bf16* BT = (bf16*)(ws + WS_CK_BT) + (size_t)slot * 2048; bf16* KT = (bf16*)(ws + WS_CK_KT) + (size_t)slot * 2048; bf16* RT = (bf16*)(ws + WS_CK_RT) + (size_t)slot * 2048;
    bf16* ATT = (bf16*)(ws + WS_CK_ATT) + (size_t)slot * 2048; bf16* VT = (bf16*)(ws + WS_CK_VT) + (size_t)cg * 2048; float* KH = (float*)(ws + WS_CK_KH) + (size_t)slot * 2048;
    LAS unsigned char* wl = F.lds + F.wave * CKL_STRIDE;
    LAS float* Nl = (LAS float*)(wl + CKL_N); LAS float* R1 = (LAS float*)(wl + CKL_R1); LAS bf16* MKA = (LAS bf16*)(wl + CKL_MKA); LAS bf16* ZT = (LAS bf16*)(wl + CKL_ZT); LAS bf16* HKT = (LAS bf16*)(wl + CKL_HKT);
    float bh_[32];
    { unsigned atp[16], vtp[16]; float aprev = 0.f, vprev = 0.f, kt_[32]; float cum = 0.f;
      LAS unsigned char* stg = wl; const size_t gro = row0 * 512 + h * 64;
#pragma unroll
      for (int hf = 0; hf < 2; ++hf) {
          wave_fence();
          { v4u xb[5][2]; f32x4 xl[4];
#pragma unroll
            for (int q = 0; q < 4; ++q) { const int p = lane + 64 * q, tk = p >> 4, pc4 = p & 15; xl[q] = *(const f32x4*)(LW + gro + (size_t)(16 * hf + tk) * 512 + 4 * pc4); }
#pragma unroll
            for (int a = 0; a < 5; ++a)
#pragma unroll
                for (int q = 0; q < 2; ++q) { const int p = lane + 64 * q, tk = p >> 3, pc8 = p & 7; const bf16* sp = a == 0 ? KK : a == 1 ? KKA : a == 2 ? KP : a == 3 ? RR : VV; xb[a][q] = *(const v4u*)(sp + gro + (size_t)(16 * hf + tk) * 512 + 8 * pc8); }
#pragma unroll
            for (int q = 0; q < 4; ++q) *(LAS f32x4*)(stg + (lane + 64 * q) * 16) = xl[q];
#pragma unroll
            for (int a = 0; a < 5; ++a)
#pragma unroll
                for (int q = 0; q < 2; ++q) *(LAS v4u*)(stg + 4096 + a * 2048 + (lane + 64 * q) * 16) = xb[a][q]; }
          wave_fence();
#pragma unroll
          for (int tt = 0; tt < 16; ++tt) { const int t = 16 * hf + tt;
              const float lw = *(const LAS float*)(stg + (tt * 64 + lane) * 4);
              const float kk = bf2f(*(const LAS bf16*)(stg + 4096 + (tt * 64 + lane) * 2)), ka = bf2f(*(const LAS bf16*)(stg + 6144 + (tt * 64 + lane) * 2)), kp = bf2f(*(const LAS bf16*)(stg + 8192 + (tt * 64 + lane) * 2));
              const float r = bf2f(*(const LAS bf16*)(stg + 10240 + (tt * 64 + lane) * 2)), v = bf2f(*(const LAS bf16*)(stg + 12288 + (tt * 64 + lane) * 2));
              const float ep = __expf(cum); cum += lw; const float en = __expf(-cum), er = __expf(cum);
              const float at = -kk * ep;
              AT[t * 64 + lane] = (bf16)(pk2(at, 0.f) & 0xffffu); BT[t * 64 + lane] = (bf16)(pk2(ka * en, 0.f) & 0xffffu); KT[t * 64 + lane] = (bf16)(pk2(kp * en, 0.f) & 0xffffu); RT[t * 64 + lane] = (bf16)(pk2(r * er, 0.f) & 0xffffu);
              kt_[t] = kp * en; bh_[t] = ka * en;
              if (t & 1) { atp[t >> 1] = pk2(aprev, at); vtp[t >> 1] = pk2(vprev, v); } else { aprev = at; vprev = v; } } }
#pragma unroll
      for (int q = 0; q < 4; ++q) { *(v4u*)(ATT + lane * 32 + 8 * q) = (v4u){atp[4 * q], atp[4 * q + 1], atp[4 * q + 2], atp[4 * q + 3]}; *(v4u*)(VT + lane * 32 + 8 * q) = (v4u){vtp[4 * q], vtp[4 * q + 1], vtp[4 * q + 2], vtp[4 * q + 3]}; }
      const float pcv = __expf(cum);
#pragma unroll
      for (int t = 0; t < 32; ++t) { KH[t * 64 + lane] = kt_[t] * pcv; bh_[t] *= pcv; }
      ((float*)(ws + WS_CK_PC))[(size_t)slot * 64 + lane] = pcv; }
    wave_fence();
    CKA_STAMP(50);
    VM_WAIT();
    f32x16 mkrT;
    { f32x16 n_, mka_, mbr_;
#pragma unroll
      for (int i = 0; i < 16; ++i) { n_[i] = 0.f; mka_[i] = 0.f; mbr_[i] = 0.f; mkrT[i] = 0.f; }
#pragma unroll
      for (int ks = 0; ks < 4; ++ks) { const int fo = r32 * 64 + 16 * ks + 8 * hi; const bf16x8 fa = ldg8(AT + fo), fb = ldg8(BT + fo), fk = ldg8(KT + fo), fr = ldg8(RT + fo);
          n_ = MFMA32(fb, fa, n_); mka_ = MFMA32(fk, fa, mka_); mbr_ = MFMA32(fb, fr, mbr_); mkrT = MFMA32(fr, fk, mkrT); }
#pragma unroll
      for (int i = 0; i < 16; ++i) { const int rw = crow(i, hi);
          Nl[rw * 32 + r32] = (rw < r32) ? n_[i] : 0.f; R1[rw * 32 + r32] = (rw <= r32) ? mbr_[i] : 0.f;
          MKA[rw * 32 + r32] = (bf16)(pk2((rw < r32) ? mka_[i] : 0.f, 0.f) & 0xffffu); mkrT[i] = (r32 <= rw) ? mkrT[i] : 0.f; } }
    wave_fence();
    CKA_STAMP(51);
#define CK_SOLVE2(ZA, ZB) do { _Pragma("unroll") for (int s_ = 30; s_ >= 0; --s_) { const LAS float* np_ = Nl + s_ * 32; asm volatile("" : "+v"(np_), "+v"(ZA[s_ + 1]), "+v"(ZB[s_ + 1]));     \
            float acca_ = ZA[s_], accb_ = ZB[s_]; \
            _Pragma("unroll") for (int u4 = (s_ + 1) & ~3; u4 < 32; u4 += 4) { const f32x4 nv = *(const LAS f32x4*)(np_ + u4);     \
                acca_ += nv[0] * ZA[u4] + nv[1] * ZA[u4 + 1] + nv[2] * ZA[u4 + 2] + nv[3] * ZA[u4 + 3]; accb_ += nv[0] * ZB[u4] + nv[1] * ZB[u4 + 1] + nv[2] * ZB[u4 + 2] + nv[3] * ZB[u4 + 3]; } \
            ZA[s_] = acca_; ZB[s_] = accb_; } } while (0)
#define CK_ZSTORE(ZZ, zr) do { _Pragma("unroll") for (int q = 0; q < 4; ++q) *(LAS v4u*)((zr) + 8 * q) = (v4u){pk2(ZZ[8 * q], ZZ[8 * q + 1]), pk2(ZZ[8 * q + 2], ZZ[8 * q + 3]), pk2(ZZ[8 * q + 4], ZZ[8 * q + 5]), pk2(ZZ[8 * q + 6], ZZ[8 * q + 7])}; } while (0)
    { float z[32];
#pragma unroll
      for (int s = 0; s < 32; ++s) z[s] = R1[s * 32 + r32];
      CK_SOLVE2(bh_, z);
      CK_ZSTORE(bh_, ZT + (32 + lane) * 40);
      if (lane < 32) CK_ZSTORE(z, ZT + r32 * 40); }
#undef CK_SOLVE2
#undef CK_ZSTORE
    wave_fence();
    CKA_STAMP(52);
    bf16x8 za[3][2];
#pragma unroll
    for (int rb = 0; rb < 3; ++rb)
#pragma unroll
        for (int ks = 0; ks < 2; ++ks) za[rb][ks] = *(const LAS bf16x8*)(ZT + (32 * rb + r32) * 40 + 16 * ks + 8 * hi);
    {
      bf16x8 mb[2];
#pragma unroll
      for (int ks = 0; ks < 2; ++ks) mb[ks] = *(const LAS bf16x8*)(MKA + r32 * 32 + 16 * ks + 8 * hi);
      f32x16 ay = mkrT; ay = MFMA32(za[0][0], mb[0], ay); ay = MFMA32(za[0][1], mb[1], ay);
      bf16* AY = (bf16*)(ws + WS_CK_AY) + (size_t)cg * 1024;
#pragma unroll
      for (int i = 0; i < 16; ++i) AY[4 * hi * 32 + r32 + ((i & 3) + 8 * (i >> 2)) * 32] = (bf16)(pk2(ay[i], 0.f) & 0xffffu);
      wave_fence();
#pragma unroll
      for (int jb = 0; jb < 2; ++jb) { int ro = r32; asm volatile("" : "+v"(ro) :: "memory"); f32x16 hk;
#pragma unroll
          for (int gi = 0; gi < 4; ++gi) { const f32x4 kh = *(const f32x4*)(KH + ro * 64 + 32 * jb + 8 * gi + 4 * hi); hk[4 * gi] = kh.x; hk[4 * gi + 1] = kh.y; hk[4 * gi + 2] = kh.z; hk[4 * gi + 3] = kh.w; }
          hk = MFMA32(za[1 + jb][0], mb[0], hk); hk = MFMA32(za[1 + jb][1], mb[1], hk);
#pragma unroll
          for (int i = 0; i < 16; ++i) HKT[(32 * jb + crow(i, hi)) * 40 + ro] = (bf16)(pk2(hk[i], 0.f) & 0xffffu); } }
    {
      bf16* QY = (bf16*)(ws + WS_CK_QY) + (size_t)cg * 2048; bf16* GT = (bf16*)(ws + WS_CK_GT) + (size_t)cg * 4096; const float* PC = (const float*)(ws + WS_CK_PC) + (size_t)slot * 64;
#pragma unroll
      for (int cb = 0; cb < 2; ++cb) { const int j = 32 * cb + r32; bf16x8 ab[2];
#pragma unroll
          for (int ks = 0; ks < 2; ++ks) ab[ks] = ldg8(ATT + j * 32 + 16 * ks + 8 * hi);
          const float pc = PC[j];
#pragma unroll
          for (int rb = 0; rb < 3; ++rb) { int jo = j; asm volatile("" : "+v"(jo) :: "memory"); f32x16 acc;
              const bf16* rtp = RT + 4 * hi * 64 + jo;
              bf16* dst = rb == 0 ? QY + 4 * hi * 64 + jo : GT + (((rb - 1) * 4 + (jo >> 4)) * 64 + 4 * hi + 32 * ((jo >> 2) & 1)) * 8 + (jo & 3) + 4 * ((jo >> 3) & 1);
#pragma unroll
              for (int i = 0; i < 16; ++i) { const int rw = crow(i, hi); acc[i] = rb == 0 ? bf2f(rtp[((i & 3) + 8 * (i >> 2)) * 64]) : ((32 * (rb - 1) + rw == jo) ? pc : 0.f); }
              acc = MFMA32(za[rb][0], ab[0], acc); acc = MFMA32(za[rb][1], ab[1], acc);
#pragma unroll
              for (int i = 0; i < 16; ++i) dst[((i & 3) + 8 * (i >> 2)) * (rb == 0 ? 64 : 8)] = (bf16)(pk2(acc[i], 0.f) & 0xffffu); } } }
    wave_fence();
    {
      bf16* HT = (bf16*)(ws + WS_CK_HT) + (size_t)cg * 4096;
#pragma unroll
      for (int ib = 0; ib < 2; ++ib) { bf16x8 vb[2];
#pragma unroll
          for (int ks = 0; ks < 2; ++ks) vb[ks] = ldg8(VT + (32 * ib + r32) * 32 + 16 * ks + 8 * hi);
#pragma unroll
          for (int jb = 0; jb < 2; ++jb) { int ro = r32; asm volatile("" : "+v"(ro) :: "memory"); f32x16 acc;
#pragma unroll
              for (int i = 0; i < 16; ++i) acc[i] = 0.f;
#pragma unroll
              for (int ks = 0; ks < 2; ++ks) acc = MFMA32(*(const LAS bf16x8*)(HKT + (32 * jb + ro) * 40 + 16 * ks + 8 * hi), vb[ks], acc);
              bf16* dst = HT + ((ib * 64 + ro + 32 * hi) * 32 + 16 * jb);
              *(v4u*)dst = (v4u){pk2(acc[0], acc[1]), pk2(acc[2], acc[3]), pk2(acc[4], acc[5]), pk2(acc[6], acc[7])}; *(v4u*)(dst + 8) = (v4u){pk2(acc[8], acc[9]), pk2(acc[10], acc[11]), pk2(acc[12], acc[13]), pk2(acc[14], acc[15])}; } } }
    wave_fence();
    CKA_STAMP(53);
}
struct CkbSet { bf16x8 g[2][4]; v4u h[4]; };
DI void ckb_load(CkbSet& S, const bf16* GT, const bf16* HT, int c, int ih, int lane) {
    const bf16* g = GT + (size_t)c * 4096 + lane * 8; const bf16* h = HT + (size_t)c * 4096 + (ih * 64 + lane) * 32;
#pragma unroll
    for (int jb = 0; jb < 2; ++jb)
#pragma unroll
        for (int ks = 0; ks < 4; ++ks) S.g[jb][ks] = *(const bf16x8*)(g + (jb * 4 + ks) * 512);
#pragma unroll
    for (int q = 0; q < 4; ++q) S.h[q] = *(const v4u*)(h + 8 * q);
}
DI void ckb_step(const CkbSet& S, f32x16& X0, f32x16& X1, bf16* sdst, int hi) {
#pragma unroll
    for (int gi = 0; gi < 4; ++gi) { *(v2u*)(sdst + 8 * gi + 4 * hi) = (v2u){pk2(X0[4 * gi], X0[4 * gi + 1]), pk2(X0[4 * gi + 2], X0[4 * gi + 3])}; *(v2u*)(sdst + 32 + 8 * gi + 4 * hi) = (v2u){pk2(X1[4 * gi], X1[4 * gi + 1]), pk2(X1[4 * gi + 2], X1[4 * gi + 3])}; }
    const bf16x8 xb0 = pack8(X0, 0), xb1 = pack8(X0, 1), xb2 = pack8(X1, 0), xb3 = pack8(X1, 1);
    f32x16 n0, n1;
#pragma unroll
    for (int q = 0; q < 2; ++q) { const v4u a = S.h[q], b2 = S.h[2 + q];
        n0[8 * q] = bflo(a.x); n0[8 * q + 1] = bfhi(a.x); n0[8 * q + 2] = bflo(a.y); n0[8 * q + 3] = bfhi(a.y); n0[8 * q + 4] = bflo(a.z); n0[8 * q + 5] = bfhi(a.z); n0[8 * q + 6] = bflo(a.w); n0[8 * q + 7] = bfhi(a.w);
        n1[8 * q] = bflo(b2.x); n1[8 * q + 1] = bfhi(b2.x); n1[8 * q + 2] = bflo(b2.y); n1[8 * q + 3] = bfhi(b2.y); n1[8 * q + 4] = bflo(b2.z); n1[8 * q + 5] = bfhi(b2.z); n1[8 * q + 6] = bflo(b2.w); n1[8 * q + 7] = bfhi(b2.w); }
    n0 = MFMA32(S.g[0][0], xb0, n0); n0 = MFMA32(S.g[0][1], xb1, n0); n0 = MFMA32(S.g[0][2], xb2, n0); n0 = MFMA32(S.g[0][3], xb3, n0);
    n1 = MFMA32(S.g[1][0], xb0, n1); n1 = MFMA32(S.g[1][1], xb1, n1); n1 = MFMA32(S.g[1][2], xb2, n1); n1 = MFMA32(S.g[1][3], xb3, n1);
    X0 = n0; X1 = n1;
}
DI void rwkv_chunk_b(const Params& P, int bh, int ih, int lane, volatile LAS int* prog) {
    unsigned char* ws = P.ws; const int r32 = lane & 31, hi = lane >> 5, icol = 32 * ih + r32;
    f32x16 X0, X1;
#pragma unroll
    for (int i = 0; i < 16; ++i) { X0[i] = 0.f; X1[i] = 0.f; }
    const bf16* GT = (const bf16*)(ws + WS_CK_GT) + (size_t)bh * 128 * 4096; const bf16* HT = (const bf16*)(ws + WS_CK_HT) + (size_t)bh * 128 * 4096; bf16* SS = (bf16*)(ws + WS_CK_S) + (size_t)bh * 128 * 4096 + icol * 64;
    CkbSet A, B, C;
    ckb_load(A, GT, HT, 0, ih, lane); ckb_load(B, GT, HT, 1, ih, lane); ckb_load(C, GT, HT, 2, ih, lane);
#define CKB_ROUND(c) do { \
        ckb_step(A, X0, X1, SS + (size_t)(c) * 4096, hi); __builtin_amdgcn_sched_barrier(0); ckb_load(A, GT, HT, (c) + 3 < 127 ? (c) + 3 : 127, ih, lane); __builtin_amdgcn_sched_barrier(0);     \
        ckb_step(B, X0, X1, SS + (size_t)((c) + 1) * 4096, hi); __builtin_amdgcn_sched_barrier(0); ckb_load(B, GT, HT, (c) + 4 < 127 ? (c) + 4 : 127, ih, lane); __builtin_amdgcn_sched_barrier(0); \
        ckb_step(C, X0, X1, SS + (size_t)((c) + 2) * 4096, hi); __builtin_amdgcn_sched_barrier(0); ckb_load(C, GT, HT, (c) + 5 < 127 ? (c) + 5 : 127, ih, lane); __builtin_amdgcn_sched_barrier(0); \
        *prog = (c) + 3;     } while (0)
    CKB_ROUND(0);
    for (int c = 3; c < 126; c += 3) CKB_ROUND(c);
#undef CKB_ROUND
    ckb_step(A, X0, X1, SS + (size_t)126 * 4096, hi); ckb_step(B, X0, X1, SS + (size_t)127 * 4096, hi);
    *prog = 128;
    float* so = P.out + O_WKVP + (size_t)bh * 4096 + icol * 64;
#pragma unroll
    for (int gi = 0; gi < 4; ++gi) { *(f32x4*)(so + 8 * gi + 4 * hi) = (f32x4){X0[4 * gi], X0[4 * gi + 1], X0[4 * gi + 2], X0[4 * gi + 3]}; *(f32x4*)(so + 32 + 8 * gi + 4 * hi) = (f32x4){X1[4 * gi], X1[4 * gi + 1], X1[4 * gi + 2], X1[4 * gi + 3]}; }
}
DI void rwkv_chunk_b_touch(const Params& P, int bh, int ih, int lane, volatile LAS int* prog) {
    const char* base = (const char*)(P.ws + ((lane & 32) ? WS_CK_HT : WS_CK_GT)) + (size_t)bh * 128 * 8192 + ih * 4096 + (lane & 31) * 128;
    int done = 3;
    for (;;) { const int cur = *prog; if (cur >= 128) break;
        const int tgt = cur + 16 < 128 ? cur + 16 : 128;
        for (; done < tgt; ++done) { unsigned d_; const char* p_ = base + (size_t)done * 8192; asm volatile("global_load_dword %0, %1, off" : "=v"(d_) : "v"(p_) : "memory"); }
        asm volatile("s_waitcnt vmcnt(0)" ::: "memory");
        __builtin_amdgcn_s_sleep(32); }
}
DI void rwkv_chunk_c(const Params& P, int cg, int lane, LAS float* ylds) {
    unsigned char* ws = P.ws; const int r32 = lane & 31, hi = lane >> 5; const int bh = cg >> 7, c = cg & 127, b = bh >> 3, h = bh & 7; const size_t row0 = (size_t)b * SEQ + c * 32;
    const bf16* QY = (const bf16*)(ws + WS_CK_QY) + (size_t)cg * 2048; const bf16* AY = (const bf16*)(ws + WS_CK_AY) + (size_t)cg * 1024; const bf16* SS = (const bf16*)(ws + WS_CK_S) + (size_t)cg * 4096; const bf16* VT = (const bf16*)(ws + WS_CK_VT) + (size_t)cg * 2048;
    bf16x8 qa[4], aa[2];
#pragma unroll
    for (int ks = 0; ks < 4; ++ks) qa[ks] = ldg8(QY + r32 * 64 + 16 * ks + 8 * hi);
#pragma unroll
    for (int ks = 0; ks < 2; ++ks) aa[ks] = ldg8(AY + r32 * 32 + 16 * ks + 8 * hi);
#pragma unroll
    for (int ib = 0; ib < 2; ++ib) { const int i = 32 * ib + r32; f32x16 acc;
#pragma unroll
        for (int q = 0; q < 16; ++q) acc[q] = 0.f;
#pragma unroll
        for (int ks = 0; ks < 4; ++ks) acc = MFMA32(qa[ks], ldg8(SS + i * 64 + 16 * ks + 8 * hi), acc);
#pragma unroll
        for (int ks = 0; ks < 2; ++ks) acc = MFMA32(aa[ks], ldg8(VT + i * 32 + 16 * ks + 8 * hi), acc);
#pragma unroll
        for (int q = 0; q < 16; ++q) ylds[crow(q, hi) * 512 + h * 64 + i] = acc[q]; }
}
DI int wq_next(unsigned* ctr, volatile LAS int* slot, int tid) {
    if (tid == 0) *slot = (int)__hip_atomic_fetch_add(ctr, 1u, __ATOMIC_RELAXED, __HIP_MEMORY_SCOPE_AGENT);
    __syncthreads(); const int u = *slot; __syncthreads(); return u;
}
DI void bg_drain_means(const Params& P, const Frame& F, unsigned* ctl, int limit) {
    volatile LAS int* wslot = (volatile LAS int*)(F.lds + LDS_BYTES - 128 + 64);
    for (int n = 0; n < limit; ++n) { const int u = wq_next(ctl + 8384, wslot, F.tid); if (u >= 1024) break; prep_means_unit(P, F, u); }
}
DI void bg_drain_w1(const Params& P, const Frame& F, unsigned* ctl) {
    volatile LAS int* wslot = (volatile LAS int*)(F.lds + LDS_BYTES - 128 + 64); constexpr int NW1 = (WI_L1 + 7) / 8;
    for (;;) { const int u = wq_next(ctl + 8448, wslot, F.tid); if (u >= NW1) break; const int i = u * 8 + F.wave; if (i < WI_L1) weight_item(P, (LAS float*)(F.lds + F.wave * 16384), wi_l1(i), F.lane); }
}
constexpr int N_PHASES = 21;
__global__ void __launch_bounds__(512, 2) mk_fwd(Params P) {
    extern __shared__ __attribute__((aligned(16))) unsigned char lds_raw[];
    Frame F;
    F.lds = (LAS unsigned char*)lds_raw;
    F.tid = threadIdx.x; F.lane = F.tid & 63; F.wave = __builtin_amdgcn_readfirstlane(F.tid >> 6);
    F.G = gridDim.x; F.gw = blockIdx.x * NWAVES + F.wave; F.ngw = F.G * NWAVES;
    volatile LAS unsigned* MISC = (volatile LAS unsigned*)(F.lds + MISC_OFF);
    for (int u = F.tid; u < (LDS_BYTES - RING_BYTES) / 4; u += 512) ((LAS unsigned*)(F.lds + RING_BYTES))[u] = 0u;
    __syncthreads();
    unsigned char* ws = P.ws;
    unsigned* ctl = (unsigned*)(ws + WS_CTL);
    XcdBarrier bar = xcd_barrier_post(ctl + 4096, MISC + 8);
    const int lo = P.ph_lo, hi = P.ph_hi;
#define IN(k) (lo <= (k) && (k) < hi)
#if MK_DIAG
    unsigned long long* tstamp = (unsigned long long*)(ctl + 65536);
    if (blockIdx.x == 0 && F.tid == 0) __hip_atomic_store(tstamp + 0, __builtin_amdgcn_s_memrealtime(), __ATOMIC_RELAXED, __HIP_MEMORY_SCOPE_AGENT);
#define STAMP(k) do { if (blockIdx.x == 0 && F.tid == 0) __hip_atomic_store(tstamp + 1 + (k), __builtin_amdgcn_s_memrealtime(), __ATOMIC_RELAXED, __HIP_MEMORY_SCOPE_AGENT); } while (0)
#define STAMPL(k) do { if (blockIdx.x == gridDim.x - 1 && F.tid == 0) __hip_atomic_store(tstamp + 1 + (k), __builtin_amdgcn_s_memrealtime(), __ATOMIC_RELAXED, __HIP_MEMORY_SCOPE_AGENT); } while (0)
#else
#define STAMP(k) do {} while (0)
#define STAMPL(k) do {} while (0)
#endif
#define SEAM(k) do { if (IN(k) && IN((k) + 1)) xcd_barrier(bar); STAMP(k); } while (0)

    if (IN(0)) {
        p0_rope(P, F);
        { LAS float* scr = (LAS float*)(F.lds + F.wave * 16384); for (int i = F.gw; i < WI_L0; i += F.ngw) weight_item(P, scr, wi_l0(i), F.lane); }
        __syncthreads();
        norm_phase(F, INF(0), INF(1), INF(8), (bf16*)(ws + WS_XN));
        for (int u = (int)blockIdx.x; u < 256; u += F.G) prep_conv_unit(P, F, u);
        p0_cmp_bias(P, F); p0_wincopy(P, F);
        for (int i = blockIdx.x * 512 + F.tid; i < 4 * MT; i += F.G * 512) ((float*)(ws + WS_SS))[i] = 0.f;
    }
    SEAM(0);
    if (IN(1)) {
        EpiIn0 e0{(bf16*)(ws + WS_RW), (bf16*)(ws + WS_Q0), (bf16*)(ws + WS_KV0), (bf16*)(ws + WS_KVS0), (const f32x2*)(ws + WS_ROPE), P.out};
        { pg8::Gemm g{(const bf16*)(ws + WS_XN), (const bf16*)(ws + WS_WIN0), MP, 3072, 1024}; pg8::StaticOrder S; S.init(MP, 3072, F.G, (int)blockIdx.x);
          EpiHead<EpiIn0> E{e0};
          pg8::gemm_phase<EpiHead<EpiIn0>, pg8::StaticOrder, PG8_ALIGN, PG8_SP2>(F.lds, g, S, E); }
        __syncthreads();
        for (int u = F.G - 1 - (int)blockIdx.x; u < 96 + 129; u += F.G) {
            if (u < 96) skinny_unit(F.lds, (const bf16*)(ws + WS_XN), (const bf16*)(ws + WS_WIN0), 1024, MP, 32 * u, e0, F.wave, F.lane);
            else skinny_unit(F.lds, (const bf16*)(ws + WS_XN), (const bf16*)(ws + WS_WG0), 1024, 128 * (u - 96), 0, EpiGates{(float*)(ws + WS_GATES), INF(24)}, F.wave, F.lane);
        }
    }
    SEAM(1);
    if (IN(2)) {
        { pg8::Gemm g{(const bf16*)(ws + WS_ACMPS), (const bf16*)(ws + WS_WCMP), 65536, 256, 1024}; pg8::StaticOrder S; S.init(65536, 256, F.G, (int)blockIdx.x);
          EpiHead<EpiCmp> E{EpiCmp{(float*)(ws + WS_HCS), 32768}};
          pg8::gemm_phase<EpiHead<EpiCmp>, pg8::StaticOrder, PG8_ALIGN, PG8_SP2>(F.lds, g, S, E); }
        __syncthreads();
        { pg8::Gemm g{(const bf16*)(ws + WS_KV0), (const bf16*)(ws + WS_WCMP), 4096, 256, 1024}; pg8::StaticOrder S; S.init(4096, 256, F.G, (int)blockIdx.x);
          EpiHead<EpiCmp> E{EpiCmp{(float*)(ws + WS_HCP), 2048}};
          pg8::gemm_phase<EpiHead<EpiCmp>, pg8::StaticOrder, PG8_ALIGN, PG8_SP2>(F.lds, g, S, E); }
        __syncthreads();
        rwkv_prep(P, F, F.G > 32 ? 16 : 0);
    }
    SEAM(2);
    if (IN(3)) {
        EpiLora el{INF(14), INF(16), INF(20), (const bf16*)(ws + WS_K), (const bf16*)(ws + WS_KK), (float*)(ws + WS_W), (bf16*)(ws + WS_KP), (bf16*)(ws + WS_KKA), (bf16*)(ws + WS_G)};
        { pg8::Gemm g{(const bf16*)(ws + WS_LA), (const bf16*)(ws + WS_WLORA), MP, 1536, 256}; pg8::StaticOrder S; S.init(MP, 1536, F.G, (int)blockIdx.x);
          EpiHead<EpiLora> E{el};
          pg8::gemm_phase<EpiHead<EpiLora>, pg8::StaticOrder, PG8_ALIGN, PG8_SP2>(F.lds, g, S, E); }
        __syncthreads();
        for (int u = F.G - 1 - (int)blockIdx.x; u < 48; u += F.G) skinny_unit(F.lds, (const bf16*)(ws + WS_LA), (const bf16*)(ws + WS_WLORA), 256, MP, 32 * u, el, F.wave, F.lane);
        cmp_stage2(P, F);
        __syncthreads();
        if ((int)blockIdx.x >= 128) bg_drain_means(P, F, ctl, 3);
    }
    SEAM(3);
    if (IN(4)) {
        for (int cg = (int)blockIdx.x * NWAVES + F.wave; cg < CKN; cg += F.G * NWAVES) rwkv_chunk_a(P, F, cg);
        __syncthreads();
        for (int wid = F.gw; wid < 2048; wid += F.ngw) scan_sample_wave(P, wid, F.lane);
    }
    SEAM(4);
    if (IN(5)) {
        unsigned* bdone = ctl + 8576;
        if ((int)blockIdx.x < 32) {
            volatile LAS int* prog = (volatile LAS int*)F.lds;
            { int t_ = F.tid; asm volatile("" : "+v"(t_)); if (t_ < 2) prog[t_] = 0; }
            __syncthreads();
            if (F.wave >= 2 && F.wave < 4) rwkv_chunk_b_touch(P, (int)blockIdx.x, F.wave - 2, F.lane, prog + (F.wave - 2));
            if (F.wave < 2) { rwkv_chunk_b(P, (int)blockIdx.x, F.wave, F.lane, prog + F.wave); __builtin_amdgcn_fence(__ATOMIC_RELEASE, "agent");
                              if (F.lane == 0) __hip_atomic_fetch_add(bdone, 1u, __ATOMIC_RELAXED, __HIP_MEMORY_SCOPE_AGENT); }
            __syncthreads(); STAMP(30); }
        volatile LAS int* wslot = (volatile LAS int*)(F.lds + LDS_BYTES - 128 + 64);
        int u;
        for (;;) { u = wq_next(ctl + 8192, wslot, F.tid); if (u >= 576) break;
            if (u >= 224 && u < 288) { const int v = u - 224; nsa_sample_unit(P, F, v >> 1, v & 1); }
            else { const int v = u < 224 ? u : u - 64; nsa_prompt_unit(P, F, (v & 7) >> 1, v & 1, 63 - (v >> 3)); } }
        if (u < 576 + 512) {
            if (F.tid == 0) { while (__hip_atomic_load(bdone, __ATOMIC_RELAXED, __HIP_MEMORY_SCOPE_AGENT) < 64u) __builtin_amdgcn_s_sleep(8); }
            __syncthreads(); __builtin_amdgcn_fence(__ATOMIC_ACQUIRE, "agent");
            for (; u < 576 + 512; u = wq_next(ctl + 8192, wslot, F.tid)) { const int v = u - 576, b = v >> 7, c = v & 127;
                rwkv_chunk_c(P, (b * 8 + F.wave) * 128 + c, F.lane, (LAS float*)F.lds);
                __syncthreads();
                rwkv_post_rows<2, true>(P, b * SEQ + c * 32 + F.wave, 8, F.lane, (const LAS float*)F.lds, F.wave); rwkv_post_rows<2, true>(P, b * SEQ + c * 32 + 16 + F.wave, 8, F.lane, (const LAS float*)F.lds, 16 + F.wave);
                __syncthreads(); } }
        for (int row = MP + F.gw; row < MP + MS; row += F.ngw) rwkv_post_rows<1, false>(P, row, 0, F.lane, (const LAS float*)F.lds, 0);
    }
    STAMP(5);
    SEAM(6);
#define GEMM_PHASE(EPI_T, epi, Aptr, Bptr, N_, K_, nskinny) do { \
        { pg8::Gemm g{(const bf16*)(Aptr), (const bf16*)(Bptr), MP, (N_), (K_)}; pg8::StaticOrder S; S.init(MP, (N_), F.G, (int)blockIdx.x); EpiHead<EPI_T> E{epi}; \
          pg8::gemm_phase<EpiHead<EPI_T>, pg8::StaticOrder, PG8_ALIGN, PG8_SP2>(F.lds, g, S, E); } \
        __syncthreads(); \
        for (int u = F.G - 1 - (int)blockIdx.x; u < 2 * (nskinny); u += F.G) skinny_unit(F.lds, (const bf16*)(Aptr), (const bf16*)(Bptr), (K_), MP, 32 * u, epi, F.wave, F.lane); } while (0)
    bf16* Hb = (bf16*)(ws + WS_H); float* SSb = (float*)(ws + WS_SS);
#define GEMM_PHASE_SC(EPI_T, epi, ssp, Aptr, Bptr, N_, K_, nskinny) do { \
        { pg8::Gemm g{(const bf16*)(Aptr), (const bf16*)(Bptr), MP, (N_), (K_)}; pg8::StaticOrder S; S.init(MP, (N_), F.G, (int)blockIdx.x); EpiHeadScaled<EPI_T> E{epi, (ssp)}; \
          pg8::gemm_phase<EpiHeadScaled<EPI_T>, pg8::StaticOrder, PG8_ALIGN, PG8_SP2>(F.lds, g, S, E); } \
        __syncthreads(); \
        { RowScaled<EPI_T> es{epi, (ssp)}; for (int u = F.G - 1 - (int)blockIdx.x; u < 2 * (nskinny); u += F.G) skinny_unit(F.lds, (const bf16*)(Aptr), (const bf16*)(Bptr), (K_), MP, 32 * u, es, F.wave, F.lane); } } while (0)
#define RESID_PHASE(F32, baseP, baseS, Aptr, Bptr, K_, ssk) do { \
        { pg8::Gemm g{(const bf16*)(Aptr), (const bf16*)(Bptr), MP, 1024, (K_)}; pg8::StaticOrder S; S.init(MP, 1024, F.G, (int)blockIdx.x); EpiResidN<F32> E{(const void*)(baseP), Hb, SSb + (size_t)(ssk) * MT}; \
          pg8::gemm_phase<EpiResidN<F32>, pg8::StaticOrder, PG8_ALIGN, PG8_SP2>(F.lds, g, S, E); } \
        __syncthreads(); \
        { EpiResidNS<F32> es{(const void*)(baseS), Hb, SSb + (size_t)(ssk) * MT}; \
          for (int u = F.G - 1 - (int)blockIdx.x; u < 32; u += F.G) skinny_unit(F.lds, (const bf16*)(Aptr), (const bf16*)(Bptr), (K_), MP, 32 * u, es, F.wave, F.lane); } } while (0)
    if (IN(8)) { RESID_PHASE(true, INF(0), INF(1), ws + WS_ATT, ws + WS_WOUT0, 1024, 0); }
    SEAM(8);
    if (IN(10)) { EpiSwiglu e{(bf16*)(ws + WS_HFF)}; GEMM_PHASE_SC(EpiSwiglu, e, SSb, Hb, ws + WS_WGU0, 5632, 1024, 88); __syncthreads(); bg_drain_w1(P, F, ctl); }
    SEAM(10);
    if (IN(11)) { RESID_PHASE(false, Hb, Hb + (size_t)MP * D, ws + WS_HFF, ws + WS_WDN0, FF, 1); }
    SEAM(11);
    if (IN(13)) { EpiIn1 e{(bf16*)(ws + WS_Q1), (bf16*)(ws + WS_K1), (bf16*)(ws + WS_K1S), (const f32x2*)(ws + WS_ROPE), P.out};
        GEMM_PHASE_SC(EpiIn1, e, SSb + (size_t)MT, Hb, ws + WS_WIN1, 1536, 1024, 24); __syncthreads(); if ((int)blockIdx.x >= 128) bg_drain_means(P, F, ctl, 4); }
    SEAM(13);
    if (IN(14)) { moba_means(P, F); __syncthreads(); bg_drain_means(P, F, ctl, 1 << 30); }
    SEAM(14);
    if (IN(15)) {
        volatile LAS int* wslot = (volatile LAS int*)(F.lds + LDS_BYTES - 128 + 64);
        for (;;) { const int u = wq_next(ctl + 8256, wslot, F.tid); if (u >= 1152) break;
            const bool samp = u < 512 && (u & 3) == 0; const int v = u < 512 ? (samp ? (u >> 2) : u - ((u + 3) >> 2)) : u - 128;
            if (samp) moba_sample_unit(P, F, v >> 2, v & 3);
            else moba_prompt_unit(P, F, (v & 15) >> 2, v & 3, 63 - (v >> 4)); }
    }
    SEAM(15);
    if (IN(16)) { RESID_PHASE(false, Hb, Hb + (size_t)MP * D, ws + WS_ATT, ws + WS_WOUT1, 1024, 2); }
    SEAM(16);
    if (IN(18)) { EpiSwiglu e{(bf16*)(ws + WS_HFF)}; GEMM_PHASE_SC(EpiSwiglu, e, SSb + (size_t)2 * MT, Hb, ws + WS_WGU1, 5632, 1024, 88); }
    SEAM(18);
    if (IN(19)) { RESID_PHASE(false, Hb, Hb + (size_t)MP * D, ws + WS_HFF, ws + WS_WDN1, FF, 3); }
    SEAM(19);
    if (IN(20)) { final_norm(P, F); }
#if MK_DIAG
    xcd_barrier(bar); STAMP(20);
    if (blockIdx.x == 0) { __syncthreads();
#define DIAG_OUT2(OFF, SLO, SHI) do { unsigned n_ = (unsigned)((__hip_atomic_load(tstamp + (SHI), __ATOMIC_RELAXED, __HIP_MEMORY_SCOPE_AGENT) - __hip_atomic_load(tstamp + (SLO), __ATOMIC_RELAXED, __HIP_MEMORY_SCOPE_AGENT) + ((MK_DIAG == 5 || MK_DIAG == 9) ? 100ull : 500ull)) / ((MK_DIAG == 5 || MK_DIAG == 9) ? 200ull : 1000ull)); \
            if (n_ > 7000u) n_ = 7000u; for (unsigned i_ = F.tid; i_ < n_; i_ += 512) ((unsigned*)P.out)[(OFF) + i_] = 0xAAAAAAAAu; } while (0)
#if MK_DIAG == 1
        DIAG_OUT2(O_YP, 0, 1); DIAG_OUT2(O_NSAP, 1, 2); DIAG_OUT2(O_MOBP, 3, 4);
#elif MK_DIAG == 2
        DIAG_OUT2(O_YP, 4, 5); DIAG_OUT2(O_NSAP, 5, 6); DIAG_OUT2(O_MOBP, 6, 7);
#elif MK_DIAG == 3
        DIAG_OUT2(O_YP, 7, 9); DIAG_OUT2(O_NSAP, 9, 11); DIAG_OUT2(O_MOBP, 11, 12);
#elif MK_DIAG == 4
        DIAG_OUT2(O_YP, 12, 14); DIAG_OUT2(O_NSAP, 14, 15); DIAG_OUT2(O_MOBP, 15, 16);
#elif MK_DIAG == 10
        DIAG_OUT2(O_YP, 2, 3); DIAG_OUT2(O_NSAP, 3, 4); DIAG_OUT2(O_MOBP, 4, 5);
#elif MK_DIAG == 11
        DIAG_OUT2(O_YP, 5, 31); DIAG_OUT2(O_NSAP, 5, 6); DIAG_OUT2(O_MOBP, 6, 7);
#elif MK_DIAG == 9
        DIAG_OUT2(O_YP, 4, 51); DIAG_OUT2(O_NSAP, 51, 53); DIAG_OUT2(O_MOBP, 53, 54);
#else
        DIAG_OUT2(O_YP, 16, 17); DIAG_OUT2(O_NSAP, 17, 19); DIAG_OUT2(O_MOBP, 19, 21);
#endif
#undef DIAG_OUT2
    }
#endif
#undef GEMM_PHASE
#undef GEMM_PHASE_SC
#undef RESID_PHASE
#undef IN
#undef SEAM
}

extern "C" void kernel_launch(void* const* d_in, const int* in_sizes, int n_in, void* d_out, int out_size, void* d_ws, size_t ws_size, hipStream_t stream) {
    static int grid = 0;
    if (grid == 0) {
        if (n_in != 33 || (size_t)out_size != O_END || ws_size < WS_END4) { fprintf(stderr, "kernel_launch: unexpected shapes n_in %d out %d ws %zu (need %zu)\n", n_in, out_size, ws_size, (size_t)WS_END4); grid = -1; return; }
        int dev = 0, cus = 0, per_cu = 0;
        if (hipGetDevice(&dev) != hipSuccess || hipDeviceGetAttribute(&cus, hipDeviceAttributeMultiprocessorCount, dev) != hipSuccess) { grid = -1; return; }
        if (hipFuncSetAttribute((const void*)mk_fwd, hipFuncAttributeMaxDynamicSharedMemorySize, LDS_BYTES) != hipSuccess) { fprintf(stderr, "kernel_launch: hipFuncSetAttribute failed\n"); grid = -1; return; }
        if (hipOccupancyMaxActiveBlocksPerMultiprocessor(&per_cu, (const void*)mk_fwd, 512, LDS_BYTES) != hipSuccess || per_cu < 1) fprintf(stderr, "kernel_launch: occupancy query says %d\n", per_cu);
        (void)hipGetLastError();
        grid = cus;
    }
    if (grid < 0) return;
    if (hipMemsetAsync((char*)d_ws + WS_CTL, 0, CTL_BYTES, stream) != hipSuccess) return;
    Params p{};
    for (int i = 0; i < 33; ++i) p.in[i] = d_in[i];
    p.out = (float*)d_out; p.ws = (unsigned char*)d_ws;
#ifndef MK_LAUNCH_PER_PHASE
#define MK_LAUNCH_PER_PHASE 0
#endif
#if MK_LAUNCH_PER_PHASE
    for (int k = 0; k < N_PHASES; ++k) { p.ph_lo = k; p.ph_hi = k + 1; hipLaunchKernelGGL(mk_fwd, dim3(grid), dim3(512), LDS_BYTES, stream, p); }
#else
    p.ph_lo = 0; p.ph_hi = N_PHASES; hipLaunchKernelGGL(mk_fwd, dim3(grid), dim3(512), LDS_BYTES, stream, p);
#endif
}
```
